# Optimizing an MI355X kernel written in HIP

```python
import math
import jax, jax.numpy as jnp
from jax import lax
import numpy as np

D_MODEL = 2048
BATCH = 4
SEQ = 4096
DEPTH = 2

HEAD_DIM = 128
FOX_HEADS = 12
FOX_W = FOX_HEADS * HEAD_DIM
MEM_HEADS = 4
MEM_W = MEM_HEADS * HEAD_DIM
MEM_LEN = 256
MIX_W = FOX_W + MEM_W
Q_BLOCK = 128
FOX_IN = 4 * FOX_W + FOX_HEADS + MEM_W

GLA_HEADS = 4
GLA_DV = FOX_W // GLA_HEADS
GLA_DK = GLA_DV // 2
GLA_KW = GLA_HEADS * GLA_DK
GLA_VW = GLA_HEADS * GLA_DV
GLA_RANK = 16
GLA_TAU = 16.0
GLA_CHUNK = 64
GLA_IN = 2 * GLA_KW + 2 * GLA_VW + GLA_RANK + MEM_W

N_GROUPS = 4
EXPERTS_PER_GROUP = 8
N_EXPERTS = N_GROUPS * EXPERTS_PER_GROUP
EXPERT_TOPK = 2
D_EXPERT = 1024
MOE_BLOCK = 128

N_FOX = (DEPTH + 1) // 2
N_GLA = DEPTH // 2
RMS_EPS = 1e-6

kernel_name = "fox_gla_hier_moe_memory_block"


def rmsnorm(x, g):
    xf = x.astype(jnp.float32)
    y = xf * lax.rsqrt(jnp.mean(xf * xf, axis=-1, keepdims=True) + RMS_EPS)
    return (y * g.astype(jnp.float32)).astype(x.dtype)


def split_cols(t, sizes):
    idx = [int(v) for v in np.cumsum(sizes)[:-1]]
    return jnp.split(t, idx, axis=-1)


def split_heads(t, n):
    b, s, w = t.shape
    return t.reshape(b, s, n, w // n).transpose(0, 2, 1, 3)


def merge_heads(t):
    b, h, s, d = t.shape
    return t.transpose(0, 2, 1, 3).reshape(b, s, h * d)


def memory_attention(q_mem, mem_k, mem_v, q_g, k_g):
    q = rmsnorm(split_heads(q_mem, MEM_HEADS), q_g)
    k = rmsnorm(split_heads(mem_k, MEM_HEADS), k_g)
    v = split_heads(mem_v, MEM_HEADS)
    s = jnp.einsum('bhsd,bhmd->bhsm', q, k).astype(jnp.float32) * (1.0 / math.sqrt(HEAD_DIM))
    p = jax.nn.softmax(s, axis=-1).astype(v.dtype)
    return merge_heads(jnp.einsum('bhsm,bhmd->bhsd', p, v))


def forgetting_attention(q, k, v, log_f):
    b, h, s, d = q.shape
    nb = s // Q_BLOCK
    c = jnp.cumsum(log_f, axis=-1)
    qb = q.reshape(b, h, nb, Q_BLOCK, d).transpose(2, 0, 1, 3, 4)
    cb = c.reshape(b, h, nb, Q_BLOCK).transpose(2, 0, 1, 3)
    key_pos = jnp.arange(s)
    scale = 1.0 / math.sqrt(d)

    def block(args):
        qi, ci, i = args
        sc = jnp.einsum('bhqd,bhkd->bhqk', qi, k).astype(jnp.float32) * scale
        sc = sc + ci[..., :, None] - c[:, :, None, :]
        qpos = i * Q_BLOCK + jnp.arange(Q_BLOCK)
        mask = key_pos[None, :] <= qpos[:, None]
        sc = jnp.where(mask, sc, -jnp.inf)
        p = jax.nn.softmax(sc, axis=-1).astype(v.dtype)
        return jnp.einsum('bhqk,bhkd->bhqd', p, v)

    o = lax.map(block, (qb, cb, jnp.arange(nb)))
    return o.transpose(1, 2, 0, 3, 4).reshape(b, h, s, d)


def gla_chunked(q, k, v, log_a):
    b, h, s, dk = q.shape
    dv = v.shape[-1]
    n = s // GLA_CHUNK
    f32 = jnp.float32

    def to_chunks(t):
        return t.reshape(b, h, n, GLA_CHUNK, t.shape[-1]).transpose(2, 0, 1, 3, 4).astype(f32)

    causal = jnp.tril(jnp.ones((GLA_CHUNK, GLA_CHUNK), dtype=bool))

    def step(state, xs):
        qc, kc, vc, gc = xs
        bc = jnp.cumsum(gc, axis=-2)
        b_last = bc[:, :, -1:, :]
        o_inter = jnp.einsum('bhcd,bhde->bhce', qc * jnp.exp(bc), state)
        diff = jnp.where(causal[None, None, :, :, None],
                         bc[:, :, :, None, :] - bc[:, :, None, :, :], -jnp.inf)
        att = jnp.einsum('bhid,bhjd,bhijd->bhij', qc, kc, jnp.exp(diff))
        o_intra = jnp.einsum('bhij,bhje->bhie', att, vc)
        k_dec = kc * jnp.exp(b_last - bc)
        state = jnp.exp(b_last)[:, :, 0, :, None] * state + jnp.einsum('bhcd,bhce->bhde', k_dec, vc)
        return state, o_inter + o_intra

    state0 = jnp.zeros((b, h, dk, dv), f32)
    _, o = lax.scan(step, state0, (to_chunks(q), to_chunks(k), to_chunks(v), to_chunks(log_a)))
    return o.transpose(1, 2, 0, 3, 4).reshape(b, h, s, dv).astype(v.dtype)


def fox_mixer(hn, w_in, b_f, q_g, k_g):
    proj = hn @ w_in
    q, k, v, og, f_logit, q_mem = split_cols(proj, [FOX_W, FOX_W, FOX_W, FOX_W, FOX_HEADS, MEM_W])
    q = rmsnorm(split_heads(q, FOX_HEADS), q_g)
    k = rmsnorm(split_heads(k, FOX_HEADS), k_g)
    v = split_heads(v, FOX_HEADS)
    log_f = jax.nn.log_sigmoid(f_logit.astype(jnp.float32) + b_f.astype(jnp.float32)).transpose(0, 2, 1)
    o = forgetting_attention(q, k, v, log_f)
    return merge_heads(o) * jax.nn.sigmoid(og), q_mem


def gla_mixer(hn, w_in, w_a2, b_a, o_g):
    proj = hn @ w_in
    q, k, v, r, a_lr, q_mem = split_cols(proj, [GLA_KW, GLA_KW, GLA_VW, GLA_VW, GLA_RANK, MEM_W])
    log_a = jax.nn.log_sigmoid((a_lr @ w_a2 + b_a).astype(jnp.float32)) / GLA_TAU
    q = split_heads(q, GLA_HEADS) * (1.0 / math.sqrt(GLA_DK))
    k = split_heads(k, GLA_HEADS)
    v = split_heads(v, GLA_HEADS)
    o = gla_chunked(q, k, v, split_heads(log_a, GLA_HEADS))
    o = rmsnorm(o, o_g)
    return merge_heads(o) * jax.nn.silu(r), q_mem


def hierarchical_moe(hn, w_grp, b_grp, w_exp, b_exp, w_gate, w_up, w_down):
    b, s, d = hn.shape
    t = b * s
    xt = hn.reshape(t, d)
    grp_prob = jax.nn.softmax((xt @ w_grp).astype(jnp.float32) + b_grp.astype(jnp.float32), axis=-1)
    g_p, g_idx = lax.top_k(grp_prob, 1)
    exp_logits = ((xt @ w_exp).astype(jnp.float32) + b_exp.astype(jnp.float32)).reshape(t, N_GROUPS, EXPERTS_PER_GROUP)
    in_grp = exp_logits[jnp.arange(t), g_idx[:, 0]]
    e_val, e_loc = lax.top_k(in_grp, EXPERT_TOPK)
    e_w = jax.nn.softmax(e_val, axis=-1) * g_p
    e_id = g_idx * EXPERTS_PER_GROUP + e_loc

    n = t * EXPERT_TOPK
    flat_e = e_id.reshape(n)
    flat_w = e_w.reshape(n)
    order = jnp.argsort(flat_e)
    sorted_e = flat_e[order]
    tok = (order // EXPERT_TOPK).astype(jnp.int32)
    counts = jnp.zeros((N_EXPERTS,), jnp.int32).at[flat_e].add(1)
    padded = (counts + MOE_BLOCK - 1) // MOE_BLOCK * MOE_BLOCK
    starts = jnp.cumsum(counts) - counts
    pad_ends = jnp.cumsum(padded)
    pad_starts = pad_ends - padded
    dest = pad_starts[sorted_e] + (jnp.arange(n) - starts[sorted_e])
    p_rows = ((n + MOE_BLOCK - 1) // MOE_BLOCK) * MOE_BLOCK + N_EXPERTS * MOE_BLOCK
    nb = p_rows // MOE_BLOCK
    row_tok = jnp.full((p_rows,), t, jnp.int32).at[dest].set(tok)
    row_w = jnp.zeros((p_rows,), jnp.float32).at[dest].set(flat_w[order])
    block_e = jnp.minimum(jnp.searchsorted(pad_ends, jnp.arange(nb) * MOE_BLOCK, side='right'), N_EXPERTS - 1)
    x_pad = jnp.concatenate([xt, jnp.zeros((1, d), xt.dtype)], axis=0)
    xb = x_pad[row_tok].reshape(nb, MOE_BLOCK, d)

    def expert_block(args):
        xi, e = args
        hid = jax.nn.silu(xi @ w_gate[e]) * (xi @ w_up[e])
        return hid @ w_down[e]

    yb = lax.map(expert_block, (xb, block_e)).reshape(p_rows, d)
    yb = yb * row_w[:, None].astype(yb.dtype)
    out = jnp.zeros((t + 1, d), yb.dtype).at[row_tok].add(yb)[:t]
    return out.reshape(b, s, d)


def setup_inputs(seed: int = 0) -> dict:
    key = jax.random.key(seed)
    ks = iter(jax.random.split(key, 32))
    f32 = jnp.float32

    def nrm(shape, scale):
        return jax.random.normal(next(ks), shape, f32) * scale

    def gain(shape):
        return 1.0 + 0.1 * jax.random.normal(next(ks), shape, f32)

    d = D_MODEL
    return {
        "x": nrm((BATCH, SEQ, d), 1.0),
        "mem": nrm((BATCH, MEM_LEN, d), 1.0),
        "mem_norm_g": gain((d,)),
        "w_mem_kv": nrm((d, 2 * MEM_W), d ** -0.5),
        "attn_norm_g": gain((DEPTH, d)),
        "fox_w_in": nrm((N_FOX, d, FOX_IN), d ** -0.5),
        "fox_b_f": 2.0 + 0.5 * jax.random.normal(next(ks), (N_FOX, FOX_HEADS), f32),
        "fox_q_g": gain((N_FOX, HEAD_DIM)),
        "fox_k_g": gain((N_FOX, HEAD_DIM)),
        "gla_w_in": nrm((N_GLA, d, GLA_IN), d ** -0.5),
        "gla_w_a2": nrm((N_GLA, GLA_RANK, GLA_KW), GLA_RANK ** -0.5),
        "gla_b_a": nrm((N_GLA, GLA_KW), 0.5),
        "gla_o_g": gain((N_GLA, GLA_DV)),
        "memq_g": gain((DEPTH, HEAD_DIM)),
        "memk_g": gain((DEPTH, HEAD_DIM)),
        "w_out": nrm((DEPTH, MIX_W, d), MIX_W ** -0.5),
        "ffn_norm_g": gain((DEPTH, d)),
        "w_grp": nrm((DEPTH, d, N_GROUPS), d ** -0.5),
        "b_grp": nrm((DEPTH, N_GROUPS), 0.01),
        "w_exp": nrm((DEPTH, d, N_EXPERTS), d ** -0.5),
        "b_exp": nrm((DEPTH, N_EXPERTS), 0.01),
        "w_gate": nrm((DEPTH, N_EXPERTS, d, D_EXPERT), d ** -0.5),
        "w_up": nrm((DEPTH, N_EXPERTS, d, D_EXPERT), d ** -0.5),
        "w_down": nrm((DEPTH, N_EXPERTS, D_EXPERT, d), D_EXPERT ** -0.5),
    }


def reference(x, mem, mem_norm_g, w_mem_kv, attn_norm_g, fox_w_in, fox_b_f, fox_q_g, fox_k_g,
              gla_w_in, gla_w_a2, gla_b_a, gla_o_g, memq_g, memk_g, w_out, ffn_norm_g,
              w_grp, b_grp, w_exp, b_exp, w_gate, w_up, w_down):
    mem_kv = rmsnorm(mem, mem_norm_g) @ w_mem_kv
    mem_k, mem_v = split_cols(mem_kv, [MEM_W, MEM_W])
    for i in range(DEPTH):
        hn = rmsnorm(x, attn_norm_g[i])
        j = i // 2
        if i % 2 == 0:
            mix, q_mem = fox_mixer(hn, fox_w_in[j], fox_b_f[j], fox_q_g[j], fox_k_g[j])
        else:
            mix, q_mem = gla_mixer(hn, gla_w_in[j], gla_w_a2[j], gla_b_a[j], gla_o_g[j])
        mo = memory_attention(q_mem, mem_k, mem_v, memq_g[i], memk_g[i])
        x = x + jnp.concatenate([mix, mo], axis=-1) @ w_out[i]
        x = x + hierarchical_moe(rmsnorm(x, ffn_norm_g[i]), w_grp[i], b_grp[i], w_exp[i], b_exp[i],
                                 w_gate[i], w_up[i], w_down[i])
    return x
```

```cpp
#include <hip/hip_runtime.h>
#include <cstdio>
#include <cstdint>
#ifndef MK_N_LAUNCHES
#define MK_N_LAUNCHES 1
#endif
namespace pg8 {
#define PG8_LAS __attribute__((address_space(3)))
typedef unsigned short bf16_t;
typedef short bf16x8 __attribute__((ext_vector_type(8)));
typedef float f32x4 __attribute__((ext_vector_type(4)));
typedef unsigned u32x4 __attribute__((ext_vector_type(4)));
constexpr int BM = 256, BK = 64, HALF = 128, HTB = HALF * BK * 2  , STAGE_BYTES = 8 * HTB, NXCD = 8, WGM = 8;

__host__ __device__ __forceinline__ int lds_byte(int r, int c) { const int st = (r >> 4) * 2 + (c >> 5), rr = r & 15, cc = c & 31, ob = rr * 64 + cc * 2; return st * 1024 + (ob ^ (((ob >> 9) & 1) << 5)); }
__host__ __device__ __forceinline__ void stage_rc(int b, int& R, int& C) { const int st = b / 1024, sb = b % 1024, swz = sb ^ (((sb >> 9) & 1) << 5); R = (st >> 1) * 16 + swz / 64; C = (st & 1) * 32 + (swz % 64) / 2; }
__host__ __device__ __forceinline__ int perm32(int rho) { const int n = rho >> 4, i = rho & 15; return 8 * (i >> 2) + 4 * n + (i & 3); }

struct Unit { int pm, pn; };
struct Gemm { const bf16_t* A; const bf16_t* Bt; int M, N, K; };

struct StaticOrder {
    int nM, nN, nwg, G, c;
    __host__ __device__ void init(int M, int N, int G_, int c_) { nM = M / BM; nN = N / BM; nwg = nM * nN; G = G_; c = c_; }
    __host__ __device__ bool next(int i, Unit& u) const {
        const long L = (long)i * G + c; if (L >= nwg) return false;
        int wgid = (int)L; { const int q = nwg / NXCD, r = nwg % NXCD, xcd = wgid % NXCD, off = wgid / NXCD; wgid = (xcd < r ? xcd * (q + 1) : r * (q + 1) + (xcd - r) * q) + off; }
        const int nig = WGM * nN, gid = wgid / nig, fm = gid * WGM, gsz = (nM - fm) < WGM ? (nM - fm) : WGM;
        u.pm = fm + ((wgid % nig) % gsz); u.pn = (wgid % nig) / gsz; return true;
    }
    __device__ __forceinline__ void a_ready(const Unit&) const {}
    __device__ __forceinline__ void done(const Unit&) const {}
};
template <class Epi, class Sched, bool ALIGN_EPI = false, bool SP2 = false>
__device__ __forceinline__ void gemm_phase(PG8_LAS unsigned char* lds, const Gemm g, const Sched& S, const Epi& E) {
    const int tid = threadIdx.x, wid = __builtin_amdgcn_readfirstlane(tid >> 6), lane = tid & 63, wr = wid >> 2, wc = wid & 3, fr = lane & 15, fq = lane >> 4;
    const int K = g.K, nt = K / BK;
    unsigned voffA[2], voffB[2];
#pragma unroll
    for (int i = 0; i < 2; ++i) { int R, C; stage_rc(tid * 16 + i * 8192, R, C); const int Rb = Epi::PERM ? ((R & ~31) + perm32(R & 31)) : R;
        voffA[i] = (unsigned)(R * K + C) * 2u; voffB[i] = (unsigned)(Rb * K + C) * 2u; }
    const size_t kstep = (size_t)(BK * 2);
    const size_t hstep = (size_t)HALF * K * 2;
    const size_t tstep = 2 * hstep;
    const unsigned ldsw = (unsigned)wid * 1024u;
    const int aoff = lds_byte(wr * 64 + fr, fq * 8), boff = lds_byte(wc * 32 + fr, fq * 8);
#define PG8_SA(b, h) (((b) * 2 + (h)) * HTB)
#define PG8_SB(b, h) ((4 + (b) * 2 + (h)) * HTB)
#define PG8_STAGE(bufoff, gbase, voff) do { _Pragma("unroll") for (int _i = 0; _i < 2; ++_i) \
        __builtin_amdgcn_global_load_lds((const unsigned*)((const char*)(gbase) + (voff)[_i]), (PG8_LAS unsigned*)(lds + (bufoff) + ldsw + _i * 8192), 16, 0, 0); } while (0)
#define PG8_LDA(dst, b, h) do { _Pragma("unroll") for (int m = 0; m < 4; ++m) _Pragma("unroll") for (int k = 0; k < 2; ++k) dst[m][k] = *(const PG8_LAS bf16x8*)(lds + PG8_SA(b, h) + aoff + m * 2048 + k * 1024); } while (0)
#define PG8_LDB(dst, b, h) do { _Pragma("unroll") for (int n = 0; n < 2; ++n) _Pragma("unroll") for (int k = 0; k < 2; ++k) dst[n][k] = *(const PG8_LAS bf16x8*)(lds + PG8_SB(b, h) + boff + n * 2048 + k * 1024); } while (0)
#define PG8_MMA(ai, bj, At, Bt) do { __builtin_amdgcn_s_setprio(1); _Pragma("unroll") for (int m = 0; m < 4; ++m) _Pragma("unroll") for (int n = 0; n < 2; ++n) _Pragma("unroll") for (int k = 0; k < 2; ++k) \
        acc[ai][bj][m][n] = __builtin_amdgcn_mfma_f32_16x16x32_bf16(Bt[n][k], At[m][k], acc[ai][bj][m][n], 0, 0, 0); __builtin_amdgcn_s_setprio(0); } while (0)
#define PG8_WAIT_V(n) asm volatile("s_waitcnt vmcnt(" #n ")" ::: "memory")
#define PG8_WAIT_L(n) asm volatile("s_waitcnt lgkmcnt(" #n ")" ::: "memory")
#define PG8_BAR __builtin_amdgcn_s_barrier()
#define PG8_SCHED __builtin_amdgcn_sched_barrier(0)
    Unit cur, nxt; int ui = 0;
    if (!S.next(0, cur)) return;
    f32x4 acc[2][2][4][2];
#pragma unroll
    for (int a = 0; a < 2; ++a)
#pragma unroll
        for (int b = 0; b < 2; ++b)
#pragma unroll
            for (int m = 0; m < 4; ++m)
#pragma unroll
                for (int n = 0; n < 2; ++n) acc[a][b][m][n] = (f32x4){0.f, 0.f, 0.f, 0.f};
    bf16x8 At[4][2], B0[2][2], B1[2][2];
    const char* cA = (const char*)g.A + (size_t)cur.pm * tstep; const char* cB = (const char*)g.Bt + (size_t)cur.pn * tstep;
    S.a_ready(cur);
    if constexpr (SP2) {
        PG8_STAGE(PG8_SB(0, 0), cB, voffB); PG8_STAGE(PG8_SB(0, 1), cB + hstep, voffB); PG8_STAGE(PG8_SA(0, 0), cA, voffA); PG8_STAGE(PG8_SA(0, 1), cA + hstep, voffA);
        if (wr == 1) PG8_BAR;
        PG8_WAIT_V(2); PG8_BAR;
        PG8_STAGE(PG8_SB(1, 0), cB + kstep, voffB); PG8_STAGE(PG8_SA(1, 0), cA + kstep, voffA); PG8_STAGE(PG8_SB(1, 1), cB + hstep + kstep, voffB);
        PG8_WAIT_V(6); PG8_BAR;
    } else {
        PG8_STAGE(PG8_SB(0, 0), cB, voffB); PG8_STAGE(PG8_SA(0, 0), cA, voffA); PG8_STAGE(PG8_SB(0, 1), cB + hstep, voffB); PG8_STAGE(PG8_SA(0, 1), cA + hstep, voffA);
        if (wr == 1) PG8_BAR;
        PG8_WAIT_V(4); PG8_BAR;
        PG8_STAGE(PG8_SB(1, 0), cB + kstep, voffB); PG8_STAGE(PG8_SA(1, 0), cA + kstep, voffA); PG8_STAGE(PG8_SB(1, 1), cB + hstep + kstep, voffB);
        PG8_WAIT_V(6); PG8_BAR;
    }
    for (;;) {
        const bool has_next = S.next(ui + 1, nxt);
        const char* nA = has_next ? (const char*)g.A + (size_t)nxt.pm * tstep : cA; const char* nB = has_next ? (const char*)g.Bt + (size_t)nxt.pn * tstep : cB;
        for (int t = 0; t < nt; t += 2) {
            const bool last = (t == nt - 2);
            const char* a1 = cA + (size_t)(t + 1) * kstep;
            const char* a2 = last ? nA : cA + (size_t)(t + 2) * kstep; const char* b2 = last ? nB : cB + (size_t)(t + 2) * kstep;
            const char* a3 = a2 + kstep; const char* b3 = b2 + kstep;
            if (last && has_next) S.a_ready(nxt);
            if constexpr (SP2) {
            PG8_LDB(B0, 0, 0); PG8_LDB(B1, 0, 1); PG8_SCHED; PG8_LDA(At, 0, 0); PG8_STAGE(PG8_SA(1, 1), a1 + hstep, voffA);
            PG8_WAIT_V(8); PG8_WAIT_L(0); PG8_BAR; PG8_MMA(0, 0, At, B0); PG8_MMA(0, 1, At, B1); PG8_BAR; PG8_SCHED;
            PG8_LDA(At, 0, 1); PG8_STAGE(PG8_SB(0, 0), b2, voffB); PG8_STAGE(PG8_SB(0, 1), b2 + hstep, voffB); PG8_STAGE(PG8_SA(0, 0), a2, voffA);
            PG8_WAIT_V(8); PG8_WAIT_L(0); PG8_BAR; PG8_MMA(1, 0, At, B0); PG8_MMA(1, 1, At, B1); PG8_BAR; PG8_SCHED;
            PG8_LDB(B0, 1, 0); PG8_LDB(B1, 1, 1); PG8_SCHED; PG8_LDA(At, 1, 0); PG8_STAGE(PG8_SA(0, 1), a2 + hstep, voffA);
            PG8_WAIT_V(8); PG8_WAIT_L(0); PG8_BAR; PG8_MMA(0, 0, At, B0); PG8_MMA(0, 1, At, B1); PG8_BAR; PG8_SCHED;
            PG8_LDA(At, 1, 1); PG8_STAGE(PG8_SB(1, 0), b3, voffB); PG8_STAGE(PG8_SB(1, 1), b3 + hstep, voffB); PG8_STAGE(PG8_SA(1, 0), a3, voffA);
            PG8_WAIT_V(8); PG8_WAIT_L(0); PG8_BAR; PG8_MMA(1, 0, At, B0); PG8_MMA(1, 1, At, B1); PG8_BAR; PG8_SCHED;
            } else {
            PG8_LDB(B0, 0, 0); PG8_SCHED; PG8_LDA(At, 0, 0); PG8_STAGE(PG8_SA(1, 1), a1 + hstep, voffA);
            PG8_WAIT_L(8); PG8_BAR; PG8_WAIT_L(0); PG8_MMA(0, 0, At, B0); PG8_BAR; PG8_SCHED;
            PG8_LDB(B1, 0, 1); PG8_STAGE(PG8_SB(0, 0), b2, voffB);
            PG8_BAR; PG8_WAIT_L(0); PG8_MMA(0, 1, At, B1); PG8_BAR;
            PG8_LDA(At, 0, 1); PG8_STAGE(PG8_SA(0, 0), a2, voffA);
            PG8_BAR; PG8_WAIT_L(0); PG8_MMA(1, 0, At, B0); PG8_BAR; PG8_SCHED;
            PG8_STAGE(PG8_SB(0, 1), b2 + hstep, voffB);
            PG8_WAIT_V(6); PG8_BAR; PG8_MMA(1, 1, At, B1); PG8_BAR;
            PG8_LDB(B0, 1, 0); PG8_SCHED; PG8_LDA(At, 1, 0); PG8_STAGE(PG8_SA(0, 1), a2 + hstep, voffA);
            PG8_WAIT_L(8); PG8_BAR; PG8_WAIT_L(0); PG8_MMA(0, 0, At, B0); PG8_BAR; PG8_SCHED;
            PG8_LDB(B1, 1, 1); PG8_STAGE(PG8_SB(1, 0), b3, voffB);
            PG8_BAR; PG8_WAIT_L(0); PG8_MMA(0, 1, At, B1); PG8_BAR;
            PG8_LDA(At, 1, 1); PG8_STAGE(PG8_SA(1, 0), a3, voffA);
            PG8_BAR; PG8_WAIT_L(0); PG8_MMA(1, 0, At, B0); PG8_BAR; PG8_SCHED;
            PG8_STAGE(PG8_SB(1, 1), b3 + hstep, voffB);
            PG8_WAIT_V(6); PG8_BAR; PG8_MMA(1, 1, At, B1); PG8_BAR;
            }
        }
        if constexpr (ALIGN_EPI) { if (wr == 0) PG8_BAR; }
        if constexpr (!Epi::AFTER_DRAIN) { E(acc, cur, wr, wc, fr, fq); S.done(cur); }
        if (!has_next) break;
#pragma unroll
        for (int a = 0; a < 2; ++a)
#pragma unroll
            for (int b = 0; b < 2; ++b)
#pragma unroll
                for (int m = 0; m < 4; ++m)
#pragma unroll
                    for (int n = 0; n < 2; ++n) acc[a][b][m][n] = (f32x4){0.f, 0.f, 0.f, 0.f};
        cur = nxt; cA = nA; cB = nB; ++ui;
        if constexpr (ALIGN_EPI) { if (wr == 1) PG8_BAR; }
    }
    PG8_WAIT_V(0);
    if constexpr (!ALIGN_EPI) { if (wr == 0) PG8_BAR; }
    PG8_BAR;
    if constexpr (Epi::AFTER_DRAIN) { E.fused(acc, cur, wr, wc, fr, fq, lds, wid, lane); S.done(cur); }
#undef PG8_SA
#undef PG8_SB
#undef PG8_STAGE
#undef PG8_LDA
#undef PG8_LDB
#undef PG8_MMA
#undef PG8_WAIT_V
#undef PG8_WAIT_L
#undef PG8_BAR
#undef PG8_SCHED
}
}

#define GAS __attribute__((address_space(1)))
#define LAS __attribute__((address_space(3)))
typedef unsigned short bf16;
typedef unsigned v4u __attribute__((ext_vector_type(4)));
typedef unsigned v2u __attribute__((ext_vector_type(2)));
typedef float f32x4 __attribute__((ext_vector_type(4)));
typedef float f32x2 __attribute__((ext_vector_type(2)));
typedef short bf16x8 __attribute__((ext_vector_type(8)));
typedef __bf16 bf16x2_t __attribute__((ext_vector_type(2)));
#define LDS_WAIT() asm volatile("s_waitcnt lgkmcnt(0)" ::: "memory")
#define VM_WAIT() asm volatile("s_waitcnt vmcnt(0)" ::: "memory")
__device__ __forceinline__ unsigned pk2(float lo, float hi) { f32x2 v = {lo, hi}; bf16x2_t r = __builtin_convertvector(v, bf16x2_t); return __builtin_bit_cast(unsigned, r); }
__device__ __forceinline__ float bflo(unsigned u) { return __builtin_bit_cast(float, u << 16); }
__device__ __forceinline__ float bfhi(unsigned u) { return __builtin_bit_cast(float, u & 0xffff0000u); }
__device__ __forceinline__ float bf2f(bf16 b) { return __builtin_bit_cast(float, ((unsigned)b) << 16); }
__device__ __forceinline__ float wave_sum(float v) {
#pragma unroll
    for (int o = 1; o < 64; o <<= 1) v += __shfl_xor(v, o);
    return v;
}
__device__ __forceinline__ float wave_max(float v) {
#pragma unroll
    for (int o = 1; o < 64; o <<= 1) v = fmaxf(v, __shfl_xor(v, o));
    return v;
}
#define XB_TMO      128
#define XB_XCNT(j)  (256  + 64 * (j))
#define XB_XSUB(j)  (1280 + 64 * (j))
#define XB_XGEN(j)  (2304 + 64 * (j))
#define XB_TOP      3328
#define XB_TOPGEN   3392
#define XCD_BAR_WORDS 3456
#define XB_SPIN_CAP (1u << 23)

__device__ __forceinline__ unsigned xb_ld(unsigned* p)              { return __hip_atomic_load(p, __ATOMIC_RELAXED, __HIP_MEMORY_SCOPE_AGENT); }
__device__ __forceinline__ unsigned xb_add(unsigned* p, unsigned v) { return __hip_atomic_fetch_add(p, v, __ATOMIC_RELAXED, __HIP_MEMORY_SCOPE_AGENT); }
__device__ __forceinline__ unsigned xb_xcc_id() { return (unsigned)__builtin_amdgcn_s_getreg((3 << 11) | 20) & 0xFu; }
#define XB_SPIN(cond, bar) do { unsigned _sp = 0; while (cond) { __builtin_amdgcn_s_sleep(1); \
    if ((++_sp & 255u) == 0u) { if (xb_ld(&(bar)[XB_TMO])) break; if (_sp > XB_SPIN_CAP) { atomicAdd(&(bar)[XB_TMO], 1u); break; } } } } while (0)

struct XcdBarrier {
    unsigned* bar; unsigned x;
    volatile LAS unsigned* st;
};

__device__ __forceinline__ XcdBarrier xcd_barrier_post(unsigned* bar, volatile LAS unsigned* st) {
    XcdBarrier b; b.bar = bar; b.x = xb_xcc_id(); b.st = st;
    if (threadIdx.x == 0) (void)xb_add(&bar[XB_XCNT(b.x)], 1u);
    return b;
}
__device__ __forceinline__ void xcd_barrier_complete(unsigned* bar, unsigned x, unsigned& nloc, unsigned& nx) {
    const unsigned G = gridDim.x * gridDim.y * gridDim.z;
    unsigned sum, cnt, mine, sp = 0u;
    for (;;) {
        sum = 0u; cnt = 0u; mine = 0u;
#pragma unroll
        for (unsigned j = 0; j < 16; ++j) { const unsigned c = xb_ld(&bar[XB_XCNT(j)]); sum += c; cnt += (c > 0u) ? 1u : 0u; mine = (j == x) ? c : mine; }
        if (sum == G) break;
        __builtin_amdgcn_s_sleep(1);
        if ((++sp & 255u) == 0u) { if (xb_ld(&bar[XB_TMO])) break; if (sp > XB_SPIN_CAP) { atomicAdd(&bar[XB_TMO], 1u); break; } }
    }
    nloc = mine > 0u ? mine : 1u; nx = cnt > 0u ? cnt : 1u;
}

__device__ __forceinline__ void xcd_barrier(const XcdBarrier& b) {
    asm volatile("s_waitcnt vmcnt(0)" ::: "memory");
    __syncthreads();
    if (threadIdx.x == 0) {
        unsigned* bar = b.bar;
        __builtin_amdgcn_s_waitcnt(0);
        unsigned nloc = b.st[0], nx = b.st[1];
        if (nloc == 0u) { xcd_barrier_complete(bar, b.x, nloc, nx); b.st[0] = nloc; b.st[1] = nx; }
        const unsigned old = xb_add(&bar[XB_XSUB(b.x)], 1u);
        const unsigned gen = old / nloc;
        if (old + 1u == (gen + 1u) * nloc) {
            __builtin_amdgcn_fence(__ATOMIC_RELEASE, "agent");
            asm volatile("s_waitcnt vmcnt(0)" ::: "memory");
            const unsigned og = xb_add(&bar[XB_TOP], 1u);
            const unsigned tg = og / nx;
            if (og + 1u == (tg + 1u) * nx) xb_add(&bar[XB_TOPGEN], 1u);
            else XB_SPIN(xb_ld(&bar[XB_TOPGEN]) == tg, bar);
            __builtin_amdgcn_fence(__ATOMIC_ACQUIRE, "agent");
            xb_add(&bar[XB_XGEN(b.x)], 1u);
            asm volatile("s_waitcnt vmcnt(0)" ::: "memory");
        } else {
            XB_SPIN(xb_ld(&bar[XB_XGEN(b.x)]) == gen, bar);
            __builtin_amdgcn_fence(__ATOMIC_ACQUIRE, "agent");
            asm volatile("s_waitcnt vmcnt(0)" ::: "memory");
        }
    }
    __syncthreads();
}

constexpr int D = 2048, NB = 4, S = 4096, T = NB * S;
constexpr int HD = 128, FH = 12, FW = 1536, MH = 4, MW = 512, ML = 256;
constexpr int FOX_IN = 6668, FOX_NP = 6912;
constexpr int GLA_IN = 5136, GLA_NP = 5376;
constexpr int GH = 4, GDK = 192, GDV = 384, GKW = 768, GVW = 1536;
constexpr int NE = 32, DE = 1024, MAXROWS = 40960, MAXTILES = 160;
constexpr int FP_Q = 0, FP_K = 1536, FP_V = 3072, FP_OG = 4608, FP_QM = 6144, FP_F = 6656;
constexpr int GP_Q = 0, GP_K = 768, GP_V = 1536, GP_R = 3072, GP_QM = 4608, GP_A = 5120;
constexpr float RMS_EPS = 1e-6f;
constexpr int NWAVES = 8;

constexpr size_t MiB = 1u << 20;
constexpr size_t WS_CTL = 0, CTL_ZERO_BYTES = 1 * MiB;
constexpr size_t WS_ROUTE = 1 * MiB;
constexpr size_t WS_WFOX = 4 * MiB;
constexpr size_t WS_WGLA = WS_WFOX + 27 * MiB;
constexpr size_t WS_WOUT = WS_WGLA + 21 * MiB;
constexpr size_t WS_WMKV = WS_WOUT + 16 * MiB;
constexpr size_t WS_WGU = WS_WMKV + 4 * MiB;
constexpr size_t WS_WD = WS_WGU + 512 * MiB;
constexpr size_t WS_HN = WS_WD + 256 * MiB;
constexpr size_t WS_P = WS_HN + 65 * MiB;
constexpr size_t WS_CAT = WS_P + 216 * MiB;
constexpr size_t WS_XA = WS_CAT + 64 * MiB;
constexpr size_t WS_XB = WS_XA + 128 * MiB;
constexpr size_t WS_XG = WS_XB + 128 * MiB;
constexpr size_t WS_H = WS_XG + 160 * MiB;
constexpr size_t WS_YB = WS_H + 80 * MiB;
constexpr size_t WS_MEMN = WS_YB + 128 * MiB;
constexpr size_t WS_MKV = WS_MEMN + 4 * MiB;
constexpr size_t WS_MK = WS_MKV + 2 * MiB;
constexpr size_t WS_C = WS_MK + 2 * MiB;
constexpr size_t WS_FL = WS_C + 1 * MiB;
constexpr size_t WS_END = WS_FL + 1 * MiB;
constexpr size_t WS_GO = WS_XG, WS_LA = WS_H;
constexpr size_t RT_TOKE = 0;
constexpr size_t RT_TOKS = RT_TOKE + 2 * T * 4;
constexpr size_t RT_TOKW = RT_TOKS + 2 * T * 4;
constexpr size_t RT_ROWDEST = RT_TOKW + 2 * T * 4;
constexpr size_t RT_ROWW = RT_ROWDEST + 2 * MAXROWS * 4;
constexpr size_t RT_TILEE = RT_ROWW + MAXROWS * 4;
constexpr size_t RT_END = RT_TILEE + 2 * 256 * 4;
static_assert(RT_END <= 3 * MiB, "routing arrays");
constexpr int CW_BAR = 4096;
constexpr int CW_CNT = 8192;
static_assert((CW_CNT + 64) * 4 <= (int)CTL_ZERO_BYTES, "ctl");

constexpr int RING_OFF = 0, RING_BYTES = 131072;
constexpr int LDSCTL_OFF = RING_BYTES, MISC_OFF = LDSCTL_OFF + 320;
constexpr int LDS_BYTES = 147456;

namespace pg8 {
struct EpiP {
    static constexpr bool PERM = true, AFTER_DRAIN = false;
    bf16_t* P; int ldp; float* FL; int ftile;
    __device__ __forceinline__ void operator()(const f32x4 (&acc)[2][2][4][2], const Unit& u, int wr, int wc, int fr, int fq) const {
        const int row0 = u.pm * BM + wr * 64 + fr, col0 = u.pn * BM + wc * 32 + 8 * fq;
#pragma unroll
        for (int ai = 0; ai < 2; ++ai)
#pragma unroll
            for (int m = 0; m < 4; ++m) { bf16_t* rowp = P + (size_t)(row0 + ai * HALF + m * 16) * ldp + col0;
#pragma unroll
                for (int bj = 0; bj < 2; ++bj) { const f32x4 v0 = acc[ai][bj][m][0], v1 = acc[ai][bj][m][1];
                    u32x4 w; w.x = pk2(v0[0], v0[1]); w.y = pk2(v0[2], v0[3]); w.z = pk2(v1[0], v1[1]); w.w = pk2(v1[2], v1[3]);
                    *(u32x4*)(rowp + bj * HALF) = w; } }
        if (u.pn == ftile && wc == 0 && fq < 2) {
#pragma unroll
            for (int ai = 0; ai < 2; ++ai)
#pragma unroll
                for (int m = 0; m < 4; ++m) { float* fp = FL + (size_t)(row0 + ai * HALF + m * 16) * 16 + 8 * fq;
                    *(f32x4*)(fp) = acc[ai][0][m][0]; *(f32x4*)(fp + 4) = acc[ai][0][m][1]; }
        }
    }
};
struct EpiRes {
    static constexpr bool PERM = false, AFTER_DRAIN = false;
    const float* R; float* C; int ldc;
    __device__ __forceinline__ void operator()(const f32x4 (&acc)[2][2][4][2], const Unit& u, int wr, int wc, int fr, int fq) const {
        const int row0 = u.pm * BM + wr * 64 + fr, col0 = u.pn * BM + wc * 32 + 4 * fq;
#pragma unroll
        for (int ai = 0; ai < 2; ++ai)
#pragma unroll
            for (int m = 0; m < 4; ++m) { const size_t ro = (size_t)(row0 + ai * HALF + m * 16) * ldc + col0;
#pragma unroll
                for (int bj = 0; bj < 2; ++bj)
#pragma unroll
                    for (int n = 0; n < 2; ++n) { const f32x4 r = *(const f32x4*)(R + ro + bj * HALF + n * 16); *(f32x4*)(C + ro + bj * HALF + n * 16) = acc[ai][bj][m][n] + r; } }
    }
};
struct EpiGU {
    static constexpr bool PERM = true, AFTER_DRAIN = false;
    bf16_t* H;
    __device__ __forceinline__ void operator()(const f32x4 (&acc)[2][2][4][2], const Unit& u, int wr, int wc, int fr, int fq) const {
        const int row0 = u.pm * BM + wr * 64 + fr, col0 = (u.pn & 7) * HALF + wc * 32 + 8 * fq;
#pragma unroll
        for (int ai = 0; ai < 2; ++ai)
#pragma unroll
            for (int m = 0; m < 4; ++m) { bf16_t* rowp = H + (size_t)(row0 + ai * HALF + m * 16) * 1024 + col0;
                float h[8];
#pragma unroll
                for (int n = 0; n < 2; ++n)
#pragma unroll
                    for (int j = 0; j < 4; ++j) { const float g = acc[ai][0][m][n][j], uu = acc[ai][1][m][n][j]; h[4 * n + j] = g * uu / (1.0f + __expf(-g)); }
                u32x4 w; w.x = pk2(h[0], h[1]); w.y = pk2(h[2], h[3]); w.z = pk2(h[4], h[5]); w.w = pk2(h[6], h[7]);
                *(u32x4*)rowp = w; }
    }
};
struct EpiDown {
    static constexpr bool PERM = true, AFTER_DRAIN = false;
    const int* rowdest; const float* roww; bf16_t* YB;
    __device__ __forceinline__ void operator()(const f32x4 (&acc)[2][2][4][2], const Unit& u, int wr, int wc, int fr, int fq) const {
        const int row0 = u.pm * BM + wr * 64 + fr, col0 = (u.pn & 7) * BM + wc * 32 + 8 * fq;
#pragma unroll
        for (int ai = 0; ai < 2; ++ai)
#pragma unroll
            for (int m = 0; m < 4; ++m) { const int row = row0 + ai * HALF + m * 16; const int dest = rowdest[row];
                if (dest >= 0) { const float w8 = roww[row]; bf16_t* rowp = YB + (size_t)dest * D + col0;
#pragma unroll
                    for (int bj = 0; bj < 2; ++bj) { const f32x4 v0 = acc[ai][bj][m][0] * w8, v1 = acc[ai][bj][m][1] * w8;
                        u32x4 w; w.x = pk2(v0[0], v0[1]); w.y = pk2(v0[2], v0[3]); w.z = pk2(v1[0], v1[1]); w.w = pk2(v1[2], v1[3]);
                        *(u32x4*)(rowp + bj * HALF) = w; } } }
    }
};
struct MoeOrder {
    const int* tile_e; int nunits, G, c;
    __device__ __forceinline__ bool next(int i, Unit& u) const {
        const long L = (long)i * G + c; if (L >= nunits) return false;
        const int tile = (int)(L >> 3), pn = (int)(L & 7); u.pm = tile; u.pn = tile_e[tile] * 8 + pn; return true;
    }
    __device__ __forceinline__ void a_ready(const Unit&) const {}
    __device__ __forceinline__ void done(const Unit&) const {}
};
}

struct Ctx {
    LAS unsigned char* lds;
    int tid, lane, wave, gw, NGW, G;
    const float* in[24]; float* out; unsigned char* ws;
};
#define WSP(type, off) ((type*)(C.ws + (off)))

__device__ __forceinline__ void load_row(const float* xrow, int lane, f32x4 (&v)[8]) {
#pragma unroll
    for (int j = 0; j < 8; ++j) v[j] = ((const f32x4*)xrow)[lane + 64 * j];
}
__device__ __forceinline__ float row_inv_rms(const f32x4 (&v)[8]) {
    float s = 0.f;
#pragma unroll
    for (int j = 0; j < 8; ++j) s += (v[j].x * v[j].x + v[j].y * v[j].y) + (v[j].z * v[j].z + v[j].w * v[j].w);
    s = wave_sum(s);
    return 1.0f / sqrtf(s * (1.0f / D) + RMS_EPS);
}
__device__ __forceinline__ void norm_store_row(bf16* orow, f32x4 (&v)[8], float inv, const float* g, int lane) {
#pragma unroll
    for (int j = 0; j < 8; ++j) { const f32x4 gg = ((const f32x4*)g)[lane + 64 * j]; v[j] = v[j] * inv * gg;
        v2u o; o.x = pk2(v[j].x, v[j].y); o.y = pk2(v[j].z, v[j].w); ((v2u*)orow)[lane + 64 * j] = o; }
}

__device__ __forceinline__ void tr_item(const float* W, int ldn, int K, bf16* WT, int drow, int k0, int n0, LAS float* scr, int lane) {
#pragma unroll 8
    for (int i = 0; i < 32; ++i) { const int kk = 2 * i + (lane >> 5); scr[kk * 33 + (lane & 31)] = W[(size_t)(k0 + kk) * ldn + n0 + (lane & 31)]; }
    LDS_WAIT(); asm volatile("" ::: "memory");
    const int c = lane & 7;
#pragma unroll
    for (int j = 0; j < 4; ++j) { const int n = (lane >> 3) + 8 * j; const LAS float* s = scr + (8 * c) * 33 + n;
        v4u o; o.x = pk2(s[0 * 33], s[1 * 33]); o.y = pk2(s[2 * 33], s[3 * 33]); o.z = pk2(s[4 * 33], s[5 * 33]); o.w = pk2(s[6 * 33], s[7 * 33]);
        *(v4u*)(WT + (size_t)(drow + n) * K + k0 + 8 * c) = o; }
    LDS_WAIT(); asm volatile("" ::: "memory");
}
__device__ __forceinline__ bool tr_group(int& r, const float* W, int ldn, int K, int c0, int nblk, bf16* WT, int drow0, LAS float* scr, int lane) {
    const int cnt = (K / 64) * nblk;
    if (r < cnt) { const int kb = r / nblk, nb = r % nblk; tr_item(W + c0, ldn, K, WT, drow0 + 32 * nb, 64 * kb, 32 * nb, scr, lane); return true; }
    r -= cnt; return false;
}
__device__ __forceinline__ void p0_prologue(const Ctx& C) {
    LAS float* scr = (LAS float*)(C.lds + RING_OFF + C.wave * 16384);
    const int lane = C.lane;
    constexpr int MOE_ITEMS = 64 * 3 * 1024;
    for (int it = C.gw; it < MOE_ITEMS; it += C.NGW) {
        const int le = it / 3072, rem = it % 3072, kind = rem >> 10, r = rem & 1023;
        if (kind < 2) {
            const float* W = (kind == 0 ? C.in[21] : C.in[22]) + (size_t)le * 2048 * 1024;
            const int kb = r >> 5, nb = r & 31, n0 = 32 * nb;
            bf16* WT = WSP(bf16, WS_WGU) + (size_t)le * 2048 * 2048;
            tr_item(W, 1024, 2048, WT, 256 * (n0 >> 7) + (n0 & 127) + 128 * kind, 64 * kb, n0, scr, lane);
        } else {
            const float* W = C.in[23] + (size_t)le * 1024 * 2048;
            const int kb = r >> 6, nb = r & 63;
            bf16* WT = WSP(bf16, WS_WD) + (size_t)le * 2048 * 1024;
            tr_item(W, 2048, 1024, WT, 32 * nb, 64 * kb, 32 * nb, scr, lane);
        }
    }
    constexpr int I_FOX = 32 * (192 + 16 + 1), I_GLA = 32 * (144 + 16 + 1), I_WO = 32 * 64, I_MKV = 32 * 32;
    constexpr int OTHER = I_FOX + I_GLA + 2 * I_WO + I_MKV;
    for (int it = C.gw; it < OTHER; it += C.NGW) {
        int r = it;
        if (tr_group(r, C.in[5], FOX_IN, D, 0, 192, WSP(bf16, WS_WFOX), 0, scr, lane)) continue;
        if (tr_group(r, C.in[5], FOX_IN, D, 6156, 16, WSP(bf16, WS_WFOX), FP_QM, scr, lane)) continue;
        if (tr_group(r, C.in[5], FOX_IN, D, 6144, 1, WSP(bf16, WS_WFOX), FP_F, scr, lane)) continue;
        if (tr_group(r, C.in[9], GLA_IN, D, 0, 144, WSP(bf16, WS_WGLA), 0, scr, lane)) continue;
        if (tr_group(r, C.in[9], GLA_IN, D, 4624, 16, WSP(bf16, WS_WGLA), GP_QM, scr, lane)) continue;
        if (tr_group(r, C.in[9], GLA_IN, D, 4608, 1, WSP(bf16, WS_WGLA), GP_A, scr, lane)) continue;
        if (tr_group(r, C.in[15], D, D, 0, 64, WSP(bf16, WS_WOUT), 0, scr, lane)) continue;
        if (tr_group(r, C.in[15] + (size_t)D * D, D, D, 0, 64, WSP(bf16, WS_WOUT) + (size_t)D * D, 0, scr, lane)) continue;
        tr_group(r, C.in[3], 1024, D, 0, 32, WSP(bf16, WS_WMKV), 0, scr, lane);
    }
    for (int m = C.gw; m < T + NB * ML; m += C.NGW) {
        f32x4 v[8];
        if (m < T) { load_row(C.in[0] + (size_t)m * D, lane, v); const float inv = row_inv_rms(v); norm_store_row(WSP(bf16, WS_HN) + (size_t)m * D, v, inv, C.in[4], lane); }
        else { const int r = m - T; load_row(C.in[1] + (size_t)r * D, lane, v); const float inv = row_inv_rms(v); norm_store_row(WSP(bf16, WS_MEMN) + (size_t)r * D, v, inv, C.in[2], lane); }
    }
    { int* rd = (int*)(C.ws + WS_ROUTE + RT_ROWDEST);
      for (int i = blockIdx.x * 512 + C.tid; i < 2 * MAXROWS; i += C.G * 512) rd[i] = -1; }
}

__device__ __forceinline__ float log_sigmoid(float x) { return fminf(x, 0.f) - log1pf(expf(-fabsf(x))); }

__device__ __forceinline__ void headnorm_inplace(bf16* rowp, int col0, int nh, const float* g, int lane) {
    const float g0 = g[2 * lane], g1 = g[2 * lane + 1];
    for (int h = 0; h < nh; ++h) {
        unsigned* p = (unsigned*)(rowp + col0 + h * HD) + lane; const unsigned u = *p; const float a = bflo(u), b = bfhi(u);
        const float ss = wave_sum(a * a + b * b); const float inv = 1.0f / sqrtf(ss * (1.0f / HD) + RMS_EPS);
        *p = pk2(a * inv * g0, b * inv * g1);
    }
}
__device__ __forceinline__ void p3_fox_thin(const Ctx& C) {
    bf16* P = WSP(bf16, WS_P);
    for (int m = C.gw; m < T; m += C.NGW) {
        bf16* rowp = P + (size_t)m * FOX_NP;
        headnorm_inplace(rowp, FP_Q, FH, C.in[7], C.lane);
        headnorm_inplace(rowp, FP_K, FH, C.in[8], C.lane);
        headnorm_inplace(rowp, FP_QM, MH, C.in[13], C.lane);
    }
    for (int it = C.gw; it < NB * ML * MH; it += C.NGW) {
        const int row = it >> 2, mh = it & 3;
        const unsigned u = *((const unsigned*)(WSP(bf16, WS_MKV) + (size_t)row * 1024 + mh * HD) + C.lane); const float a = bflo(u), b = bfhi(u);
        const float ss = wave_sum(a * a + b * b); const float inv = 1.0f / sqrtf(ss * (1.0f / HD) + RMS_EPS);
#pragma unroll
        for (int l = 0; l < 2; ++l) { const float* g = C.in[14] + l * HD;
            *((unsigned*)(WSP(bf16, WS_MK) + (size_t)l * 1024 * 512 + (size_t)row * 512 + mh * HD) + C.lane) = pk2(a * inv * g[2 * C.lane], b * inv * g[2 * C.lane + 1]); }
    }
    LAS float* sm = (LAS float*)(C.lds + RING_OFF);
    for (int bh = blockIdx.x; bh < NB * FH; bh += C.G) {
        const int b = bh / FH, h = bh % FH; const float bf = C.in[6][h];
        const float* fl = WSP(float, WS_FL) + (size_t)(b * S) * 16 + h;
        float ls[8], tot = 0.f;
#pragma unroll
        for (int i = 0; i < 8; ++i) { ls[i] = log_sigmoid(fl[(size_t)(8 * C.tid + i) * 16] + bf); tot += ls[i]; ls[i] = tot; }
        float inc = tot;
#pragma unroll
        for (int o = 1; o < 64; o <<= 1) { const float t = __shfl_up(inc, o); if (C.lane >= o) inc += t; }
        __syncthreads();
        if (C.lane == 63) sm[C.wave] = inc;
        __syncthreads();
        float woff = 0.f;
        for (int w = 0; w < C.wave; ++w) woff += sm[w];
        const float excl = woff + inc - tot;
        float* cp = WSP(float, WS_C) + (size_t)bh * S + 8 * C.tid;
#pragma unroll
        for (int i = 0; i < 8; ++i) cp[i] = excl + ls[i];
    }
}

__device__ __forceinline__ void naive_attn_row(const bf16* qptr, const bf16* Kb, int kstride, const bf16* Vb, int vstride, int nk, const float* cptr, float ct,
                                               LAS float* qs, int lane, float& o0, float& o1) {
    { const unsigned qq = *((const unsigned*)qptr + lane); qs[2 * lane] = bflo(qq); qs[2 * lane + 1] = bfhi(qq); }
    LDS_WAIT(); asm volatile("" ::: "memory");
    float m = -1e30f, l = 0.f, a0 = 0.f, a1 = 0.f;
    for (int j0 = 0; j0 < nk; j0 += 64) {
        const int j = j0 + lane; const bool valid = j < nk; const int jc = valid ? j : nk - 1;
        const bf16* kr = Kb + (size_t)jc * kstride;
        float s = 0.f;
#pragma unroll 4
        for (int d8 = 0; d8 < 16; ++d8) {
            const v4u kk = *(const v4u*)(kr + 8 * d8);
            const f32x4 qa = *(const LAS f32x4*)(qs + 8 * d8), qb = *(const LAS f32x4*)(qs + 8 * d8 + 4);
            s += bflo(kk.x) * qa.x + bfhi(kk.x) * qa.y + bflo(kk.y) * qa.z + bfhi(kk.y) * qa.w + bflo(kk.z) * qb.x + bfhi(kk.z) * qb.y + bflo(kk.w) * qb.z + bfhi(kk.w) * qb.w;
        }
        s *= 0.08838834764831845f;
        if (cptr) s += ct - cptr[jc];
        if (!valid) s = -__builtin_inff();
        const float mn = fmaxf(m, wave_max(s)); const float alpha = expf(m - mn); const float p = valid ? expf(s - mn) : 0.f;
        l = l * alpha + wave_sum(p); a0 *= alpha; a1 *= alpha; m = mn;
        const int cnt = (nk - j0) < 64 ? (nk - j0) : 64;
        for (int jj = 0; jj < cnt; ++jj) { const float pj = __shfl(p, jj); const unsigned vv = *((const unsigned*)(Vb + (size_t)(j0 + jj) * vstride) + lane); a0 += pj * bflo(vv); a1 += pj * bfhi(vv); }
    }
    o0 = a0 / l; o1 = a1 / l;
    asm volatile("" ::: "memory");
}
__device__ __forceinline__ void naive_mem_attn(const Ctx& C, const bf16* P, int ldp, int qcol, int layer, int row, int mh, LAS float* qs) {
    const int b = row / S; float o0, o1;
    naive_attn_row(P + (size_t)row * ldp + qcol + mh * HD, WSP(bf16, WS_MK) + (size_t)layer * 1024 * 512 + (size_t)(b * ML) * 512 + mh * HD, 512,
                   WSP(bf16, WS_MKV) + (size_t)(b * ML) * 1024 + 512 + mh * HD, 1024, ML, nullptr, 0.f, qs, C.lane, o0, o1);
    *((unsigned*)(WSP(bf16, WS_CAT) + (size_t)row * D + FW + mh * HD) + C.lane) = pk2(o0, o1);
}
__device__ __forceinline__ void p4_fox_attn_naive(const Ctx& C) {
    LAS float* qs = (LAS float*)(C.lds + RING_OFF + C.wave * 16384);
    const bf16* P = WSP(bf16, WS_P);
    for (int it = C.gw; it < T * 16; it += C.NGW) {
        const int hh = it / T, row = it % T;
        if (hh < FH) {
            const int b = row / S, t = row % S; float o0, o1;
            const float* cp = WSP(float, WS_C) + (size_t)(b * FH + hh) * S;
            naive_attn_row(P + (size_t)row * FOX_NP + FP_Q + hh * HD, P + (size_t)(b * S) * FOX_NP + FP_K + hh * HD, FOX_NP, P + (size_t)(b * S) * FOX_NP + FP_V + hh * HD, FOX_NP,
                           t + 1, cp, cp[t], qs, C.lane, o0, o1);
            const unsigned og = *((const unsigned*)(P + (size_t)row * FOX_NP + FP_OG + hh * HD) + C.lane);
            const float g0 = 1.0f / (1.0f + expf(-bflo(og))), g1 = 1.0f / (1.0f + expf(-bfhi(og)));
            *((unsigned*)(WSP(bf16, WS_CAT) + (size_t)row * D + hh * HD) + C.lane) = pk2(o0 * g0, o1 * g1);
        } else naive_mem_attn(C, P, FOX_NP, FP_QM, 0, row, hh - FH, qs);
    }
}

__device__ __forceinline__ void p12_gla_thin(const Ctx& C) {
    bf16* P = WSP(bf16, WS_P);
    const float* w2 = C.in[10]; const float* ba = C.in[11];
    for (int m = C.gw; m < T; m += C.NGW) {
        headnorm_inplace(P + (size_t)m * GLA_NP, GP_QM, MH, C.in[13] + HD, C.lane);
        const float* fl = WSP(float, WS_FL) + (size_t)m * 16;
        float al[16];
#pragma unroll
        for (int r = 0; r < 16; ++r) al[r] = fl[r];
        float* la = WSP(float, WS_LA) + (size_t)m * GKW;
#pragma unroll 1
        for (int j = 0; j < 12; ++j) { const int c = C.lane + 64 * j; float s = ba[c];
#pragma unroll
            for (int r = 0; r < 16; ++r) s += al[r] * w2[r * GKW + c];
            la[c] = expf(log_sigmoid(s) * (1.0f / 16.0f)); }
    }
}
__device__ __forceinline__ void p13_gla_naive(const Ctx& C) {
    const bf16* P = WSP(bf16, WS_P); const float* LA = WSP(float, WS_LA); float* GO = WSP(float, WS_GO);
    const int lane = C.lane;
    for (int it = C.gw; it < NB * GH * 128; it += C.NGW) {
        const int bh = it >> 7, e0 = (it & 127) * 3, b = bh >> 2, h = bh & 3;
        float st[3][3];
#pragma unroll
        for (int i = 0; i < 3; ++i)
#pragma unroll
            for (int e = 0; e < 3; ++e) st[i][e] = 0.f;
        const float qsc = 0.07216878364870322f;
        for (int t0 = 0; t0 < S; t0 += 4) {
            float a[4][3], k[4][3], q[4][3], v[4][3];
#pragma unroll
            for (int u = 0; u < 4; ++u) { const size_t row = (size_t)(b * S + t0 + u);
#pragma unroll
                for (int i = 0; i < 3; ++i) { const int d = lane + 64 * i;
                    a[u][i] = LA[row * GKW + h * GDK + d]; k[u][i] = bf2f(P[row * GLA_NP + GP_K + h * GDK + d]); q[u][i] = bf2f(P[row * GLA_NP + GP_Q + h * GDK + d]) * qsc; }
#pragma unroll
                for (int e = 0; e < 3; ++e) v[u][e] = bf2f(P[row * GLA_NP + GP_V + h * GDV + e0 + e]); }
#pragma unroll
            for (int u = 0; u < 4; ++u) { float o[3] = {0.f, 0.f, 0.f};
#pragma unroll
                for (int i = 0; i < 3; ++i)
#pragma unroll
                    for (int e = 0; e < 3; ++e) { st[i][e] = a[u][i] * st[i][e] + k[u][i] * v[u][e]; o[e] += q[u][i] * st[i][e]; }
#pragma unroll
                for (int e = 0; e < 3; ++e) o[e] = wave_sum(o[e]);
                if (lane < 3) GO[(size_t)(b * S + t0 + u) * GVW + h * GDV + e0 + lane] = lane == 0 ? o[0] : (lane == 1 ? o[1] : o[2]); }
        }
    }
    LAS float* qs = (LAS float*)(C.lds + RING_OFF + C.wave * 16384);
    for (int it = C.gw; it < T * MH; it += C.NGW) naive_mem_attn(C, P, GLA_NP, GP_QM, 1, it % T, it / T, qs);
}
__device__ __forceinline__ void p14_gla_onorm(const Ctx& C) {
    const bf16* P = WSP(bf16, WS_P); const float* GO = WSP(float, WS_GO); const float* og = C.in[12];
    for (int m = C.gw; m < T; m += C.NGW) {
#pragma unroll 1
        for (int h = 0; h < GH; ++h) {
            f32x2 x[3]; float ss = 0.f;
#pragma unroll
            for (int i = 0; i < 3; ++i) { x[i] = *((const f32x2*)(GO + (size_t)m * GVW + h * GDV + 128 * i) + C.lane); ss += x[i].x * x[i].x + x[i].y * x[i].y; }
            ss = wave_sum(ss); const float inv = 1.0f / sqrtf(ss * (1.0f / GDV) + RMS_EPS);
#pragma unroll
            for (int i = 0; i < 3; ++i) { const int e = 128 * i + 2 * C.lane;
                const unsigned ru = *((const unsigned*)(P + (size_t)m * GLA_NP + GP_R + h * GDV + 128 * i) + C.lane); const float r0 = bflo(ru), r1 = bfhi(ru);
                const float y0 = x[i].x * inv * og[e] * (r0 / (1.0f + expf(-r0))), y1 = x[i].y * inv * og[e + 1] * (r1 / (1.0f + expf(-r1)));
                *((unsigned*)(WSP(bf16, WS_CAT) + (size_t)m * D + h * GDV + 128 * i) + C.lane) = pk2(y0, y1); }
        }
    }
}

__device__ __forceinline__ void p6_router(const Ctx& C, int layer) {
    const float* X = WSP(float, WS_XB); const float* g = C.in[16] + layer * D;
    const float* wg = C.in[17] + (size_t)layer * D * 4; const float* we = C.in[19] + (size_t)layer * D * 32;
    const float* bg = C.in[18] + layer * 4; const float* be = C.in[20] + layer * 32;
    unsigned* cnt = (unsigned*)(C.ws + WS_CTL) + CW_CNT + layer * 32;
    int* toke = (int*)(C.ws + WS_ROUTE + RT_TOKE); int* toks = (int*)(C.ws + WS_ROUTE + RT_TOKS); float* tokw = (float*)(C.ws + WS_ROUTE + RT_TOKW);
    const int lane = C.lane;
    LAS float* hs = (LAS float*)(C.lds + RING_OFF + C.wave * 16384);
    for (int pr = C.gw; pr < T / 2; pr += C.NGW) {
        {
            f32x4 x0[8], x1[8];
            load_row(X + (size_t)(2 * pr) * D, lane, x0); load_row(X + (size_t)(2 * pr + 1) * D, lane, x1);
            const float i0 = row_inv_rms(x0), i1 = row_inv_rms(x1);
            norm_store_row(WSP(bf16, WS_HN) + (size_t)(2 * pr) * D, x0, i0, g, lane);
            norm_store_row(WSP(bf16, WS_HN) + (size_t)(2 * pr + 1) * D, x1, i1, g, lane);
#pragma unroll
            for (int j = 0; j < 8; ++j) { ((LAS f32x4*)hs)[lane + 64 * j] = x0[j]; ((LAS f32x4*)(hs + D))[lane + 64 * j] = x1[j]; }
        }
        LDS_WAIT(); asm volatile("" ::: "memory");
        float a0[36], a1[36];
#pragma unroll
        for (int n = 0; n < 36; ++n) { a0[n] = 0.f; a1[n] = 0.f; }
#pragma unroll 2
        for (int kk = 0; kk < 32; ++kk) {
            const int k = lane + 64 * kk; const float h0 = hs[k], h1 = hs[D + k];
            const f32x4 w4 = *(const f32x4*)(wg + (size_t)k * 4);
#pragma unroll
            for (int n = 0; n < 4; ++n) { a0[n] += h0 * w4[n]; a1[n] += h1 * w4[n]; }
#pragma unroll
            for (int q = 0; q < 8; ++q) { const f32x4 w = *(const f32x4*)(we + (size_t)k * 32 + 4 * q);
#pragma unroll
                for (int n = 0; n < 4; ++n) { a0[4 + 4 * q + n] += h0 * w[n]; a1[4 + 4 * q + n] += h1 * w[n]; } }
        }
        asm volatile("" ::: "memory");
#pragma unroll
        for (int n = 0; n < 36; ++n) { a0[n] = wave_sum(a0[n]); a1[n] = wave_sum(a1[n]); }
#pragma unroll
        for (int rr = 0; rr < 2; ++rr) {
            float lg[36];
#pragma unroll
            for (int n = 0; n < 36; ++n) lg[n] = rr == 0 ? a0[n] : a1[n];
            float gl[4]; int gi = 0; float gm;
#pragma unroll
            for (int n = 0; n < 4; ++n) gl[n] = lg[n] + bg[n];
            gm = gl[0];
#pragma unroll
            for (int n = 1; n < 4; ++n) if (gl[n] > gm) { gm = gl[n]; gi = n; }
            float gs = 0.f;
#pragma unroll
            for (int n = 0; n < 4; ++n) gs += expf(gl[n] - gm);
            const float gp = 1.0f / gs;
            float ev[8];
#pragma unroll
            for (int j = 0; j < 8; ++j) { const float v0 = lg[4 + j] + be[j], v1 = lg[12 + j] + be[8 + j], v2 = lg[20 + j] + be[16 + j], v3 = lg[28 + j] + be[24 + j];
                ev[j] = gi == 0 ? v0 : (gi == 1 ? v1 : (gi == 2 ? v2 : v3)); }
            int e1 = 0; float m1 = ev[0];
#pragma unroll
            for (int j = 1; j < 8; ++j) if (ev[j] > m1) { m1 = ev[j]; e1 = j; }
            int e2 = -1; float m2 = -__builtin_inff();
#pragma unroll
            for (int j = 0; j < 8; ++j) if (j != e1 && ev[j] > m2) { m2 = ev[j]; e2 = j; }
            const float z = expf(m2 - m1); const float w1 = gp / (1.0f + z), w2 = gp * z / (1.0f + z);
            if (lane == 0) {
                const int tok = 2 * pr + rr; const int id1 = gi * 8 + e1, id2 = gi * 8 + e2;
                const unsigned s1 = atomicAdd(cnt + id1, 1u), s2 = atomicAdd(cnt + id2, 1u);
                toke[2 * tok] = id1; toks[2 * tok] = (int)s1; tokw[2 * tok] = w1;
                toke[2 * tok + 1] = id2; toks[2 * tok + 1] = (int)s2; tokw[2 * tok + 1] = w2;
            }
        }
    }
}
__device__ __forceinline__ void p7_dispatch(const Ctx& C, int layer) {
    const unsigned* cnt = (const unsigned*)(C.ws + WS_CTL) + CW_CNT + layer * 32;
    const int* toke = (const int*)(C.ws + WS_ROUTE + RT_TOKE); const int* toks = (const int*)(C.ws + WS_ROUTE + RT_TOKS); const float* tokw = (const float*)(C.ws + WS_ROUTE + RT_TOKW);
    int* rowdest = (int*)(C.ws + WS_ROUTE + RT_ROWDEST) + layer * MAXROWS; float* roww = (float*)(C.ws + WS_ROUTE + RT_ROWW);
    int* tilee = (int*)(C.ws + WS_ROUTE + RT_TILEE) + layer * 256;
    const int lane = C.lane;
    const int c = lane < NE ? (int)__hip_atomic_load(cnt + lane, __ATOMIC_RELAXED, __HIP_MEMORY_SCOPE_AGENT) : 0;
    const int padded = (c + 255) & ~255;
    int inc = padded;
#pragma unroll
    for (int o = 1; o < 64; o <<= 1) { const int t = __shfl_up(inc, o); if (lane >= o) inc += t; }
    const int pstart = inc - padded;
    if (blockIdx.x == 0 && C.wave == 0) {
        if (lane < NE) for (int tl = pstart >> 8; tl < (pstart + padded) >> 8; ++tl) tilee[tl] = lane;
        if (lane == 63) tilee[255] = inc >> 8;
    }
    const bf16* HN = WSP(bf16, WS_HN); bf16* XG = WSP(bf16, WS_XG);
    for (int a = C.gw; a < 2 * T; a += C.NGW) {
        const int e = toke[a], slot = toks[a]; const int dest = __shfl(pstart, e) + slot;
        const v4u* src = (const v4u*)(HN + (size_t)(a >> 1) * D); v4u* dst = (v4u*)(XG + (size_t)dest * D);
#pragma unroll
        for (int i = 0; i < 4; ++i) dst[lane + 64 * i] = src[lane + 64 * i];
        if (lane == 0) { rowdest[dest] = a; roww[dest] = tokw[a]; }
    }
}
__device__ __forceinline__ void p_combine(const Ctx& C, const float* xi, float* xo, const float* g) {
    const bf16* YB = WSP(bf16, WS_YB);
    for (int m = C.gw; m < T; m += C.NGW) {
        f32x4 v[8]; load_row(xi + (size_t)m * D, C.lane, v);
#pragma unroll
        for (int j = 0; j < 8; ++j) {
            const v2u y0 = ((const v2u*)(YB + (size_t)(2 * m) * D))[C.lane + 64 * j], y1 = ((const v2u*)(YB + (size_t)(2 * m + 1) * D))[C.lane + 64 * j];
            v[j].x += bflo(y0.x) + bflo(y1.x); v[j].y += bfhi(y0.x) + bfhi(y1.x); v[j].z += bflo(y0.y) + bflo(y1.y); v[j].w += bfhi(y0.y) + bfhi(y1.y);
            ((f32x4*)(xo + (size_t)m * D))[C.lane + 64 * j] = v[j];
        }
        if (g) { const float inv = row_inv_rms(v); norm_store_row(WSP(bf16, WS_HN) + (size_t)m * D, v, inv, g, C.lane); }
    }
}

constexpr int NPHASE = 21;
struct Args { const float* in[24]; float* out; unsigned char* ws; int ph_lo, ph_hi; };
#define PG8_ALIGN true
#define PG8_SP2 true

template <class Epi, class Sched>
__device__ __forceinline__ void run_gemm(const Ctx& C, const bf16* A, const bf16* Bt, int K, const Sched& Sd, const Epi& E) {
    pg8::Gemm g{A, Bt, 0, 0, K};
    pg8::gemm_phase<Epi, Sched, PG8_ALIGN, PG8_SP2>(C.lds + RING_OFF, g, Sd, E);
}
__device__ __forceinline__ void dense_gemm_p(const Ctx& C, const bf16* A, const bf16* Bt, int M, int N, int K, bf16* P, int ldp, float* FL, int ftile) {
    pg8::StaticOrder Sd; Sd.init(M, N, C.G, (int)blockIdx.x); pg8::EpiP E{P, ldp, FL, ftile}; run_gemm(C, A, Bt, K, Sd, E);
}
__device__ __forceinline__ void ph_wout(const Ctx& C, int layer) {
    pg8::StaticOrder Sd; Sd.init(T, D, C.G, (int)blockIdx.x);
    pg8::EpiRes E{layer == 0 ? C.in[0] : WSP(float, WS_XA), WSP(float, WS_XB), D};
    run_gemm(C, WSP(bf16, WS_CAT), WSP(bf16, WS_WOUT) + (size_t)layer * D * D, D, Sd, E);
}
__device__ __forceinline__ void ph_gu(const Ctx& C, int layer) {
    const int* tilee = (const int*)(C.ws + WS_ROUTE + RT_TILEE) + layer * 256;
    pg8::MoeOrder Sd{tilee, tilee[255] * 8, C.G, (int)blockIdx.x}; pg8::EpiGU E{WSP(bf16, WS_H)};
    run_gemm(C, WSP(bf16, WS_XG), WSP(bf16, WS_WGU) + (size_t)layer * NE * 2048 * 2048, D, Sd, E);
}
__device__ __forceinline__ void ph_down(const Ctx& C, int layer) {
    const int* tilee = (const int*)(C.ws + WS_ROUTE + RT_TILEE) + layer * 256;
    pg8::MoeOrder Sd{tilee, tilee[255] * 8, C.G, (int)blockIdx.x};
    pg8::EpiDown E{(const int*)(C.ws + WS_ROUTE + RT_ROWDEST) + layer * MAXROWS, (const float*)(C.ws + WS_ROUTE + RT_ROWW), WSP(bf16, WS_YB)};
    run_gemm(C, WSP(bf16, WS_H), WSP(bf16, WS_WD) + (size_t)layer * NE * 2048 * 1024, DE, Sd, E);
}

__global__ void __launch_bounds__(NWAVES * 64, 2) fwd_kernel(Args args) {
    extern __shared__ __attribute__((aligned(16))) unsigned char lds[];
    Ctx C;
    C.lds = (LAS unsigned char*)lds;
    C.tid = threadIdx.x; C.lane = C.tid & 63; C.wave = __builtin_amdgcn_readfirstlane(C.tid >> 6);
    C.G = gridDim.x; C.gw = blockIdx.x * NWAVES + C.wave; C.NGW = C.G * NWAVES;
#pragma unroll
    for (int i = 0; i < 24; ++i) C.in[i] = args.in[i];
    C.out = args.out; C.ws = args.ws;
    volatile LAS unsigned* MISC = (volatile LAS unsigned*)(C.lds + MISC_OFF);
    for (int u = C.tid; u < (LDS_BYTES - LDSCTL_OFF) / 4; u += NWAVES * 64) ((LAS unsigned*)(C.lds + LDSCTL_OFF))[u] = 0u;
    __syncthreads();
    const int lo = args.ph_lo, hi = args.ph_hi;
    XcdBarrier bar; bar.bar = (unsigned*)(C.ws + WS_CTL) + CW_BAR; bar.x = 0; bar.st = nullptr;
    if (hi - lo > 1) bar = xcd_barrier_post((unsigned*)(C.ws + WS_CTL) + CW_BAR, MISC + 8);
#ifndef PHSEL
#define PHSEL 0xFFFFFFFFu
#endif
#define SITE(s) ((PHSEL >> (s)) & 1u)
#define IN(k) (lo <= (k) && (k) < hi)
#define SEAM(k) do { if (IN(k) && IN((k) + 1)) xcd_barrier(bar); } while (0)

    if (SITE(0) && IN(0)) p0_prologue(C);
    SEAM(0);
    if (SITE(1) && IN(1)) dense_gemm_p(C, WSP(bf16, WS_MEMN), WSP(bf16, WS_WMKV), NB * ML, 1024, D, WSP(bf16, WS_MKV), 1024, nullptr, -1);
    SEAM(1);
    if (SITE(2) && IN(2)) dense_gemm_p(C, WSP(bf16, WS_HN), WSP(bf16, WS_WFOX), T, FOX_NP, D, WSP(bf16, WS_P), FOX_NP, WSP(float, WS_FL), FP_F / 256);
    SEAM(2);
    if (SITE(3) && IN(3)) p3_fox_thin(C);
    SEAM(3);
    if (SITE(4) && IN(4)) p4_fox_attn_naive(C);
    SEAM(4);
    if (SITE(5) && IN(5)) ph_wout(C, 0);
    SEAM(5);
    if (SITE(6) && IN(6)) p6_router(C, 0);
    SEAM(6);
    if (SITE(7) && IN(7)) p7_dispatch(C, 0);
    SEAM(7);
    if (SITE(8) && IN(8)) ph_gu(C, 0);
    SEAM(8);
    if (SITE(9) && IN(9)) ph_down(C, 0);
    SEAM(9);
    if (SITE(10) && IN(10)) p_combine(C, WSP(float, WS_XB), WSP(float, WS_XA), C.in[4] + D);
    SEAM(10);
    if (SITE(11) && IN(11)) dense_gemm_p(C, WSP(bf16, WS_HN), WSP(bf16, WS_WGLA), T, GLA_NP, D, WSP(bf16, WS_P), GLA_NP, WSP(float, WS_FL), GP_A / 256);
    SEAM(11);
    if (SITE(12) && IN(12)) p12_gla_thin(C);
    SEAM(12);
    if (SITE(13) && IN(13)) p13_gla_naive(C);
    SEAM(13);
    if (SITE(14) && IN(14)) p14_gla_onorm(C);
    SEAM(14);
    if (SITE(15) && IN(15)) ph_wout(C, 1);
    SEAM(15);
    if (SITE(16) && IN(16)) p6_router(C, 1);
    SEAM(16);
    if (SITE(17) && IN(17)) p7_dispatch(C, 1);
    SEAM(17);
    if (SITE(18) && IN(18)) ph_gu(C, 1);
    SEAM(18);
    if (SITE(19) && IN(19)) ph_down(C, 1);
    SEAM(19);
    if (SITE(20) && IN(20)) p_combine(C, WSP(float, WS_XB), C.out, nullptr);
#undef IN
#undef SEAM
}

extern "C" void kernel_launch(void* const* d_in, const int* in_sizes, int n_in, void* d_out, int out_size, void* d_ws, size_t ws_size, hipStream_t stream) {
    static int grid = 0;
    if (grid == 0) {
        if (n_in != 24 || out_size != T * D || ws_size < WS_END) { fprintf(stderr, "kernel_launch: unexpected problem (n_in %d, out %d, ws %zu < %zu)\n", n_in, out_size, ws_size, (size_t)WS_END); grid = -1; return; }
        int dev = 0, cus = 0, per_cu = 0;
        if (hipGetDevice(&dev) != hipSuccess || hipDeviceGetAttribute(&cus, hipDeviceAttributeMultiprocessorCount, dev) != hipSuccess) { grid = -1; return; }
        if (hipFuncSetAttribute((const void*)fwd_kernel, hipFuncAttributeMaxDynamicSharedMemorySize, LDS_BYTES) != hipSuccess) { fprintf(stderr, "kernel_launch: hipFuncSetAttribute failed\n"); grid = -1; return; }
        if (hipOccupancyMaxActiveBlocksPerMultiprocessor(&per_cu, (const void*)fwd_kernel, NWAVES * 64, LDS_BYTES) != hipSuccess || per_cu < 1)
            fprintf(stderr, "kernel_launch: occupancy query reports %d workgroups per CU\n", per_cu);
        (void)hipGetLastError();
        grid = cus;
    }
    if (grid < 0) return;
    if (hipMemsetAsync((char*)d_ws + WS_CTL, 0, CTL_ZERO_BYTES, stream) != hipSuccess) return;
    Args a{};
    for (int i = 0; i < 24; ++i) a.in[i] = (const float*)d_in[i];
    a.out = (float*)d_out; a.ws = (unsigned char*)d_ws;
#if MK_N_LAUNCHES == 1
    a.ph_lo = 0; a.ph_hi = NPHASE;
    hipLaunchKernelGGL(fwd_kernel, dim3(grid), dim3(NWAVES * 64), LDS_BYTES, stream, a);
#else
    for (int p = 0; p < NPHASE; ++p) { a.ph_lo = p; a.ph_hi = p + 1; hipLaunchKernelGGL(fwd_kernel, dim3(grid), dim3(NWAVES * 64), LDS_BYTES, stream, a); }
#endif
}
```

```cpp
#include <hip/hip_runtime.h>
#include <cstdio>
#include <cstdint>
#ifndef MK_N_LAUNCHES
#define MK_N_LAUNCHES 1
#endif
namespace pg8 {
#define PG8_LAS __attribute__((address_space(3)))
typedef unsigned short bf16_t;
typedef short bf16x8 __attribute__((ext_vector_type(8)));
typedef float f32x4 __attribute__((ext_vector_type(4)));
typedef unsigned u32x4 __attribute__((ext_vector_type(4)));
constexpr int BM = 256, BK = 64, HALF = 128, HTB = HALF * BK * 2  , STAGE_BYTES = 8 * HTB, NXCD = 8, WGM = 8;

__host__ __device__ __forceinline__ int lds_byte(int r, int c) { const int st = (r >> 4) * 2 + (c >> 5), rr = r & 15, cc = c & 31, ob = rr * 64 + cc * 2; return st * 1024 + (ob ^ (((ob >> 9) & 1) << 5)); }
__host__ __device__ __forceinline__ void stage_rc(int b, int& R, int& C) { const int st = b / 1024, sb = b % 1024, swz = sb ^ (((sb >> 9) & 1) << 5); R = (st >> 1) * 16 + swz / 64; C = (st & 1) * 32 + (swz % 64) / 2; }
__host__ __device__ __forceinline__ int perm32(int rho) { const int n = rho >> 4, i = rho & 15; return 8 * (i >> 2) + 4 * n + (i & 3); }

struct Unit { int pm, pn; };
struct Gemm { const bf16_t* A; const bf16_t* Bt; int M, N, K; };

struct StaticOrder {
    int nM, nN, nwg, G, c;
    __host__ __device__ void init(int M, int N, int G_, int c_) { nM = M / BM; nN = N / BM; nwg = nM * nN; G = G_; c = c_; }
    __host__ __device__ bool next(int i, Unit& u) const {
        const long L = (long)i * G + c; if (L >= nwg) return false;
        int wgid = (int)L; { const int q = nwg / NXCD, r = nwg % NXCD, xcd = wgid % NXCD, off = wgid / NXCD; wgid = (xcd < r ? xcd * (q + 1) : r * (q + 1) + (xcd - r) * q) + off; }
        const int nig = WGM * nN, gid = wgid / nig, fm = gid * WGM, gsz = (nM - fm) < WGM ? (nM - fm) : WGM;
        u.pm = fm + ((wgid % nig) % gsz); u.pn = (wgid % nig) / gsz; return true;
    }
    __device__ __forceinline__ void a_ready(const Unit&) const {}
    __device__ __forceinline__ void done(const Unit&) const {}
};
template <class Epi, class Sched, bool ALIGN_EPI = false, bool SP2 = false>
__device__ __forceinline__ void gemm_phase(PG8_LAS unsigned char* lds, const Gemm g, const Sched& S, const Epi& E) {
    const int tid = threadIdx.x, wid = __builtin_amdgcn_readfirstlane(tid >> 6), lane = tid & 63, wr = wid >> 2, wc = wid & 3, fr = lane & 15, fq = lane >> 4;
    const int K = g.K, nt = K / BK;
    unsigned voffA[2], voffB[2];
#pragma unroll
    for (int i = 0; i < 2; ++i) { int R, C; stage_rc(tid * 16 + i * 8192, R, C); const int Rb = Epi::PERM ? ((R & ~31) + perm32(R & 31)) : R;
        voffA[i] = (unsigned)(R * K + C) * 2u; voffB[i] = (unsigned)(Rb * K + C) * 2u; }
    const size_t kstep = (size_t)(BK * 2);
    const size_t hstep = (size_t)HALF * K * 2;
    const size_t tstep = 2 * hstep;
    const unsigned ldsw = (unsigned)wid * 1024u;
    const int aoff = lds_byte(wr * 64 + fr, fq * 8), boff = lds_byte(wc * 32 + fr, fq * 8);
#define PG8_SA(b, h) (((b) * 2 + (h)) * HTB)
#define PG8_SB(b, h) ((4 + (b) * 2 + (h)) * HTB)
#define PG8_STAGE(bufoff, gbase, voff) do { _Pragma("unroll") for (int _i = 0; _i < 2; ++_i) \
        __builtin_amdgcn_global_load_lds((const unsigned*)((const char*)(gbase) + (voff)[_i]), (PG8_LAS unsigned*)(lds + (bufoff) + ldsw + _i * 8192), 16, 0, 0); } while (0)
#define PG8_LDA(dst, b, h) do { _Pragma("unroll") for (int m = 0; m < 4; ++m) _Pragma("unroll") for (int k = 0; k < 2; ++k) dst[m][k] = *(const PG8_LAS bf16x8*)(lds + PG8_SA(b, h) + aoff + m * 2048 + k * 1024); } while (0)
#define PG8_LDB(dst, b, h) do { _Pragma("unroll") for (int n = 0; n < 2; ++n) _Pragma("unroll") for (int k = 0; k < 2; ++k) dst[n][k] = *(const PG8_LAS bf16x8*)(lds + PG8_SB(b, h) + boff + n * 2048 + k * 1024); } while (0)
#define PG8_MMA(ai, bj, At, Bt) do { __builtin_amdgcn_s_setprio(1); _Pragma("unroll") for (int m = 0; m < 4; ++m) _Pragma("unroll") for (int n = 0; n < 2; ++n) _Pragma("unroll") for (int k = 0; k < 2; ++k) \
        acc[ai][bj][m][n] = __builtin_amdgcn_mfma_f32_16x16x32_bf16(Bt[n][k], At[m][k], acc[ai][bj][m][n], 0, 0, 0); __builtin_amdgcn_s_setprio(0); } while (0)
#define PG8_WAIT_V(n) asm volatile("s_waitcnt vmcnt(" #n ")" ::: "memory")
#define PG8_WAIT_L(n) asm volatile("s_waitcnt lgkmcnt(" #n ")" ::: "memory")
#define PG8_BAR __builtin_amdgcn_s_barrier()
#define PG8_SCHED __builtin_amdgcn_sched_barrier(0)
    Unit cur, nxt; int ui = 0;
    if (!S.next(0, cur)) return;
    f32x4 acc[2][2][4][2];
#pragma unroll
    for (int a = 0; a < 2; ++a)
#pragma unroll
        for (int b = 0; b < 2; ++b)
#pragma unroll
            for (int m = 0; m < 4; ++m)
#pragma unroll
                for (int n = 0; n < 2; ++n) acc[a][b][m][n] = (f32x4){0.f, 0.f, 0.f, 0.f};
    bf16x8 At[4][2], B0[2][2], B1[2][2];
    const char* cA = (const char*)g.A + (size_t)cur.pm * tstep; const char* cB = (const char*)g.Bt + (size_t)cur.pn * tstep;
    S.a_ready(cur);
    if constexpr (SP2) {
        PG8_STAGE(PG8_SB(0, 0), cB, voffB); PG8_STAGE(PG8_SB(0, 1), cB + hstep, voffB); PG8_STAGE(PG8_SA(0, 0), cA, voffA); PG8_STAGE(PG8_SA(0, 1), cA + hstep, voffA);
        if (wr == 1) PG8_BAR;
        PG8_WAIT_V(2); PG8_BAR;
        PG8_STAGE(PG8_SB(1, 0), cB + kstep, voffB); PG8_STAGE(PG8_SA(1, 0), cA + kstep, voffA); PG8_STAGE(PG8_SB(1, 1), cB + hstep + kstep, voffB);
        PG8_WAIT_V(6); PG8_BAR;
    } else {
        PG8_STAGE(PG8_SB(0, 0), cB, voffB); PG8_STAGE(PG8_SA(0, 0), cA, voffA); PG8_STAGE(PG8_SB(0, 1), cB + hstep, voffB); PG8_STAGE(PG8_SA(0, 1), cA + hstep, voffA);
        if (wr == 1) PG8_BAR;
        PG8_WAIT_V(4); PG8_BAR;
        PG8_STAGE(PG8_SB(1, 0), cB + kstep, voffB); PG8_STAGE(PG8_SA(1, 0), cA + kstep, voffA); PG8_STAGE(PG8_SB(1, 1), cB + hstep + kstep, voffB);
        PG8_WAIT_V(6); PG8_BAR;
    }
    for (;;) {
        const bool has_next = S.next(ui + 1, nxt);
        const char* nA = has_next ? (const char*)g.A + (size_t)nxt.pm * tstep : cA; const char* nB = has_next ? (const char*)g.Bt + (size_t)nxt.pn * tstep : cB;
        for (int t = 0; t < nt; t += 2) {
            const bool last = (t == nt - 2);
            const char* a1 = cA + (size_t)(t + 1) * kstep;
            const char* a2 = last ? nA : cA + (size_t)(t + 2) * kstep; const char* b2 = last ? nB : cB + (size_t)(t + 2) * kstep;
            const char* a3 = a2 + kstep; const char* b3 = b2 + kstep;
            if (last && has_next) S.a_ready(nxt);
            if constexpr (SP2) {
            PG8_LDB(B0, 0, 0); PG8_LDB(B1, 0, 1); PG8_SCHED; PG8_LDA(At, 0, 0); PG8_STAGE(PG8_SA(1, 1), a1 + hstep, voffA);
            PG8_WAIT_V(8); PG8_WAIT_L(0); PG8_BAR; PG8_MMA(0, 0, At, B0); PG8_MMA(0, 1, At, B1); PG8_BAR; PG8_SCHED;
            PG8_LDA(At, 0, 1); PG8_STAGE(PG8_SB(0, 0), b2, voffB); PG8_STAGE(PG8_SB(0, 1), b2 + hstep, voffB); PG8_STAGE(PG8_SA(0, 0), a2, voffA);
            PG8_WAIT_V(8); PG8_WAIT_L(0); PG8_BAR; PG8_MMA(1, 0, At, B0); PG8_MMA(1, 1, At, B1); PG8_BAR; PG8_SCHED;
            PG8_LDB(B0, 1, 0); PG8_LDB(B1, 1, 1); PG8_SCHED; PG8_LDA(At, 1, 0); PG8_STAGE(PG8_SA(0, 1), a2 + hstep, voffA);
            PG8_WAIT_V(8); PG8_WAIT_L(0); PG8_BAR; PG8_MMA(0, 0, At, B0); PG8_MMA(0, 1, At, B1); PG8_BAR; PG8_SCHED;
            PG8_LDA(At, 1, 1); PG8_STAGE(PG8_SB(1, 0), b3, voffB); PG8_STAGE(PG8_SB(1, 1), b3 + hstep, voffB); PG8_STAGE(PG8_SA(1, 0), a3, voffA);
            PG8_WAIT_V(8); PG8_WAIT_L(0); PG8_BAR; PG8_MMA(1, 0, At, B0); PG8_MMA(1, 1, At, B1); PG8_BAR; PG8_SCHED;
            } else {
            PG8_LDB(B0, 0, 0); PG8_SCHED; PG8_LDA(At, 0, 0); PG8_STAGE(PG8_SA(1, 1), a1 + hstep, voffA);
            PG8_WAIT_L(8); PG8_BAR; PG8_WAIT_L(0); PG8_MMA(0, 0, At, B0); PG8_BAR; PG8_SCHED;
            PG8_LDB(B1, 0, 1); PG8_STAGE(PG8_SB(0, 0), b2, voffB);
            PG8_BAR; PG8_WAIT_L(0); PG8_MMA(0, 1, At, B1); PG8_BAR;
            PG8_LDA(At, 0, 1); PG8_STAGE(PG8_SA(0, 0), a2, voffA);
            PG8_BAR; PG8_WAIT_L(0); PG8_MMA(1, 0, At, B0); PG8_BAR; PG8_SCHED;
            PG8_STAGE(PG8_SB(0, 1), b2 + hstep, voffB);
            PG8_WAIT_V(6); PG8_BAR; PG8_MMA(1, 1, At, B1); PG8_BAR;
            PG8_LDB(B0, 1, 0); PG8_SCHED; PG8_LDA(At, 1, 0); PG8_STAGE(PG8_SA(0, 1), a2 + hstep, voffA);
            PG8_WAIT_L(8); PG8_BAR; PG8_WAIT_L(0); PG8_MMA(0, 0, At, B0); PG8_BAR; PG8_SCHED;
            PG8_LDB(B1, 1, 1); PG8_STAGE(PG8_SB(1, 0), b3, voffB);
            PG8_BAR; PG8_WAIT_L(0); PG8_MMA(0, 1, At, B1); PG8_BAR;
            PG8_LDA(At, 1, 1); PG8_STAGE(PG8_SA(1, 0), a3, voffA);
            PG8_BAR; PG8_WAIT_L(0); PG8_MMA(1, 0, At, B0); PG8_BAR; PG8_SCHED;
            PG8_STAGE(PG8_SB(1, 1), b3 + hstep, voffB);
            PG8_WAIT_V(6); PG8_BAR; PG8_MMA(1, 1, At, B1); PG8_BAR;
            }
        }
        if constexpr (ALIGN_EPI) { if (wr == 0) PG8_BAR; }
        if constexpr (!Epi::AFTER_DRAIN) { E(acc, cur, wr, wc, fr, fq); S.done(cur); }
        if (!has_next) break;
#pragma unroll
        for (int a = 0; a < 2; ++a)
#pragma unroll
            for (int b = 0; b < 2; ++b)
#pragma unroll
                for (int m = 0; m < 4; ++m)
#pragma unroll
                    for (int n = 0; n < 2; ++n) acc[a][b][m][n] = (f32x4){0.f, 0.f, 0.f, 0.f};
        cur = nxt; cA = nA; cB = nB; ++ui;
        if constexpr (ALIGN_EPI) { if (wr == 1) PG8_BAR; }
    }
    PG8_WAIT_V(0);
    if constexpr (!ALIGN_EPI) { if (wr == 0) PG8_BAR; }
    PG8_BAR;
    if constexpr (Epi::AFTER_DRAIN) { E.fused(acc, cur, wr, wc, fr, fq, lds, wid, lane); S.done(cur); }
#undef PG8_SA
#undef PG8_SB
#undef PG8_STAGE
#undef PG8_LDA
#undef PG8_LDB
#undef PG8_MMA
#undef PG8_WAIT_V
#undef PG8_WAIT_L
#undef PG8_BAR
#undef PG8_SCHED
}
}

#define GAS __attribute__((address_space(1)))
#define LAS __attribute__((address_space(3)))
typedef unsigned short bf16;
typedef unsigned v4u __attribute__((ext_vector_type(4)));
typedef unsigned v2u __attribute__((ext_vector_type(2)));
typedef float f32x4 __attribute__((ext_vector_type(4)));
typedef float f32x2 __attribute__((ext_vector_type(2)));
typedef short bf16x8 __attribute__((ext_vector_type(8)));
typedef __bf16 bf16x2_t __attribute__((ext_vector_type(2)));
#define LDS_WAIT() asm volatile("s_waitcnt lgkmcnt(0)" ::: "memory")
#define VM_WAIT() asm volatile("s_waitcnt vmcnt(0)" ::: "memory")
__device__ __forceinline__ unsigned pk2(float lo, float hi) { f32x2 v = {lo, hi}; bf16x2_t r = __builtin_convertvector(v, bf16x2_t); return __builtin_bit_cast(unsigned, r); }
__device__ __forceinline__ float bflo(unsigned u) { return __builtin_bit_cast(float, u << 16); }
__device__ __forceinline__ float bfhi(unsigned u) { return __builtin_bit_cast(float, u & 0xffff0000u); }
__device__ __forceinline__ float bf2f(bf16 b) { return __builtin_bit_cast(float, ((unsigned)b) << 16); }
__device__ __forceinline__ float wave_sum(float v) {
#pragma unroll
    for (int o = 1; o < 64; o <<= 1) v += __shfl_xor(v, o);
    return v;
}
__device__ __forceinline__ float wave_max(float v) {
#pragma unroll
    for (int o = 1; o < 64; o <<= 1) v = fmaxf(v, __shfl_xor(v, o));
    return v;
}
#define XB_TMO      128
#define XB_XCNT(j)  (256  + 64 * (j))
#define XB_XSUB(j)  (1280 + 64 * (j))
#define XB_XGEN(j)  (2304 + 64 * (j))
#define XB_TOP      3328
#define XB_TOPGEN   3392
#define XCD_BAR_WORDS 3456
#define XB_SPIN_CAP (1u << 23)

__device__ __forceinline__ unsigned xb_ld(unsigned* p)              { return __hip_atomic_load(p, __ATOMIC_RELAXED, __HIP_MEMORY_SCOPE_AGENT); }
__device__ __forceinline__ unsigned xb_add(unsigned* p, unsigned v) { return __hip_atomic_fetch_add(p, v, __ATOMIC_RELAXED, __HIP_MEMORY_SCOPE_AGENT); }
__device__ __forceinline__ unsigned xb_xcc_id() { return (unsigned)__builtin_amdgcn_s_getreg((3 << 11) | 20) & 0xFu; }
#define XB_SPIN(cond, bar) do { unsigned _sp = 0; while (cond) { __builtin_amdgcn_s_sleep(1); \
    if ((++_sp & 255u) == 0u) { if (xb_ld(&(bar)[XB_TMO])) break; if (_sp > XB_SPIN_CAP) { atomicAdd(&(bar)[XB_TMO], 1u); break; } } } } while (0)

struct XcdBarrier {
    unsigned* bar; unsigned x;
    volatile LAS unsigned* st;
};

__device__ __forceinline__ XcdBarrier xcd_barrier_post(unsigned* bar, volatile LAS unsigned* st) {
    XcdBarrier b; b.bar = bar; b.x = xb_xcc_id(); b.st = st;
    if (threadIdx.x == 0) (void)xb_add(&bar[XB_XCNT(b.x)], 1u);
    return b;
}
__device__ __forceinline__ void xcd_barrier_complete(unsigned* bar, unsigned x, unsigned& nloc, unsigned& nx) {
    const unsigned G = gridDim.x * gridDim.y * gridDim.z;
    unsigned sum, cnt, mine, sp = 0u;
    for (;;) {
        sum = 0u; cnt = 0u; mine = 0u;
#pragma unroll
        for (unsigned j = 0; j < 16; ++j) { const unsigned c = xb_ld(&bar[XB_XCNT(j)]); sum += c; cnt += (c > 0u) ? 1u : 0u; mine = (j == x) ? c : mine; }
        if (sum == G) break;
        __builtin_amdgcn_s_sleep(1);
        if ((++sp & 255u) == 0u) { if (xb_ld(&bar[XB_TMO])) break; if (sp > XB_SPIN_CAP) { atomicAdd(&bar[XB_TMO], 1u); break; } }
    }
    nloc = mine > 0u ? mine : 1u; nx = cnt > 0u ? cnt : 1u;
}

__device__ __forceinline__ void xcd_barrier(const XcdBarrier& b) {
    asm volatile("s_waitcnt vmcnt(0)" ::: "memory");
    __syncthreads();
    if (threadIdx.x == 0) {
        unsigned* bar = b.bar;
        __builtin_amdgcn_s_waitcnt(0);
        unsigned nloc = b.st[0], nx = b.st[1];
        if (nloc == 0u) { xcd_barrier_complete(bar, b.x, nloc, nx); b.st[0] = nloc; b.st[1] = nx; }
        const unsigned old = xb_add(&bar[XB_XSUB(b.x)], 1u);
        const unsigned gen = old / nloc;
        if (old + 1u == (gen + 1u) * nloc) {
            __builtin_amdgcn_fence(__ATOMIC_RELEASE, "agent");
            asm volatile("s_waitcnt vmcnt(0)" ::: "memory");
            const unsigned og = xb_add(&bar[XB_TOP], 1u);
            const unsigned tg = og / nx;
            if (og + 1u == (tg + 1u) * nx) xb_add(&bar[XB_TOPGEN], 1u);
            else XB_SPIN(xb_ld(&bar[XB_TOPGEN]) == tg, bar);
            __builtin_amdgcn_fence(__ATOMIC_ACQUIRE, "agent");
            xb_add(&bar[XB_XGEN(b.x)], 1u);
            asm volatile("s_waitcnt vmcnt(0)" ::: "memory");
        } else {
            XB_SPIN(xb_ld(&bar[XB_XGEN(b.x)]) == gen, bar);
            __builtin_amdgcn_fence(__ATOMIC_ACQUIRE, "agent");
            asm volatile("s_waitcnt vmcnt(0)" ::: "memory");
        }
    }
    __syncthreads();
}

constexpr int D = 2048, NB = 4, S = 4096, T = NB * S;
constexpr int HD = 128, FH = 12, FW = 1536, MH = 4, MW = 512, ML = 256;
constexpr int FOX_IN = 6668, FOX_NP = 6912;
constexpr int GLA_IN = 5136, GLA_NP = 5376;
constexpr int GH = 4, GDK = 192, GDV = 384, GKW = 768, GVW = 1536;
constexpr int NE = 32, DE = 1024, MAXROWS = 40960, MAXTILES = 160;
constexpr int FP_Q = 0, FP_K = 1536, FP_V = 3072, FP_OG = 4608, FP_QM = 6144, FP_F = 6656;
constexpr int GP_Q = 0, GP_K = 768, GP_V = 1536, GP_R = 3072, GP_QM = 4608, GP_A = 5120;
constexpr float RMS_EPS = 1e-6f;
constexpr int NWAVES = 8;

constexpr size_t MiB = 1u << 20;
constexpr size_t WS_CTL = 0, CTL_ZERO_BYTES = 1 * MiB;
constexpr size_t WS_ROUTE = 1 * MiB;
constexpr size_t WS_WFOX = 4 * MiB;
constexpr size_t WS_WGLA = WS_WFOX + 27 * MiB;
constexpr size_t WS_WOUT = WS_WGLA + 21 * MiB;
constexpr size_t WS_WMKV = WS_WOUT + 16 * MiB;
constexpr size_t WS_WGU = WS_WMKV + 4 * MiB;
constexpr size_t WS_WD = WS_WGU + 512 * MiB;
constexpr size_t WS_HN = WS_WD + 256 * MiB;
constexpr size_t WS_P = WS_HN + 65 * MiB;
constexpr size_t WS_CAT = WS_P + 216 * MiB;
constexpr size_t WS_XA = WS_CAT + 64 * MiB;
constexpr size_t WS_XB = WS_XA + 128 * MiB;
constexpr size_t WS_XG = WS_XB + 128 * MiB;
constexpr size_t WS_H = WS_XG + 160 * MiB;
constexpr size_t WS_YB = WS_H + 80 * MiB;
constexpr size_t WS_MEMN = WS_YB + 128 * MiB;
constexpr size_t WS_MKV = WS_MEMN + 4 * MiB;
constexpr size_t WS_MK = WS_MKV + 2 * MiB;
constexpr size_t WS_C = WS_MK + 2 * MiB;
constexpr size_t WS_FL = WS_C + 1 * MiB;
constexpr size_t WS_END = WS_FL + 1 * MiB;
constexpr size_t WS_GO = WS_XG, WS_LA = WS_H;
constexpr size_t RT_TOKE = 0;
constexpr size_t RT_TOKS = RT_TOKE + 2 * T * 4;
constexpr size_t RT_TOKW = RT_TOKS + 2 * T * 4;
constexpr size_t RT_ROWDEST = RT_TOKW + 2 * T * 4;
constexpr size_t RT_ROWW = RT_ROWDEST + 2 * MAXROWS * 4;
constexpr size_t RT_TILEE = RT_ROWW + MAXROWS * 4;
constexpr size_t RT_END = RT_TILEE + 2 * 256 * 4;
static_assert(RT_END <= 3 * MiB, "routing arrays");
constexpr int CW_BAR = 4096;
constexpr int CW_CNT = 8192;
constexpr int CW_Q0 = 8320, CW_Q1 = 8384;
static_assert((CW_Q1 + 64) * 4 <= (int)CTL_ZERO_BYTES, "ctl");

constexpr int RING_OFF = 0, RING_BYTES = 131072;
constexpr int LDSCTL_OFF = RING_BYTES, MISC_OFF = LDSCTL_OFF + 320;
constexpr int LDS_BYTES = 147456;

namespace pg8 {
struct EpiP {
    static constexpr bool PERM = true, AFTER_DRAIN = false;
    bf16_t* P; int ldp; float* FL; int ftile;
    __device__ __forceinline__ void operator()(const f32x4 (&acc)[2][2][4][2], const Unit& u, int wr, int wc, int fr, int fq) const {
        const int row0 = u.pm * BM + wr * 64 + fr, col0 = u.pn * BM + wc * 32 + 8 * fq;
#pragma unroll
        for (int ai = 0; ai < 2; ++ai)
#pragma unroll
            for (int m = 0; m < 4; ++m) { bf16_t* rowp = P + (size_t)(row0 + ai * HALF + m * 16) * ldp + col0;
#pragma unroll
                for (int bj = 0; bj < 2; ++bj) { const f32x4 v0 = acc[ai][bj][m][0], v1 = acc[ai][bj][m][1];
                    u32x4 w; w.x = pk2(v0[0], v0[1]); w.y = pk2(v0[2], v0[3]); w.z = pk2(v1[0], v1[1]); w.w = pk2(v1[2], v1[3]);
                    *(u32x4*)(rowp + bj * HALF) = w; } }
        if (u.pn == ftile && wc == 0 && fq < 2) {
#pragma unroll
            for (int ai = 0; ai < 2; ++ai)
#pragma unroll
                for (int m = 0; m < 4; ++m) { float* fp = FL + (size_t)(row0 + ai * HALF + m * 16) * 16 + 8 * fq;
                    *(f32x4*)(fp) = acc[ai][0][m][0]; *(f32x4*)(fp + 4) = acc[ai][0][m][1]; }
        }
    }
};
struct EpiRes {
    static constexpr bool PERM = false, AFTER_DRAIN = false;
    const float* R; float* C; int ldc;
    __device__ __forceinline__ void operator()(const f32x4 (&acc)[2][2][4][2], const Unit& u, int wr, int wc, int fr, int fq) const {
        const int row0 = u.pm * BM + wr * 64 + fr, col0 = u.pn * BM + wc * 32 + 4 * fq;
#pragma unroll
        for (int ai = 0; ai < 2; ++ai)
#pragma unroll
            for (int m = 0; m < 4; ++m) { const size_t ro = (size_t)(row0 + ai * HALF + m * 16) * ldc + col0;
#pragma unroll
                for (int bj = 0; bj < 2; ++bj)
#pragma unroll
                    for (int n = 0; n < 2; ++n) { const f32x4 r = *(const f32x4*)(R + ro + bj * HALF + n * 16); *(f32x4*)(C + ro + bj * HALF + n * 16) = acc[ai][bj][m][n] + r; } }
    }
};
struct EpiGU {
    static constexpr bool PERM = true, AFTER_DRAIN = false;
    bf16_t* H;
    __device__ __forceinline__ void operator()(const f32x4 (&acc)[2][2][4][2], const Unit& u, int wr, int wc, int fr, int fq) const {
        const int row0 = u.pm * BM + wr * 64 + fr, col0 = (u.pn & 7) * HALF + wc * 32 + 8 * fq;
#pragma unroll
        for (int ai = 0; ai < 2; ++ai)
#pragma unroll
            for (int m = 0; m < 4; ++m) { bf16_t* rowp = H + (size_t)(row0 + ai * HALF + m * 16) * 1024 + col0;
                float h[8];
#pragma unroll
                for (int n = 0; n < 2; ++n)
#pragma unroll
                    for (int j = 0; j < 4; ++j) { const float g = acc[ai][0][m][n][j], uu = acc[ai][1][m][n][j]; h[4 * n + j] = g * uu / (1.0f + __expf(-g)); }
                u32x4 w; w.x = pk2(h[0], h[1]); w.y = pk2(h[2], h[3]); w.z = pk2(h[4], h[5]); w.w = pk2(h[6], h[7]);
                *(u32x4*)rowp = w; }
    }
};
struct EpiDown {
    static constexpr bool PERM = true, AFTER_DRAIN = false;
    const int* rowdest; const float* roww; bf16_t* YB;
    __device__ __forceinline__ void operator()(const f32x4 (&acc)[2][2][4][2], const Unit& u, int wr, int wc, int fr, int fq) const {
        const int row0 = u.pm * BM + wr * 64 + fr, col0 = (u.pn & 7) * BM + wc * 32 + 8 * fq;
#pragma unroll
        for (int ai = 0; ai < 2; ++ai)
#pragma unroll
            for (int m = 0; m < 4; ++m) { const int row = row0 + ai * HALF + m * 16; const int dest = rowdest[row];
                if (dest >= 0) { const float w8 = roww[row]; bf16_t* rowp = YB + (size_t)dest * D + col0;
#pragma unroll
                    for (int bj = 0; bj < 2; ++bj) { const f32x4 v0 = acc[ai][bj][m][0] * w8, v1 = acc[ai][bj][m][1] * w8;
                        u32x4 w; w.x = pk2(v0[0], v0[1]); w.y = pk2(v0[2], v0[3]); w.z = pk2(v1[0], v1[1]); w.w = pk2(v1[2], v1[3]);
                        *(u32x4*)(rowp + bj * HALF) = w; } } }
    }
};
struct MoeOrder {
    const int* tile_e; int nunits, G, c;
    __device__ __forceinline__ bool next(int i, Unit& u) const {
        const long L = (long)i * G + c; if (L >= nunits) return false;
        const int tile = (int)(L >> 3), pn = (int)(L & 7); u.pm = tile; u.pn = tile_e[tile] * 8 + pn; return true;
    }
    __device__ __forceinline__ void a_ready(const Unit&) const {}
    __device__ __forceinline__ void done(const Unit&) const {}
};
}

struct Ctx {
    LAS unsigned char* lds;
    int tid, lane, wave, gw, NGW, G;
    const float* in[24]; float* out; unsigned char* ws;
};
#define WSP(type, off) ((type*)(C.ws + (off)))

__device__ __forceinline__ void load_row(const float* xrow, int lane, f32x4 (&v)[8]) {
#pragma unroll
    for (int j = 0; j < 8; ++j) v[j] = ((const f32x4*)xrow)[lane + 64 * j];
}
__device__ __forceinline__ float row_inv_rms(const f32x4 (&v)[8]) {
    float s = 0.f;
#pragma unroll
    for (int j = 0; j < 8; ++j) s += (v[j].x * v[j].x + v[j].y * v[j].y) + (v[j].z * v[j].z + v[j].w * v[j].w);
    s = wave_sum(s);
    return 1.0f / sqrtf(s * (1.0f / D) + RMS_EPS);
}
__device__ __forceinline__ void norm_store_row(bf16* orow, f32x4 (&v)[8], float inv, const float* g, int lane) {
#pragma unroll
    for (int j = 0; j < 8; ++j) { const f32x4 gg = ((const f32x4*)g)[lane + 64 * j]; v[j] = v[j] * inv * gg;
        v2u o; o.x = pk2(v[j].x, v[j].y); o.y = pk2(v[j].z, v[j].w); ((v2u*)orow)[lane + 64 * j] = o; }
}

__device__ __forceinline__ void tr_item(const float* W, int ldn, int K, bf16* WT, int drow, int k0, int n0, LAS float* scr, int lane) {
#pragma unroll 8
    for (int i = 0; i < 32; ++i) { const int kk = 2 * i + (lane >> 5); scr[kk * 33 + (lane & 31)] = W[(size_t)(k0 + kk) * ldn + n0 + (lane & 31)]; }
    LDS_WAIT(); asm volatile("" ::: "memory");
    const int c = lane & 7;
#pragma unroll
    for (int j = 0; j < 4; ++j) { const int n = (lane >> 3) + 8 * j; const LAS float* s = scr + (8 * c) * 33 + n;
        v4u o; o.x = pk2(s[0 * 33], s[1 * 33]); o.y = pk2(s[2 * 33], s[3 * 33]); o.z = pk2(s[4 * 33], s[5 * 33]); o.w = pk2(s[6 * 33], s[7 * 33]);
        *(v4u*)(WT + (size_t)(drow + n) * K + k0 + 8 * c) = o; }
    LDS_WAIT(); asm volatile("" ::: "memory");
}
__device__ __forceinline__ bool tr_group(int& r, const float* W, int ldn, int K, int c0, int nblk, bf16* WT, int drow0, LAS float* scr, int lane) {
    const int cnt = (K / 64) * nblk;
    if (r < cnt) { const int kb = r / nblk, nb = r % nblk; tr_item(W + c0, ldn, K, WT, drow0 + 32 * nb, 64 * kb, 32 * nb, scr, lane); return true; }
    r -= cnt; return false;
}
__device__ __forceinline__ void p0_prologue(const Ctx& C) {
    LAS float* scr = (LAS float*)(C.lds + RING_OFF + C.wave * 16384);
    const int lane = C.lane;
    constexpr int MOE_ITEMS = 64 * 3 * 1024;
    for (int it = C.gw; it < MOE_ITEMS; it += C.NGW) {
        const int le = it / 3072, rem = it % 3072, kind = rem >> 10, r = rem & 1023;
        if (kind < 2) {
            const float* W = (kind == 0 ? C.in[21] : C.in[22]) + (size_t)le * 2048 * 1024;
            const int kb = r >> 5, nb = r & 31, n0 = 32 * nb;
            bf16* WT = WSP(bf16, WS_WGU) + (size_t)le * 2048 * 2048;
            tr_item(W, 1024, 2048, WT, 256 * (n0 >> 7) + (n0 & 127) + 128 * kind, 64 * kb, n0, scr, lane);
        } else {
            const float* W = C.in[23] + (size_t)le * 1024 * 2048;
            const int kb = r >> 6, nb = r & 63;
            bf16* WT = WSP(bf16, WS_WD) + (size_t)le * 2048 * 1024;
            tr_item(W, 2048, 1024, WT, 32 * nb, 64 * kb, 32 * nb, scr, lane);
        }
    }
    constexpr int I_FOX = 32 * (192 + 16 + 1), I_GLA = 32 * (144 + 16 + 1), I_WO = 32 * 64, I_MKV = 32 * 32;
    constexpr int OTHER = I_FOX + I_GLA + 2 * I_WO + I_MKV;
    for (int it = C.gw; it < OTHER; it += C.NGW) {
        int r = it;
        if (tr_group(r, C.in[5], FOX_IN, D, 0, 192, WSP(bf16, WS_WFOX), 0, scr, lane)) continue;
        if (tr_group(r, C.in[5], FOX_IN, D, 6156, 16, WSP(bf16, WS_WFOX), FP_QM, scr, lane)) continue;
        if (tr_group(r, C.in[5], FOX_IN, D, 6144, 1, WSP(bf16, WS_WFOX), FP_F, scr, lane)) continue;
        if (tr_group(r, C.in[9], GLA_IN, D, 0, 144, WSP(bf16, WS_WGLA), 0, scr, lane)) continue;
        if (tr_group(r, C.in[9], GLA_IN, D, 4624, 16, WSP(bf16, WS_WGLA), GP_QM, scr, lane)) continue;
        if (tr_group(r, C.in[9], GLA_IN, D, 4608, 1, WSP(bf16, WS_WGLA), GP_A, scr, lane)) continue;
        if (tr_group(r, C.in[15], D, D, 0, 64, WSP(bf16, WS_WOUT), 0, scr, lane)) continue;
        if (tr_group(r, C.in[15] + (size_t)D * D, D, D, 0, 64, WSP(bf16, WS_WOUT) + (size_t)D * D, 0, scr, lane)) continue;
        tr_group(r, C.in[3], 1024, D, 0, 32, WSP(bf16, WS_WMKV), 0, scr, lane);
    }
    for (int m = C.gw; m < T + NB * ML; m += C.NGW) {
        f32x4 v[8];
        if (m < T) { load_row(C.in[0] + (size_t)m * D, lane, v); const float inv = row_inv_rms(v); norm_store_row(WSP(bf16, WS_HN) + (size_t)m * D, v, inv, C.in[4], lane); }
        else { const int r = m - T; load_row(C.in[1] + (size_t)r * D, lane, v); const float inv = row_inv_rms(v); norm_store_row(WSP(bf16, WS_MEMN) + (size_t)r * D, v, inv, C.in[2], lane); }
    }
    { int* rd = (int*)(C.ws + WS_ROUTE + RT_ROWDEST);
      for (int i = blockIdx.x * 512 + C.tid; i < 2 * MAXROWS; i += C.G * 512) rd[i] = -1; }
}

__device__ __forceinline__ float log_sigmoid(float x) { return fminf(x, 0.f) - log1pf(expf(-fabsf(x))); }

__device__ __forceinline__ void headnorm_inplace(bf16* rowp, int col0, int nh, const float* g, int lane) {
    const float g0 = g[2 * lane], g1 = g[2 * lane + 1];
    for (int h = 0; h < nh; ++h) {
        unsigned* p = (unsigned*)(rowp + col0 + h * HD) + lane; const unsigned u = *p; const float a = bflo(u), b = bfhi(u);
        const float ss = wave_sum(a * a + b * b); const float inv = 1.0f / sqrtf(ss * (1.0f / HD) + RMS_EPS);
        *p = pk2(a * inv * g0, b * inv * g1);
    }
}
__device__ __forceinline__ void p3_fox_thin(const Ctx& C) {
    bf16* P = WSP(bf16, WS_P);
    for (int m = C.gw; m < T; m += C.NGW) {
        bf16* rowp = P + (size_t)m * FOX_NP;
        headnorm_inplace(rowp, FP_Q, FH, C.in[7], C.lane);
        headnorm_inplace(rowp, FP_K, FH, C.in[8], C.lane);
        headnorm_inplace(rowp, FP_QM, MH, C.in[13], C.lane);
    }
    for (int it = C.gw; it < NB * ML * MH; it += C.NGW) {
        const int row = it >> 2, mh = it & 3;
        const unsigned u = *((const unsigned*)(WSP(bf16, WS_MKV) + (size_t)row * 1024 + mh * HD) + C.lane); const float a = bflo(u), b = bfhi(u);
        const float ss = wave_sum(a * a + b * b); const float inv = 1.0f / sqrtf(ss * (1.0f / HD) + RMS_EPS);
#pragma unroll
        for (int l = 0; l < 2; ++l) { const float* g = C.in[14] + l * HD;
            *((unsigned*)(WSP(bf16, WS_MK) + (size_t)l * 1024 * 512 + (size_t)row * 512 + mh * HD) + C.lane) = pk2(a * inv * g[2 * C.lane], b * inv * g[2 * C.lane + 1]); }
    }
    LAS float* sm = (LAS float*)(C.lds + RING_OFF);
    for (int bh = blockIdx.x; bh < NB * FH; bh += C.G) {
        const int b = bh / FH, h = bh % FH; const float bf = C.in[6][h];
        const float* fl = WSP(float, WS_FL) + (size_t)(b * S) * 16 + h;
        float ls[8], tot = 0.f;
#pragma unroll
        for (int i = 0; i < 8; ++i) { ls[i] = log_sigmoid(fl[(size_t)(8 * C.tid + i) * 16] + bf); tot += ls[i]; ls[i] = tot; }
        float inc = tot;
#pragma unroll
        for (int o = 1; o < 64; o <<= 1) { const float t = __shfl_up(inc, o); if (C.lane >= o) inc += t; }
        __syncthreads();
        if (C.lane == 63) sm[C.wave] = inc;
        __syncthreads();
        float woff = 0.f;
        for (int w = 0; w < C.wave; ++w) woff += sm[w];
        const float excl = woff + inc - tot;
        float* cp = WSP(float, WS_C) + (size_t)bh * S + 8 * C.tid;
#pragma unroll
        for (int i = 0; i < 8; ++i) cp[i] = excl + ls[i];
    }
}

__device__ __forceinline__ void naive_attn_row(const bf16* qptr, const bf16* Kb, int kstride, const bf16* Vb, int vstride, int nk, const float* cptr, float ct,
                                               LAS float* qs, int lane, float& o0, float& o1) {
    { const unsigned qq = *((const unsigned*)qptr + lane); qs[2 * lane] = bflo(qq); qs[2 * lane + 1] = bfhi(qq); }
    LDS_WAIT(); asm volatile("" ::: "memory");
    float m = -1e30f, l = 0.f, a0 = 0.f, a1 = 0.f;
    for (int j0 = 0; j0 < nk; j0 += 64) {
        const int j = j0 + lane; const bool valid = j < nk; const int jc = valid ? j : nk - 1;
        const bf16* kr = Kb + (size_t)jc * kstride;
        float s = 0.f;
#pragma unroll 4
        for (int d8 = 0; d8 < 16; ++d8) {
            const v4u kk = *(const v4u*)(kr + 8 * d8);
            const f32x4 qa = *(const LAS f32x4*)(qs + 8 * d8), qb = *(const LAS f32x4*)(qs + 8 * d8 + 4);
            s += bflo(kk.x) * qa.x + bfhi(kk.x) * qa.y + bflo(kk.y) * qa.z + bfhi(kk.y) * qa.w + bflo(kk.z) * qb.x + bfhi(kk.z) * qb.y + bflo(kk.w) * qb.z + bfhi(kk.w) * qb.w;
        }
        s *= 0.08838834764831845f;
        if (cptr) s += ct - cptr[jc];
        if (!valid) s = -__builtin_inff();
        const float mn = fmaxf(m, wave_max(s)); const float alpha = expf(m - mn); const float p = valid ? expf(s - mn) : 0.f;
        l = l * alpha + wave_sum(p); a0 *= alpha; a1 *= alpha; m = mn;
        const int cnt = (nk - j0) < 64 ? (nk - j0) : 64;
        for (int jj = 0; jj < cnt; ++jj) { const float pj = __shfl(p, jj); const unsigned vv = *((const unsigned*)(Vb + (size_t)(j0 + jj) * vstride) + lane); a0 += pj * bflo(vv); a1 += pj * bfhi(vv); }
    }
    o0 = a0 / l; o1 = a1 / l;
    asm volatile("" ::: "memory");
}
__device__ __forceinline__ void naive_mem_attn(const Ctx& C, const bf16* P, int ldp, int qcol, int layer, int row, int mh, LAS float* qs) {
    const int b = row / S; float o0, o1;
    naive_attn_row(P + (size_t)row * ldp + qcol + mh * HD, WSP(bf16, WS_MK) + (size_t)layer * 1024 * 512 + (size_t)(b * ML) * 512 + mh * HD, 512,
                   WSP(bf16, WS_MKV) + (size_t)(b * ML) * 1024 + 512 + mh * HD, 1024, ML, nullptr, 0.f, qs, C.lane, o0, o1);
    *((unsigned*)(WSP(bf16, WS_CAT) + (size_t)row * D + FW + mh * HD) + C.lane) = pk2(o0, o1);
}
__device__ __forceinline__ void p4_fox_attn_naive(const Ctx& C) {
    LAS float* qs = (LAS float*)(C.lds + RING_OFF + C.wave * 16384);
    const bf16* P = WSP(bf16, WS_P);
    for (int it = C.gw; it < T * 16; it += C.NGW) {
        const int hh = it / T, row = it % T;
        if (hh < FH) {
            const int b = row / S, t = row % S; float o0, o1;
            const float* cp = WSP(float, WS_C) + (size_t)(b * FH + hh) * S;
            naive_attn_row(P + (size_t)row * FOX_NP + FP_Q + hh * HD, P + (size_t)(b * S) * FOX_NP + FP_K + hh * HD, FOX_NP, P + (size_t)(b * S) * FOX_NP + FP_V + hh * HD, FOX_NP,
                           t + 1, cp, cp[t], qs, C.lane, o0, o1);
            const unsigned og = *((const unsigned*)(P + (size_t)row * FOX_NP + FP_OG + hh * HD) + C.lane);
            const float g0 = 1.0f / (1.0f + expf(-bflo(og))), g1 = 1.0f / (1.0f + expf(-bfhi(og)));
            *((unsigned*)(WSP(bf16, WS_CAT) + (size_t)row * D + hh * HD) + C.lane) = pk2(o0 * g0, o1 * g1);
        } else naive_mem_attn(C, P, FOX_NP, FP_QM, 0, row, hh - FH, qs);
    }
}

__device__ __forceinline__ void p12_gla_thin(const Ctx& C) {
    bf16* P = WSP(bf16, WS_P);
    const float* w2 = C.in[10]; const float* ba = C.in[11];
    for (int m = C.gw; m < T; m += C.NGW) {
        headnorm_inplace(P + (size_t)m * GLA_NP, GP_QM, MH, C.in[13] + HD, C.lane);
        const float* fl = WSP(float, WS_FL) + (size_t)m * 16;
        float al[16];
#pragma unroll
        for (int r = 0; r < 16; ++r) al[r] = fl[r];
        float* la = WSP(float, WS_LA) + (size_t)m * GKW;
#pragma unroll 1
        for (int j = 0; j < 12; ++j) { const int c = C.lane + 64 * j; float s = ba[c];
#pragma unroll
            for (int r = 0; r < 16; ++r) s += al[r] * w2[r * GKW + c];
            la[c] = expf(log_sigmoid(s) * (1.0f / 16.0f)); }
    }
}
__device__ __forceinline__ void p13_gla_naive(const Ctx& C) {
    const bf16* P = WSP(bf16, WS_P); const float* LA = WSP(float, WS_LA); float* GO = WSP(float, WS_GO);
    const int lane = C.lane;
    for (int it = C.gw; it < NB * GH * 128; it += C.NGW) {
        const int bh = it >> 7, e0 = (it & 127) * 3, b = bh >> 2, h = bh & 3;
        float st[3][3];
#pragma unroll
        for (int i = 0; i < 3; ++i)
#pragma unroll
            for (int e = 0; e < 3; ++e) st[i][e] = 0.f;
        const float qsc = 0.07216878364870322f;
        for (int t0 = 0; t0 < S; t0 += 4) {
            float a[4][3], k[4][3], q[4][3], v[4][3];
#pragma unroll
            for (int u = 0; u < 4; ++u) { const size_t row = (size_t)(b * S + t0 + u);
#pragma unroll
                for (int i = 0; i < 3; ++i) { const int d = lane + 64 * i;
                    a[u][i] = LA[row * GKW + h * GDK + d]; k[u][i] = bf2f(P[row * GLA_NP + GP_K + h * GDK + d]); q[u][i] = bf2f(P[row * GLA_NP + GP_Q + h * GDK + d]) * qsc; }
#pragma unroll
                for (int e = 0; e < 3; ++e) v[u][e] = bf2f(P[row * GLA_NP + GP_V + h * GDV + e0 + e]); }
#pragma unroll
            for (int u = 0; u < 4; ++u) { float o[3] = {0.f, 0.f, 0.f};
#pragma unroll
                for (int i = 0; i < 3; ++i)
#pragma unroll
                    for (int e = 0; e < 3; ++e) { st[i][e] = a[u][i] * st[i][e] + k[u][i] * v[u][e]; o[e] += q[u][i] * st[i][e]; }
#pragma unroll
                for (int e = 0; e < 3; ++e) o[e] = wave_sum(o[e]);
                if (lane < 3) GO[(size_t)(b * S + t0 + u) * GVW + h * GDV + e0 + lane] = lane == 0 ? o[0] : (lane == 1 ? o[1] : o[2]); }
        }
    }
}
__device__ __forceinline__ void p14_gla_onorm(const Ctx& C) {
    const bf16* P = WSP(bf16, WS_P); const float* GO = WSP(float, WS_GO); const float* og = C.in[12];
    for (int m = C.gw; m < T; m += C.NGW) {
#pragma unroll 1
        for (int h = 0; h < GH; ++h) {
            f32x2 x[3]; float ss = 0.f;
#pragma unroll
            for (int i = 0; i < 3; ++i) { x[i] = *((const f32x2*)(GO + (size_t)m * GVW + h * GDV + 128 * i) + C.lane); ss += x[i].x * x[i].x + x[i].y * x[i].y; }
            ss = wave_sum(ss); const float inv = 1.0f / sqrtf(ss * (1.0f / GDV) + RMS_EPS);
#pragma unroll
            for (int i = 0; i < 3; ++i) { const int e = 128 * i + 2 * C.lane;
                const unsigned ru = *((const unsigned*)(P + (size_t)m * GLA_NP + GP_R + h * GDV + 128 * i) + C.lane); const float r0 = bflo(ru), r1 = bfhi(ru);
                const float y0 = x[i].x * inv * og[e] * (r0 / (1.0f + expf(-r0))), y1 = x[i].y * inv * og[e + 1] * (r1 / (1.0f + expf(-r1)));
                *((unsigned*)(WSP(bf16, WS_CAT) + (size_t)m * D + h * GDV + 128 * i) + C.lane) = pk2(y0, y1); }
        }
    }
}

__device__ __forceinline__ void p6_router(const Ctx& C, int layer) {
    const float* X = WSP(float, WS_XB); const float* g = C.in[16] + layer * D;
    const float* wg = C.in[17] + (size_t)layer * D * 4; const float* we = C.in[19] + (size_t)layer * D * 32;
    const float* bg = C.in[18] + layer * 4; const float* be = C.in[20] + layer * 32;
    unsigned* cnt = (unsigned*)(C.ws + WS_CTL) + CW_CNT + layer * 32;
    int* toke = (int*)(C.ws + WS_ROUTE + RT_TOKE); int* toks = (int*)(C.ws + WS_ROUTE + RT_TOKS); float* tokw = (float*)(C.ws + WS_ROUTE + RT_TOKW);
    const int lane = C.lane;
    LAS float* hs = (LAS float*)(C.lds + RING_OFF + C.wave * 16384);
    for (int pr = C.gw; pr < T / 2; pr += C.NGW) {
        {
            f32x4 x0[8], x1[8];
            load_row(X + (size_t)(2 * pr) * D, lane, x0); load_row(X + (size_t)(2 * pr + 1) * D, lane, x1);
            const float i0 = row_inv_rms(x0), i1 = row_inv_rms(x1);
            norm_store_row(WSP(bf16, WS_HN) + (size_t)(2 * pr) * D, x0, i0, g, lane);
            norm_store_row(WSP(bf16, WS_HN) + (size_t)(2 * pr + 1) * D, x1, i1, g, lane);
#pragma unroll
            for (int j = 0; j < 8; ++j) { ((LAS f32x4*)hs)[lane + 64 * j] = x0[j]; ((LAS f32x4*)(hs + D))[lane + 64 * j] = x1[j]; }
        }
        LDS_WAIT(); asm volatile("" ::: "memory");
        float a0[36], a1[36];
#pragma unroll
        for (int n = 0; n < 36; ++n) { a0[n] = 0.f; a1[n] = 0.f; }
#pragma unroll 2
        for (int kk = 0; kk < 32; ++kk) {
            const int k = lane + 64 * kk; const float h0 = hs[k], h1 = hs[D + k];
            const f32x4 w4 = *(const f32x4*)(wg + (size_t)k * 4);
#pragma unroll
            for (int n = 0; n < 4; ++n) { a0[n] += h0 * w4[n]; a1[n] += h1 * w4[n]; }
#pragma unroll
            for (int q = 0; q < 8; ++q) { const f32x4 w = *(const f32x4*)(we + (size_t)k * 32 + 4 * q);
#pragma unroll
                for (int n = 0; n < 4; ++n) { a0[4 + 4 * q + n] += h0 * w[n]; a1[4 + 4 * q + n] += h1 * w[n]; } }
        }
        asm volatile("" ::: "memory");
#pragma unroll
        for (int n = 0; n < 36; ++n) { a0[n] = wave_sum(a0[n]); a1[n] = wave_sum(a1[n]); }
#pragma unroll
        for (int rr = 0; rr < 2; ++rr) {
            float lg[36];
#pragma unroll
            for (int n = 0; n < 36; ++n) lg[n] = rr == 0 ? a0[n] : a1[n];
            float gl[4]; int gi = 0; float gm;
#pragma unroll
            for (int n = 0; n < 4; ++n) gl[n] = lg[n] + bg[n];
            gm = gl[0];
#pragma unroll
            for (int n = 1; n < 4; ++n) if (gl[n] > gm) { gm = gl[n]; gi = n; }
            float gs = 0.f;
#pragma unroll
            for (int n = 0; n < 4; ++n) gs += expf(gl[n] - gm);
            const float gp = 1.0f / gs;
            float ev[8];
#pragma unroll
            for (int j = 0; j < 8; ++j) { const float v0 = lg[4 + j] + be[j], v1 = lg[12 + j] + be[8 + j], v2 = lg[20 + j] + be[16 + j], v3 = lg[28 + j] + be[24 + j];
                ev[j] = gi == 0 ? v0 : (gi == 1 ? v1 : (gi == 2 ? v2 : v3)); }
            int e1 = 0; float m1 = ev[0];
#pragma unroll
            for (int j = 1; j < 8; ++j) if (ev[j] > m1) { m1 = ev[j]; e1 = j; }
            int e2 = -1; float m2 = -__builtin_inff();
#pragma unroll
            for (int j = 0; j < 8; ++j) if (j != e1 && ev[j] > m2) { m2 = ev[j]; e2 = j; }
            const float z = expf(m2 - m1); const float w1 = gp / (1.0f + z), w2 = gp * z / (1.0f + z);
            if (lane == 0) {
                const int tok = 2 * pr + rr; const int id1 = gi * 8 + e1, id2 = gi * 8 + e2;
                const unsigned s1 = atomicAdd(cnt + id1, 1u), s2 = atomicAdd(cnt + id2, 1u);
                toke[2 * tok] = id1; toks[2 * tok] = (int)s1; tokw[2 * tok] = w1;
                toke[2 * tok + 1] = id2; toks[2 * tok + 1] = (int)s2; tokw[2 * tok + 1] = w2;
            }
        }
    }
}
__device__ __forceinline__ void p7_dispatch(const Ctx& C, int layer) {
    const unsigned* cnt = (const unsigned*)(C.ws + WS_CTL) + CW_CNT + layer * 32;
    const int* toke = (const int*)(C.ws + WS_ROUTE + RT_TOKE); const int* toks = (const int*)(C.ws + WS_ROUTE + RT_TOKS); const float* tokw = (const float*)(C.ws + WS_ROUTE + RT_TOKW);
    int* rowdest = (int*)(C.ws + WS_ROUTE + RT_ROWDEST) + layer * MAXROWS; float* roww = (float*)(C.ws + WS_ROUTE + RT_ROWW);
    int* tilee = (int*)(C.ws + WS_ROUTE + RT_TILEE) + layer * 256;
    const int lane = C.lane;
    const int c = lane < NE ? (int)__hip_atomic_load(cnt + lane, __ATOMIC_RELAXED, __HIP_MEMORY_SCOPE_AGENT) : 0;
    const int padded = (c + 255) & ~255;
    int inc = padded;
#pragma unroll
    for (int o = 1; o < 64; o <<= 1) { const int t = __shfl_up(inc, o); if (lane >= o) inc += t; }
    const int pstart = inc - padded;
    if (blockIdx.x == 0 && C.wave == 0) {
        if (lane < NE) for (int tl = pstart >> 8; tl < (pstart + padded) >> 8; ++tl) tilee[tl] = lane;
        if (lane == 63) tilee[255] = inc >> 8;
    }
    const bf16* HN = WSP(bf16, WS_HN); bf16* XG = WSP(bf16, WS_XG);
    for (int a = C.gw; a < 2 * T; a += C.NGW) {
        const int e = toke[a], slot = toks[a]; const int dest = __shfl(pstart, e) + slot;
        const v4u* src = (const v4u*)(HN + (size_t)(a >> 1) * D); v4u* dst = (v4u*)(XG + (size_t)dest * D);
#pragma unroll
        for (int i = 0; i < 4; ++i) dst[lane + 64 * i] = src[lane + 64 * i];
        if (lane == 0) { rowdest[dest] = a; roww[dest] = tokw[a]; }
    }
}
__device__ __forceinline__ void p_combine(const Ctx& C, const float* xi, float* xo, const float* g) {
    const bf16* YB = WSP(bf16, WS_YB);
    for (int m = C.gw; m < T; m += C.NGW) {
        f32x4 v[8]; load_row(xi + (size_t)m * D, C.lane, v);
#pragma unroll
        for (int j = 0; j < 8; ++j) {
            const v2u y0 = ((const v2u*)(YB + (size_t)(2 * m) * D))[C.lane + 64 * j], y1 = ((const v2u*)(YB + (size_t)(2 * m + 1) * D))[C.lane + 64 * j];
            v[j].x += bflo(y0.x) + bflo(y1.x); v[j].y += bfhi(y0.x) + bfhi(y1.x); v[j].z += bflo(y0.y) + bflo(y1.y); v[j].w += bfhi(y0.y) + bfhi(y1.y);
            ((f32x4*)(xo + (size_t)m * D))[C.lane + 64 * j] = v[j];
        }
        if (g) { const float inv = row_inv_rms(v); norm_store_row(WSP(bf16, WS_HN) + (size_t)m * D, v, inv, g, C.lane); }
    }
}

typedef float f32x16 __attribute__((ext_vector_type(16)));
typedef short s16x4 __attribute__((ext_vector_type(4)));
constexpr int AT_K = 0, AT_V = 32768, AT_C = 65536, AT_U = 66560;
constexpr float LOG2E = 1.4426950408889634f;
constexpr float AT_C2 = 0.08838834764831845f * 1.4426950408889634f;
__device__ __forceinline__ unsigned off_b(unsigned row, unsigned ch) { return 256u * row + 16u * (ch ^ (((row & 3u) << 2) | ((row >> 2) & 3u))); }

template <bool FOX>
__device__ __forceinline__ void attn_unit(LAS unsigned char* lds, const bf16* Qb, int ldq, const bf16* Kb, int ldk, const bf16* Vb, int ldv, const float* cb, int qrow0, int nkt,
                                          bf16* Ob, int ldo, const bf16* OGb, int ldog, int tid, int lane, int wave) {
    const int r = lane & 31, h = lane >> 5;
    const int qpos = qrow0 + 32 * wave + r;
    bf16x8 qf[8];
    { const bf16* qp = Qb + (size_t)(32 * wave + r) * ldq + 8 * h;
#pragma unroll
      for (int s = 0; s < 8; ++s) qf[s] = *(const bf16x8*)(qp + 16 * s); }
    const float cq2 = FOX ? cb[qpos] * LOG2E : 0.f;
    f32x16 o[4];
#pragma unroll
    for (int c = 0; c < 4; ++c)
#pragma unroll
        for (int i = 0; i < 16; ++i) o[c][i] = 0.f;
    float m = -1e30f, l = 0.f;
    const int srow = tid >> 4, sch = tid & 15;
    const unsigned so0 = off_b(srow, sch), so1 = off_b(srow + 32, sch);
    const bf16* kg = Kb + (size_t)srow * ldk + 8 * sch; const bf16* vg = Vb + (size_t)srow * ldv + 8 * sch;
    v4u kr0, kr1, vr0, vr1; float cr = 0.f;
#define AT_LOAD(kt) do { const size_t ko = (size_t)(64 * (kt)) * ldk, vo = (size_t)(64 * (kt)) * ldv; \
        kr0 = *(const v4u*)(kg + ko); kr1 = *(const v4u*)(kg + ko + (size_t)32 * ldk); vr0 = *(const v4u*)(vg + vo); vr1 = *(const v4u*)(vg + vo + (size_t)32 * ldv); \
        if (FOX && tid < 64) cr = cb[64 * (kt) + tid] * LOG2E; } while (0)
#define AT_STORE(b) do { *(LAS v4u*)(lds + AT_K + (b) * 16384 + so0) = kr0; *(LAS v4u*)(lds + AT_K + (b) * 16384 + so1) = kr1; \
        *(LAS v4u*)(lds + AT_V + (b) * 16384 + so0) = vr0; *(LAS v4u*)(lds + AT_V + (b) * 16384 + so1) = vr1; \
        if (FOX && tid < 64) *(LAS float*)(lds + AT_C + (b) * 256 + 4 * tid) = cr; } while (0)
    AT_LOAD(0); AT_STORE(0);
    if (nkt > 1) AT_LOAD(1);
    __syncthreads();
    const unsigned kb0 = 256u * r + 16u * ((unsigned)h ^ (((r & 3u) << 2) | ((r >> 2) & 3u)));
    const unsigned tq = (lane & 15) >> 2, tp = lane & 3, tblk = (lane >> 4) & 1;
    const unsigned vb0 = 1024u * h + 256u * tq + 64u * tq + 16u * ((2u * tblk + (tp >> 1)) ^ ((unsigned)h & 3u)) + 8u * (tp & 1);
    const unsigned vb1 = 2048u + 1024u * h + 256u * tq + 64u * tq + 16u * ((2u * tblk + (tp >> 1)) ^ ((2u + (unsigned)h) & 3u)) + 8u * (tp & 1);
    const int minq = qrow0 + 32 * wave;
#pragma unroll 1
    for (int kt = 0; kt < nkt; ++kt) {
        const int b = kt & 1;
        const bool active = !FOX || (64 * kt <= minq + 31);
        if (active) {
            f32x16 p0, p1;
#pragma unroll
            for (int i = 0; i < 16; ++i) { p0[i] = 0.f; p1[i] = 0.f; }
            const LAS unsigned char* kbuf = lds + AT_K + b * 16384;
#pragma unroll
            for (int s = 0; s < 8; ++s) {
                const bf16x8 a0 = *(const LAS bf16x8*)(kbuf + (kb0 ^ (32u * s))), a1 = *(const LAS bf16x8*)(kbuf + (kb0 ^ (32u * s)) + 8192);
                p0 = __builtin_amdgcn_mfma_f32_32x32x16_bf16(a0, qf[s], p0, 0, 0, 0);
                p1 = __builtin_amdgcn_mfma_f32_32x32x16_bf16(a1, qf[s], p1, 0, 0, 0);
            }
            if (FOX) {
                const LAS float* cbuf = (const LAS float*)(lds + AT_C + b * 256);
#pragma unroll
                for (int g = 0; g < 4; ++g) { const f32x4 c0 = *(const LAS f32x4*)(cbuf + 8 * g + 4 * h), c1 = *(const LAS f32x4*)(cbuf + 32 + 8 * g + 4 * h);
#pragma unroll
                    for (int j = 0; j < 4; ++j) { p0[4 * g + j] = fmaf(p0[4 * g + j], AT_C2, cq2 - c0[j]); p1[4 * g + j] = fmaf(p1[4 * g + j], AT_C2, cq2 - c1[j]); } }
                if (64 * kt + 63 > minq) {
                    const int dq = qpos - 64 * kt - 4 * h;
#pragma unroll
                    for (int i = 0; i < 16; ++i) { const int ci = (i & 3) + 8 * (i >> 2);
                        if (ci > dq) p0[i] = -__builtin_inff();
                        if (ci + 32 > dq) p1[i] = -__builtin_inff(); }
                }
            } else {
#pragma unroll
                for (int i = 0; i < 16; ++i) { p0[i] *= AT_C2; p1[i] *= AT_C2; }
            }
            float pmax = p0[0];
#pragma unroll
            for (int i = 1; i < 16; ++i) pmax = fmaxf(pmax, p0[i]);
#pragma unroll
            for (int i = 0; i < 16; ++i) pmax = fmaxf(pmax, p1[i]);
            pmax = fmaxf(pmax, __shfl_xor(pmax, 32));
            const float mn = fmaxf(m, pmax), alpha = __builtin_amdgcn_exp2f(m - mn);
            m = mn;
            float ps = 0.f;
#pragma unroll
            for (int i = 0; i < 16; ++i) { p0[i] = __builtin_amdgcn_exp2f(p0[i] - mn); p1[i] = __builtin_amdgcn_exp2f(p1[i] - mn); ps += p0[i] + p1[i]; }
            ps += __shfl_xor(ps, 32);
            l = l * alpha + ps;
#pragma unroll
            for (int c = 0; c < 4; ++c)
#pragma unroll
                for (int i = 0; i < 16; ++i) o[c][i] *= alpha;
            bf16x8 pf[4];
#pragma unroll
            for (int s = 0; s < 2; ++s) {
                v4u w0, w1;
                w0.x = pk2(p0[8 * s], p0[8 * s + 1]); w0.y = pk2(p0[8 * s + 2], p0[8 * s + 3]); w0.z = pk2(p0[8 * s + 4], p0[8 * s + 5]); w0.w = pk2(p0[8 * s + 6], p0[8 * s + 7]);
                w1.x = pk2(p1[8 * s], p1[8 * s + 1]); w1.y = pk2(p1[8 * s + 2], p1[8 * s + 3]); w1.z = pk2(p1[8 * s + 4], p1[8 * s + 5]); w1.w = pk2(p1[8 * s + 6], p1[8 * s + 7]);
                pf[s] = __builtin_bit_cast(bf16x8, w0); pf[2 + s] = __builtin_bit_cast(bf16x8, w1);
            }
            const LAS unsigned char* vbuf = lds + AT_V + b * 16384;
#pragma unroll
            for (int ks = 0; ks < 4; ++ks)
#pragma unroll
                for (int c = 0; c < 4; ++c) {
                    const s16x4 lo = __builtin_amdgcn_ds_read_tr16_b64_v4i16((LAS s16x4*)(vbuf + ((vb0 ^ (64u * c)) + 4096u * ks)));
                    const s16x4 hi = __builtin_amdgcn_ds_read_tr16_b64_v4i16((LAS s16x4*)(vbuf + ((vb1 ^ (64u * c)) + 4096u * ks)));
                    const bf16x8 vf = __builtin_shufflevector(lo, hi, 0, 1, 2, 3, 4, 5, 6, 7);
                    o[c] = __builtin_amdgcn_mfma_f32_32x32x16_bf16(vf, pf[ks], o[c], 0, 0, 0);
                }
        }
        if (kt + 1 < nkt) { AT_STORE(b ^ 1); if (kt + 2 < nkt) AT_LOAD(kt + 2); }
        __syncthreads();
    }
#undef AT_LOAD
#undef AT_STORE
    const float il = 1.0f / l;
    bf16* orow = Ob + (size_t)(32 * wave + r) * ldo + 4 * h;
    const bf16* grow = FOX ? OGb + (size_t)(32 * wave + r) * ldog + 4 * h : nullptr;
#pragma unroll
    for (int c = 0; c < 4; ++c)
#pragma unroll
        for (int g = 0; g < 4; ++g) {
            float y0 = o[c][4 * g] * il, y1 = o[c][4 * g + 1] * il, y2 = o[c][4 * g + 2] * il, y3 = o[c][4 * g + 3] * il;
            if (FOX) { const v2u gg = *(const v2u*)(grow + 32 * c + 8 * g);
                y0 *= 1.0f / (1.0f + __expf(-bflo(gg.x))); y1 *= 1.0f / (1.0f + __expf(-bfhi(gg.x))); y2 *= 1.0f / (1.0f + __expf(-bflo(gg.y))); y3 *= 1.0f / (1.0f + __expf(-bfhi(gg.y))); }
            v2u w; w.x = pk2(y0, y1); w.y = pk2(y2, y3);
            *(v2u*)(orow + 32 * c + 8 * g) = w;
        }
}
__device__ __forceinline__ void mem_attn_unit(const Ctx& C, int v, const bf16* P, int ldp, int qcol, int layer) {
    const int qblk = v >> 2, mh = v & 3, b = qblk >> 4;
    attn_unit<false>(C.lds + RING_OFF, P + (size_t)(qblk * 256) * ldp + qcol + mh * HD, ldp,
                     WSP(bf16, WS_MK) + (size_t)layer * 1024 * 512 + (size_t)(b * ML) * 512 + mh * HD, 512, WSP(bf16, WS_MKV) + (size_t)(b * ML) * 1024 + 512 + mh * HD, 1024,
                     nullptr, 0, ML / 64, WSP(bf16, WS_CAT) + (size_t)(qblk * 256) * D + FW + mh * HD, D, nullptr, 0, C.tid, C.lane, C.wave);
}
__device__ __forceinline__ void p4_fox_attn(const Ctx& C) {
    const bf16* P = WSP(bf16, WS_P);
    unsigned* ctr = (unsigned*)(C.ws + WS_CTL) + CW_Q0;
    volatile LAS unsigned* uw = (volatile LAS unsigned*)(C.lds + RING_OFF + AT_U);
    for (;;) {
        __syncthreads();
        if (C.tid == 0) *uw = atomicAdd(ctr, 1u);
        __syncthreads();
        const int u = (int)*uw;
        if (u >= 768 + 256) break;
#if !defined(AT_ONLY_MEM)
        if (u < 768) {
            const int qb = 15 - u / 48, bh = u % 48, b = bh / FH, hh = bh % FH;
            const size_t rb = (size_t)(b * S + 256 * qb);
            attn_unit<true>(C.lds + RING_OFF, P + rb * FOX_NP + FP_Q + hh * HD, FOX_NP, P + (size_t)(b * S) * FOX_NP + FP_K + hh * HD, FOX_NP, P + (size_t)(b * S) * FOX_NP + FP_V + hh * HD, FOX_NP,
                           WSP(float, WS_C) + (size_t)bh * S, 256 * qb, 4 * qb + 4, WSP(bf16, WS_CAT) + rb * D + hh * HD, D, P + rb * FOX_NP + FP_OG + hh * HD, FOX_NP, C.tid, C.lane, C.wave);
        } else
#endif
#if !defined(AT_ONLY_FOX)
        mem_attn_unit(C, u - 768, P, FOX_NP, FP_QM, 0);
#else
        {}
#endif
    }
}

__device__ __forceinline__ void p13_mem_attn(const Ctx& C) {
    const bf16* P = WSP(bf16, WS_P);
    unsigned* ctr = (unsigned*)(C.ws + WS_CTL) + CW_Q1;
    volatile LAS unsigned* uw = (volatile LAS unsigned*)(C.lds + RING_OFF + AT_U);
    for (;;) {
        __syncthreads();
        if (C.tid == 0) *uw = atomicAdd(ctr, 1u);
        __syncthreads();
        const int u = (int)*uw;
        if (u >= 256) break;
        mem_attn_unit(C, u, P, GLA_NP, GP_QM, 1);
    }
}

constexpr int NPHASE = 21;
struct Args { const float* in[24]; float* out; unsigned char* ws; int ph_lo, ph_hi; };
#define PG8_ALIGN true
#define PG8_SP2 true

template <class Epi, class Sched>
__device__ __forceinline__ void run_gemm(const Ctx& C, const bf16* A, const bf16* Bt, int K, const Sched& Sd, const Epi& E) {
    pg8::Gemm g{A, Bt, 0, 0, K};
    pg8::gemm_phase<Epi, Sched, PG8_ALIGN, PG8_SP2>(C.lds + RING_OFF, g, Sd, E);
}
__device__ __forceinline__ void dense_gemm_p(const Ctx& C, const bf16* A, const bf16* Bt, int M, int N, int K, bf16* P, int ldp, float* FL, int ftile) {
    pg8::StaticOrder Sd; Sd.init(M, N, C.G, (int)blockIdx.x); pg8::EpiP E{P, ldp, FL, ftile}; run_gemm(C, A, Bt, K, Sd, E);
}
__device__ __forceinline__ void ph_wout(const Ctx& C, int layer) {
    pg8::StaticOrder Sd; Sd.init(T, D, C.G, (int)blockIdx.x);
    pg8::EpiRes E{layer == 0 ? C.in[0] : WSP(float, WS_XA), WSP(float, WS_XB), D};
    run_gemm(C, WSP(bf16, WS_CAT), WSP(bf16, WS_WOUT) + (size_t)layer * D * D, D, Sd, E);
}
__device__ __forceinline__ void ph_gu(const Ctx& C, int layer) {
    const int* tilee = (const int*)(C.ws + WS_ROUTE + RT_TILEE) + layer * 256;
    pg8::MoeOrder Sd{tilee, tilee[255] * 8, C.G, (int)blockIdx.x}; pg8::EpiGU E{WSP(bf16, WS_H)};
    run_gemm(C, WSP(bf16, WS_XG), WSP(bf16, WS_WGU) + (size_t)layer * NE * 2048 * 2048, D, Sd, E);
}
__device__ __forceinline__ void ph_down(const Ctx& C, int layer) {
    const int* tilee = (const int*)(C.ws + WS_ROUTE + RT_TILEE) + layer * 256;
    pg8::MoeOrder Sd{tilee, tilee[255] * 8, C.G, (int)blockIdx.x};
    pg8::EpiDown E{(const int*)(C.ws + WS_ROUTE + RT_ROWDEST) + layer * MAXROWS, (const float*)(C.ws + WS_ROUTE + RT_ROWW), WSP(bf16, WS_YB)};
    run_gemm(C, WSP(bf16, WS_H), WSP(bf16, WS_WD) + (size_t)layer * NE * 2048 * 1024, DE, Sd, E);
}

__global__ void __launch_bounds__(NWAVES * 64, 2) fwd_kernel(Args args) {
    extern __shared__ __attribute__((aligned(16))) unsigned char lds[];
    Ctx C;
    C.lds = (LAS unsigned char*)lds;
    C.tid = threadIdx.x; C.lane = C.tid & 63; C.wave = __builtin_amdgcn_readfirstlane(C.tid >> 6);
    C.G = gridDim.x; C.gw = blockIdx.x * NWAVES + C.wave; C.NGW = C.G * NWAVES;
#pragma unroll
    for (int i = 0; i < 24; ++i) C.in[i] = args.in[i];
    C.out = args.out; C.ws = args.ws;
    volatile LAS unsigned* MISC = (volatile LAS unsigned*)(C.lds + MISC_OFF);
    for (int u = C.tid; u < (LDS_BYTES - LDSCTL_OFF) / 4; u += NWAVES * 64) ((LAS unsigned*)(C.lds + LDSCTL_OFF))[u] = 0u;
    __syncthreads();
    const int lo = args.ph_lo, hi = args.ph_hi;
    XcdBarrier bar; bar.bar = (unsigned*)(C.ws + WS_CTL) + CW_BAR; bar.x = 0; bar.st = nullptr;
    if (hi - lo > 1) bar = xcd_barrier_post((unsigned*)(C.ws + WS_CTL) + CW_BAR, MISC + 8);
#ifndef PHSEL
#define PHSEL 0xFFFFFFFFu
#endif
#define SITE(s) ((PHSEL >> (s)) & 1u)
#define IN(k) (lo <= (k) && (k) < hi)
#define SEAM(k) do { if (IN(k) && IN((k) + 1)) xcd_barrier(bar); } while (0)

    if (SITE(0) && IN(0)) p0_prologue(C);
    SEAM(0);
    if (SITE(1) && IN(1)) dense_gemm_p(C, WSP(bf16, WS_MEMN), WSP(bf16, WS_WMKV), NB * ML, 1024, D, WSP(bf16, WS_MKV), 1024, nullptr, -1);
    SEAM(1);
    if (SITE(2) && IN(2)) dense_gemm_p(C, WSP(bf16, WS_HN), WSP(bf16, WS_WFOX), T, FOX_NP, D, WSP(bf16, WS_P), FOX_NP, WSP(float, WS_FL), FP_F / 256);
    SEAM(2);
    if (SITE(3) && IN(3)) p3_fox_thin(C);
    SEAM(3);
    if (SITE(4) && IN(4)) p4_fox_attn(C);
    SEAM(4);
    if (SITE(5) && IN(5)) ph_wout(C, 0);
    SEAM(5);
    if (SITE(6) && IN(6)) p6_router(C, 0);
    SEAM(6);
    if (SITE(7) && IN(7)) p7_dispatch(C, 0);
    SEAM(7);
    if (SITE(8) && IN(8)) ph_gu(C, 0);
    SEAM(8);
    if (SITE(9) && IN(9)) ph_down(C, 0);
    SEAM(9);
    if (SITE(10) && IN(10)) p_combine(C, WSP(float, WS_XB), WSP(float, WS_XA), C.in[4] + D);
    SEAM(10);
    if (SITE(11) && IN(11)) dense_gemm_p(C, WSP(bf16, WS_HN), WSP(bf16, WS_WGLA), T, GLA_NP, D, WSP(bf16, WS_P), GLA_NP, WSP(float, WS_FL), GP_A / 256);
    SEAM(11);
    if (SITE(12) && IN(12)) p12_gla_thin(C);
    SEAM(12);
    if (SITE(13) && IN(13)) { p13_gla_naive(C); p13_mem_attn(C); }
    SEAM(13);
    if (SITE(14) && IN(14)) p14_gla_onorm(C);
    SEAM(14);
    if (SITE(15) && IN(15)) ph_wout(C, 1);
    SEAM(15);
    if (SITE(16) && IN(16)) p6_router(C, 1);
    SEAM(16);
    if (SITE(17) && IN(17)) p7_dispatch(C, 1);
    SEAM(17);
    if (SITE(18) && IN(18)) ph_gu(C, 1);
    SEAM(18);
    if (SITE(19) && IN(19)) ph_down(C, 1);
    SEAM(19);
    if (SITE(20) && IN(20)) p_combine(C, WSP(float, WS_XB), C.out, nullptr);
#undef IN
#undef SEAM
}

extern "C" void kernel_launch(void* const* d_in, const int* in_sizes, int n_in, void* d_out, int out_size, void* d_ws, size_t ws_size, hipStream_t stream) {
    static int grid = 0;
    if (grid == 0) {
        if (n_in != 24 || out_size != T * D || ws_size < WS_END) { fprintf(stderr, "kernel_launch: unexpected problem (n_in %d, out %d, ws %zu < %zu)\n", n_in, out_size, ws_size, (size_t)WS_END); grid = -1; return; }
        int dev = 0, cus = 0, per_cu = 0;
        if (hipGetDevice(&dev) != hipSuccess || hipDeviceGetAttribute(&cus, hipDeviceAttributeMultiprocessorCount, dev) != hipSuccess) { grid = -1; return; }
        if (hipFuncSetAttribute((const void*)fwd_kernel, hipFuncAttributeMaxDynamicSharedMemorySize, LDS_BYTES) != hipSuccess) { fprintf(stderr, "kernel_launch: hipFuncSetAttribute failed\n"); grid = -1; return; }
        if (hipOccupancyMaxActiveBlocksPerMultiprocessor(&per_cu, (const void*)fwd_kernel, NWAVES * 64, LDS_BYTES) != hipSuccess || per_cu < 1)
            fprintf(stderr, "kernel_launch: occupancy query reports %d workgroups per CU\n", per_cu);
        (void)hipGetLastError();
        grid = cus;
    }
    if (grid < 0) return;
    if (hipMemsetAsync((char*)d_ws + WS_CTL, 0, CTL_ZERO_BYTES, stream) != hipSuccess) return;
    Args a{};
    for (int i = 0; i < 24; ++i) a.in[i] = (const float*)d_in[i];
    a.out = (float*)d_out; a.ws = (unsigned char*)d_ws;
#if MK_N_LAUNCHES == 1
    a.ph_lo = 0; a.ph_hi = NPHASE;
    hipLaunchKernelGGL(fwd_kernel, dim3(grid), dim3(NWAVES * 64), LDS_BYTES, stream, a);
#else
    for (int p = 0; p < NPHASE; ++p) { a.ph_lo = p; a.ph_hi = p + 1; hipLaunchKernelGGL(fwd_kernel, dim3(grid), dim3(NWAVES * 64), LDS_BYTES, stream, a); }
#endif
}
```

```cpp
#include <hip/hip_runtime.h>
#include <cstdio>
#include <cstdint>
#ifndef MK_N_LAUNCHES
#define MK_N_LAUNCHES 1
#endif
namespace pg8 {
#define PG8_LAS __attribute__((address_space(3)))
typedef unsigned short bf16_t;
typedef short bf16x8 __attribute__((ext_vector_type(8)));
typedef float f32x4 __attribute__((ext_vector_type(4)));
typedef unsigned u32x4 __attribute__((ext_vector_type(4)));
constexpr int BM = 256, BK = 64, HALF = 128, HTB = HALF * BK * 2  , STAGE_BYTES = 8 * HTB, NXCD = 8, WGM = 8;

__host__ __device__ __forceinline__ int lds_byte(int r, int c) { const int st = (r >> 4) * 2 + (c >> 5), rr = r & 15, cc = c & 31, ob = rr * 64 + cc * 2; return st * 1024 + (ob ^ (((ob >> 9) & 1) << 5)); }
__host__ __device__ __forceinline__ void stage_rc(int b, int& R, int& C) { const int st = b / 1024, sb = b % 1024, swz = sb ^ (((sb >> 9) & 1) << 5); R = (st >> 1) * 16 + swz / 64; C = (st & 1) * 32 + (swz % 64) / 2; }
__host__ __device__ __forceinline__ int perm32(int rho) { const int n = rho >> 4, i = rho & 15; return 8 * (i >> 2) + 4 * n + (i & 3); }

struct Unit { int pm, pn; };
struct Gemm { const bf16_t* A; const bf16_t* Bt; int M, N, K; };

struct StaticOrder {
    int nM, nN, nwg, G, c;
    __host__ __device__ void init(int M, int N, int G_, int c_) { nM = M / BM; nN = N / BM; nwg = nM * nN; G = G_; c = c_; }
    __host__ __device__ bool next(int i, Unit& u) const {
        const long L = (long)i * G + c; if (L >= nwg) return false;
        int wgid = (int)L; { const int q = nwg / NXCD, r = nwg % NXCD, xcd = wgid % NXCD, off = wgid / NXCD; wgid = (xcd < r ? xcd * (q + 1) : r * (q + 1) + (xcd - r) * q) + off; }
        const int nig = WGM * nN, gid = wgid / nig, fm = gid * WGM, gsz = (nM - fm) < WGM ? (nM - fm) : WGM;
        u.pm = fm + ((wgid % nig) % gsz); u.pn = (wgid % nig) / gsz; return true;
    }
    __device__ __forceinline__ void a_ready(const Unit&) const {}
    __device__ __forceinline__ void done(const Unit&) const {}
};
template <class Epi, class Sched, bool ALIGN_EPI = false, bool SP2 = false>
__device__ __forceinline__ void gemm_phase(PG8_LAS unsigned char* lds, const Gemm g, const Sched& S, const Epi& E) {
    const int tid = threadIdx.x, wid = __builtin_amdgcn_readfirstlane(tid >> 6), lane = tid & 63, wr = wid >> 2, wc = wid & 3, fr = lane & 15, fq = lane >> 4;
    const int K = g.K, nt = K / BK;
    unsigned voffA[2], voffB[2];
#pragma unroll
    for (int i = 0; i < 2; ++i) { int R, C; stage_rc(tid * 16 + i * 8192, R, C); const int Rb = Epi::PERM ? ((R & ~31) + perm32(R & 31)) : R;
        voffA[i] = (unsigned)(R * K + C) * 2u; voffB[i] = (unsigned)(Rb * K + C) * 2u; }
    const size_t kstep = (size_t)(BK * 2);
    const size_t hstep = (size_t)HALF * K * 2;
    const size_t tstep = 2 * hstep;
    const unsigned ldsw = (unsigned)wid * 1024u;
    const int aoff = lds_byte(wr * 64 + fr, fq * 8), boff = lds_byte(wc * 32 + fr, fq * 8);
#define PG8_SA(b, h) (((b) * 2 + (h)) * HTB)
#define PG8_SB(b, h) ((4 + (b) * 2 + (h)) * HTB)
#define PG8_STAGE(bufoff, gbase, voff) do { _Pragma("unroll") for (int _i = 0; _i < 2; ++_i) \
        __builtin_amdgcn_global_load_lds((const unsigned*)((const char*)(gbase) + (voff)[_i]), (PG8_LAS unsigned*)(lds + (bufoff) + ldsw + _i * 8192), 16, 0, 0); } while (0)
#define PG8_LDA(dst, b, h) do { _Pragma("unroll") for (int m = 0; m < 4; ++m) _Pragma("unroll") for (int k = 0; k < 2; ++k) dst[m][k] = *(const PG8_LAS bf16x8*)(lds + PG8_SA(b, h) + aoff + m * 2048 + k * 1024); } while (0)
#define PG8_LDB(dst, b, h) do { _Pragma("unroll") for (int n = 0; n < 2; ++n) _Pragma("unroll") for (int k = 0; k < 2; ++k) dst[n][k] = *(const PG8_LAS bf16x8*)(lds + PG8_SB(b, h) + boff + n * 2048 + k * 1024); } while (0)
#define PG8_MMA(ai, bj, At, Bt) do { __builtin_amdgcn_s_setprio(1); _Pragma("unroll") for (int m = 0; m < 4; ++m) _Pragma("unroll") for (int n = 0; n < 2; ++n) _Pragma("unroll") for (int k = 0; k < 2; ++k) \
        acc[ai][bj][m][n] = __builtin_amdgcn_mfma_f32_16x16x32_bf16(Bt[n][k], At[m][k], acc[ai][bj][m][n], 0, 0, 0); __builtin_amdgcn_s_setprio(0); } while (0)
#define PG8_WAIT_V(n) asm volatile("s_waitcnt vmcnt(" #n ")" ::: "memory")
#define PG8_WAIT_L(n) asm volatile("s_waitcnt lgkmcnt(" #n ")" ::: "memory")
#define PG8_BAR __builtin_amdgcn_s_barrier()
#define PG8_SCHED __builtin_amdgcn_sched_barrier(0)
    Unit cur, nxt; int ui = 0;
    if (!S.next(0, cur)) return;
    f32x4 acc[2][2][4][2];
#pragma unroll
    for (int a = 0; a < 2; ++a)
#pragma unroll
        for (int b = 0; b < 2; ++b)
#pragma unroll
            for (int m = 0; m < 4; ++m)
#pragma unroll
                for (int n = 0; n < 2; ++n) acc[a][b][m][n] = (f32x4){0.f, 0.f, 0.f, 0.f};
    bf16x8 At[4][2], B0[2][2], B1[2][2];
    const char* cA = (const char*)g.A + (size_t)cur.pm * tstep; const char* cB = (const char*)g.Bt + (size_t)cur.pn * tstep;
    S.a_ready(cur);
    if constexpr (SP2) {
        PG8_STAGE(PG8_SB(0, 0), cB, voffB); PG8_STAGE(PG8_SB(0, 1), cB + hstep, voffB); PG8_STAGE(PG8_SA(0, 0), cA, voffA); PG8_STAGE(PG8_SA(0, 1), cA + hstep, voffA);
        if (wr == 1) PG8_BAR;
        PG8_WAIT_V(2); PG8_BAR;
        PG8_STAGE(PG8_SB(1, 0), cB + kstep, voffB); PG8_STAGE(PG8_SA(1, 0), cA + kstep, voffA); PG8_STAGE(PG8_SB(1, 1), cB + hstep + kstep, voffB);
        PG8_WAIT_V(6); PG8_BAR;
    } else {
        PG8_STAGE(PG8_SB(0, 0), cB, voffB); PG8_STAGE(PG8_SA(0, 0), cA, voffA); PG8_STAGE(PG8_SB(0, 1), cB + hstep, voffB); PG8_STAGE(PG8_SA(0, 1), cA + hstep, voffA);
        if (wr == 1) PG8_BAR;
        PG8_WAIT_V(4); PG8_BAR;
        PG8_STAGE(PG8_SB(1, 0), cB + kstep, voffB); PG8_STAGE(PG8_SA(1, 0), cA + kstep, voffA); PG8_STAGE(PG8_SB(1, 1), cB + hstep + kstep, voffB);
        PG8_WAIT_V(6); PG8_BAR;
    }
    for (;;) {
        const bool has_next = S.next(ui + 1, nxt);
        const char* nA = has_next ? (const char*)g.A + (size_t)nxt.pm * tstep : cA; const char* nB = has_next ? (const char*)g.Bt + (size_t)nxt.pn * tstep : cB;
        for (int t = 0; t < nt; t += 2) {
            const bool last = (t == nt - 2);
            const char* a1 = cA + (size_t)(t + 1) * kstep;
            const char* a2 = last ? nA : cA + (size_t)(t + 2) * kstep; const char* b2 = last ? nB : cB + (size_t)(t + 2) * kstep;
            const char* a3 = a2 + kstep; const char* b3 = b2 + kstep;
            if (last && has_next) S.a_ready(nxt);
            if constexpr (SP2) {
            PG8_LDB(B0, 0, 0); PG8_LDB(B1, 0, 1); PG8_SCHED; PG8_LDA(At, 0, 0); PG8_STAGE(PG8_SA(1, 1), a1 + hstep, voffA);
            PG8_WAIT_V(8); PG8_WAIT_L(0); PG8_BAR; PG8_MMA(0, 0, At, B0); PG8_MMA(0, 1, At, B1); PG8_BAR; PG8_SCHED;
            PG8_LDA(At, 0, 1); PG8_STAGE(PG8_SB(0, 0), b2, voffB); PG8_STAGE(PG8_SB(0, 1), b2 + hstep, voffB); PG8_STAGE(PG8_SA(0, 0), a2, voffA);
            PG8_WAIT_V(8); PG8_WAIT_L(0); PG8_BAR; PG8_MMA(1, 0, At, B0); PG8_MMA(1, 1, At, B1); PG8_BAR; PG8_SCHED;
            PG8_LDB(B0, 1, 0); PG8_LDB(B1, 1, 1); PG8_SCHED; PG8_LDA(At, 1, 0); PG8_STAGE(PG8_SA(0, 1), a2 + hstep, voffA);
            PG8_WAIT_V(8); PG8_WAIT_L(0); PG8_BAR; PG8_MMA(0, 0, At, B0); PG8_MMA(0, 1, At, B1); PG8_BAR; PG8_SCHED;
            PG8_LDA(At, 1, 1); PG8_STAGE(PG8_SB(1, 0), b3, voffB); PG8_STAGE(PG8_SB(1, 1), b3 + hstep, voffB); PG8_STAGE(PG8_SA(1, 0), a3, voffA);
            PG8_WAIT_V(8); PG8_WAIT_L(0); PG8_BAR; PG8_MMA(1, 0, At, B0); PG8_MMA(1, 1, At, B1); PG8_BAR; PG8_SCHED;
            } else {
            PG8_LDB(B0, 0, 0); PG8_SCHED; PG8_LDA(At, 0, 0); PG8_STAGE(PG8_SA(1, 1), a1 + hstep, voffA);
            PG8_WAIT_L(8); PG8_BAR; PG8_WAIT_L(0); PG8_MMA(0, 0, At, B0); PG8_BAR; PG8_SCHED;
            PG8_LDB(B1, 0, 1); PG8_STAGE(PG8_SB(0, 0), b2, voffB);
            PG8_BAR; PG8_WAIT_L(0); PG8_MMA(0, 1, At, B1); PG8_BAR;
            PG8_LDA(At, 0, 1); PG8_STAGE(PG8_SA(0, 0), a2, voffA);
            PG8_BAR; PG8_WAIT_L(0); PG8_MMA(1, 0, At, B0); PG8_BAR; PG8_SCHED;
            PG8_STAGE(PG8_SB(0, 1), b2 + hstep, voffB);
            PG8_WAIT_V(6); PG8_BAR; PG8_MMA(1, 1, At, B1); PG8_BAR;
            PG8_LDB(B0, 1, 0); PG8_SCHED; PG8_LDA(At, 1, 0); PG8_STAGE(PG8_SA(0, 1), a2 + hstep, voffA);
            PG8_WAIT_L(8); PG8_BAR; PG8_WAIT_L(0); PG8_MMA(0, 0, At, B0); PG8_BAR; PG8_SCHED;
            PG8_LDB(B1, 1, 1); PG8_STAGE(PG8_SB(1, 0), b3, voffB);
            PG8_BAR; PG8_WAIT_L(0); PG8_MMA(0, 1, At, B1); PG8_BAR;
            PG8_LDA(At, 1, 1); PG8_STAGE(PG8_SA(1, 0), a3, voffA);
            PG8_BAR; PG8_WAIT_L(0); PG8_MMA(1, 0, At, B0); PG8_BAR; PG8_SCHED;
            PG8_STAGE(PG8_SB(1, 1), b3 + hstep, voffB);
            PG8_WAIT_V(6); PG8_BAR; PG8_MMA(1, 1, At, B1); PG8_BAR;
            }
        }
        if constexpr (ALIGN_EPI) { if (wr == 0) PG8_BAR; }
        if constexpr (!Epi::AFTER_DRAIN) { E(acc, cur, wr, wc, fr, fq); S.done(cur); }
        if (!has_next) break;
#pragma unroll
        for (int a = 0; a < 2; ++a)
#pragma unroll
            for (int b = 0; b < 2; ++b)
#pragma unroll
                for (int m = 0; m < 4; ++m)
#pragma unroll
                    for (int n = 0; n < 2; ++n) acc[a][b][m][n] = (f32x4){0.f, 0.f, 0.f, 0.f};
        cur = nxt; cA = nA; cB = nB; ++ui;
        if constexpr (ALIGN_EPI) { if (wr == 1) PG8_BAR; }
    }
    PG8_WAIT_V(0);
    if constexpr (!ALIGN_EPI) { if (wr == 0) PG8_BAR; }
    PG8_BAR;
    if constexpr (Epi::AFTER_DRAIN) { E.fused(acc, cur, wr, wc, fr, fq, lds, wid, lane); S.done(cur); }
#undef PG8_SA
#undef PG8_SB
#undef PG8_STAGE
#undef PG8_LDA
#undef PG8_LDB
#undef PG8_MMA
#undef PG8_WAIT_V
#undef PG8_WAIT_L
#undef PG8_BAR
#undef PG8_SCHED
}
}

#define GAS __attribute__((address_space(1)))
#define LAS __attribute__((address_space(3)))
typedef unsigned short bf16;
typedef unsigned v4u __attribute__((ext_vector_type(4)));
typedef unsigned v2u __attribute__((ext_vector_type(2)));
typedef float f32x4 __attribute__((ext_vector_type(4)));
typedef float f32x2 __attribute__((ext_vector_type(2)));
typedef short bf16x8 __attribute__((ext_vector_type(8)));
typedef __bf16 bf16x2_t __attribute__((ext_vector_type(2)));
#define LDS_WAIT() asm volatile("s_waitcnt lgkmcnt(0)" ::: "memory")
#define VM_WAIT() asm volatile("s_waitcnt vmcnt(0)" ::: "memory")
__device__ __forceinline__ unsigned pk2(float lo, float hi) { f32x2 v = {lo, hi}; bf16x2_t r = __builtin_convertvector(v, bf16x2_t); return __builtin_bit_cast(unsigned, r); }
__device__ __forceinline__ float bflo(unsigned u) { return __builtin_bit_cast(float, u << 16); }
__device__ __forceinline__ float bfhi(unsigned u) { return __builtin_bit_cast(float, u & 0xffff0000u); }
__device__ __forceinline__ float bf2f(bf16 b) { return __builtin_bit_cast(float, ((unsigned)b) << 16); }
__device__ __forceinline__ float wave_sum(float v) {
#pragma unroll
    for (int o = 1; o < 64; o <<= 1) v += __shfl_xor(v, o);
    return v;
}
__device__ __forceinline__ float wave_max(float v) {
#pragma unroll
    for (int o = 1; o < 64; o <<= 1) v = fmaxf(v, __shfl_xor(v, o));
    return v;
}
#define XB_TMO      128
#define XB_XCNT(j)  (256  + 64 * (j))
#define XB_XSUB(j)  (1280 + 64 * (j))
#define XB_XGEN(j)  (2304 + 64 * (j))
#define XB_TOP      3328
#define XB_TOPGEN   3392
#define XCD_BAR_WORDS 3456
#define XB_SPIN_CAP (1u << 23)

__device__ __forceinline__ unsigned xb_ld(unsigned* p)              { return __hip_atomic_load(p, __ATOMIC_RELAXED, __HIP_MEMORY_SCOPE_AGENT); }
__device__ __forceinline__ unsigned xb_add(unsigned* p, unsigned v) { return __hip_atomic_fetch_add(p, v, __ATOMIC_RELAXED, __HIP_MEMORY_SCOPE_AGENT); }
__device__ __forceinline__ unsigned xb_xcc_id() { return (unsigned)__builtin_amdgcn_s_getreg((3 << 11) | 20) & 0xFu; }
#define XB_SPIN(cond, bar) do { unsigned _sp = 0; while (cond) { __builtin_amdgcn_s_sleep(1); \
    if ((++_sp & 255u) == 0u) { if (xb_ld(&(bar)[XB_TMO])) break; if (_sp > XB_SPIN_CAP) { atomicAdd(&(bar)[XB_TMO], 1u); break; } } } } while (0)

struct XcdBarrier {
    unsigned* bar; unsigned x;
    volatile LAS unsigned* st;
};

__device__ __forceinline__ XcdBarrier xcd_barrier_post(unsigned* bar, volatile LAS unsigned* st) {
    XcdBarrier b; b.bar = bar; b.x = xb_xcc_id(); b.st = st;
    if (threadIdx.x == 0) (void)xb_add(&bar[XB_XCNT(b.x)], 1u);
    return b;
}
__device__ __forceinline__ void xcd_barrier_complete(unsigned* bar, unsigned x, unsigned& nloc, unsigned& nx) {
    const unsigned G = gridDim.x * gridDim.y * gridDim.z;
    unsigned sum, cnt, mine, sp = 0u;
    for (;;) {
        sum = 0u; cnt = 0u; mine = 0u;
#pragma unroll
        for (unsigned j = 0; j < 16; ++j) { const unsigned c = xb_ld(&bar[XB_XCNT(j)]); sum += c; cnt += (c > 0u) ? 1u : 0u; mine = (j == x) ? c : mine; }
        if (sum == G) break;
        __builtin_amdgcn_s_sleep(1);
        if ((++sp & 255u) == 0u) { if (xb_ld(&bar[XB_TMO])) break; if (sp > XB_SPIN_CAP) { atomicAdd(&bar[XB_TMO], 1u); break; } }
    }
    nloc = mine > 0u ? mine : 1u; nx = cnt > 0u ? cnt : 1u;
}

__device__ __forceinline__ void xcd_barrier(const XcdBarrier& b) {
    asm volatile("s_waitcnt vmcnt(0)" ::: "memory");
    __syncthreads();
    if (threadIdx.x == 0) {
        unsigned* bar = b.bar;
        __builtin_amdgcn_s_waitcnt(0);
        unsigned nloc = b.st[0], nx = b.st[1];
        if (nloc == 0u) { xcd_barrier_complete(bar, b.x, nloc, nx); b.st[0] = nloc; b.st[1] = nx; }
        const unsigned old = xb_add(&bar[XB_XSUB(b.x)], 1u);
        const unsigned gen = old / nloc;
        if (old + 1u == (gen + 1u) * nloc) {
            __builtin_amdgcn_fence(__ATOMIC_RELEASE, "agent");
            asm volatile("s_waitcnt vmcnt(0)" ::: "memory");
            const unsigned og = xb_add(&bar[XB_TOP], 1u);
            const unsigned tg = og / nx;
            if (og + 1u == (tg + 1u) * nx) xb_add(&bar[XB_TOPGEN], 1u);
            else XB_SPIN(xb_ld(&bar[XB_TOPGEN]) == tg, bar);
            __builtin_amdgcn_fence(__ATOMIC_ACQUIRE, "agent");
            xb_add(&bar[XB_XGEN(b.x)], 1u);
            asm volatile("s_waitcnt vmcnt(0)" ::: "memory");
        } else {
            XB_SPIN(xb_ld(&bar[XB_XGEN(b.x)]) == gen, bar);
            __builtin_amdgcn_fence(__ATOMIC_ACQUIRE, "agent");
            asm volatile("s_waitcnt vmcnt(0)" ::: "memory");
        }
    }
    __syncthreads();
}

constexpr int D = 2048, NB = 4, S = 4096, T = NB * S;
constexpr int HD = 128, FH = 12, FW = 1536, MH = 4, MW = 512, ML = 256;
constexpr int FOX_IN = 6668, FOX_NP = 6912;
constexpr int GLA_IN = 5136, GLA_NP = 5376;
constexpr int GH = 4, GDK = 192, GDV = 384, GKW = 768, GVW = 1536;
constexpr int NE = 32, DE = 1024, MAXROWS = 40960, MAXTILES = 160;
constexpr int FP_Q = 0, FP_K = 1536, FP_V = 3072, FP_OG = 4608, FP_QM = 6144, FP_F = 6656;
constexpr int GP_Q = 0, GP_K = 768, GP_V = 1536, GP_R = 3072, GP_QM = 4608, GP_A = 5120;
constexpr float RMS_EPS = 1e-6f;
constexpr int NWAVES = 8;

constexpr size_t MiB = 1u << 20;
constexpr size_t WS_CTL = 0, CTL_ZERO_BYTES = 1 * MiB;
constexpr size_t WS_ROUTE = 1 * MiB;
constexpr size_t WS_WFOX = 4 * MiB;
constexpr size_t WS_WGLA = WS_WFOX + 27 * MiB;
constexpr size_t WS_WOUT = WS_WGLA + 21 * MiB;
constexpr size_t WS_WMKV = WS_WOUT + 16 * MiB;
constexpr size_t WS_WGU = WS_WMKV + 4 * MiB;
constexpr size_t WS_WD = WS_WGU + 512 * MiB;
constexpr size_t WS_HN = WS_WD + 256 * MiB;
constexpr size_t WS_P = WS_HN + 65 * MiB;
constexpr size_t WS_CAT = WS_P + 216 * MiB;
constexpr size_t WS_XA = WS_CAT + 64 * MiB;
constexpr size_t WS_XB = WS_XA + 128 * MiB;
constexpr size_t WS_XG = WS_XB + 128 * MiB;
constexpr size_t WS_H = WS_XG + 160 * MiB;
constexpr size_t WS_YB = WS_H + 80 * MiB;
constexpr size_t WS_MEMN = WS_YB + 128 * MiB;
constexpr size_t WS_MKV = WS_MEMN + 4 * MiB;
constexpr size_t WS_MK = WS_MKV + 2 * MiB;
constexpr size_t WS_C = WS_MK + 2 * MiB;
constexpr size_t WS_FL = WS_C + 1 * MiB;
constexpr size_t WS_END = WS_FL + 1 * MiB;
constexpr size_t WS_GO = WS_XG, WS_LA = WS_H;
constexpr size_t RT_TOKE = 0;
constexpr size_t RT_TOKS = RT_TOKE + 2 * T * 4;
constexpr size_t RT_TOKW = RT_TOKS + 2 * T * 4;
constexpr size_t RT_ROWDEST = RT_TOKW + 2 * T * 4;
constexpr size_t RT_ROWW = RT_ROWDEST + 2 * MAXROWS * 4;
constexpr size_t RT_TILEE = RT_ROWW + MAXROWS * 4;
constexpr size_t RT_END = RT_TILEE + 2 * 256 * 4;
static_assert(RT_END <= 3 * MiB, "routing arrays");
constexpr int CW_BAR = 4096;
constexpr int CW_CNT = 8192;
constexpr int CW_Q0 = 8320, CW_Q1 = 8384;
static_assert((CW_Q1 + 64) * 4 <= (int)CTL_ZERO_BYTES, "ctl");

constexpr int RING_OFF = 0, RING_BYTES = 131072;
constexpr int LDSCTL_OFF = RING_BYTES, MISC_OFF = LDSCTL_OFF + 320;
constexpr int LDS_BYTES = 147456;

namespace pg8 {
struct EpiP {
    static constexpr bool PERM = true, AFTER_DRAIN = false;
    bf16_t* P; int ldp; float* FL; int ftile;
    __device__ __forceinline__ void operator()(const f32x4 (&acc)[2][2][4][2], const Unit& u, int wr, int wc, int fr, int fq) const {
        const int row0 = u.pm * BM + wr * 64 + fr, col0 = u.pn * BM + wc * 32 + 8 * fq;
#pragma unroll
        for (int ai = 0; ai < 2; ++ai)
#pragma unroll
            for (int m = 0; m < 4; ++m) { bf16_t* rowp = P + (size_t)(row0 + ai * HALF + m * 16) * ldp + col0;
#pragma unroll
                for (int bj = 0; bj < 2; ++bj) { const f32x4 v0 = acc[ai][bj][m][0], v1 = acc[ai][bj][m][1];
                    u32x4 w; w.x = pk2(v0[0], v0[1]); w.y = pk2(v0[2], v0[3]); w.z = pk2(v1[0], v1[1]); w.w = pk2(v1[2], v1[3]);
                    *(u32x4*)(rowp + bj * HALF) = w; } }
        if (u.pn == ftile && wc == 0 && fq < 2) {
#pragma unroll
            for (int ai = 0; ai < 2; ++ai)
#pragma unroll
                for (int m = 0; m < 4; ++m) { float* fp = FL + (size_t)(row0 + ai * HALF + m * 16) * 16 + 8 * fq;
                    *(f32x4*)(fp) = acc[ai][0][m][0]; *(f32x4*)(fp + 4) = acc[ai][0][m][1]; }
        }
    }
};
struct EpiRes {
    static constexpr bool PERM = false, AFTER_DRAIN = false;
    const float* R; float* C; int ldc;
    __device__ __forceinline__ void operator()(const f32x4 (&acc)[2][2][4][2], const Unit& u, int wr, int wc, int fr, int fq) const {
        const int row0 = u.pm * BM + wr * 64 + fr, col0 = u.pn * BM + wc * 32 + 4 * fq;
#pragma unroll
        for (int ai = 0; ai < 2; ++ai)
#pragma unroll
            for (int m = 0; m < 4; ++m) { const size_t ro = (size_t)(row0 + ai * HALF + m * 16) * ldc + col0;
#pragma unroll
                for (int bj = 0; bj < 2; ++bj)
#pragma unroll
                    for (int n = 0; n < 2; ++n) { const f32x4 r = *(const f32x4*)(R + ro + bj * HALF + n * 16); *(f32x4*)(C + ro + bj * HALF + n * 16) = acc[ai][bj][m][n] + r; } }
    }
};
struct EpiGU {
    static constexpr bool PERM = true, AFTER_DRAIN = false;
    bf16_t* H;
    __device__ __forceinline__ void operator()(const f32x4 (&acc)[2][2][4][2], const Unit& u, int wr, int wc, int fr, int fq) const {
        const int row0 = u.pm * BM + wr * 64 + fr, col0 = (u.pn & 7) * HALF + wc * 32 + 8 * fq;
#pragma unroll
        for (int ai = 0; ai < 2; ++ai)
#pragma unroll
            for (int m = 0; m < 4; ++m) { bf16_t* rowp = H + (size_t)(row0 + ai * HALF + m * 16) * 1024 + col0;
                float h[8];
#pragma unroll
                for (int n = 0; n < 2; ++n)
#pragma unroll
                    for (int j = 0; j < 4; ++j) { const float g = acc[ai][0][m][n][j], uu = acc[ai][1][m][n][j]; h[4 * n + j] = g * uu / (1.0f + __expf(-g)); }
                u32x4 w; w.x = pk2(h[0], h[1]); w.y = pk2(h[2], h[3]); w.z = pk2(h[4], h[5]); w.w = pk2(h[6], h[7]);
                *(u32x4*)rowp = w; }
    }
};
struct EpiDown {
    static constexpr bool PERM = true, AFTER_DRAIN = false;
    const int* rowdest; const float* roww; bf16_t* YB;
    __device__ __forceinline__ void operator()(const f32x4 (&acc)[2][2][4][2], const Unit& u, int wr, int wc, int fr, int fq) const {
        const int row0 = u.pm * BM + wr * 64 + fr, col0 = (u.pn & 7) * BM + wc * 32 + 8 * fq;
#pragma unroll
        for (int ai = 0; ai < 2; ++ai)
#pragma unroll
            for (int m = 0; m < 4; ++m) { const int row = row0 + ai * HALF + m * 16; const int dest = rowdest[row];
                if (dest >= 0) { const float w8 = roww[row]; bf16_t* rowp = YB + (size_t)dest * D + col0;
#pragma unroll
                    for (int bj = 0; bj < 2; ++bj) { const f32x4 v0 = acc[ai][bj][m][0] * w8, v1 = acc[ai][bj][m][1] * w8;
                        u32x4 w; w.x = pk2(v0[0], v0[1]); w.y = pk2(v0[2], v0[3]); w.z = pk2(v1[0], v1[1]); w.w = pk2(v1[2], v1[3]);
                        *(u32x4*)(rowp + bj * HALF) = w; } } }
    }
};
struct MoeOrder {
    const int* tile_e; int nunits, G, c;
    __device__ __forceinline__ bool next(int i, Unit& u) const {
        const long L = (long)i * G + c; if (L >= nunits) return false;
        const int tile = (int)(L >> 3), pn = (int)(L & 7); u.pm = tile; u.pn = tile_e[tile] * 8 + pn; return true;
    }
    __device__ __forceinline__ void a_ready(const Unit&) const {}
    __device__ __forceinline__ void done(const Unit&) const {}
};
}

struct Ctx {
    LAS unsigned char* lds;
    int tid, lane, wave, gw, NGW, G;
    const float* in[24]; float* out; unsigned char* ws;
};
#define WSP(type, off) ((type*)(C.ws + (off)))

__device__ __forceinline__ void load_row(const float* xrow, int lane, f32x4 (&v)[8]) {
#pragma unroll
    for (int j = 0; j < 8; ++j) v[j] = ((const f32x4*)xrow)[lane + 64 * j];
}
__device__ __forceinline__ float row_inv_rms(const f32x4 (&v)[8]) {
    float s = 0.f;
#pragma unroll
    for (int j = 0; j < 8; ++j) s += (v[j].x * v[j].x + v[j].y * v[j].y) + (v[j].z * v[j].z + v[j].w * v[j].w);
    s = wave_sum(s);
    return 1.0f / sqrtf(s * (1.0f / D) + RMS_EPS);
}
__device__ __forceinline__ void norm_store_row(bf16* orow, f32x4 (&v)[8], float inv, const float* g, int lane) {
#pragma unroll
    for (int j = 0; j < 8; ++j) { const f32x4 gg = ((const f32x4*)g)[lane + 64 * j]; v[j] = v[j] * inv * gg;
        v2u o; o.x = pk2(v[j].x, v[j].y); o.y = pk2(v[j].z, v[j].w); ((v2u*)orow)[lane + 64 * j] = o; }
}

__device__ __forceinline__ void tr_item(const float* W, int ldn, int K, bf16* WT, int drow, int k0, int n0, LAS float* scr, int lane) {
#pragma unroll 8
    for (int i = 0; i < 32; ++i) { const int kk = 2 * i + (lane >> 5); scr[kk * 33 + (lane & 31)] = W[(size_t)(k0 + kk) * ldn + n0 + (lane & 31)]; }
    LDS_WAIT(); asm volatile("" ::: "memory");
    const int c = lane & 7;
#pragma unroll
    for (int j = 0; j < 4; ++j) { const int n = (lane >> 3) + 8 * j; const LAS float* s = scr + (8 * c) * 33 + n;
        v4u o; o.x = pk2(s[0 * 33], s[1 * 33]); o.y = pk2(s[2 * 33], s[3 * 33]); o.z = pk2(s[4 * 33], s[5 * 33]); o.w = pk2(s[6 * 33], s[7 * 33]);
        *(v4u*)(WT + (size_t)(drow + n) * K + k0 + 8 * c) = o; }
    LDS_WAIT(); asm volatile("" ::: "memory");
}
__device__ __forceinline__ bool tr_group(int& r, const float* W, int ldn, int K, int c0, int nblk, bf16* WT, int drow0, LAS float* scr, int lane) {
    const int cnt = (K / 64) * nblk;
    if (r < cnt) { const int kb = r / nblk, nb = r % nblk; tr_item(W + c0, ldn, K, WT, drow0 + 32 * nb, 64 * kb, 32 * nb, scr, lane); return true; }
    r -= cnt; return false;
}
__device__ __forceinline__ void p0_prologue(const Ctx& C) {
    LAS float* scr = (LAS float*)(C.lds + RING_OFF + C.wave * 16384);
    const int lane = C.lane;
    constexpr int MOE_ITEMS = 64 * 3 * 1024;
    for (int it = C.gw; it < MOE_ITEMS; it += C.NGW) {
        const int le = it / 3072, rem = it % 3072, kind = rem >> 10, r = rem & 1023;
        if (kind < 2) {
            const float* W = (kind == 0 ? C.in[21] : C.in[22]) + (size_t)le * 2048 * 1024;
            const int kb = r >> 5, nb = r & 31, n0 = 32 * nb;
            bf16* WT = WSP(bf16, WS_WGU) + (size_t)le * 2048 * 2048;
            tr_item(W, 1024, 2048, WT, 256 * (n0 >> 7) + (n0 & 127) + 128 * kind, 64 * kb, n0, scr, lane);
        } else {
            const float* W = C.in[23] + (size_t)le * 1024 * 2048;
            const int kb = r >> 6, nb = r & 63;
            bf16* WT = WSP(bf16, WS_WD) + (size_t)le * 2048 * 1024;
            tr_item(W, 2048, 1024, WT, 32 * nb, 64 * kb, 32 * nb, scr, lane);
        }
    }
    constexpr int I_FOX = 32 * (192 + 16 + 1), I_GLA = 32 * (144 + 16 + 1), I_WO = 32 * 64, I_MKV = 32 * 32;
    constexpr int OTHER = I_FOX + I_GLA + 2 * I_WO + I_MKV;
    for (int it = C.gw; it < OTHER; it += C.NGW) {
        int r = it;
        if (tr_group(r, C.in[5], FOX_IN, D, 0, 192, WSP(bf16, WS_WFOX), 0, scr, lane)) continue;
        if (tr_group(r, C.in[5], FOX_IN, D, 6156, 16, WSP(bf16, WS_WFOX), FP_QM, scr, lane)) continue;
        if (tr_group(r, C.in[5], FOX_IN, D, 6144, 1, WSP(bf16, WS_WFOX), FP_F, scr, lane)) continue;
        if (tr_group(r, C.in[9], GLA_IN, D, 0, 144, WSP(bf16, WS_WGLA), 0, scr, lane)) continue;
        if (tr_group(r, C.in[9], GLA_IN, D, 4624, 16, WSP(bf16, WS_WGLA), GP_QM, scr, lane)) continue;
        if (tr_group(r, C.in[9], GLA_IN, D, 4608, 1, WSP(bf16, WS_WGLA), GP_A, scr, lane)) continue;
        if (tr_group(r, C.in[15], D, D, 0, 64, WSP(bf16, WS_WOUT), 0, scr, lane)) continue;
        if (tr_group(r, C.in[15] + (size_t)D * D, D, D, 0, 64, WSP(bf16, WS_WOUT) + (size_t)D * D, 0, scr, lane)) continue;
        tr_group(r, C.in[3], 1024, D, 0, 32, WSP(bf16, WS_WMKV), 0, scr, lane);
    }
    for (int m = C.gw; m < T + NB * ML; m += C.NGW) {
        f32x4 v[8];
        if (m < T) { load_row(C.in[0] + (size_t)m * D, lane, v); const float inv = row_inv_rms(v); norm_store_row(WSP(bf16, WS_HN) + (size_t)m * D, v, inv, C.in[4], lane); }
        else { const int r = m - T; load_row(C.in[1] + (size_t)r * D, lane, v); const float inv = row_inv_rms(v); norm_store_row(WSP(bf16, WS_MEMN) + (size_t)r * D, v, inv, C.in[2], lane); }
    }
    { int* rd = (int*)(C.ws + WS_ROUTE + RT_ROWDEST);
      for (int i = blockIdx.x * 512 + C.tid; i < 2 * MAXROWS; i += C.G * 512) rd[i] = -1; }
}

__device__ __forceinline__ float log_sigmoid(float x) { return fminf(x, 0.f) - log1pf(expf(-fabsf(x))); }

__device__ __forceinline__ void headnorm_inplace(bf16* rowp, int col0, int nh, const float* g, int lane) {
    const float g0 = g[2 * lane], g1 = g[2 * lane + 1];
    for (int h = 0; h < nh; ++h) {
        unsigned* p = (unsigned*)(rowp + col0 + h * HD) + lane; const unsigned u = *p; const float a = bflo(u), b = bfhi(u);
        const float ss = wave_sum(a * a + b * b); const float inv = 1.0f / sqrtf(ss * (1.0f / HD) + RMS_EPS);
        *p = pk2(a * inv * g0, b * inv * g1);
    }
}
__device__ __forceinline__ void p3_fox_thin(const Ctx& C) {
    bf16* P = WSP(bf16, WS_P);
    for (int m = C.gw; m < T; m += C.NGW) {
        bf16* rowp = P + (size_t)m * FOX_NP;
        headnorm_inplace(rowp, FP_Q, FH, C.in[7], C.lane);
        headnorm_inplace(rowp, FP_K, FH, C.in[8], C.lane);
        headnorm_inplace(rowp, FP_QM, MH, C.in[13], C.lane);
    }
    for (int it = C.gw; it < NB * ML * MH; it += C.NGW) {
        const int row = it >> 2, mh = it & 3;
        const unsigned u = *((const unsigned*)(WSP(bf16, WS_MKV) + (size_t)row * 1024 + mh * HD) + C.lane); const float a = bflo(u), b = bfhi(u);
        const float ss = wave_sum(a * a + b * b); const float inv = 1.0f / sqrtf(ss * (1.0f / HD) + RMS_EPS);
#pragma unroll
        for (int l = 0; l < 2; ++l) { const float* g = C.in[14] + l * HD;
            *((unsigned*)(WSP(bf16, WS_MK) + (size_t)l * 1024 * 512 + (size_t)row * 512 + mh * HD) + C.lane) = pk2(a * inv * g[2 * C.lane], b * inv * g[2 * C.lane + 1]); }
    }
    LAS float* sm = (LAS float*)(C.lds + RING_OFF);
    for (int bh = blockIdx.x; bh < NB * FH; bh += C.G) {
        const int b = bh / FH, h = bh % FH; const float bf = C.in[6][h];
        const float* fl = WSP(float, WS_FL) + (size_t)(b * S) * 16 + h;
        float ls[8], tot = 0.f;
#pragma unroll
        for (int i = 0; i < 8; ++i) { ls[i] = log_sigmoid(fl[(size_t)(8 * C.tid + i) * 16] + bf); tot += ls[i]; ls[i] = tot; }
        float inc = tot;
#pragma unroll
        for (int o = 1; o < 64; o <<= 1) { const float t = __shfl_up(inc, o); if (C.lane >= o) inc += t; }
        __syncthreads();
        if (C.lane == 63) sm[C.wave] = inc;
        __syncthreads();
        float woff = 0.f;
        for (int w = 0; w < C.wave; ++w) woff += sm[w];
        const float excl = woff + inc - tot;
        float* cp = WSP(float, WS_C) + (size_t)bh * S + 8 * C.tid;
#pragma unroll
        for (int i = 0; i < 8; ++i) cp[i] = excl + ls[i];
    }
}

__device__ __forceinline__ void naive_attn_row(const bf16* qptr, const bf16* Kb, int kstride, const bf16* Vb, int vstride, int nk, const float* cptr, float ct,
                                               LAS float* qs, int lane, float& o0, float& o1) {
    { const unsigned qq = *((const unsigned*)qptr + lane); qs[2 * lane] = bflo(qq); qs[2 * lane + 1] = bfhi(qq); }
    LDS_WAIT(); asm volatile("" ::: "memory");
    float m = -1e30f, l = 0.f, a0 = 0.f, a1 = 0.f;
    for (int j0 = 0; j0 < nk; j0 += 64) {
        const int j = j0 + lane; const bool valid = j < nk; const int jc = valid ? j : nk - 1;
        const bf16* kr = Kb + (size_t)jc * kstride;
        float s = 0.f;
#pragma unroll 4
        for (int d8 = 0; d8 < 16; ++d8) {
            const v4u kk = *(const v4u*)(kr + 8 * d8);
            const f32x4 qa = *(const LAS f32x4*)(qs + 8 * d8), qb = *(const LAS f32x4*)(qs + 8 * d8 + 4);
            s += bflo(kk.x) * qa.x + bfhi(kk.x) * qa.y + bflo(kk.y) * qa.z + bfhi(kk.y) * qa.w + bflo(kk.z) * qb.x + bfhi(kk.z) * qb.y + bflo(kk.w) * qb.z + bfhi(kk.w) * qb.w;
        }
        s *= 0.08838834764831845f;
        if (cptr) s += ct - cptr[jc];
        if (!valid) s = -__builtin_inff();
        const float mn = fmaxf(m, wave_max(s)); const float alpha = expf(m - mn); const float p = valid ? expf(s - mn) : 0.f;
        l = l * alpha + wave_sum(p); a0 *= alpha; a1 *= alpha; m = mn;
        const int cnt = (nk - j0) < 64 ? (nk - j0) : 64;
        for (int jj = 0; jj < cnt; ++jj) { const float pj = __shfl(p, jj); const unsigned vv = *((const unsigned*)(Vb + (size_t)(j0 + jj) * vstride) + lane); a0 += pj * bflo(vv); a1 += pj * bfhi(vv); }
    }
    o0 = a0 / l; o1 = a1 / l;
    asm volatile("" ::: "memory");
}
__device__ __forceinline__ void naive_mem_attn(const Ctx& C, const bf16* P, int ldp, int qcol, int layer, int row, int mh, LAS float* qs) {
    const int b = row / S; float o0, o1;
    naive_attn_row(P + (size_t)row * ldp + qcol + mh * HD, WSP(bf16, WS_MK) + (size_t)layer * 1024 * 512 + (size_t)(b * ML) * 512 + mh * HD, 512,
                   WSP(bf16, WS_MKV) + (size_t)(b * ML) * 1024 + 512 + mh * HD, 1024, ML, nullptr, 0.f, qs, C.lane, o0, o1);
    *((unsigned*)(WSP(bf16, WS_CAT) + (size_t)row * D + FW + mh * HD) + C.lane) = pk2(o0, o1);
}
__device__ __forceinline__ void p4_fox_attn_naive(const Ctx& C) {
    LAS float* qs = (LAS float*)(C.lds + RING_OFF + C.wave * 16384);
    const bf16* P = WSP(bf16, WS_P);
    for (int it = C.gw; it < T * 16; it += C.NGW) {
        const int hh = it / T, row = it % T;
        if (hh < FH) {
            const int b = row / S, t = row % S; float o0, o1;
            const float* cp = WSP(float, WS_C) + (size_t)(b * FH + hh) * S;
            naive_attn_row(P + (size_t)row * FOX_NP + FP_Q + hh * HD, P + (size_t)(b * S) * FOX_NP + FP_K + hh * HD, FOX_NP, P + (size_t)(b * S) * FOX_NP + FP_V + hh * HD, FOX_NP,
                           t + 1, cp, cp[t], qs, C.lane, o0, o1);
            const unsigned og = *((const unsigned*)(P + (size_t)row * FOX_NP + FP_OG + hh * HD) + C.lane);
            const float g0 = 1.0f / (1.0f + expf(-bflo(og))), g1 = 1.0f / (1.0f + expf(-bfhi(og)));
            *((unsigned*)(WSP(bf16, WS_CAT) + (size_t)row * D + hh * HD) + C.lane) = pk2(o0 * g0, o1 * g1);
        } else naive_mem_attn(C, P, FOX_NP, FP_QM, 0, row, hh - FH, qs);
    }
}

__device__ __forceinline__ void p12_gla_thin(const Ctx& C) {
    bf16* P = WSP(bf16, WS_P);
    const float* w2 = C.in[10]; const float* ba = C.in[11];
    for (int m = C.gw; m < T; m += C.NGW) {
        headnorm_inplace(P + (size_t)m * GLA_NP, GP_QM, MH, C.in[13] + HD, C.lane);
        const float* fl = WSP(float, WS_FL) + (size_t)m * 16;
        float al[16];
#pragma unroll
        for (int r = 0; r < 16; ++r) al[r] = fl[r];
        float* la = WSP(float, WS_LA) + (size_t)m * GKW;
#pragma unroll 1
        for (int j = 0; j < 12; ++j) { const int c = C.lane + 64 * j; float s = ba[c];
#pragma unroll
            for (int r = 0; r < 16; ++r) s += al[r] * w2[r * GKW + c];
            la[c] = expf(log_sigmoid(s) * (1.0f / 16.0f)); }
    }
}
__device__ __forceinline__ void p13_gla_naive(const Ctx& C) {
    const bf16* P = WSP(bf16, WS_P); const float* LA = WSP(float, WS_LA); float* GO = WSP(float, WS_GO);
    const int lane = C.lane;
    for (int it = C.gw; it < NB * GH * 128; it += C.NGW) {
        const int bh = it >> 7, e0 = (it & 127) * 3, b = bh >> 2, h = bh & 3;
        float st[3][3];
#pragma unroll
        for (int i = 0; i < 3; ++i)
#pragma unroll
            for (int e = 0; e < 3; ++e) st[i][e] = 0.f;
        const float qsc = 0.07216878364870322f;
        for (int t0 = 0; t0 < S; t0 += 4) {
            float a[4][3], k[4][3], q[4][3], v[4][3];
#pragma unroll
            for (int u = 0; u < 4; ++u) { const size_t row = (size_t)(b * S + t0 + u);
#pragma unroll
                for (int i = 0; i < 3; ++i) { const int d = lane + 64 * i;
                    a[u][i] = LA[row * GKW + h * GDK + d]; k[u][i] = bf2f(P[row * GLA_NP + GP_K + h * GDK + d]); q[u][i] = bf2f(P[row * GLA_NP + GP_Q + h * GDK + d]) * qsc; }
#pragma unroll
                for (int e = 0; e < 3; ++e) v[u][e] = bf2f(P[row * GLA_NP + GP_V + h * GDV + e0 + e]); }
#pragma unroll
            for (int u = 0; u < 4; ++u) { float o[3] = {0.f, 0.f, 0.f};
#pragma unroll
                for (int i = 0; i < 3; ++i)
#pragma unroll
                    for (int e = 0; e < 3; ++e) { st[i][e] = a[u][i] * st[i][e] + k[u][i] * v[u][e]; o[e] += q[u][i] * st[i][e]; }
#pragma unroll
                for (int e = 0; e < 3; ++e) o[e] = wave_sum(o[e]);
                if (lane < 3) GO[(size_t)(b * S + t0 + u) * GVW + h * GDV + e0 + lane] = lane == 0 ? o[0] : (lane == 1 ? o[1] : o[2]); }
        }
    }
}
__device__ __forceinline__ void p14_gla_onorm(const Ctx& C) {
    const bf16* P = WSP(bf16, WS_P); const float* GO = WSP(float, WS_GO); const float* og = C.in[12];
    for (int m = C.gw; m < T; m += C.NGW) {
#pragma unroll 1
        for (int h = 0; h < GH; ++h) {
            f32x2 x[3]; float ss = 0.f;
#pragma unroll
            for (int i = 0; i < 3; ++i) { x[i] = *((const f32x2*)(GO + (size_t)m * GVW + h * GDV + 128 * i) + C.lane); ss += x[i].x * x[i].x + x[i].y * x[i].y; }
            ss = wave_sum(ss); const float inv = 1.0f / sqrtf(ss * (1.0f / GDV) + RMS_EPS);
#pragma unroll
            for (int i = 0; i < 3; ++i) { const int e = 128 * i + 2 * C.lane;
                const unsigned ru = *((const unsigned*)(P + (size_t)m * GLA_NP + GP_R + h * GDV + 128 * i) + C.lane); const float r0 = bflo(ru), r1 = bfhi(ru);
                const float y0 = x[i].x * inv * og[e] * (r0 / (1.0f + expf(-r0))), y1 = x[i].y * inv * og[e + 1] * (r1 / (1.0f + expf(-r1)));
                *((unsigned*)(WSP(bf16, WS_CAT) + (size_t)m * D + h * GDV + 128 * i) + C.lane) = pk2(y0, y1); }
        }
    }
}

__device__ __forceinline__ void p6_router(const Ctx& C, int layer) {
    const float* X = WSP(float, WS_XB); const float* g = C.in[16] + layer * D;
    const float* wg = C.in[17] + (size_t)layer * D * 4; const float* we = C.in[19] + (size_t)layer * D * 32;
    const float* bg = C.in[18] + layer * 4; const float* be = C.in[20] + layer * 32;
    unsigned* cnt = (unsigned*)(C.ws + WS_CTL) + CW_CNT + layer * 32;
    int* toke = (int*)(C.ws + WS_ROUTE + RT_TOKE); int* toks = (int*)(C.ws + WS_ROUTE + RT_TOKS); float* tokw = (float*)(C.ws + WS_ROUTE + RT_TOKW);
    const int lane = C.lane;
    LAS float* hs = (LAS float*)(C.lds + RING_OFF + C.wave * 16384);
    for (int pr = C.gw; pr < T / 2; pr += C.NGW) {
        {
            f32x4 x0[8], x1[8];
            load_row(X + (size_t)(2 * pr) * D, lane, x0); load_row(X + (size_t)(2 * pr + 1) * D, lane, x1);
            const float i0 = row_inv_rms(x0), i1 = row_inv_rms(x1);
            norm_store_row(WSP(bf16, WS_HN) + (size_t)(2 * pr) * D, x0, i0, g, lane);
            norm_store_row(WSP(bf16, WS_HN) + (size_t)(2 * pr + 1) * D, x1, i1, g, lane);
#pragma unroll
            for (int j = 0; j < 8; ++j) { ((LAS f32x4*)hs)[lane + 64 * j] = x0[j]; ((LAS f32x4*)(hs + D))[lane + 64 * j] = x1[j]; }
        }
        LDS_WAIT(); asm volatile("" ::: "memory");
        float a0[36], a1[36];
#pragma unroll
        for (int n = 0; n < 36; ++n) { a0[n] = 0.f; a1[n] = 0.f; }
#pragma unroll 2
        for (int kk = 0; kk < 32; ++kk) {
            const int k = lane + 64 * kk; const float h0 = hs[k], h1 = hs[D + k];
            const f32x4 w4 = *(const f32x4*)(wg + (size_t)k * 4);
#pragma unroll
            for (int n = 0; n < 4; ++n) { a0[n] += h0 * w4[n]; a1[n] += h1 * w4[n]; }
#pragma unroll
            for (int q = 0; q < 8; ++q) { const f32x4 w = *(const f32x4*)(we + (size_t)k * 32 + 4 * q);
#pragma unroll
                for (int n = 0; n < 4; ++n) { a0[4 + 4 * q + n] += h0 * w[n]; a1[4 + 4 * q + n] += h1 * w[n]; } }
        }
        asm volatile("" ::: "memory");
#pragma unroll
        for (int n = 0; n < 36; ++n) { a0[n] = wave_sum(a0[n]); a1[n] = wave_sum(a1[n]); }
#pragma unroll
        for (int rr = 0; rr < 2; ++rr) {
            float lg[36];
#pragma unroll
            for (int n = 0; n < 36; ++n) lg[n] = rr == 0 ? a0[n] : a1[n];
            float gl[4]; int gi = 0; float gm;
#pragma unroll
            for (int n = 0; n < 4; ++n) gl[n] = lg[n] + bg[n];
            gm = gl[0];
#pragma unroll
            for (int n = 1; n < 4; ++n) if (gl[n] > gm) { gm = gl[n]; gi = n; }
            float gs = 0.f;
#pragma unroll
            for (int n = 0; n < 4; ++n) gs += expf(gl[n] - gm);
            const float gp = 1.0f / gs;
            float ev[8];
#pragma unroll
            for (int j = 0; j < 8; ++j) { const float v0 = lg[4 + j] + be[j], v1 = lg[12 + j] + be[8 + j], v2 = lg[20 + j] + be[16 + j], v3 = lg[28 + j] + be[24 + j];
                ev[j] = gi == 0 ? v0 : (gi == 1 ? v1 : (gi == 2 ? v2 : v3)); }
            int e1 = 0; float m1 = ev[0];
#pragma unroll
            for (int j = 1; j < 8; ++j) if (ev[j] > m1) { m1 = ev[j]; e1 = j; }
            int e2 = -1; float m2 = -__builtin_inff();
#pragma unroll
            for (int j = 0; j < 8; ++j) if (j != e1 && ev[j] > m2) { m2 = ev[j]; e2 = j; }
            const float z = expf(m2 - m1); const float w1 = gp / (1.0f + z), w2 = gp * z / (1.0f + z);
            if (lane == 0) {
                const int tok = 2 * pr + rr; const int id1 = gi * 8 + e1, id2 = gi * 8 + e2;
                const unsigned s1 = atomicAdd(cnt + id1, 1u), s2 = atomicAdd(cnt + id2, 1u);
                toke[2 * tok] = id1; toks[2 * tok] = (int)s1; tokw[2 * tok] = w1;
                toke[2 * tok + 1] = id2; toks[2 * tok + 1] = (int)s2; tokw[2 * tok + 1] = w2;
            }
        }
    }
}
__device__ __forceinline__ void p7_dispatch(const Ctx& C, int layer) {
    const unsigned* cnt = (const unsigned*)(C.ws + WS_CTL) + CW_CNT + layer * 32;
    const int* toke = (const int*)(C.ws + WS_ROUTE + RT_TOKE); const int* toks = (const int*)(C.ws + WS_ROUTE + RT_TOKS); const float* tokw = (const float*)(C.ws + WS_ROUTE + RT_TOKW);
    int* rowdest = (int*)(C.ws + WS_ROUTE + RT_ROWDEST) + layer * MAXROWS; float* roww = (float*)(C.ws + WS_ROUTE + RT_ROWW);
    int* tilee = (int*)(C.ws + WS_ROUTE + RT_TILEE) + layer * 256;
    const int lane = C.lane;
    const int c = lane < NE ? (int)__hip_atomic_load(cnt + lane, __ATOMIC_RELAXED, __HIP_MEMORY_SCOPE_AGENT) : 0;
    const int padded = (c + 255) & ~255;
    int inc = padded;
#pragma unroll
    for (int o = 1; o < 64; o <<= 1) { const int t = __shfl_up(inc, o); if (lane >= o) inc += t; }
    const int pstart = inc - padded;
    if (blockIdx.x == 0 && C.wave == 0) {
        if (lane < NE) for (int tl = pstart >> 8; tl < (pstart + padded) >> 8; ++tl) tilee[tl] = lane;
        if (lane == 63) tilee[255] = inc >> 8;
    }
    const bf16* HN = WSP(bf16, WS_HN); bf16* XG = WSP(bf16, WS_XG);
    for (int a = C.gw; a < 2 * T; a += C.NGW) {
        const int e = toke[a], slot = toks[a]; const int dest = __shfl(pstart, e) + slot;
        const v4u* src = (const v4u*)(HN + (size_t)(a >> 1) * D); v4u* dst = (v4u*)(XG + (size_t)dest * D);
#pragma unroll
        for (int i = 0; i < 4; ++i) dst[lane + 64 * i] = src[lane + 64 * i];
        if (lane == 0) { rowdest[dest] = a; roww[dest] = tokw[a]; }
    }
}
__device__ __forceinline__ void p_combine(const Ctx& C, const float* xi, float* xo, const float* g) {
    const bf16* YB = WSP(bf16, WS_YB);
    for (int m = C.gw; m < T; m += C.NGW) {
        f32x4 v[8]; load_row(xi + (size_t)m * D, C.lane, v);
#pragma unroll
        for (int j = 0; j < 8; ++j) {
            const v2u y0 = ((const v2u*)(YB + (size_t)(2 * m) * D))[C.lane + 64 * j], y1 = ((const v2u*)(YB + (size_t)(2 * m + 1) * D))[C.lane + 64 * j];
            v[j].x += bflo(y0.x) + bflo(y1.x); v[j].y += bfhi(y0.x) + bfhi(y1.x); v[j].z += bflo(y0.y) + bflo(y1.y); v[j].w += bfhi(y0.y) + bfhi(y1.y);
            ((f32x4*)(xo + (size_t)m * D))[C.lane + 64 * j] = v[j];
        }
        if (g) { const float inv = row_inv_rms(v); norm_store_row(WSP(bf16, WS_HN) + (size_t)m * D, v, inv, g, C.lane); }
    }
}

typedef float f32x16 __attribute__((ext_vector_type(16)));
typedef short s16x4 __attribute__((ext_vector_type(4)));
constexpr int AT_K = 0, AT_V = 32768, AT_C = 65536, AT_U = 66560;
constexpr float LOG2E = 1.4426950408889634f;
constexpr float AT_C2 = 0.08838834764831845f * 1.4426950408889634f;
__device__ __forceinline__ unsigned off_b(unsigned row, unsigned ch) { return 256u * row + 16u * (ch ^ (((row & 3u) << 2) | ((row >> 2) & 3u))); }

template <bool FOX>
__device__ __forceinline__ void attn_unit(LAS unsigned char* lds, const bf16* Qb, int ldq, const bf16* Kb, int ldk, const bf16* Vb, int ldv, const float* cb, int qrow0, int nkt,
                                          bf16* Ob, int ldo, const bf16* OGb, int ldog, int tid, int lane, int wave) {
    const int r = lane & 31, h = lane >> 5;
    const int qpos = qrow0 + 32 * wave + r;
    bf16x8 qf[8];
    { const bf16* qp = Qb + (size_t)(32 * wave + r) * ldq + 8 * h;
#pragma unroll
      for (int s = 0; s < 8; ++s) qf[s] = *(const bf16x8*)(qp + 16 * s); }
    const float cq2 = FOX ? cb[qpos] * LOG2E : 0.f;
    f32x16 o[4];
#pragma unroll
    for (int c = 0; c < 4; ++c)
#pragma unroll
        for (int i = 0; i < 16; ++i) o[c][i] = 0.f;
    float m = -1e30f, l = 0.f;
    const int srow = tid >> 4, sch = tid & 15;
    const unsigned so0 = off_b(srow, sch), so1 = off_b(srow + 32, sch);
    const bf16* kg = Kb + (size_t)srow * ldk + 8 * sch; const bf16* vg = Vb + (size_t)srow * ldv + 8 * sch;
    v4u kr0, kr1, vr0, vr1; float cr = 0.f;
#define AT_LOAD(kt) do { const size_t ko = (size_t)(64 * (kt)) * ldk, vo = (size_t)(64 * (kt)) * ldv; \
        kr0 = *(const v4u*)(kg + ko); kr1 = *(const v4u*)(kg + ko + (size_t)32 * ldk); vr0 = *(const v4u*)(vg + vo); vr1 = *(const v4u*)(vg + vo + (size_t)32 * ldv); \
        if (FOX && tid < 64) cr = cb[64 * (kt) + tid] * LOG2E; } while (0)
#define AT_STORE(b) do { *(LAS v4u*)(lds + AT_K + (b) * 16384 + so0) = kr0; *(LAS v4u*)(lds + AT_K + (b) * 16384 + so1) = kr1; \
        *(LAS v4u*)(lds + AT_V + (b) * 16384 + so0) = vr0; *(LAS v4u*)(lds + AT_V + (b) * 16384 + so1) = vr1; \
        if (FOX && tid < 64) *(LAS float*)(lds + AT_C + (b) * 256 + 4 * tid) = cr; } while (0)
    AT_LOAD(0); AT_STORE(0);
    if (nkt > 1) AT_LOAD(1);
    __syncthreads();
    unsigned kb0 = 256u * r + 16u * ((unsigned)h ^ (((r & 3u) << 2) | ((r >> 2) & 3u)));
    const unsigned tq = (lane & 15) >> 2, tp = lane & 3, tblk = (lane >> 4) & 1;
    unsigned vb0 = 1024u * h + 256u * tq + 64u * tq + 16u * ((2u * tblk + (tp >> 1)) ^ ((unsigned)h & 3u)) + 8u * (tp & 1);
    unsigned vb1 = 2048u + 1024u * h + 256u * tq + 64u * tq + 16u * ((2u * tblk + (tp >> 1)) ^ ((2u + (unsigned)h) & 3u)) + 8u * (tp & 1);
    const int minq = qrow0 + 32 * wave;
#pragma unroll 1
    for (int kt = 0; kt < nkt; ++kt) {
        asm volatile("" : "+v"(kb0), "+v"(vb0), "+v"(vb1));
        const int b = kt & 1;
        const bool active = !FOX || (64 * kt <= minq + 31);
        if (active) {
            f32x16 p0, p1;
#pragma unroll
            for (int i = 0; i < 16; ++i) { p0[i] = 0.f; p1[i] = 0.f; }
            const LAS unsigned char* kbuf = lds + AT_K + b * 16384;
#pragma unroll
            for (int s = 0; s < 8; ++s) {
                const bf16x8 a0 = *(const LAS bf16x8*)(kbuf + (kb0 ^ (32u * s))), a1 = *(const LAS bf16x8*)(kbuf + (kb0 ^ (32u * s)) + 8192);
                p0 = __builtin_amdgcn_mfma_f32_32x32x16_bf16(a0, qf[s], p0, 0, 0, 0);
                p1 = __builtin_amdgcn_mfma_f32_32x32x16_bf16(a1, qf[s], p1, 0, 0, 0);
            }
            if (FOX) {
                const LAS float* cbuf = (const LAS float*)(lds + AT_C + b * 256);
#pragma unroll
                for (int g = 0; g < 4; ++g) { const f32x4 c0 = *(const LAS f32x4*)(cbuf + 8 * g + 4 * h), c1 = *(const LAS f32x4*)(cbuf + 32 + 8 * g + 4 * h);
#pragma unroll
                    for (int j = 0; j < 4; ++j) { p0[4 * g + j] = fmaf(p0[4 * g + j], AT_C2, cq2 - c0[j]); p1[4 * g + j] = fmaf(p1[4 * g + j], AT_C2, cq2 - c1[j]); } }
                if (64 * kt + 63 > minq) {
                    const int dq = qpos - 64 * kt - 4 * h;
#pragma unroll
                    for (int i = 0; i < 16; ++i) { const int ci = (i & 3) + 8 * (i >> 2);
                        if (ci > dq) p0[i] = -__builtin_inff();
                        if (ci + 32 > dq) p1[i] = -__builtin_inff(); }
                }
            } else {
#pragma unroll
                for (int i = 0; i < 16; ++i) { p0[i] *= AT_C2; p1[i] *= AT_C2; }
            }
            float pmax = p0[0];
#pragma unroll
            for (int i = 1; i < 16; ++i) pmax = fmaxf(pmax, p0[i]);
#pragma unroll
            for (int i = 0; i < 16; ++i) pmax = fmaxf(pmax, p1[i]);
            pmax = fmaxf(pmax, __shfl_xor(pmax, 32));
            const float mn = fmaxf(m, pmax), alpha = __builtin_amdgcn_exp2f(m - mn);
            m = mn;
            float ps = 0.f;
#pragma unroll
            for (int i = 0; i < 16; ++i) { p0[i] = __builtin_amdgcn_exp2f(p0[i] - mn); p1[i] = __builtin_amdgcn_exp2f(p1[i] - mn); ps += p0[i] + p1[i]; }
            ps += __shfl_xor(ps, 32);
            l = l * alpha + ps;
#pragma unroll
            for (int c = 0; c < 4; ++c)
#pragma unroll
                for (int i = 0; i < 16; ++i) o[c][i] *= alpha;
            bf16x8 pf[4];
#pragma unroll
            for (int s = 0; s < 2; ++s) {
                v4u w0, w1;
                w0.x = pk2(p0[8 * s], p0[8 * s + 1]); w0.y = pk2(p0[8 * s + 2], p0[8 * s + 3]); w0.z = pk2(p0[8 * s + 4], p0[8 * s + 5]); w0.w = pk2(p0[8 * s + 6], p0[8 * s + 7]);
                w1.x = pk2(p1[8 * s], p1[8 * s + 1]); w1.y = pk2(p1[8 * s + 2], p1[8 * s + 3]); w1.z = pk2(p1[8 * s + 4], p1[8 * s + 5]); w1.w = pk2(p1[8 * s + 6], p1[8 * s + 7]);
                pf[s] = __builtin_bit_cast(bf16x8, w0); pf[2 + s] = __builtin_bit_cast(bf16x8, w1);
            }
            const LAS unsigned char* vbuf = lds + AT_V + b * 16384;
#pragma unroll
            for (int ks = 0; ks < 4; ++ks)
#pragma unroll
                for (int c = 0; c < 4; ++c) {
                    const s16x4 lo = __builtin_amdgcn_ds_read_tr16_b64_v4i16((LAS s16x4*)(vbuf + ((vb0 ^ (64u * c)) + 4096u * ks)));
                    const s16x4 hi = __builtin_amdgcn_ds_read_tr16_b64_v4i16((LAS s16x4*)(vbuf + ((vb1 ^ (64u * c)) + 4096u * ks)));
                    const bf16x8 vf = __builtin_shufflevector(lo, hi, 0, 1, 2, 3, 4, 5, 6, 7);
                    o[c] = __builtin_amdgcn_mfma_f32_32x32x16_bf16(vf, pf[ks], o[c], 0, 0, 0);
                }
        }
        if (kt + 1 < nkt) { AT_STORE(b ^ 1); if (kt + 2 < nkt) AT_LOAD(kt + 2); }
        __syncthreads();
    }
#undef AT_LOAD
#undef AT_STORE
    const float il = 1.0f / l;
    bf16* orow = Ob + (size_t)(32 * wave + r) * ldo + 4 * h;
    const bf16* grow = FOX ? OGb + (size_t)(32 * wave + r) * ldog + 4 * h : nullptr;
#pragma unroll
    for (int c = 0; c < 4; ++c)
#pragma unroll
        for (int g = 0; g < 4; ++g) {
            float y0 = o[c][4 * g] * il, y1 = o[c][4 * g + 1] * il, y2 = o[c][4 * g + 2] * il, y3 = o[c][4 * g + 3] * il;
            if (FOX) { const v2u gg = *(const v2u*)(grow + 32 * c + 8 * g);
                y0 *= 1.0f / (1.0f + __expf(-bflo(gg.x))); y1 *= 1.0f / (1.0f + __expf(-bfhi(gg.x))); y2 *= 1.0f / (1.0f + __expf(-bflo(gg.y))); y3 *= 1.0f / (1.0f + __expf(-bfhi(gg.y))); }
            v2u w; w.x = pk2(y0, y1); w.y = pk2(y2, y3);
            *(v2u*)(orow + 32 * c + 8 * g) = w;
        }
}
__device__ __forceinline__ void mem_attn_unit(const Ctx& C, int v, const bf16* P, int ldp, int qcol, int layer) {
    const int qblk = v >> 2, mh = v & 3, b = qblk >> 4;
    attn_unit<false>(C.lds + RING_OFF, P + (size_t)(qblk * 256) * ldp + qcol + mh * HD, ldp,
                     WSP(bf16, WS_MK) + (size_t)layer * 1024 * 512 + (size_t)(b * ML) * 512 + mh * HD, 512, WSP(bf16, WS_MKV) + (size_t)(b * ML) * 1024 + 512 + mh * HD, 1024,
                     nullptr, 0, ML / 64, WSP(bf16, WS_CAT) + (size_t)(qblk * 256) * D + FW + mh * HD, D, nullptr, 0, C.tid, C.lane, C.wave);
}
__device__ __forceinline__ void p4_fox_attn(const Ctx& C) {
    const bf16* P = WSP(bf16, WS_P);
    unsigned* ctr = (unsigned*)(C.ws + WS_CTL) + CW_Q0;
    volatile LAS unsigned* uw = (volatile LAS unsigned*)(C.lds + RING_OFF + AT_U);
    for (;;) {
        __syncthreads();
        if (C.tid == 0) *uw = atomicAdd(ctr, 1u);
        __syncthreads();
        const int u = (int)*uw;
        if (u >= 768 + 256) break;
#if !defined(AT_ONLY_MEM)
        if (u < 768) {
            const int qb = 15 - u / 48, bh = u % 48, b = bh / FH, hh = bh % FH;
            const size_t rb = (size_t)(b * S + 256 * qb);
            attn_unit<true>(C.lds + RING_OFF, P + rb * FOX_NP + FP_Q + hh * HD, FOX_NP, P + (size_t)(b * S) * FOX_NP + FP_K + hh * HD, FOX_NP, P + (size_t)(b * S) * FOX_NP + FP_V + hh * HD, FOX_NP,
                           WSP(float, WS_C) + (size_t)bh * S, 256 * qb, 4 * qb + 4, WSP(bf16, WS_CAT) + rb * D + hh * HD, D, P + rb * FOX_NP + FP_OG + hh * HD, FOX_NP, C.tid, C.lane, C.wave);
        } else
#endif
#if !defined(AT_ONLY_FOX)
        mem_attn_unit(C, u - 768, P, FOX_NP, FP_QM, 0);
#else
        {}
#endif
    }
}

__device__ __forceinline__ void p13_mem_attn(const Ctx& C) {
    const bf16* P = WSP(bf16, WS_P);
    unsigned* ctr = (unsigned*)(C.ws + WS_CTL) + CW_Q1;
    volatile LAS unsigned* uw = (volatile LAS unsigned*)(C.lds + RING_OFF + AT_U);
    for (;;) {
        __syncthreads();
        if (C.tid == 0) *uw = atomicAdd(ctr, 1u);
        __syncthreads();
        const int u = (int)*uw;
        if (u >= 256) break;
        mem_attn_unit(C, u, P, GLA_NP, GP_QM, 1);
    }
}

constexpr int GT_STRIDE = 400;
constexpr int GT_QE = 0, GT_KE = 25600, GT_V = 51200;
constexpr int GSEG = 8, GCH = 8;
constexpr size_t WS_QE = WS_H, WS_KE = WS_H + 24 * MiB, WS_DL = WS_H + 48 * MiB, WS_DSEG = WS_H + 49 * MiB;
constexpr size_t WS_SLOC = WS_XG + 96 * MiB;

__device__ __forceinline__ void p12_gla_prep(const Ctx& C) {
    bf16* P = WSP(bf16, WS_P);
    for (int m = C.gw; m < T; m += C.NGW) headnorm_inplace(P + (size_t)m * GLA_NP, GP_QM, MH, C.in[13] + HD, C.lane);
    const float* w2 = C.in[10]; const float* ba = C.in[11];
    bf16* QE = WSP(bf16, WS_QE); bf16* KE = WSP(bf16, WS_KE); float* DL = WSP(float, WS_DL);
    const float qsc = 0.07216878364870322f;
    for (int cg = blockIdx.x; cg < T / 64; cg += C.G) {
        for (int c = C.tid; c < GKW; c += 512) {
            float w[16];
#pragma unroll
            for (int r = 0; r < 16; ++r) w[r] = w2[r * GKW + c];
            const float bb = ba[c]; float bc = 0.f;
#pragma unroll 2
            for (int t = 0; t < 64; ++t) {
                const size_t row = (size_t)cg * 64 + t;
                const float* fl = WSP(float, WS_FL) + row * 16;
                float s = bb;
#pragma unroll
                for (int r = 0; r < 16; ++r) s += fl[r] * w[r];
                bc += log_sigmoid(s) * (1.0f / 16.0f);
                const float e = expf(bc);
                const float q = bf2f(P[row * GLA_NP + GP_Q + c]), k = bf2f(P[row * GLA_NP + GP_K + c]);
                QE[row * GKW + c] = (bf16)(pk2(q * e * qsc, 0.f) & 0xffffu);
                KE[row * GKW + c] = (bf16)(pk2(k / e, 0.f) & 0xffffu);
            }
            DL[(size_t)cg * GKW + c] = expf(bc);
        }
    }
}

__device__ __forceinline__ bf16x8 pack8(const f32x16& x, int s) {
    v4u w; w.x = pk2(x[8 * s], x[8 * s + 1]); w.y = pk2(x[8 * s + 2], x[8 * s + 3]); w.z = pk2(x[8 * s + 4], x[8 * s + 5]); w.w = pk2(x[8 * s + 6], x[8 * s + 7]);
    return __builtin_bit_cast(bf16x8, w);
}
__device__ __forceinline__ s16x4 tr4(const LAS unsigned char* tile, int r0, int c0, int lane) {
    const int q = (lane & 15) >> 2, p = lane & 3, blk = (lane >> 4) & 1;
    return __builtin_amdgcn_ds_read_tr16_b64_v4i16((LAS s16x4*)(tile + (r0 + q) * GT_STRIDE + 2 * (c0 + 16 * blk + 4 * p)));
}
template <bool OUT>
__device__ __forceinline__ void gla_unit(const Ctx& C, int u) {
    const int seg = u & 7, eh = (u >> 3) & 1, bh = u >> 4, b = bh >> 2, hd = bh & 3;
    const int tid = C.tid, lane = C.lane, w = C.wave, r = lane & 31, h = lane >> 5;
    LAS unsigned char* lds = C.lds + RING_OFF;
    const bf16* QE = WSP(bf16, WS_QE); const bf16* KE = WSP(bf16, WS_KE); const bf16* P = WSP(bf16, WS_P);
    const float* DL = WSP(float, WS_DL); float* DSEG = WSP(float, WS_DSEG); float* SLOC = WSP(float, WS_SLOC); float* GO = WSP(float, WS_GO);
    f32x16 Sx[6];
#pragma unroll
    for (int dt = 0; dt < 6; ++dt)
#pragma unroll
        for (int i = 0; i < 16; ++i) Sx[dt][i] = 0.f;
    if (OUT && w < 6) {
        for (int sp = 0; sp < seg; ++sp) {
            const float* sl = SLOC + ((((size_t)(bh * GSEG + sp) * 2 + eh) * 6 + w) * 6) * 1024;
            const float* dsg = DSEG + (size_t)(bh * GSEG + sp) * GDK;
#pragma unroll
            for (int dt = 0; dt < 6; ++dt)
#pragma unroll
                for (int g = 0; g < 4; ++g) { const f32x4 dv = *(const f32x4*)(dsg + 32 * dt + 8 * g + 4 * h);
#pragma unroll
                    for (int j = 0; j < 4; ++j) Sx[dt][4 * g + j] = dv[j] * Sx[dt][4 * g + j] + sl[(dt * 16 + 4 * g + j) * 64 + lane]; }
        }
    }
    float dacc[3] = {1.f, 1.f, 1.f};
#pragma unroll 1
    for (int cc = 0; cc < GCH; ++cc) {
        const int cs = seg * GCH + cc; const size_t row0 = (size_t)b * S + (size_t)cs * 64; const int cg = b * 64 + cs;
        __syncthreads();
#pragma unroll
        for (int i = 0; i < 3; ++i) { const int n = tid + 512 * i, row = n / 24, ch = n % 24;
            if (OUT) *(LAS v4u*)(lds + GT_QE + row * GT_STRIDE + 16 * ch) = *(const v4u*)(QE + (row0 + row) * GKW + hd * GDK + 8 * ch);
            *(LAS v4u*)(lds + GT_KE + row * GT_STRIDE + 16 * ch) = *(const v4u*)(KE + (row0 + row) * GKW + hd * GDK + 8 * ch);
            *(LAS v4u*)(lds + GT_V + row * GT_STRIDE + 16 * ch) = *(const v4u*)(P + (row0 + row) * GLA_NP + GP_V + hd * GDV + eh * 192 + 8 * ch); }
        __syncthreads();
        if (w < 6) {
            int lane = C.lane; asm volatile("" : "+v"(lane));
            const int r = lane & 31, h = lane >> 5;
            const LAS unsigned char* tq = lds + GT_QE; const LAS unsigned char* tk = lds + GT_KE; const LAS unsigned char* tv = lds + GT_V;
            if (OUT) {
#pragma unroll
                for (int it = 0; it < 2; ++it) {
                    f32x16 ao;
#pragma unroll
                    for (int i = 0; i < 16; ++i) ao[i] = 0.f;
#pragma unroll
                    for (int dt = 0; dt < 6; ++dt)
#pragma unroll
                        for (int s = 0; s < 2; ++s) {
                            const bf16x8 a = pack8(Sx[dt], s);
                            const LAS unsigned char* qp = tq + (32 * it + r) * GT_STRIDE + 2 * (32 * dt + 16 * s + 4 * h);
                            const s16x4 lo = *(const LAS s16x4*)qp, hi = *(const LAS s16x4*)(qp + 16);
                            const bf16x8 bq = __builtin_shufflevector(lo, hi, 0, 1, 2, 3, 4, 5, 6, 7);
                            ao = __builtin_amdgcn_mfma_f32_32x32x16_bf16(a, bq, ao, 0, 0, 0);
                        }
                    __builtin_amdgcn_sched_barrier(0);
#pragma unroll
                    for (int jt = 0; jt <= it; ++jt) {
                        f32x16 at;
#pragma unroll
                        for (int i = 0; i < 16; ++i) at[i] = 0.f;
#pragma unroll
                        for (int s = 0; s < 12; ++s) {
                            const bf16x8 a = *(const LAS bf16x8*)(tk + (32 * jt + r) * GT_STRIDE + 16 * (2 * s + h));
                            const bf16x8 bq = *(const LAS bf16x8*)(tq + (32 * it + r) * GT_STRIDE + 16 * (2 * s + h));
                            at = __builtin_amdgcn_mfma_f32_32x32x16_bf16(a, bq, at, 0, 0, 0);
                        }
                        if (jt == it) {
#pragma unroll
                            for (int i = 0; i < 16; ++i) if (((i & 3) + 8 * (i >> 2) + 4 * h) > r) at[i] = 0.f;
                        }
#pragma unroll
                        for (int s = 0; s < 2; ++s) {
                            const bf16x8 bp = pack8(at, s);
                            const s16x4 lo = tr4(tv, 32 * jt + 16 * s + 4 * h, 32 * w, lane), hi = tr4(tv, 32 * jt + 16 * s + 8 + 4 * h, 32 * w, lane);
                            const bf16x8 av = __builtin_shufflevector(lo, hi, 0, 1, 2, 3, 4, 5, 6, 7);
                            ao = __builtin_amdgcn_mfma_f32_32x32x16_bf16(av, bp, ao, 0, 0, 0);
                        }
                    }
                    __builtin_amdgcn_sched_barrier(0);
                    float* op = GO + (row0 + 32 * it + r) * GVW + hd * GDV + eh * 192 + 32 * w + 4 * h;
#pragma unroll
                    for (int g = 0; g < 4; ++g) *(f32x4*)(op + 8 * g) = (f32x4){ao[4 * g], ao[4 * g + 1], ao[4 * g + 2], ao[4 * g + 3]};
                }
            }
            __builtin_amdgcn_sched_barrier(0);
            bf16x8 bv[4];
#pragma unroll
            for (int ks = 0; ks < 4; ++ks) { const s16x4 lo = tr4(tv, 16 * ks + 8 * h, 32 * w, lane), hi = tr4(tv, 16 * ks + 8 * h + 4, 32 * w, lane);
                bv[ks] = __builtin_shufflevector(lo, hi, 0, 1, 2, 3, 4, 5, 6, 7); }
            const float* dlp = DL + (size_t)cg * GKW + hd * GDK;
#pragma unroll
            for (int dt = 0; dt < 6; ++dt) {
#pragma unroll
                for (int ks = 0; ks < 4; ++ks) { const s16x4 lo = tr4(tk, 16 * ks + 8 * h, 32 * dt, lane), hi = tr4(tk, 16 * ks + 8 * h + 4, 32 * dt, lane);
                    const bf16x8 ak = __builtin_shufflevector(lo, hi, 0, 1, 2, 3, 4, 5, 6, 7);
                    Sx[dt] = __builtin_amdgcn_mfma_f32_32x32x16_bf16(ak, bv[ks], Sx[dt], 0, 0, 0); }
#pragma unroll
                for (int g = 0; g < 4; ++g) { const f32x4 dv = *(const f32x4*)(dlp + 32 * dt + 8 * g + 4 * h);
#pragma unroll
                    for (int j = 0; j < 4; ++j) Sx[dt][4 * g + j] *= dv[j]; }
            }
        } else if (!OUT && w == 6) {
            const float* dlp = DL + (size_t)cg * GKW + hd * GDK;
#pragma unroll
            for (int i = 0; i < 3; ++i) dacc[i] *= dlp[lane + 64 * i];
        }
    }
    if (!OUT) {
        if (w < 6) { float* sl = SLOC + ((((size_t)(bh * GSEG + seg) * 2 + eh) * 6 + w) * 6) * 1024;
#pragma unroll
            for (int dt = 0; dt < 6; ++dt)
#pragma unroll
                for (int i = 0; i < 16; ++i) sl[(dt * 16 + i) * 64 + lane] = Sx[dt][i]; }
        else if (w == 6 && eh == 0) {
#pragma unroll
            for (int i = 0; i < 3; ++i) DSEG[(size_t)(bh * GSEG + seg) * GDK + lane + 64 * i] = dacc[i]; }
    }
}
__device__ __forceinline__ void p13a_gla_local(const Ctx& C) { for (int u = blockIdx.x; u < 256; u += C.G) if ((u & 7) != 7) gla_unit<false>(C, u); }
__device__ __forceinline__ void p13b_gla_out(const Ctx& C) { for (int u = blockIdx.x; u < 256; u += C.G) gla_unit<true>(C, u); }

constexpr int NPHASE = 22;
struct Args { const float* in[24]; float* out; unsigned char* ws; int ph_lo, ph_hi; };
#define PG8_ALIGN true
#define PG8_SP2 true

template <class Epi, class Sched>
__device__ __forceinline__ void run_gemm(const Ctx& C, const bf16* A, const bf16* Bt, int K, const Sched& Sd, const Epi& E) {
    pg8::Gemm g{A, Bt, 0, 0, K};
    pg8::gemm_phase<Epi, Sched, PG8_ALIGN, PG8_SP2>(C.lds + RING_OFF, g, Sd, E);
}
__device__ __forceinline__ void dense_gemm_p(const Ctx& C, const bf16* A, const bf16* Bt, int M, int N, int K, bf16* P, int ldp, float* FL, int ftile) {
    pg8::StaticOrder Sd; Sd.init(M, N, C.G, (int)blockIdx.x); pg8::EpiP E{P, ldp, FL, ftile}; run_gemm(C, A, Bt, K, Sd, E);
}
__device__ __forceinline__ void ph_wout(const Ctx& C, int layer) {
    pg8::StaticOrder Sd; Sd.init(T, D, C.G, (int)blockIdx.x);
    pg8::EpiRes E{layer == 0 ? C.in[0] : WSP(float, WS_XA), WSP(float, WS_XB), D};
    run_gemm(C, WSP(bf16, WS_CAT), WSP(bf16, WS_WOUT) + (size_t)layer * D * D, D, Sd, E);
}
__device__ __forceinline__ void ph_gu(const Ctx& C, int layer) {
    const int* tilee = (const int*)(C.ws + WS_ROUTE + RT_TILEE) + layer * 256;
    pg8::MoeOrder Sd{tilee, tilee[255] * 8, C.G, (int)blockIdx.x}; pg8::EpiGU E{WSP(bf16, WS_H)};
    run_gemm(C, WSP(bf16, WS_XG), WSP(bf16, WS_WGU) + (size_t)layer * NE * 2048 * 2048, D, Sd, E);
}
__device__ __forceinline__ void ph_down(const Ctx& C, int layer) {
    const int* tilee = (const int*)(C.ws + WS_ROUTE + RT_TILEE) + layer * 256;
    pg8::MoeOrder Sd{tilee, tilee[255] * 8, C.G, (int)blockIdx.x};
    pg8::EpiDown E{(const int*)(C.ws + WS_ROUTE + RT_ROWDEST) + layer * MAXROWS, (const float*)(C.ws + WS_ROUTE + RT_ROWW), WSP(bf16, WS_YB)};
    run_gemm(C, WSP(bf16, WS_H), WSP(bf16, WS_WD) + (size_t)layer * NE * 2048 * 1024, DE, Sd, E);
}

__global__ void __launch_bounds__(NWAVES * 64, 2) fwd_kernel(Args args) {
    extern __shared__ __attribute__((aligned(16))) unsigned char lds[];
    Ctx C;
    C.lds = (LAS unsigned char*)lds;
    C.tid = threadIdx.x; C.lane = C.tid & 63; C.wave = __builtin_amdgcn_readfirstlane(C.tid >> 6);
    C.G = gridDim.x; C.gw = blockIdx.x * NWAVES + C.wave; C.NGW = C.G * NWAVES;
#pragma unroll
    for (int i = 0; i < 24; ++i) C.in[i] = args.in[i];
    C.out = args.out; C.ws = args.ws;
    volatile LAS unsigned* MISC = (volatile LAS unsigned*)(C.lds + MISC_OFF);
    for (int u = C.tid; u < (LDS_BYTES - LDSCTL_OFF) / 4; u += NWAVES * 64) ((LAS unsigned*)(C.lds + LDSCTL_OFF))[u] = 0u;
    __syncthreads();
    const int lo = args.ph_lo, hi = args.ph_hi;
    XcdBarrier bar; bar.bar = (unsigned*)(C.ws + WS_CTL) + CW_BAR; bar.x = 0; bar.st = nullptr;
    if (hi - lo > 1) bar = xcd_barrier_post((unsigned*)(C.ws + WS_CTL) + CW_BAR, MISC + 8);
#ifndef PHSEL
#define PHSEL 0xFFFFFFFFu
#endif
#define SITE(s) ((PHSEL >> (s)) & 1u)
#define IN(k) (lo <= (k) && (k) < hi)
#define SEAM(k) do { if (IN(k) && IN((k) + 1)) xcd_barrier(bar); } while (0)

    if (SITE(0) && IN(0)) p0_prologue(C);
    SEAM(0);
    if (SITE(1) && IN(1)) dense_gemm_p(C, WSP(bf16, WS_MEMN), WSP(bf16, WS_WMKV), NB * ML, 1024, D, WSP(bf16, WS_MKV), 1024, nullptr, -1);
    SEAM(1);
    if (SITE(2) && IN(2)) dense_gemm_p(C, WSP(bf16, WS_HN), WSP(bf16, WS_WFOX), T, FOX_NP, D, WSP(bf16, WS_P), FOX_NP, WSP(float, WS_FL), FP_F / 256);
    SEAM(2);
    if (SITE(3) && IN(3)) p3_fox_thin(C);
    SEAM(3);
    if (SITE(4) && IN(4)) p4_fox_attn(C);
    SEAM(4);
    if (SITE(5) && IN(5)) ph_wout(C, 0);
    SEAM(5);
    if (SITE(6) && IN(6)) p6_router(C, 0);
    SEAM(6);
    if (SITE(7) && IN(7)) p7_dispatch(C, 0);
    SEAM(7);
    if (SITE(8) && IN(8)) ph_gu(C, 0);
    SEAM(8);
    if (SITE(9) && IN(9)) ph_down(C, 0);
    SEAM(9);
    if (SITE(10) && IN(10)) p_combine(C, WSP(float, WS_XB), WSP(float, WS_XA), C.in[4] + D);
    SEAM(10);
    if (SITE(11) && IN(11)) dense_gemm_p(C, WSP(bf16, WS_HN), WSP(bf16, WS_WGLA), T, GLA_NP, D, WSP(bf16, WS_P), GLA_NP, WSP(float, WS_FL), GP_A / 256);
    SEAM(11);
    if (SITE(12) && IN(12)) p12_gla_prep(C);
    SEAM(12);
    if (SITE(13) && IN(13)) p13a_gla_local(C);
    SEAM(13);
#if defined(NO_MEM14)
    if (SITE(14) && IN(14)) { p13b_gla_out(C); }
#elif defined(NO_GLA14)
    if (SITE(14) && IN(14)) { p13_mem_attn(C); }
#else
    if (SITE(14) && IN(14)) { p13b_gla_out(C); p13_mem_attn(C); }
#endif
    SEAM(14);
    if (SITE(15) && IN(15)) p14_gla_onorm(C);
    SEAM(15);
    if (SITE(16) && IN(16)) ph_wout(C, 1);
    SEAM(16);
    if (SITE(17) && IN(17)) p6_router(C, 1);
    SEAM(17);
    if (SITE(18) && IN(18)) p7_dispatch(C, 1);
    SEAM(18);
    if (SITE(19) && IN(19)) ph_gu(C, 1);
    SEAM(19);
    if (SITE(20) && IN(20)) ph_down(C, 1);
    SEAM(20);
    if (SITE(21) && IN(21)) p_combine(C, WSP(float, WS_XB), C.out, nullptr);
#undef IN
#undef SEAM
}

extern "C" void kernel_launch(void* const* d_in, const int* in_sizes, int n_in, void* d_out, int out_size, void* d_ws, size_t ws_size, hipStream_t stream) {
    static int grid = 0;
    if (grid == 0) {
        if (n_in != 24 || out_size != T * D || ws_size < WS_END) { fprintf(stderr, "kernel_launch: unexpected problem (n_in %d, out %d, ws %zu < %zu)\n", n_in, out_size, ws_size, (size_t)WS_END); grid = -1; return; }
        int dev = 0, cus = 0, per_cu = 0;
        if (hipGetDevice(&dev) != hipSuccess || hipDeviceGetAttribute(&cus, hipDeviceAttributeMultiprocessorCount, dev) != hipSuccess) { grid = -1; return; }
        if (hipFuncSetAttribute((const void*)fwd_kernel, hipFuncAttributeMaxDynamicSharedMemorySize, LDS_BYTES) != hipSuccess) { fprintf(stderr, "kernel_launch: hipFuncSetAttribute failed\n"); grid = -1; return; }
        if (hipOccupancyMaxActiveBlocksPerMultiprocessor(&per_cu, (const void*)fwd_kernel, NWAVES * 64, LDS_BYTES) != hipSuccess || per_cu < 1)
            fprintf(stderr, "kernel_launch: occupancy query reports %d workgroups per CU\n", per_cu);
        (void)hipGetLastError();
        grid = cus;
    }
    if (grid < 0) return;
    if (hipMemsetAsync((char*)d_ws + WS_CTL, 0, CTL_ZERO_BYTES, stream) != hipSuccess) return;
    Args a{};
    for (int i = 0; i < 24; ++i) a.in[i] = (const float*)d_in[i];
    a.out = (float*)d_out; a.ws = (unsigned char*)d_ws;
#if MK_N_LAUNCHES == 1
    a.ph_lo = 0; a.ph_hi = NPHASE;
    hipLaunchKernelGGL(fwd_kernel, dim3(grid), dim3(NWAVES * 64), LDS_BYTES, stream, a);
#else
    for (int p = 0; p < NPHASE; ++p) { a.ph_lo = p; a.ph_hi = p + 1; hipLaunchKernelGGL(fwd_kernel, dim3(grid), dim3(NWAVES * 64), LDS_BYTES, stream, a); }
#endif
}
```

```cpp
#include <hip/hip_runtime.h>
#include <cstdio>
#include <cstdint>
#ifndef MK_N_LAUNCHES
#define MK_N_LAUNCHES 1
#endif
namespace pg8 {
#define PG8_LAS __attribute__((address_space(3)))
typedef unsigned short bf16_t;
typedef short bf16x8 __attribute__((ext_vector_type(8)));
typedef float f32x4 __attribute__((ext_vector_type(4)));
typedef unsigned u32x4 __attribute__((ext_vector_type(4)));
constexpr int BM = 256, BK = 64, HALF = 128, HTB = HALF * BK * 2  , STAGE_BYTES = 8 * HTB, NXCD = 8, WGM = 8;

__host__ __device__ __forceinline__ int lds_byte(int r, int c) { const int st = (r >> 4) * 2 + (c >> 5), rr = r & 15, cc = c & 31, ob = rr * 64 + cc * 2; return st * 1024 + (ob ^ (((ob >> 9) & 1) << 5)); }
__host__ __device__ __forceinline__ void stage_rc(int b, int& R, int& C) { const int st = b / 1024, sb = b % 1024, swz = sb ^ (((sb >> 9) & 1) << 5); R = (st >> 1) * 16 + swz / 64; C = (st & 1) * 32 + (swz % 64) / 2; }
__host__ __device__ __forceinline__ int perm32(int rho) { const int n = rho >> 4, i = rho & 15; return 8 * (i >> 2) + 4 * n + (i & 3); }

struct Unit { int pm, pn; };
struct Gemm { const bf16_t* A; const bf16_t* Bt; int M, N, K; };

struct StaticOrder {
    int nM, nN, nwg, G, c;
    __host__ __device__ void init(int M, int N, int G_, int c_) { nM = M / BM; nN = N / BM; nwg = nM * nN; G = G_; c = c_; }
    __host__ __device__ bool next(int i, Unit& u) const {
        const long L = (long)i * G + c; if (L >= nwg) return false;
        int wgid = (int)L; { const int q = nwg / NXCD, r = nwg % NXCD, xcd = wgid % NXCD, off = wgid / NXCD; wgid = (xcd < r ? xcd * (q + 1) : r * (q + 1) + (xcd - r) * q) + off; }
        const int nig = WGM * nN, gid = wgid / nig, fm = gid * WGM, gsz = (nM - fm) < WGM ? (nM - fm) : WGM;
        u.pm = fm + ((wgid % nig) % gsz); u.pn = (wgid % nig) / gsz; return true;
    }
    __device__ __forceinline__ void a_ready(const Unit&) const {}
    __device__ __forceinline__ void done(const Unit&) const {}
};
template <class Epi, class Sched, bool ALIGN_EPI = false, bool SP2 = false>
__device__ __forceinline__ void gemm_phase(PG8_LAS unsigned char* lds, const Gemm g, const Sched& S, const Epi& E) {
    const int tid = threadIdx.x, wid = __builtin_amdgcn_readfirstlane(tid >> 6), lane = tid & 63, wr = wid >> 2, wc = wid & 3, fr = lane & 15, fq = lane >> 4;
    const int K = g.K, nt = K / BK;
    unsigned voffA[2], voffB[2];
#pragma unroll
    for (int i = 0; i < 2; ++i) { int R, C; stage_rc(tid * 16 + i * 8192, R, C); const int Rb = Epi::PERM ? ((R & ~31) + perm32(R & 31)) : R;
        voffA[i] = (unsigned)(R * K + C) * 2u; voffB[i] = (unsigned)(Rb * K + C) * 2u; }
    const size_t kstep = (size_t)(BK * 2);
    const size_t hstep = (size_t)HALF * K * 2;
    const size_t tstep = 2 * hstep;
    const unsigned ldsw = (unsigned)wid * 1024u;
    const int aoff = lds_byte(wr * 64 + fr, fq * 8), boff = lds_byte(wc * 32 + fr, fq * 8);
#define PG8_SA(b, h) (((b) * 2 + (h)) * HTB)
#define PG8_SB(b, h) ((4 + (b) * 2 + (h)) * HTB)
#define PG8_STAGE(bufoff, gbase, voff) do { _Pragma("unroll") for (int _i = 0; _i < 2; ++_i) \
        __builtin_amdgcn_global_load_lds((const unsigned*)((const char*)(gbase) + (voff)[_i]), (PG8_LAS unsigned*)(lds + (bufoff) + ldsw + _i * 8192), 16, 0, 0); } while (0)
#define PG8_LDA(dst, b, h) do { _Pragma("unroll") for (int m = 0; m < 4; ++m) _Pragma("unroll") for (int k = 0; k < 2; ++k) dst[m][k] = *(const PG8_LAS bf16x8*)(lds + PG8_SA(b, h) + aoff + m * 2048 + k * 1024); } while (0)
#define PG8_LDB(dst, b, h) do { _Pragma("unroll") for (int n = 0; n < 2; ++n) _Pragma("unroll") for (int k = 0; k < 2; ++k) dst[n][k] = *(const PG8_LAS bf16x8*)(lds + PG8_SB(b, h) + boff + n * 2048 + k * 1024); } while (0)
#define PG8_MMA(ai, bj, At, Bt) do { __builtin_amdgcn_s_setprio(1); _Pragma("unroll") for (int m = 0; m < 4; ++m) _Pragma("unroll") for (int n = 0; n < 2; ++n) _Pragma("unroll") for (int k = 0; k < 2; ++k) \
        acc[ai][bj][m][n] = __builtin_amdgcn_mfma_f32_16x16x32_bf16(Bt[n][k], At[m][k], acc[ai][bj][m][n], 0, 0, 0); __builtin_amdgcn_s_setprio(0); } while (0)
#define PG8_WAIT_V(n) asm volatile("s_waitcnt vmcnt(" #n ")" ::: "memory")
#define PG8_WAIT_L(n) asm volatile("s_waitcnt lgkmcnt(" #n ")" ::: "memory")
#define PG8_BAR __builtin_amdgcn_s_barrier()
#define PG8_SCHED __builtin_amdgcn_sched_barrier(0)
    Unit cur, nxt; int ui = 0;
    if (!S.next(0, cur)) return;
    f32x4 acc[2][2][4][2];
#pragma unroll
    for (int a = 0; a < 2; ++a)
#pragma unroll
        for (int b = 0; b < 2; ++b)
#pragma unroll
            for (int m = 0; m < 4; ++m)
#pragma unroll
                for (int n = 0; n < 2; ++n) acc[a][b][m][n] = (f32x4){0.f, 0.f, 0.f, 0.f};
    bf16x8 At[4][2], B0[2][2], B1[2][2];
    const char* cA = (const char*)g.A + (size_t)cur.pm * tstep; const char* cB = (const char*)g.Bt + (size_t)cur.pn * tstep;
    S.a_ready(cur);
    if constexpr (SP2) {
        PG8_STAGE(PG8_SB(0, 0), cB, voffB); PG8_STAGE(PG8_SB(0, 1), cB + hstep, voffB); PG8_STAGE(PG8_SA(0, 0), cA, voffA); PG8_STAGE(PG8_SA(0, 1), cA + hstep, voffA);
        if (wr == 1) PG8_BAR;
        PG8_WAIT_V(2); PG8_BAR;
        PG8_STAGE(PG8_SB(1, 0), cB + kstep, voffB); PG8_STAGE(PG8_SA(1, 0), cA + kstep, voffA); PG8_STAGE(PG8_SB(1, 1), cB + hstep + kstep, voffB);
        PG8_WAIT_V(6); PG8_BAR;
    } else {
        PG8_STAGE(PG8_SB(0, 0), cB, voffB); PG8_STAGE(PG8_SA(0, 0), cA, voffA); PG8_STAGE(PG8_SB(0, 1), cB + hstep, voffB); PG8_STAGE(PG8_SA(0, 1), cA + hstep, voffA);
        if (wr == 1) PG8_BAR;
        PG8_WAIT_V(4); PG8_BAR;
        PG8_STAGE(PG8_SB(1, 0), cB + kstep, voffB); PG8_STAGE(PG8_SA(1, 0), cA + kstep, voffA); PG8_STAGE(PG8_SB(1, 1), cB + hstep + kstep, voffB);
        PG8_WAIT_V(6); PG8_BAR;
    }
    for (;;) {
        const bool has_next = S.next(ui + 1, nxt);
        const char* nA = has_next ? (const char*)g.A + (size_t)nxt.pm * tstep : cA; const char* nB = has_next ? (const char*)g.Bt + (size_t)nxt.pn * tstep : cB;
        for (int t = 0; t < nt; t += 2) {
            const bool last = (t == nt - 2);
            const char* a1 = cA + (size_t)(t + 1) * kstep;
            const char* a2 = last ? nA : cA + (size_t)(t + 2) * kstep; const char* b2 = last ? nB : cB + (size_t)(t + 2) * kstep;
            const char* a3 = a2 + kstep; const char* b3 = b2 + kstep;
            if (last && has_next) S.a_ready(nxt);
            if constexpr (SP2) {
            PG8_LDB(B0, 0, 0); PG8_LDB(B1, 0, 1); PG8_SCHED; PG8_LDA(At, 0, 0); PG8_STAGE(PG8_SA(1, 1), a1 + hstep, voffA);
            PG8_WAIT_V(8); PG8_WAIT_L(0); PG8_BAR; PG8_MMA(0, 0, At, B0); PG8_MMA(0, 1, At, B1); PG8_BAR; PG8_SCHED;
            PG8_LDA(At, 0, 1); PG8_STAGE(PG8_SB(0, 0), b2, voffB); PG8_STAGE(PG8_SB(0, 1), b2 + hstep, voffB); PG8_STAGE(PG8_SA(0, 0), a2, voffA);
            PG8_WAIT_V(8); PG8_WAIT_L(0); PG8_BAR; PG8_MMA(1, 0, At, B0); PG8_MMA(1, 1, At, B1); PG8_BAR; PG8_SCHED;
            PG8_LDB(B0, 1, 0); PG8_LDB(B1, 1, 1); PG8_SCHED; PG8_LDA(At, 1, 0); PG8_STAGE(PG8_SA(0, 1), a2 + hstep, voffA);
            PG8_WAIT_V(8); PG8_WAIT_L(0); PG8_BAR; PG8_MMA(0, 0, At, B0); PG8_MMA(0, 1, At, B1); PG8_BAR; PG8_SCHED;
            PG8_LDA(At, 1, 1); PG8_STAGE(PG8_SB(1, 0), b3, voffB); PG8_STAGE(PG8_SB(1, 1), b3 + hstep, voffB); PG8_STAGE(PG8_SA(1, 0), a3, voffA);
            PG8_WAIT_V(8); PG8_WAIT_L(0); PG8_BAR; PG8_MMA(1, 0, At, B0); PG8_MMA(1, 1, At, B1); PG8_BAR; PG8_SCHED;
            } else {
            PG8_LDB(B0, 0, 0); PG8_SCHED; PG8_LDA(At, 0, 0); PG8_STAGE(PG8_SA(1, 1), a1 + hstep, voffA);
            PG8_WAIT_L(8); PG8_BAR; PG8_WAIT_L(0); PG8_MMA(0, 0, At, B0); PG8_BAR; PG8_SCHED;
            PG8_LDB(B1, 0, 1); PG8_STAGE(PG8_SB(0, 0), b2, voffB);
            PG8_BAR; PG8_WAIT_L(0); PG8_MMA(0, 1, At, B1); PG8_BAR;
            PG8_LDA(At, 0, 1); PG8_STAGE(PG8_SA(0, 0), a2, voffA);
            PG8_BAR; PG8_WAIT_L(0); PG8_MMA(1, 0, At, B0); PG8_BAR; PG8_SCHED;
            PG8_STAGE(PG8_SB(0, 1), b2 + hstep, voffB);
            PG8_WAIT_V(6); PG8_BAR; PG8_MMA(1, 1, At, B1); PG8_BAR;
            PG8_LDB(B0, 1, 0); PG8_SCHED; PG8_LDA(At, 1, 0); PG8_STAGE(PG8_SA(0, 1), a2 + hstep, voffA);
            PG8_WAIT_L(8); PG8_BAR; PG8_WAIT_L(0); PG8_MMA(0, 0, At, B0); PG8_BAR; PG8_SCHED;
            PG8_LDB(B1, 1, 1); PG8_STAGE(PG8_SB(1, 0), b3, voffB);
            PG8_BAR; PG8_WAIT_L(0); PG8_MMA(0, 1, At, B1); PG8_BAR;
            PG8_LDA(At, 1, 1); PG8_STAGE(PG8_SA(1, 0), a3, voffA);
            PG8_BAR; PG8_WAIT_L(0); PG8_MMA(1, 0, At, B0); PG8_BAR; PG8_SCHED;
            PG8_STAGE(PG8_SB(1, 1), b3 + hstep, voffB);
            PG8_WAIT_V(6); PG8_BAR; PG8_MMA(1, 1, At, B1); PG8_BAR;
            }
        }
        if constexpr (ALIGN_EPI) { if (wr == 0) PG8_BAR; }
        if constexpr (!Epi::AFTER_DRAIN) { E(acc, cur, wr, wc, fr, fq); S.done(cur); }
        if (!has_next) break;
#pragma unroll
        for (int a = 0; a < 2; ++a)
#pragma unroll
            for (int b = 0; b < 2; ++b)
#pragma unroll
                for (int m = 0; m < 4; ++m)
#pragma unroll
                    for (int n = 0; n < 2; ++n) acc[a][b][m][n] = (f32x4){0.f, 0.f, 0.f, 0.f};
        cur = nxt; cA = nA; cB = nB; ++ui;
        if constexpr (ALIGN_EPI) { if (wr == 1) PG8_BAR; }
    }
    PG8_WAIT_V(0);
    if constexpr (!ALIGN_EPI) { if (wr == 0) PG8_BAR; }
    PG8_BAR;
    if constexpr (Epi::AFTER_DRAIN) { E.fused(acc, cur, wr, wc, fr, fq, lds, wid, lane); S.done(cur); }
#undef PG8_SA
#undef PG8_SB
#undef PG8_STAGE
#undef PG8_LDA
#undef PG8_LDB
#undef PG8_MMA
#undef PG8_WAIT_V
#undef PG8_WAIT_L
#undef PG8_BAR
#undef PG8_SCHED
}
}

#define GAS __attribute__((address_space(1)))
#define LAS __attribute__((address_space(3)))
typedef unsigned short bf16;
typedef unsigned v4u __attribute__((ext_vector_type(4)));
typedef unsigned v2u __attribute__((ext_vector_type(2)));
typedef float f32x4 __attribute__((ext_vector_type(4)));
typedef float f32x2 __attribute__((ext_vector_type(2)));
typedef short bf16x8 __attribute__((ext_vector_type(8)));
typedef float f32x16 __attribute__((ext_vector_type(16)));
typedef short s16x4 __attribute__((ext_vector_type(4)));
typedef __bf16 bf16x2_t __attribute__((ext_vector_type(2)));
#define LDS_WAIT() asm volatile("s_waitcnt lgkmcnt(0)" ::: "memory")
#define VM_WAIT() asm volatile("s_waitcnt vmcnt(0)" ::: "memory")
__device__ __forceinline__ unsigned pk2(float lo, float hi) { f32x2 v = {lo, hi}; bf16x2_t r = __builtin_convertvector(v, bf16x2_t); return __builtin_bit_cast(unsigned, r); }
__device__ __forceinline__ float bflo(unsigned u) { return __builtin_bit_cast(float, u << 16); }
__device__ __forceinline__ float bfhi(unsigned u) { return __builtin_bit_cast(float, u & 0xffff0000u); }
__device__ __forceinline__ float bf2f(bf16 b) { return __builtin_bit_cast(float, ((unsigned)b) << 16); }
__device__ __forceinline__ float wave_sum(float v) {
#pragma unroll
    for (int o = 1; o < 64; o <<= 1) v += __shfl_xor(v, o);
    return v;
}
__device__ __forceinline__ float wave_max(float v) {
#pragma unroll
    for (int o = 1; o < 64; o <<= 1) v = fmaxf(v, __shfl_xor(v, o));
    return v;
}
#define XB_TMO      128
#define XB_XCNT(j)  (256  + 64 * (j))
#define XB_XSUB(j)  (1280 + 64 * (j))
#define XB_XGEN(j)  (2304 + 64 * (j))
#define XB_TOP      3328
#define XB_TOPGEN   3392
#define XCD_BAR_WORDS 3456
#define XB_SPIN_CAP (1u << 23)

__device__ __forceinline__ unsigned xb_ld(unsigned* p)              { return __hip_atomic_load(p, __ATOMIC_RELAXED, __HIP_MEMORY_SCOPE_AGENT); }
__device__ __forceinline__ unsigned xb_add(unsigned* p, unsigned v) { return __hip_atomic_fetch_add(p, v, __ATOMIC_RELAXED, __HIP_MEMORY_SCOPE_AGENT); }
__device__ __forceinline__ unsigned xb_xcc_id() { return (unsigned)__builtin_amdgcn_s_getreg((3 << 11) | 20) & 0xFu; }
#define XB_SPIN(cond, bar) do { unsigned _sp = 0; while (cond) { __builtin_amdgcn_s_sleep(1); \
    if ((++_sp & 255u) == 0u) { if (xb_ld(&(bar)[XB_TMO])) break; if (_sp > XB_SPIN_CAP) { atomicAdd(&(bar)[XB_TMO], 1u); break; } } } } while (0)

struct XcdBarrier {
    unsigned* bar; unsigned x;
    volatile LAS unsigned* st;
};

__device__ __forceinline__ XcdBarrier xcd_barrier_post(unsigned* bar, volatile LAS unsigned* st) {
    XcdBarrier b; b.bar = bar; b.x = xb_xcc_id(); b.st = st;
    if (threadIdx.x == 0) (void)xb_add(&bar[XB_XCNT(b.x)], 1u);
    return b;
}
__device__ __forceinline__ void xcd_barrier_complete(unsigned* bar, unsigned x, unsigned& nloc, unsigned& nx) {
    const unsigned G = gridDim.x * gridDim.y * gridDim.z;
    unsigned sum, cnt, mine, sp = 0u;
    for (;;) {
        sum = 0u; cnt = 0u; mine = 0u;
#pragma unroll
        for (unsigned j = 0; j < 16; ++j) { const unsigned c = xb_ld(&bar[XB_XCNT(j)]); sum += c; cnt += (c > 0u) ? 1u : 0u; mine = (j == x) ? c : mine; }
        if (sum == G) break;
        __builtin_amdgcn_s_sleep(1);
        if ((++sp & 255u) == 0u) { if (xb_ld(&bar[XB_TMO])) break; if (sp > XB_SPIN_CAP) { atomicAdd(&bar[XB_TMO], 1u); break; } }
    }
    nloc = mine > 0u ? mine : 1u; nx = cnt > 0u ? cnt : 1u;
}

__device__ __forceinline__ void xcd_barrier(const XcdBarrier& b) {
    asm volatile("s_waitcnt vmcnt(0)" ::: "memory");
    __syncthreads();
    if (threadIdx.x == 0) {
        unsigned* bar = b.bar;
        __builtin_amdgcn_s_waitcnt(0);
        unsigned nloc = b.st[0], nx = b.st[1];
        if (nloc == 0u) { xcd_barrier_complete(bar, b.x, nloc, nx); b.st[0] = nloc; b.st[1] = nx; }
        const unsigned old = xb_add(&bar[XB_XSUB(b.x)], 1u);
        const unsigned gen = old / nloc;
        if (old + 1u == (gen + 1u) * nloc) {
            __builtin_amdgcn_fence(__ATOMIC_RELEASE, "agent");
            asm volatile("s_waitcnt vmcnt(0)" ::: "memory");
            const unsigned og = xb_add(&bar[XB_TOP], 1u);
            const unsigned tg = og / nx;
            if (og + 1u == (tg + 1u) * nx) xb_add(&bar[XB_TOPGEN], 1u);
            else XB_SPIN(xb_ld(&bar[XB_TOPGEN]) == tg, bar);
            __builtin_amdgcn_fence(__ATOMIC_ACQUIRE, "agent");
            xb_add(&bar[XB_XGEN(b.x)], 1u);
            asm volatile("s_waitcnt vmcnt(0)" ::: "memory");
        } else {
            XB_SPIN(xb_ld(&bar[XB_XGEN(b.x)]) == gen, bar);
            __builtin_amdgcn_fence(__ATOMIC_ACQUIRE, "agent");
            asm volatile("s_waitcnt vmcnt(0)" ::: "memory");
        }
    }
    __syncthreads();
}

constexpr int D = 2048, NB = 4, S = 4096, T = NB * S;
constexpr int HD = 128, FH = 12, FW = 1536, MH = 4, MW = 512, ML = 256;
constexpr int FOX_IN = 6668, FOX_NP = 6912;
constexpr int GLA_IN = 5136, GLA_NP = 5376;
constexpr int GH = 4, GDK = 192, GDV = 384, GKW = 768, GVW = 1536;
constexpr int NE = 32, DE = 1024, MAXROWS = 40960, MAXTILES = 160;
constexpr int FP_Q = 0, FP_K = 1536, FP_V = 3072, FP_OG = 4608, FP_QM = 6144, FP_F = 6656;
constexpr int GP_Q = 0, GP_K = 768, GP_V = 1536, GP_R = 3072, GP_QM = 4608, GP_A = 5120;
constexpr float RMS_EPS = 1e-6f;
constexpr int NWAVES = 8;

constexpr size_t MiB = 1u << 20;
constexpr size_t WS_CTL = 0, CTL_ZERO_BYTES = 1 * MiB;
constexpr size_t WS_ROUTE = 1 * MiB;
constexpr size_t WS_WFOX = 4 * MiB;
constexpr size_t WS_WGLA = WS_WFOX + 27 * MiB;
constexpr size_t WS_WOUT = WS_WGLA + 21 * MiB;
constexpr size_t WS_WMKV = WS_WOUT + 16 * MiB;
constexpr size_t WS_WGU = WS_WMKV + 4 * MiB;
constexpr size_t WS_WD = WS_WGU + 512 * MiB;
constexpr size_t WS_HN = WS_WD + 256 * MiB;
constexpr size_t WS_P = WS_HN + 65 * MiB;
constexpr size_t WS_CAT = WS_P + 216 * MiB;
constexpr size_t WS_XA = WS_CAT + 64 * MiB;
constexpr size_t WS_XB = WS_XA + 128 * MiB;
constexpr size_t WS_XG = WS_XB + 128 * MiB;
constexpr size_t WS_H = WS_XG + 160 * MiB;
constexpr size_t WS_YB = WS_H + 80 * MiB;
constexpr size_t WS_MEMN = WS_YB + 128 * MiB;
constexpr size_t WS_MKV = WS_MEMN + 4 * MiB;
constexpr size_t WS_MK = WS_MKV + 2 * MiB;
constexpr size_t WS_C = WS_MK + 2 * MiB;
constexpr size_t WS_FL = WS_C + 1 * MiB;
constexpr size_t WS_WR = WS_FL + 1 * MiB;
constexpr size_t WS_INV = WS_WR + 1 * MiB;
constexpr size_t WS_END = WS_INV + 1 * MiB;
constexpr size_t WS_GO = WS_XG, WS_LA = WS_H;
constexpr size_t RT_TOKE = 0;
constexpr size_t RT_TOKS = RT_TOKE + 2 * T * 4;
constexpr size_t RT_TOKW = RT_TOKS + 2 * T * 4;
constexpr size_t RT_ROWDEST = RT_TOKW + 2 * T * 4;
constexpr size_t RT_ROWW = RT_ROWDEST + 2 * MAXROWS * 4;
constexpr size_t RT_TILEE = RT_ROWW + MAXROWS * 4;
constexpr size_t RT_END = RT_TILEE + 2 * 256 * 4;
static_assert(RT_END <= 3 * MiB, "routing arrays");
constexpr int CW_BAR = 4096;
constexpr int CW_CNT = 8192;
constexpr int CW_Q0 = 8320, CW_Q1 = 8384;
static_assert((CW_Q1 + 64) * 4 <= (int)CTL_ZERO_BYTES, "ctl");

constexpr int RING_OFF = 0, RING_BYTES = 131072;
constexpr int LDSCTL_OFF = RING_BYTES, MISC_OFF = LDSCTL_OFF + 320;
constexpr int LDS_BYTES = 147456;

namespace pg8 {
struct EpiP {
    static constexpr bool PERM = true, AFTER_DRAIN = false;
    bf16_t* P; int ldp; float* FL; int ftile;
    __device__ __forceinline__ void operator()(const f32x4 (&acc)[2][2][4][2], const Unit& u, int wr, int wc, int fr, int fq) const {
        const int row0 = u.pm * BM + wr * 64 + fr, col0 = u.pn * BM + wc * 32 + 8 * fq;
#pragma unroll
        for (int ai = 0; ai < 2; ++ai)
#pragma unroll
            for (int m = 0; m < 4; ++m) { bf16_t* rowp = P + (size_t)(row0 + ai * HALF + m * 16) * ldp + col0;
#pragma unroll
                for (int bj = 0; bj < 2; ++bj) { const f32x4 v0 = acc[ai][bj][m][0], v1 = acc[ai][bj][m][1];
                    u32x4 w; w.x = pk2(v0[0], v0[1]); w.y = pk2(v0[2], v0[3]); w.z = pk2(v1[0], v1[1]); w.w = pk2(v1[2], v1[3]);
                    *(u32x4*)(rowp + bj * HALF) = w; } }
        if (u.pn == ftile && wc == 0 && fq < 2) {
#pragma unroll
            for (int ai = 0; ai < 2; ++ai)
#pragma unroll
                for (int m = 0; m < 4; ++m) { float* fp = FL + (size_t)(row0 + ai * HALF + m * 16) * 16 + 8 * fq;
                    *(f32x4*)(fp) = acc[ai][0][m][0]; *(f32x4*)(fp + 4) = acc[ai][0][m][1]; }
        }
    }
};
struct EpiRes {
    static constexpr bool PERM = false, AFTER_DRAIN = false;
    const float* R; float* C; int ldc;
    __device__ __forceinline__ void operator()(const f32x4 (&acc)[2][2][4][2], const Unit& u, int wr, int wc, int fr, int fq) const {
        const int row0 = u.pm * BM + wr * 64 + fr, col0 = u.pn * BM + wc * 32 + 4 * fq;
#pragma unroll
        for (int ai = 0; ai < 2; ++ai)
#pragma unroll
            for (int m = 0; m < 4; ++m) { const size_t ro = (size_t)(row0 + ai * HALF + m * 16) * ldc + col0;
#pragma unroll
                for (int bj = 0; bj < 2; ++bj)
#pragma unroll
                    for (int n = 0; n < 2; ++n) { const f32x4 r = *(const f32x4*)(R + ro + bj * HALF + n * 16); *(f32x4*)(C + ro + bj * HALF + n * 16) = acc[ai][bj][m][n] + r; } }
    }
};
struct EpiGU {
    static constexpr bool PERM = true, AFTER_DRAIN = false;
    bf16_t* H;
    __device__ __forceinline__ void operator()(const f32x4 (&acc)[2][2][4][2], const Unit& u, int wr, int wc, int fr, int fq) const {
        const int row0 = u.pm * BM + wr * 64 + fr, col0 = (u.pn & 7) * HALF + wc * 32 + 8 * fq;
#pragma unroll
        for (int ai = 0; ai < 2; ++ai)
#pragma unroll
            for (int m = 0; m < 4; ++m) { bf16_t* rowp = H + (size_t)(row0 + ai * HALF + m * 16) * 1024 + col0;
                float h[8];
#pragma unroll
                for (int n = 0; n < 2; ++n)
#pragma unroll
                    for (int j = 0; j < 4; ++j) { const float g = acc[ai][0][m][n][j], uu = acc[ai][1][m][n][j]; h[4 * n + j] = g * uu / (1.0f + __expf(-g)); }
                u32x4 w; w.x = pk2(h[0], h[1]); w.y = pk2(h[2], h[3]); w.z = pk2(h[4], h[5]); w.w = pk2(h[6], h[7]);
                *(u32x4*)rowp = w; }
    }
};
struct EpiDown {
    static constexpr bool PERM = true, AFTER_DRAIN = false;
    const int* rowdest; const float* roww; bf16_t* YB;
    __device__ __forceinline__ void operator()(const f32x4 (&acc)[2][2][4][2], const Unit& u, int wr, int wc, int fr, int fq) const {
        const int row0 = u.pm * BM + wr * 64 + fr, col0 = (u.pn & 7) * BM + wc * 32 + 8 * fq;
#pragma unroll
        for (int ai = 0; ai < 2; ++ai)
#pragma unroll
            for (int m = 0; m < 4; ++m) { const int row = row0 + ai * HALF + m * 16; const int dest = rowdest[row];
                if (dest >= 0) { const float w8 = roww[row]; bf16_t* rowp = YB + (size_t)dest * D + col0;
#pragma unroll
                    for (int bj = 0; bj < 2; ++bj) { const f32x4 v0 = acc[ai][bj][m][0] * w8, v1 = acc[ai][bj][m][1] * w8;
                        u32x4 w; w.x = pk2(v0[0], v0[1]); w.y = pk2(v0[2], v0[3]); w.z = pk2(v1[0], v1[1]); w.w = pk2(v1[2], v1[3]);
                        *(u32x4*)(rowp + bj * HALF) = w; } } }
    }
};
struct MoeOrder {
    const int* tile_e; int nunits, G, c;
    __device__ __forceinline__ bool next(int i, Unit& u) const {
        const long L = (long)i * G + c; if (L >= nunits) return false;
        const int tile = (int)(L >> 3), pn = (int)(L & 7); u.pm = tile; u.pn = tile_e[tile] * 8 + pn; return true;
    }
    __device__ __forceinline__ void a_ready(const Unit&) const {}
    __device__ __forceinline__ void done(const Unit&) const {}
};
}

struct Ctx {
    LAS unsigned char* lds;
    int tid, lane, wave, gw, NGW, G;
    const float* in[24]; float* out; unsigned char* ws;
};
#define WSP(type, off) ((type*)(C.ws + (off)))

__device__ __forceinline__ void load_row(const float* xrow, int lane, f32x4 (&v)[8]) {
#pragma unroll
    for (int j = 0; j < 8; ++j) v[j] = ((const f32x4*)xrow)[lane + 64 * j];
}
__device__ __forceinline__ float row_inv_rms(const f32x4 (&v)[8]) {
    float s = 0.f;
#pragma unroll
    for (int j = 0; j < 8; ++j) s += (v[j].x * v[j].x + v[j].y * v[j].y) + (v[j].z * v[j].z + v[j].w * v[j].w);
    s = wave_sum(s);
    return 1.0f / sqrtf(s * (1.0f / D) + RMS_EPS);
}
__device__ __forceinline__ void norm_store_row(bf16* orow, f32x4 (&v)[8], float inv, const float* g, int lane) {
#pragma unroll
    for (int j = 0; j < 8; ++j) { const f32x4 gg = ((const f32x4*)g)[lane + 64 * j]; v[j] = v[j] * inv * gg;
        v2u o; o.x = pk2(v[j].x, v[j].y); o.y = pk2(v[j].z, v[j].w); ((v2u*)orow)[lane + 64 * j] = o; }
}

__device__ __forceinline__ void tr_item(const float* W, int ldn, int K, bf16* WT, int drow, int k0, int n0, LAS float* scr, int lane) {
#pragma unroll 8
    for (int i = 0; i < 32; ++i) { const int kk = 2 * i + (lane >> 5); scr[kk * 33 + (lane & 31)] = W[(size_t)(k0 + kk) * ldn + n0 + (lane & 31)]; }
    LDS_WAIT(); asm volatile("" ::: "memory");
    const int c = lane & 7;
#pragma unroll
    for (int j = 0; j < 4; ++j) { const int n = (lane >> 3) + 8 * j; const LAS float* s = scr + (8 * c) * 33 + n;
        v4u o; o.x = pk2(s[0 * 33], s[1 * 33]); o.y = pk2(s[2 * 33], s[3 * 33]); o.z = pk2(s[4 * 33], s[5 * 33]); o.w = pk2(s[6 * 33], s[7 * 33]);
        *(v4u*)(WT + (size_t)(drow + n) * K + k0 + 8 * c) = o; }
    LDS_WAIT(); asm volatile("" ::: "memory");
}
__device__ __forceinline__ bool tr_group(int& r, const float* W, int ldn, int K, int c0, int nblk, bf16* WT, int drow0, LAS float* scr, int lane) {
    const int cnt = (K / 64) * nblk;
    if (r < cnt) { const int kb = r / nblk, nb = r % nblk; tr_item(W + c0, ldn, K, WT, drow0 + 32 * nb, 64 * kb, 32 * nb, scr, lane); return true; }
    r -= cnt; return false;
}
__device__ __forceinline__ void p0_prologue(const Ctx& C) {
    LAS float* scr = (LAS float*)(C.lds + RING_OFF + C.wave * 16384);
    const int lane = C.lane;
    constexpr int MOE_ITEMS = 64 * 3 * 1024;
    for (int it = C.gw; it < MOE_ITEMS; it += C.NGW) {
        const int le = it / 3072, rem = it % 3072, kind = rem >> 10, r = rem & 1023;
        if (kind < 2) {
            const float* W = (kind == 0 ? C.in[21] : C.in[22]) + (size_t)le * 2048 * 1024;
            const int kb = r >> 5, nb = r & 31, n0 = 32 * nb;
            bf16* WT = WSP(bf16, WS_WGU) + (size_t)le * 2048 * 2048;
            tr_item(W, 1024, 2048, WT, 256 * (n0 >> 7) + (n0 & 127) + 128 * kind, 64 * kb, n0, scr, lane);
        } else {
            const float* W = C.in[23] + (size_t)le * 1024 * 2048;
            const int kb = r >> 6, nb = r & 63;
            bf16* WT = WSP(bf16, WS_WD) + (size_t)le * 2048 * 1024;
            tr_item(W, 2048, 1024, WT, 32 * nb, 64 * kb, 32 * nb, scr, lane);
        }
    }
    constexpr int I_FOX = 32 * (192 + 16 + 1), I_GLA = 32 * (144 + 16 + 1), I_WO = 32 * 64, I_MKV = 32 * 32;
    constexpr int OTHER = I_FOX + I_GLA + 2 * I_WO + I_MKV;
    for (int it = C.gw; it < OTHER; it += C.NGW) {
        int r = it;
        if (tr_group(r, C.in[5], FOX_IN, D, 0, 192, WSP(bf16, WS_WFOX), 0, scr, lane)) continue;
        if (tr_group(r, C.in[5], FOX_IN, D, 6156, 16, WSP(bf16, WS_WFOX), FP_QM, scr, lane)) continue;
        if (tr_group(r, C.in[5], FOX_IN, D, 6144, 1, WSP(bf16, WS_WFOX), FP_F, scr, lane)) continue;
        if (tr_group(r, C.in[9], GLA_IN, D, 0, 144, WSP(bf16, WS_WGLA), 0, scr, lane)) continue;
        if (tr_group(r, C.in[9], GLA_IN, D, 4624, 16, WSP(bf16, WS_WGLA), GP_QM, scr, lane)) continue;
        if (tr_group(r, C.in[9], GLA_IN, D, 4608, 1, WSP(bf16, WS_WGLA), GP_A, scr, lane)) continue;
        if (tr_group(r, C.in[15], D, D, 0, 64, WSP(bf16, WS_WOUT), 0, scr, lane)) continue;
        if (tr_group(r, C.in[15] + (size_t)D * D, D, D, 0, 64, WSP(bf16, WS_WOUT) + (size_t)D * D, 0, scr, lane)) continue;
        tr_group(r, C.in[3], 1024, D, 0, 32, WSP(bf16, WS_WMKV), 0, scr, lane);
    }
    for (int m = C.gw; m < T + NB * ML; m += C.NGW) {
        f32x4 v[8];
        if (m < T) { load_row(C.in[0] + (size_t)m * D, lane, v); const float inv = row_inv_rms(v); norm_store_row(WSP(bf16, WS_HN) + (size_t)m * D, v, inv, C.in[4], lane); }
        else { const int r = m - T; load_row(C.in[1] + (size_t)r * D, lane, v); const float inv = row_inv_rms(v); norm_store_row(WSP(bf16, WS_MEMN) + (size_t)r * D, v, inv, C.in[2], lane); }
    }
    for (int i = blockIdx.x * 512 + C.tid; i < 2 * 64 * D; i += C.G * 512) {
        const int k = i & (D - 1), rho = (i >> 11) & 63, layer = i >> 17;
        float v = 0.f;
        if (rho < 32) { const int hh = (rho >> 2) & 1, reg = 4 * (rho >> 3) + (rho & 3), e = (2 * hh + (reg >> 3)) * 8 + (reg & 7); v = C.in[19][((size_t)layer * D + k) * 32 + e]; }
        else if (rho < 40) v = C.in[17][((size_t)layer * D + k) * 4 + (rho & 3)];
        const unsigned hi = pk2(v, 0.f) & 0xffffu; const float lo = v - bflo(hi);
        bf16* wr = WSP(bf16, WS_WR) + (size_t)layer * 2 * 64 * D;
        wr[(size_t)rho * D + k] = (bf16)hi; wr[(size_t)(64 + rho) * D + k] = (bf16)(pk2(lo, 0.f) & 0xffffu);
    }
    { int* rd = (int*)(C.ws + WS_ROUTE + RT_ROWDEST);
      for (int i = blockIdx.x * 512 + C.tid; i < 2 * MAXROWS; i += C.G * 512) rd[i] = -1; }
}

__device__ __forceinline__ float log_sigmoid(float x) { return fminf(x, 0.f) - log1pf(expf(-fabsf(x))); }

__device__ __forceinline__ void headnorm_inplace(bf16* rowp, int col0, int nh, const float* g, int lane) {
    const float g0 = g[2 * lane], g1 = g[2 * lane + 1];
    for (int h = 0; h < nh; ++h) {
        unsigned* p = (unsigned*)(rowp + col0 + h * HD) + lane; const unsigned u = *p; const float a = bflo(u), b = bfhi(u);
        const float ss = wave_sum(a * a + b * b); const float inv = 1.0f / sqrtf(ss * (1.0f / HD) + RMS_EPS);
        *p = pk2(a * inv * g0, b * inv * g1);
    }
}
__device__ __forceinline__ void p3_fox_thin(const Ctx& C) {
    bf16* P = WSP(bf16, WS_P);
    for (int m = C.gw; m < T; m += C.NGW) {
        bf16* rowp = P + (size_t)m * FOX_NP;
        headnorm_inplace(rowp, FP_Q, FH, C.in[7], C.lane);
        headnorm_inplace(rowp, FP_K, FH, C.in[8], C.lane);
        headnorm_inplace(rowp, FP_QM, MH, C.in[13], C.lane);
    }
    for (int it = C.gw; it < NB * ML * MH; it += C.NGW) {
        const int row = it >> 2, mh = it & 3;
        const unsigned u = *((const unsigned*)(WSP(bf16, WS_MKV) + (size_t)row * 1024 + mh * HD) + C.lane); const float a = bflo(u), b = bfhi(u);
        const float ss = wave_sum(a * a + b * b); const float inv = 1.0f / sqrtf(ss * (1.0f / HD) + RMS_EPS);
#pragma unroll
        for (int l = 0; l < 2; ++l) { const float* g = C.in[14] + l * HD;
            *((unsigned*)(WSP(bf16, WS_MK) + (size_t)l * 1024 * 512 + (size_t)row * 512 + mh * HD) + C.lane) = pk2(a * inv * g[2 * C.lane], b * inv * g[2 * C.lane + 1]); }
    }
    LAS float* sm = (LAS float*)(C.lds + RING_OFF);
    for (int bh = blockIdx.x; bh < NB * FH; bh += C.G) {
        const int b = bh / FH, h = bh % FH; const float bf = C.in[6][h];
        const float* fl = WSP(float, WS_FL) + (size_t)(b * S) * 16 + h;
        float ls[8], tot = 0.f;
#pragma unroll
        for (int i = 0; i < 8; ++i) { ls[i] = log_sigmoid(fl[(size_t)(8 * C.tid + i) * 16] + bf); tot += ls[i]; ls[i] = tot; }
        float inc = tot;
#pragma unroll
        for (int o = 1; o < 64; o <<= 1) { const float t = __shfl_up(inc, o); if (C.lane >= o) inc += t; }
        __syncthreads();
        if (C.lane == 63) sm[C.wave] = inc;
        __syncthreads();
        float woff = 0.f;
        for (int w = 0; w < C.wave; ++w) woff += sm[w];
        const float excl = woff + inc - tot;
        float* cp = WSP(float, WS_C) + (size_t)bh * S + 8 * C.tid;
#pragma unroll
        for (int i = 0; i < 8; ++i) cp[i] = excl + ls[i];
    }
}

__device__ __forceinline__ void naive_attn_row(const bf16* qptr, const bf16* Kb, int kstride, const bf16* Vb, int vstride, int nk, const float* cptr, float ct,
                                               LAS float* qs, int lane, float& o0, float& o1) {
    { const unsigned qq = *((const unsigned*)qptr + lane); qs[2 * lane] = bflo(qq); qs[2 * lane + 1] = bfhi(qq); }
    LDS_WAIT(); asm volatile("" ::: "memory");
    float m = -1e30f, l = 0.f, a0 = 0.f, a1 = 0.f;
    for (int j0 = 0; j0 < nk; j0 += 64) {
        const int j = j0 + lane; const bool valid = j < nk; const int jc = valid ? j : nk - 1;
        const bf16* kr = Kb + (size_t)jc * kstride;
        float s = 0.f;
#pragma unroll 4
        for (int d8 = 0; d8 < 16; ++d8) {
            const v4u kk = *(const v4u*)(kr + 8 * d8);
            const f32x4 qa = *(const LAS f32x4*)(qs + 8 * d8), qb = *(const LAS f32x4*)(qs + 8 * d8 + 4);
            s += bflo(kk.x) * qa.x + bfhi(kk.x) * qa.y + bflo(kk.y) * qa.z + bfhi(kk.y) * qa.w + bflo(kk.z) * qb.x + bfhi(kk.z) * qb.y + bflo(kk.w) * qb.z + bfhi(kk.w) * qb.w;
        }
        s *= 0.08838834764831845f;
        if (cptr) s += ct - cptr[jc];
        if (!valid) s = -__builtin_inff();
        const float mn = fmaxf(m, wave_max(s)); const float alpha = expf(m - mn); const float p = valid ? expf(s - mn) : 0.f;
        l = l * alpha + wave_sum(p); a0 *= alpha; a1 *= alpha; m = mn;
        const int cnt = (nk - j0) < 64 ? (nk - j0) : 64;
        for (int jj = 0; jj < cnt; ++jj) { const float pj = __shfl(p, jj); const unsigned vv = *((const unsigned*)(Vb + (size_t)(j0 + jj) * vstride) + lane); a0 += pj * bflo(vv); a1 += pj * bfhi(vv); }
    }
    o0 = a0 / l; o1 = a1 / l;
    asm volatile("" ::: "memory");
}
__device__ __forceinline__ void naive_mem_attn(const Ctx& C, const bf16* P, int ldp, int qcol, int layer, int row, int mh, LAS float* qs) {
    const int b = row / S; float o0, o1;
    naive_attn_row(P + (size_t)row * ldp + qcol + mh * HD, WSP(bf16, WS_MK) + (size_t)layer * 1024 * 512 + (size_t)(b * ML) * 512 + mh * HD, 512,
                   WSP(bf16, WS_MKV) + (size_t)(b * ML) * 1024 + 512 + mh * HD, 1024, ML, nullptr, 0.f, qs, C.lane, o0, o1);
    *((unsigned*)(WSP(bf16, WS_CAT) + (size_t)row * D + FW + mh * HD) + C.lane) = pk2(o0, o1);
}
__device__ __forceinline__ void p4_fox_attn_naive(const Ctx& C) {
    LAS float* qs = (LAS float*)(C.lds + RING_OFF + C.wave * 16384);
    const bf16* P = WSP(bf16, WS_P);
    for (int it = C.gw; it < T * 16; it += C.NGW) {
        const int hh = it / T, row = it % T;
        if (hh < FH) {
            const int b = row / S, t = row % S; float o0, o1;
            const float* cp = WSP(float, WS_C) + (size_t)(b * FH + hh) * S;
            naive_attn_row(P + (size_t)row * FOX_NP + FP_Q + hh * HD, P + (size_t)(b * S) * FOX_NP + FP_K + hh * HD, FOX_NP, P + (size_t)(b * S) * FOX_NP + FP_V + hh * HD, FOX_NP,
                           t + 1, cp, cp[t], qs, C.lane, o0, o1);
            const unsigned og = *((const unsigned*)(P + (size_t)row * FOX_NP + FP_OG + hh * HD) + C.lane);
            const float g0 = 1.0f / (1.0f + expf(-bflo(og))), g1 = 1.0f / (1.0f + expf(-bfhi(og)));
            *((unsigned*)(WSP(bf16, WS_CAT) + (size_t)row * D + hh * HD) + C.lane) = pk2(o0 * g0, o1 * g1);
        } else naive_mem_attn(C, P, FOX_NP, FP_QM, 0, row, hh - FH, qs);
    }
}

__device__ __forceinline__ void p12_gla_thin(const Ctx& C) {
    bf16* P = WSP(bf16, WS_P);
    const float* w2 = C.in[10]; const float* ba = C.in[11];
    for (int m = C.gw; m < T; m += C.NGW) {
        headnorm_inplace(P + (size_t)m * GLA_NP, GP_QM, MH, C.in[13] + HD, C.lane);
        const float* fl = WSP(float, WS_FL) + (size_t)m * 16;
        float al[16];
#pragma unroll
        for (int r = 0; r < 16; ++r) al[r] = fl[r];
        float* la = WSP(float, WS_LA) + (size_t)m * GKW;
#pragma unroll 1
        for (int j = 0; j < 12; ++j) { const int c = C.lane + 64 * j; float s = ba[c];
#pragma unroll
            for (int r = 0; r < 16; ++r) s += al[r] * w2[r * GKW + c];
            la[c] = expf(log_sigmoid(s) * (1.0f / 16.0f)); }
    }
}
__device__ __forceinline__ void p13_gla_naive(const Ctx& C) {
    const bf16* P = WSP(bf16, WS_P); const float* LA = WSP(float, WS_LA); float* GO = WSP(float, WS_GO);
    const int lane = C.lane;
    for (int it = C.gw; it < NB * GH * 128; it += C.NGW) {
        const int bh = it >> 7, e0 = (it & 127) * 3, b = bh >> 2, h = bh & 3;
        float st[3][3];
#pragma unroll
        for (int i = 0; i < 3; ++i)
#pragma unroll
            for (int e = 0; e < 3; ++e) st[i][e] = 0.f;
        const float qsc = 0.07216878364870322f;
        for (int t0 = 0; t0 < S; t0 += 4) {
            float a[4][3], k[4][3], q[4][3], v[4][3];
#pragma unroll
            for (int u = 0; u < 4; ++u) { const size_t row = (size_t)(b * S + t0 + u);
#pragma unroll
                for (int i = 0; i < 3; ++i) { const int d = lane + 64 * i;
                    a[u][i] = LA[row * GKW + h * GDK + d]; k[u][i] = bf2f(P[row * GLA_NP + GP_K + h * GDK + d]); q[u][i] = bf2f(P[row * GLA_NP + GP_Q + h * GDK + d]) * qsc; }
#pragma unroll
                for (int e = 0; e < 3; ++e) v[u][e] = bf2f(P[row * GLA_NP + GP_V + h * GDV + e0 + e]); }
#pragma unroll
            for (int u = 0; u < 4; ++u) { float o[3] = {0.f, 0.f, 0.f};
#pragma unroll
                for (int i = 0; i < 3; ++i)
#pragma unroll
                    for (int e = 0; e < 3; ++e) { st[i][e] = a[u][i] * st[i][e] + k[u][i] * v[u][e]; o[e] += q[u][i] * st[i][e]; }
#pragma unroll
                for (int e = 0; e < 3; ++e) o[e] = wave_sum(o[e]);
                if (lane < 3) GO[(size_t)(b * S + t0 + u) * GVW + h * GDV + e0 + lane] = lane == 0 ? o[0] : (lane == 1 ? o[1] : o[2]); }
        }
    }
}
__device__ __forceinline__ void p14_gla_onorm(const Ctx& C) {
    const bf16* P = WSP(bf16, WS_P); const float* GO = WSP(float, WS_GO); const float* og = C.in[12];
    for (int m = C.gw; m < T; m += C.NGW) {
#pragma unroll 1
        for (int h = 0; h < GH; ++h) {
            f32x2 x[3]; float ss = 0.f;
#pragma unroll
            for (int i = 0; i < 3; ++i) { x[i] = *((const f32x2*)(GO + (size_t)m * GVW + h * GDV + 128 * i) + C.lane); ss += x[i].x * x[i].x + x[i].y * x[i].y; }
            ss = wave_sum(ss); const float inv = 1.0f / sqrtf(ss * (1.0f / GDV) + RMS_EPS);
#pragma unroll
            for (int i = 0; i < 3; ++i) { const int e = 128 * i + 2 * C.lane;
                const unsigned ru = *((const unsigned*)(P + (size_t)m * GLA_NP + GP_R + h * GDV + 128 * i) + C.lane); const float r0 = bflo(ru), r1 = bfhi(ru);
                const float y0 = x[i].x * inv * og[e] * (r0 / (1.0f + expf(-r0))), y1 = x[i].y * inv * og[e + 1] * (r1 / (1.0f + expf(-r1)));
                *((unsigned*)(WSP(bf16, WS_CAT) + (size_t)m * D + h * GDV + 128 * i) + C.lane) = pk2(y0, y1); }
        }
    }
}

__device__ __forceinline__ void p6_router(const Ctx& C, int layer, bool commit = true) {
    const float* X = WSP(float, WS_XB); const float* g = C.in[16] + layer * D;
    const float* wg = C.in[17] + (size_t)layer * D * 4; const float* we = C.in[19] + (size_t)layer * D * 32;
    const float* bg = C.in[18] + layer * 4; const float* be = C.in[20] + layer * 32;
    unsigned* cnt = (unsigned*)(C.ws + WS_CTL) + CW_CNT + layer * 32;
    int* toke = (int*)(C.ws + WS_ROUTE + RT_TOKE); int* toks = (int*)(C.ws + WS_ROUTE + RT_TOKS); float* tokw = (float*)(C.ws + WS_ROUTE + RT_TOKW);
    const int lane = C.lane;
    LAS float* hs = (LAS float*)(C.lds + RING_OFF + C.wave * 16384);
    for (int pr = C.gw; pr < T / 2; pr += C.NGW) {
        {
            f32x4 x0[8], x1[8];
            load_row(X + (size_t)(2 * pr) * D, lane, x0); load_row(X + (size_t)(2 * pr + 1) * D, lane, x1);
            const float i0 = row_inv_rms(x0), i1 = row_inv_rms(x1);
            norm_store_row(WSP(bf16, WS_HN) + (size_t)(2 * pr) * D, x0, i0, g, lane);
            norm_store_row(WSP(bf16, WS_HN) + (size_t)(2 * pr + 1) * D, x1, i1, g, lane);
#pragma unroll
            for (int j = 0; j < 8; ++j) { ((LAS f32x4*)hs)[lane + 64 * j] = x0[j]; ((LAS f32x4*)(hs + D))[lane + 64 * j] = x1[j]; }
        }
        LDS_WAIT(); asm volatile("" ::: "memory");
        float a0[36], a1[36];
#pragma unroll
        for (int n = 0; n < 36; ++n) { a0[n] = 0.f; a1[n] = 0.f; }
#pragma unroll 2
        for (int kk = 0; kk < 32; ++kk) {
            const int k = lane + 64 * kk; const float h0 = hs[k], h1 = hs[D + k];
            const f32x4 w4 = *(const f32x4*)(wg + (size_t)k * 4);
#pragma unroll
            for (int n = 0; n < 4; ++n) { a0[n] += h0 * w4[n]; a1[n] += h1 * w4[n]; }
#pragma unroll
            for (int q = 0; q < 8; ++q) { const f32x4 w = *(const f32x4*)(we + (size_t)k * 32 + 4 * q);
#pragma unroll
                for (int n = 0; n < 4; ++n) { a0[4 + 4 * q + n] += h0 * w[n]; a1[4 + 4 * q + n] += h1 * w[n]; } }
        }
        asm volatile("" ::: "memory");
#pragma unroll
        for (int n = 0; n < 36; ++n) { a0[n] = wave_sum(a0[n]); a1[n] = wave_sum(a1[n]); }
#pragma unroll
        for (int rr = 0; rr < 2; ++rr) {
            float lg[36];
#pragma unroll
            for (int n = 0; n < 36; ++n) lg[n] = rr == 0 ? a0[n] : a1[n];
            float gl[4]; int gi = 0; float gm;
#pragma unroll
            for (int n = 0; n < 4; ++n) gl[n] = lg[n] + bg[n];
            gm = gl[0];
#pragma unroll
            for (int n = 1; n < 4; ++n) if (gl[n] > gm) { gm = gl[n]; gi = n; }
            float gs = 0.f;
#pragma unroll
            for (int n = 0; n < 4; ++n) gs += expf(gl[n] - gm);
            const float gp = 1.0f / gs;
            float ev[8];
#pragma unroll
            for (int j = 0; j < 8; ++j) { const float v0 = lg[4 + j] + be[j], v1 = lg[12 + j] + be[8 + j], v2 = lg[20 + j] + be[16 + j], v3 = lg[28 + j] + be[24 + j];
                ev[j] = gi == 0 ? v0 : (gi == 1 ? v1 : (gi == 2 ? v2 : v3)); }
            int e1 = 0; float m1 = ev[0];
#pragma unroll
            for (int j = 1; j < 8; ++j) if (ev[j] > m1) { m1 = ev[j]; e1 = j; }
            int e2 = -1; float m2 = -__builtin_inff();
#pragma unroll
            for (int j = 0; j < 8; ++j) if (j != e1 && ev[j] > m2) { m2 = ev[j]; e2 = j; }
            const float z = expf(m2 - m1); const float w1 = gp / (1.0f + z), w2 = gp * z / (1.0f + z);
            if (lane == 0) {
                const int tok = 2 * pr + rr; const int id1 = gi * 8 + e1, id2 = gi * 8 + e2;
                if (commit) { const unsigned s1 = atomicAdd(cnt + id1, 1u), s2 = atomicAdd(cnt + id2, 1u); toks[2 * tok] = (int)s1; toks[2 * tok + 1] = (int)s2; }
                toke[2 * tok] = id1; tokw[2 * tok] = w1;
                toke[2 * tok + 1] = id2; tokw[2 * tok + 1] = w2;
            }
        }
    }
}
__device__ __forceinline__ void p6_router_mfma(const Ctx& C, int layer, bool commit = true) {
    const float* X = WSP(float, WS_XB); const float* g = C.in[16] + layer * D;
    const bf16* WR = WSP(bf16, WS_WR) + (size_t)layer * 2 * 64 * D;
    const float* bg = C.in[18] + layer * 4; const float* be = C.in[20] + layer * 32;
    unsigned* cnt = (unsigned*)(C.ws + WS_CTL) + CW_CNT + layer * 32;
    int* toke = (int*)(C.ws + WS_ROUTE + RT_TOKE); int* toks = (int*)(C.ws + WS_ROUTE + RT_TOKS); float* tokw = (float*)(C.ws + WS_ROUTE + RT_TOKW);
    float* INV = WSP(float, WS_INV);
    const int lane = C.lane, r = lane & 31, h = lane >> 5;
    for (int task = C.wave * C.G + blockIdx.x; task < T / 32; task += C.NGW) {
        const int row = 32 * task + r;
        const float* xp = X + (size_t)row * D + 8 * h; const float* gp = g + 8 * h;
        const bf16* w0 = WR + (size_t)r * D + 8 * h;
        f32x16 acc0, acc1;
#pragma unroll
        for (int i = 0; i < 16; ++i) { acc0[i] = 0.f; acc1[i] = 0.f; }
        float ss = 0.f;
#pragma unroll 4
        for (int s = 0; s < D / 16; ++s) {
            const f32x4 xa = *(const f32x4*)(xp + 16 * s), xb = *(const f32x4*)(xp + 16 * s + 4);
            const f32x4 ga = *(const f32x4*)(gp + 16 * s), gb = *(const f32x4*)(gp + 16 * s + 4);
            ss += (xa.x * xa.x + xa.y * xa.y) + (xa.z * xa.z + xa.w * xa.w) + (xb.x * xb.x + xb.y * xb.y) + (xb.z * xb.z + xb.w * xb.w);
            const f32x4 va = xa * ga, vb = xb * gb;
            v4u hi; hi.x = pk2(va.x, va.y); hi.y = pk2(va.z, va.w); hi.z = pk2(vb.x, vb.y); hi.w = pk2(vb.z, vb.w);
            v4u lo; lo.x = pk2(va.x - bflo(hi.x), va.y - bfhi(hi.x)); lo.y = pk2(va.z - bflo(hi.y), va.w - bfhi(hi.y));
            lo.z = pk2(vb.x - bflo(hi.z), vb.y - bfhi(hi.z)); lo.w = pk2(vb.z - bflo(hi.w), vb.w - bfhi(hi.w));
            const bf16x8 xh = __builtin_bit_cast(bf16x8, hi), xl = __builtin_bit_cast(bf16x8, lo);
            const bf16x8 a0h = *(const bf16x8*)(w0 + 16 * s), a1h = *(const bf16x8*)(w0 + (size_t)32 * D + 16 * s);
            const bf16x8 a0l = *(const bf16x8*)(w0 + (size_t)64 * D + 16 * s), a1l = *(const bf16x8*)(w0 + (size_t)96 * D + 16 * s);
            acc0 = __builtin_amdgcn_mfma_f32_32x32x16_bf16(a0h, xh, acc0, 0, 0, 0); acc1 = __builtin_amdgcn_mfma_f32_32x32x16_bf16(a1h, xh, acc1, 0, 0, 0);
            acc0 = __builtin_amdgcn_mfma_f32_32x32x16_bf16(a0l, xh, acc0, 0, 0, 0); acc1 = __builtin_amdgcn_mfma_f32_32x32x16_bf16(a1l, xh, acc1, 0, 0, 0);
            acc0 = __builtin_amdgcn_mfma_f32_32x32x16_bf16(a0h, xl, acc0, 0, 0, 0); acc1 = __builtin_amdgcn_mfma_f32_32x32x16_bf16(a1h, xl, acc1, 0, 0, 0);
        }
        ss += __shfl_xor(ss, 32);
        const float inv = 1.0f / sqrtf(ss * (1.0f / D) + RMS_EPS);
        if (h == 0) INV[row] = inv;
        float gl[4]; int gi = 0;
#pragma unroll
        for (int n = 0; n < 4; ++n) gl[n] = acc1[n] * inv + bg[n];
        float gm = gl[0];
#pragma unroll
        for (int n = 1; n < 4; ++n) if (gl[n] > gm) { gm = gl[n]; gi = n; }
        float gs = 0.f;
#pragma unroll
        for (int n = 0; n < 4; ++n) gs += expf(gl[n] - gm);
        const float gpr = 1.0f / gs;
        float ev[8];
#pragma unroll
        for (int j = 0; j < 8; ++j) ev[j] = ((gi & 1) ? acc0[8 + j] : acc0[j]) * inv + be[gi * 8 + j];
        int e1 = 0; float m1 = ev[0];
#pragma unroll
        for (int j = 1; j < 8; ++j) if (ev[j] > m1) { m1 = ev[j]; e1 = j; }
        int e2 = -1; float m2 = -__builtin_inff();
#pragma unroll
        for (int j = 0; j < 8; ++j) if (j != e1 && ev[j] > m2) { m2 = ev[j]; e2 = j; }
        const float z = expf(m2 - m1); const float w1 = gpr / (1.0f + z), w2 = gpr * z / (1.0f + z);
        if (h == (gi >> 1)) {
            const int tok = row; const int id1 = gi * 8 + e1, id2 = gi * 8 + e2;
            if (commit) { const unsigned s1 = atomicAdd(cnt + id1, 1u), s2 = atomicAdd(cnt + id2, 1u); toks[2 * tok] = (int)s1; toks[2 * tok + 1] = (int)s2; }
            toke[2 * tok] = id1; tokw[2 * tok] = w1;
            toke[2 * tok + 1] = id2; tokw[2 * tok + 1] = w2;
        }
    }
}
__device__ __forceinline__ void p7_dispatch(const Ctx& C, int layer) {
    const unsigned* cnt = (const unsigned*)(C.ws + WS_CTL) + CW_CNT + layer * 32;
    const int* toke = (const int*)(C.ws + WS_ROUTE + RT_TOKE); const int* toks = (const int*)(C.ws + WS_ROUTE + RT_TOKS); const float* tokw = (const float*)(C.ws + WS_ROUTE + RT_TOKW);
    int* rowdest = (int*)(C.ws + WS_ROUTE + RT_ROWDEST) + layer * MAXROWS; float* roww = (float*)(C.ws + WS_ROUTE + RT_ROWW);
    int* tilee = (int*)(C.ws + WS_ROUTE + RT_TILEE) + layer * 256;
    const int lane = C.lane;
    const int c = lane < NE ? (int)__hip_atomic_load(cnt + lane, __ATOMIC_RELAXED, __HIP_MEMORY_SCOPE_AGENT) : 0;
    const int padded = (c + 255) & ~255;
    int inc = padded;
#pragma unroll
    for (int o = 1; o < 64; o <<= 1) { const int t = __shfl_up(inc, o); if (lane >= o) inc += t; }
    const int pstart = inc - padded;
    if (blockIdx.x == 0 && C.wave == 0) {
        if (lane < NE) for (int tl = pstart >> 8; tl < (pstart + padded) >> 8; ++tl) tilee[tl] = lane;
        if (lane == 63) tilee[255] = inc >> 8;
    }
    const float* X = WSP(float, WS_XB); const float* INV = WSP(float, WS_INV); const float* g = C.in[16] + layer * D; bf16* XG = WSP(bf16, WS_XG);
    for (int a = C.gw; a < 2 * T; a += C.NGW) {
        const int e = toke[a], slot = toks[a]; const int dest = __shfl(pstart, e) + slot; const int tok = a >> 1;
        f32x4 v[8]; load_row(X + (size_t)tok * D, lane, v);
        norm_store_row(XG + (size_t)dest * D, v, INV[tok], g, lane);
        if (lane == 0) { rowdest[dest] = a; roww[dest] = tokw[a]; }
    }
}
__device__ __forceinline__ void p_combine(const Ctx& C, const float* xi, float* xo, const float* g) {
    const bf16* YB = WSP(bf16, WS_YB);
    for (int m = C.gw; m < T; m += C.NGW) {
        f32x4 v[8]; load_row(xi + (size_t)m * D, C.lane, v);
#pragma unroll
        for (int j = 0; j < 8; ++j) {
            const v2u y0 = ((const v2u*)(YB + (size_t)(2 * m) * D))[C.lane + 64 * j], y1 = ((const v2u*)(YB + (size_t)(2 * m + 1) * D))[C.lane + 64 * j];
            v[j].x += bflo(y0.x) + bflo(y1.x); v[j].y += bfhi(y0.x) + bfhi(y1.x); v[j].z += bflo(y0.y) + bflo(y1.y); v[j].w += bfhi(y0.y) + bfhi(y1.y);
            ((f32x4*)(xo + (size_t)m * D))[C.lane + 64 * j] = v[j];
        }
        if (g) { const float inv = row_inv_rms(v); norm_store_row(WSP(bf16, WS_HN) + (size_t)m * D, v, inv, g, C.lane); }
    }
}

constexpr int AT_K = 0, AT_V = 32768, AT_C = 65536, AT_U = 66560;
constexpr float LOG2E = 1.4426950408889634f;
constexpr float AT_C2 = 0.08838834764831845f * 1.4426950408889634f;
__device__ __forceinline__ unsigned off_b(unsigned row, unsigned ch) { return 256u * row + 16u * (ch ^ (((row & 3u) << 2) | ((row >> 2) & 3u))); }

template <bool FOX>
__device__ __forceinline__ void attn_unit(LAS unsigned char* lds, const bf16* Qb, int ldq, const bf16* Kb, int ldk, const bf16* Vb, int ldv, const float* cb, int qrow0, int nkt,
                                          bf16* Ob, int ldo, const bf16* OGb, int ldog, int tid, int lane, int wave) {
    const int r = lane & 31, h = lane >> 5;
    const int qpos = qrow0 + 32 * wave + r;
    bf16x8 qf[8];
    { const bf16* qp = Qb + (size_t)(32 * wave + r) * ldq + 8 * h;
#pragma unroll
      for (int s = 0; s < 8; ++s) qf[s] = *(const bf16x8*)(qp + 16 * s); }
    const float cq2 = FOX ? cb[qpos] * LOG2E : 0.f;
    f32x16 o[4];
#pragma unroll
    for (int c = 0; c < 4; ++c)
#pragma unroll
        for (int i = 0; i < 16; ++i) o[c][i] = 0.f;
    float m = -1e30f, l = 0.f;
    const int srow = tid >> 4, sch = tid & 15;
    const unsigned so0 = off_b(srow, sch), so1 = off_b(srow + 32, sch);
    const bf16* kg = Kb + (size_t)srow * ldk + 8 * sch; const bf16* vg = Vb + (size_t)srow * ldv + 8 * sch;
    v4u kr0, kr1, vr0, vr1; float cr = 0.f;
#define AT_LOAD(kt) do { const size_t ko = (size_t)(64 * (kt)) * ldk, vo = (size_t)(64 * (kt)) * ldv; \
        kr0 = *(const v4u*)(kg + ko); kr1 = *(const v4u*)(kg + ko + (size_t)32 * ldk); vr0 = *(const v4u*)(vg + vo); vr1 = *(const v4u*)(vg + vo + (size_t)32 * ldv); \
        if (FOX && tid < 64) cr = cb[64 * (kt) + tid] * LOG2E; } while (0)
#define AT_STORE(b) do { *(LAS v4u*)(lds + AT_K + (b) * 16384 + so0) = kr0; *(LAS v4u*)(lds + AT_K + (b) * 16384 + so1) = kr1; \
        *(LAS v4u*)(lds + AT_V + (b) * 16384 + so0) = vr0; *(LAS v4u*)(lds + AT_V + (b) * 16384 + so1) = vr1; \
        if (FOX && tid < 64) *(LAS float*)(lds + AT_C + (b) * 256 + 4 * tid) = cr; } while (0)
    AT_LOAD(0); AT_STORE(0);
    if (nkt > 1) AT_LOAD(1);
    __syncthreads();
    unsigned kb0 = 256u * r + 16u * ((unsigned)h ^ (((r & 3u) << 2) | ((r >> 2) & 3u)));
    const unsigned tq = (lane & 15) >> 2, tp = lane & 3, tblk = (lane >> 4) & 1;
    unsigned vb0 = 1024u * h + 256u * tq + 64u * tq + 16u * ((2u * tblk + (tp >> 1)) ^ ((unsigned)h & 3u)) + 8u * (tp & 1);
    unsigned vb1 = 2048u + 1024u * h + 256u * tq + 64u * tq + 16u * ((2u * tblk + (tp >> 1)) ^ ((2u + (unsigned)h) & 3u)) + 8u * (tp & 1);
    const int minq = qrow0 + 32 * wave;
#pragma unroll 1
    for (int kt = 0; kt < nkt; ++kt) {
        asm volatile("" : "+v"(kb0), "+v"(vb0), "+v"(vb1));
        const int b = kt & 1;
        const bool active = !FOX || (64 * kt <= minq + 31);
        if (active) {
            f32x16 p0, p1;
#pragma unroll
            for (int i = 0; i < 16; ++i) { p0[i] = 0.f; p1[i] = 0.f; }
            const LAS unsigned char* kbuf = lds + AT_K + b * 16384;
#pragma unroll
            for (int s = 0; s < 8; ++s) {
                const bf16x8 a0 = *(const LAS bf16x8*)(kbuf + (kb0 ^ (32u * s))), a1 = *(const LAS bf16x8*)(kbuf + (kb0 ^ (32u * s)) + 8192);
                p0 = __builtin_amdgcn_mfma_f32_32x32x16_bf16(a0, qf[s], p0, 0, 0, 0);
                p1 = __builtin_amdgcn_mfma_f32_32x32x16_bf16(a1, qf[s], p1, 0, 0, 0);
            }
            if (FOX) {
                const LAS float* cbuf = (const LAS float*)(lds + AT_C + b * 256);
#pragma unroll
                for (int g = 0; g < 4; ++g) { const f32x4 c0 = *(const LAS f32x4*)(cbuf + 8 * g + 4 * h), c1 = *(const LAS f32x4*)(cbuf + 32 + 8 * g + 4 * h);
#pragma unroll
                    for (int j = 0; j < 4; ++j) { p0[4 * g + j] = fmaf(p0[4 * g + j], AT_C2, cq2 - c0[j]); p1[4 * g + j] = fmaf(p1[4 * g + j], AT_C2, cq2 - c1[j]); } }
                if (64 * kt + 63 > minq) {
                    const int dq = qpos - 64 * kt - 4 * h;
#pragma unroll
                    for (int i = 0; i < 16; ++i) { const int ci = (i & 3) + 8 * (i >> 2);
                        if (ci > dq) p0[i] = -__builtin_inff();
                        if (ci + 32 > dq) p1[i] = -__builtin_inff(); }
                }
            } else {
#pragma unroll
                for (int i = 0; i < 16; ++i) { p0[i] *= AT_C2; p1[i] *= AT_C2; }
            }
            float pmax = p0[0];
#pragma unroll
            for (int i = 1; i < 16; ++i) pmax = fmaxf(pmax, p0[i]);
#pragma unroll
            for (int i = 0; i < 16; ++i) pmax = fmaxf(pmax, p1[i]);
            pmax = fmaxf(pmax, __shfl_xor(pmax, 32));
            const float mn = fmaxf(m, pmax), alpha = __builtin_amdgcn_exp2f(m - mn);
            m = mn;
            float ps = 0.f;
#pragma unroll
            for (int i = 0; i < 16; ++i) { p0[i] = __builtin_amdgcn_exp2f(p0[i] - mn); p1[i] = __builtin_amdgcn_exp2f(p1[i] - mn); ps += p0[i] + p1[i]; }
            ps += __shfl_xor(ps, 32);
            l = l * alpha + ps;
#pragma unroll
            for (int c = 0; c < 4; ++c)
#pragma unroll
                for (int i = 0; i < 16; ++i) o[c][i] *= alpha;
            bf16x8 pf[4];
#pragma unroll
            for (int s = 0; s < 2; ++s) {
                v4u w0, w1;
                w0.x = pk2(p0[8 * s], p0[8 * s + 1]); w0.y = pk2(p0[8 * s + 2], p0[8 * s + 3]); w0.z = pk2(p0[8 * s + 4], p0[8 * s + 5]); w0.w = pk2(p0[8 * s + 6], p0[8 * s + 7]);
                w1.x = pk2(p1[8 * s], p1[8 * s + 1]); w1.y = pk2(p1[8 * s + 2], p1[8 * s + 3]); w1.z = pk2(p1[8 * s + 4], p1[8 * s + 5]); w1.w = pk2(p1[8 * s + 6], p1[8 * s + 7]);
                pf[s] = __builtin_bit_cast(bf16x8, w0); pf[2 + s] = __builtin_bit_cast(bf16x8, w1);
            }
            const LAS unsigned char* vbuf = lds + AT_V + b * 16384;
#pragma unroll
            for (int ks = 0; ks < 4; ++ks)
#pragma unroll
                for (int c = 0; c < 4; ++c) {
                    const s16x4 lo = __builtin_amdgcn_ds_read_tr16_b64_v4i16((LAS s16x4*)(vbuf + ((vb0 ^ (64u * c)) + 4096u * ks)));
                    const s16x4 hi = __builtin_amdgcn_ds_read_tr16_b64_v4i16((LAS s16x4*)(vbuf + ((vb1 ^ (64u * c)) + 4096u * ks)));
                    const bf16x8 vf = __builtin_shufflevector(lo, hi, 0, 1, 2, 3, 4, 5, 6, 7);
                    o[c] = __builtin_amdgcn_mfma_f32_32x32x16_bf16(vf, pf[ks], o[c], 0, 0, 0);
                }
        }
        if (kt + 1 < nkt) { AT_STORE(b ^ 1); if (kt + 2 < nkt) AT_LOAD(kt + 2); }
        __syncthreads();
    }
#undef AT_LOAD
#undef AT_STORE
    const float il = 1.0f / l;
    bf16* orow = Ob + (size_t)(32 * wave + r) * ldo + 4 * h;
    const bf16* grow = FOX ? OGb + (size_t)(32 * wave + r) * ldog + 4 * h : nullptr;
#pragma unroll
    for (int c = 0; c < 4; ++c)
#pragma unroll
        for (int g = 0; g < 4; ++g) {
            float y0 = o[c][4 * g] * il, y1 = o[c][4 * g + 1] * il, y2 = o[c][4 * g + 2] * il, y3 = o[c][4 * g + 3] * il;
            if (FOX) { const v2u gg = *(const v2u*)(grow + 32 * c + 8 * g);
                y0 *= 1.0f / (1.0f + __expf(-bflo(gg.x))); y1 *= 1.0f / (1.0f + __expf(-bfhi(gg.x))); y2 *= 1.0f / (1.0f + __expf(-bflo(gg.y))); y3 *= 1.0f / (1.0f + __expf(-bfhi(gg.y))); }
            v2u w; w.x = pk2(y0, y1); w.y = pk2(y2, y3);
            *(v2u*)(orow + 32 * c + 8 * g) = w;
        }
}
__device__ __forceinline__ void mem_attn_unit(const Ctx& C, int v, const bf16* P, int ldp, int qcol, int layer) {
    const int qblk = v >> 2, mh = v & 3, b = qblk >> 4;
    attn_unit<false>(C.lds + RING_OFF, P + (size_t)(qblk * 256) * ldp + qcol + mh * HD, ldp,
                     WSP(bf16, WS_MK) + (size_t)layer * 1024 * 512 + (size_t)(b * ML) * 512 + mh * HD, 512, WSP(bf16, WS_MKV) + (size_t)(b * ML) * 1024 + 512 + mh * HD, 1024,
                     nullptr, 0, ML / 64, WSP(bf16, WS_CAT) + (size_t)(qblk * 256) * D + FW + mh * HD, D, nullptr, 0, C.tid, C.lane, C.wave);
}
__device__ __forceinline__ void p4_fox_attn(const Ctx& C) {
    const bf16* P = WSP(bf16, WS_P);
    unsigned* ctr = (unsigned*)(C.ws + WS_CTL) + CW_Q0;
    volatile LAS unsigned* uw = (volatile LAS unsigned*)(C.lds + RING_OFF + AT_U);
    for (;;) {
        __syncthreads();
        if (C.tid == 0) *uw = atomicAdd(ctr, 1u);
        __syncthreads();
        const int u = (int)*uw;
        if (u >= 768 + 256) break;
#if !defined(AT_ONLY_MEM)
        if (u < 768) {
            const int qb = 15 - u / 48, bh = u % 48, b = bh / FH, hh = bh % FH;
            const size_t rb = (size_t)(b * S + 256 * qb);
            attn_unit<true>(C.lds + RING_OFF, P + rb * FOX_NP + FP_Q + hh * HD, FOX_NP, P + (size_t)(b * S) * FOX_NP + FP_K + hh * HD, FOX_NP, P + (size_t)(b * S) * FOX_NP + FP_V + hh * HD, FOX_NP,
                           WSP(float, WS_C) + (size_t)bh * S, 256 * qb, 4 * qb + 4, WSP(bf16, WS_CAT) + rb * D + hh * HD, D, P + rb * FOX_NP + FP_OG + hh * HD, FOX_NP, C.tid, C.lane, C.wave);
        } else
#endif
#if !defined(AT_ONLY_FOX)
        mem_attn_unit(C, u - 768, P, FOX_NP, FP_QM, 0);
#else
        {}
#endif
    }
}

__device__ __forceinline__ void p13_mem_attn(const Ctx& C) {
    const bf16* P = WSP(bf16, WS_P);
    unsigned* ctr = (unsigned*)(C.ws + WS_CTL) + CW_Q1;
    volatile LAS unsigned* uw = (volatile LAS unsigned*)(C.lds + RING_OFF + AT_U);
    for (;;) {
        __syncthreads();
        if (C.tid == 0) *uw = atomicAdd(ctr, 1u);
        __syncthreads();
        const int u = (int)*uw;
        if (u >= 256) break;
        mem_attn_unit(C, u, P, GLA_NP, GP_QM, 1);
    }
}

constexpr int GT_STRIDE = 400;
constexpr int GT_QE = 0, GT_KE = 25600, GT_V = 51200;
constexpr int GSEG = 8, GCH = 8;
constexpr size_t WS_QE = WS_H, WS_KE = WS_H + 24 * MiB, WS_DL = WS_H + 48 * MiB, WS_DSEG = WS_H + 49 * MiB;
constexpr size_t WS_SLOC = WS_XG + 96 * MiB;

__device__ __forceinline__ void p12_gla_prep(const Ctx& C) {
    bf16* P = WSP(bf16, WS_P);
    for (int m = C.gw; m < T; m += C.NGW) headnorm_inplace(P + (size_t)m * GLA_NP, GP_QM, MH, C.in[13] + HD, C.lane);
    const float* w2 = C.in[10]; const float* ba = C.in[11];
    bf16* QE = WSP(bf16, WS_QE); bf16* KE = WSP(bf16, WS_KE); float* DL = WSP(float, WS_DL);
    const float qsc = 0.07216878364870322f;
    for (int cg = blockIdx.x; cg < T / 64; cg += C.G) {
        for (int c = C.tid; c < GKW; c += 512) {
            float w[16];
#pragma unroll
            for (int r = 0; r < 16; ++r) w[r] = w2[r * GKW + c];
            const float bb = ba[c]; float bc = 0.f;
#pragma unroll 2
            for (int t = 0; t < 64; ++t) {
                const size_t row = (size_t)cg * 64 + t;
                const float* fl = WSP(float, WS_FL) + row * 16;
                float s = bb;
#pragma unroll
                for (int r = 0; r < 16; ++r) s += fl[r] * w[r];
                bc += log_sigmoid(s) * (1.0f / 16.0f);
                const float e = expf(bc);
                const float q = bf2f(P[row * GLA_NP + GP_Q + c]), k = bf2f(P[row * GLA_NP + GP_K + c]);
                QE[row * GKW + c] = (bf16)(pk2(q * e * qsc, 0.f) & 0xffffu);
                KE[row * GKW + c] = (bf16)(pk2(k / e, 0.f) & 0xffffu);
            }
            DL[(size_t)cg * GKW + c] = expf(bc);
        }
    }
}

__device__ __forceinline__ bf16x8 pack8(const f32x16& x, int s) {
    v4u w; w.x = pk2(x[8 * s], x[8 * s + 1]); w.y = pk2(x[8 * s + 2], x[8 * s + 3]); w.z = pk2(x[8 * s + 4], x[8 * s + 5]); w.w = pk2(x[8 * s + 6], x[8 * s + 7]);
    return __builtin_bit_cast(bf16x8, w);
}
__device__ __forceinline__ s16x4 tr4(const LAS unsigned char* tile, int r0, int c0, int lane) {
    const int q = (lane & 15) >> 2, p = lane & 3, blk = (lane >> 4) & 1;
    return __builtin_amdgcn_ds_read_tr16_b64_v4i16((LAS s16x4*)(tile + (r0 + q) * GT_STRIDE + 2 * (c0 + 16 * blk + 4 * p)));
}
template <bool OUT>
__device__ __forceinline__ void gla_unit(const Ctx& C, int u) {
    const int seg = u & 7, eh = (u >> 3) & 1, bh = u >> 4, b = bh >> 2, hd = bh & 3;
    const int tid = C.tid, lane = C.lane, w = C.wave, r = lane & 31, h = lane >> 5;
    LAS unsigned char* lds = C.lds + RING_OFF;
    const bf16* QE = WSP(bf16, WS_QE); const bf16* KE = WSP(bf16, WS_KE); const bf16* P = WSP(bf16, WS_P);
    const float* DL = WSP(float, WS_DL); float* DSEG = WSP(float, WS_DSEG); float* SLOC = WSP(float, WS_SLOC); float* GO = WSP(float, WS_GO);
    f32x16 Sx[6];
#pragma unroll
    for (int dt = 0; dt < 6; ++dt)
#pragma unroll
        for (int i = 0; i < 16; ++i) Sx[dt][i] = 0.f;
    if (OUT && w < 6) {
        for (int sp = 0; sp < seg; ++sp) {
            const float* sl = SLOC + ((((size_t)(bh * GSEG + sp) * 2 + eh) * 6 + w) * 6) * 1024;
            const float* dsg = DSEG + (size_t)(bh * GSEG + sp) * GDK;
#pragma unroll
            for (int dt = 0; dt < 6; ++dt)
#pragma unroll
                for (int g = 0; g < 4; ++g) { const f32x4 dv = *(const f32x4*)(dsg + 32 * dt + 8 * g + 4 * h);
#pragma unroll
                    for (int j = 0; j < 4; ++j) Sx[dt][4 * g + j] = dv[j] * Sx[dt][4 * g + j] + sl[(dt * 16 + 4 * g + j) * 64 + lane]; }
        }
    }
    float dacc[3] = {1.f, 1.f, 1.f};
#pragma unroll 1
    for (int cc = 0; cc < GCH; ++cc) {
        const int cs = seg * GCH + cc; const size_t row0 = (size_t)b * S + (size_t)cs * 64; const int cg = b * 64 + cs;
        __syncthreads();
#pragma unroll
        for (int i = 0; i < 3; ++i) { const int n = tid + 512 * i, row = n / 24, ch = n % 24;
            if (OUT) *(LAS v4u*)(lds + GT_QE + row * GT_STRIDE + 16 * ch) = *(const v4u*)(QE + (row0 + row) * GKW + hd * GDK + 8 * ch);
            *(LAS v4u*)(lds + GT_KE + row * GT_STRIDE + 16 * ch) = *(const v4u*)(KE + (row0 + row) * GKW + hd * GDK + 8 * ch);
            *(LAS v4u*)(lds + GT_V + row * GT_STRIDE + 16 * ch) = *(const v4u*)(P + (row0 + row) * GLA_NP + GP_V + hd * GDV + eh * 192 + 8 * ch); }
        __syncthreads();
        if (w < 6) {
            int lane = C.lane; asm volatile("" : "+v"(lane));
            const int r = lane & 31, h = lane >> 5;
            const LAS unsigned char* tq = lds + GT_QE; const LAS unsigned char* tk = lds + GT_KE; const LAS unsigned char* tv = lds + GT_V;
            if (OUT) {
#pragma unroll
                for (int it = 0; it < 2; ++it) {
                    f32x16 ao;
#pragma unroll
                    for (int i = 0; i < 16; ++i) ao[i] = 0.f;
#pragma unroll
                    for (int dt = 0; dt < 6; ++dt)
#pragma unroll
                        for (int s = 0; s < 2; ++s) {
                            const bf16x8 a = pack8(Sx[dt], s);
                            const LAS unsigned char* qp = tq + (32 * it + r) * GT_STRIDE + 2 * (32 * dt + 16 * s + 4 * h);
                            const s16x4 lo = *(const LAS s16x4*)qp, hi = *(const LAS s16x4*)(qp + 16);
                            const bf16x8 bq = __builtin_shufflevector(lo, hi, 0, 1, 2, 3, 4, 5, 6, 7);
                            ao = __builtin_amdgcn_mfma_f32_32x32x16_bf16(a, bq, ao, 0, 0, 0);
                        }
                    __builtin_amdgcn_sched_barrier(0);
#pragma unroll
                    for (int jt = 0; jt <= it; ++jt) {
                        f32x16 at;
#pragma unroll
                        for (int i = 0; i < 16; ++i) at[i] = 0.f;
#pragma unroll
                        for (int s = 0; s < 12; ++s) {
                            const bf16x8 a = *(const LAS bf16x8*)(tk + (32 * jt + r) * GT_STRIDE + 16 * (2 * s + h));
                            const bf16x8 bq = *(const LAS bf16x8*)(tq + (32 * it + r) * GT_STRIDE + 16 * (2 * s + h));
                            at = __builtin_amdgcn_mfma_f32_32x32x16_bf16(a, bq, at, 0, 0, 0);
                        }
                        if (jt == it) {
#pragma unroll
                            for (int i = 0; i < 16; ++i) if (((i & 3) + 8 * (i >> 2) + 4 * h) > r) at[i] = 0.f;
                        }
#pragma unroll
                        for (int s = 0; s < 2; ++s) {
                            const bf16x8 bp = pack8(at, s);
                            const s16x4 lo = tr4(tv, 32 * jt + 16 * s + 4 * h, 32 * w, lane), hi = tr4(tv, 32 * jt + 16 * s + 8 + 4 * h, 32 * w, lane);
                            const bf16x8 av = __builtin_shufflevector(lo, hi, 0, 1, 2, 3, 4, 5, 6, 7);
                            ao = __builtin_amdgcn_mfma_f32_32x32x16_bf16(av, bp, ao, 0, 0, 0);
                        }
                    }
                    __builtin_amdgcn_sched_barrier(0);
                    float* op = GO + (row0 + 32 * it + r) * GVW + hd * GDV + eh * 192 + 32 * w + 4 * h;
#pragma unroll
                    for (int g = 0; g < 4; ++g) *(f32x4*)(op + 8 * g) = (f32x4){ao[4 * g], ao[4 * g + 1], ao[4 * g + 2], ao[4 * g + 3]};
                }
            }
            __builtin_amdgcn_sched_barrier(0);
            bf16x8 bv[4];
#pragma unroll
            for (int ks = 0; ks < 4; ++ks) { const s16x4 lo = tr4(tv, 16 * ks + 8 * h, 32 * w, lane), hi = tr4(tv, 16 * ks + 8 * h + 4, 32 * w, lane);
                bv[ks] = __builtin_shufflevector(lo, hi, 0, 1, 2, 3, 4, 5, 6, 7); }
            const float* dlp = DL + (size_t)cg * GKW + hd * GDK;
#pragma unroll
            for (int dt = 0; dt < 6; ++dt) {
#pragma unroll
                for (int ks = 0; ks < 4; ++ks) { const s16x4 lo = tr4(tk, 16 * ks + 8 * h, 32 * dt, lane), hi = tr4(tk, 16 * ks + 8 * h + 4, 32 * dt, lane);
                    const bf16x8 ak = __builtin_shufflevector(lo, hi, 0, 1, 2, 3, 4, 5, 6, 7);
                    Sx[dt] = __builtin_amdgcn_mfma_f32_32x32x16_bf16(ak, bv[ks], Sx[dt], 0, 0, 0); }
#pragma unroll
                for (int g = 0; g < 4; ++g) { const f32x4 dv = *(const f32x4*)(dlp + 32 * dt + 8 * g + 4 * h);
#pragma unroll
                    for (int j = 0; j < 4; ++j) Sx[dt][4 * g + j] *= dv[j]; }
            }
        } else if (!OUT && w == 6) {
            const float* dlp = DL + (size_t)cg * GKW + hd * GDK;
#pragma unroll
            for (int i = 0; i < 3; ++i) dacc[i] *= dlp[lane + 64 * i];
        }
    }
    if (!OUT) {
        if (w < 6) { float* sl = SLOC + ((((size_t)(bh * GSEG + seg) * 2 + eh) * 6 + w) * 6) * 1024;
#pragma unroll
            for (int dt = 0; dt < 6; ++dt)
#pragma unroll
                for (int i = 0; i < 16; ++i) sl[(dt * 16 + i) * 64 + lane] = Sx[dt][i]; }
        else if (w == 6 && eh == 0) {
#pragma unroll
            for (int i = 0; i < 3; ++i) DSEG[(size_t)(bh * GSEG + seg) * GDK + lane + 64 * i] = dacc[i]; }
    }
}
__device__ __forceinline__ void p13a_gla_local(const Ctx& C) { for (int u = blockIdx.x; u < 256; u += C.G) if ((u & 7) != 7) gla_unit<false>(C, u); }
__device__ __forceinline__ void p13b_gla_out(const Ctx& C) { for (int u = blockIdx.x; u < 256; u += C.G) gla_unit<true>(C, u); }

constexpr int NPHASE = 22;
struct Args { const float* in[24]; float* out; unsigned char* ws; int ph_lo, ph_hi; };
#define PG8_ALIGN true
#define PG8_SP2 true

template <class Epi, class Sched>
__device__ __forceinline__ void run_gemm(const Ctx& C, const bf16* A, const bf16* Bt, int K, const Sched& Sd, const Epi& E) {
    pg8::Gemm g{A, Bt, 0, 0, K};
    pg8::gemm_phase<Epi, Sched, PG8_ALIGN, PG8_SP2>(C.lds + RING_OFF, g, Sd, E);
}
__device__ __forceinline__ void dense_gemm_p(const Ctx& C, const bf16* A, const bf16* Bt, int M, int N, int K, bf16* P, int ldp, float* FL, int ftile) {
    pg8::StaticOrder Sd; Sd.init(M, N, C.G, (int)blockIdx.x); pg8::EpiP E{P, ldp, FL, ftile}; run_gemm(C, A, Bt, K, Sd, E);
}
__device__ __forceinline__ void ph_wout(const Ctx& C, int layer) {
    pg8::StaticOrder Sd; Sd.init(T, D, C.G, (int)blockIdx.x);
    pg8::EpiRes E{layer == 0 ? C.in[0] : WSP(float, WS_XA), WSP(float, WS_XB), D};
    run_gemm(C, WSP(bf16, WS_CAT), WSP(bf16, WS_WOUT) + (size_t)layer * D * D, D, Sd, E);
}
__device__ __forceinline__ void ph_gu(const Ctx& C, int layer) {
    const int* tilee = (const int*)(C.ws + WS_ROUTE + RT_TILEE) + layer * 256;
    pg8::MoeOrder Sd{tilee, tilee[255] * 8, C.G, (int)blockIdx.x}; pg8::EpiGU E{WSP(bf16, WS_H)};
    run_gemm(C, WSP(bf16, WS_XG), WSP(bf16, WS_WGU) + (size_t)layer * NE * 2048 * 2048, D, Sd, E);
}
__device__ __forceinline__ void ph_down(const Ctx& C, int layer) {
    const int* tilee = (const int*)(C.ws + WS_ROUTE + RT_TILEE) + layer * 256;
    pg8::MoeOrder Sd{tilee, tilee[255] * 8, C.G, (int)blockIdx.x};
    pg8::EpiDown E{(const int*)(C.ws + WS_ROUTE + RT_ROWDEST) + layer * MAXROWS, (const float*)(C.ws + WS_ROUTE + RT_ROWW), WSP(bf16, WS_YB)};
    run_gemm(C, WSP(bf16, WS_H), WSP(bf16, WS_WD) + (size_t)layer * NE * 2048 * 1024, DE, Sd, E);
}

__global__ void __launch_bounds__(NWAVES * 64, 2) fwd_kernel(Args args) {
    extern __shared__ __attribute__((aligned(16))) unsigned char lds[];
    Ctx C;
    C.lds = (LAS unsigned char*)lds;
    C.tid = threadIdx.x; C.lane = C.tid & 63; C.wave = __builtin_amdgcn_readfirstlane(C.tid >> 6);
    C.G = gridDim.x; C.gw = blockIdx.x * NWAVES + C.wave; C.NGW = C.G * NWAVES;
#pragma unroll
    for (int i = 0; i < 24; ++i) C.in[i] = args.in[i];
    C.out = args.out; C.ws = args.ws;
    volatile LAS unsigned* MISC = (volatile LAS unsigned*)(C.lds + MISC_OFF);
    for (int u = C.tid; u < (LDS_BYTES - LDSCTL_OFF) / 4; u += NWAVES * 64) ((LAS unsigned*)(C.lds + LDSCTL_OFF))[u] = 0u;
    __syncthreads();
    const int lo = args.ph_lo, hi = args.ph_hi;
    XcdBarrier bar; bar.bar = (unsigned*)(C.ws + WS_CTL) + CW_BAR; bar.x = 0; bar.st = nullptr;
    if (hi - lo > 1) bar = xcd_barrier_post((unsigned*)(C.ws + WS_CTL) + CW_BAR, MISC + 8);
#ifndef PHSEL
#define PHSEL 0xFFFFFFFFu
#endif
#define SITE(s) ((PHSEL >> (s)) & 1u)
#ifndef DUPMASK
#define DUPMASK 0u
#endif
#define DUP(s) ((DUPMASK >> (s)) & 1u)
#define IN(k) (lo <= (k) && (k) < hi)
#define SEAM(k) do { if (IN(k) && IN((k) + 1)) xcd_barrier(bar); } while (0)

    if (SITE(0) && IN(0)) p0_prologue(C);
    if (DUP(0) && IN(0)) { __syncthreads(); p0_prologue(C); }
    SEAM(0);
    if (SITE(1) && IN(1)) dense_gemm_p(C, WSP(bf16, WS_MEMN), WSP(bf16, WS_WMKV), NB * ML, 1024, D, WSP(bf16, WS_MKV), 1024, nullptr, -1);
    if (DUP(1) && IN(1)) { __syncthreads(); dense_gemm_p(C, WSP(bf16, WS_MEMN), WSP(bf16, WS_WMKV), NB * ML, 1024, D, WSP(bf16, WS_MKV), 1024, nullptr, -1); }
    SEAM(1);
    if (SITE(2) && IN(2)) dense_gemm_p(C, WSP(bf16, WS_HN), WSP(bf16, WS_WFOX), T, FOX_NP, D, WSP(bf16, WS_P), FOX_NP, WSP(float, WS_FL), FP_F / 256);
    if (DUP(2) && IN(2)) { __syncthreads(); dense_gemm_p(C, WSP(bf16, WS_HN), WSP(bf16, WS_WFOX), T, FOX_NP, D, WSP(bf16, WS_P), FOX_NP, WSP(float, WS_FL), FP_F / 256); }
    SEAM(2);
    if (SITE(3) && IN(3)) p3_fox_thin(C);
    if (DUP(3) && IN(3)) { __syncthreads(); p3_fox_thin(C); }
    SEAM(3);
    if (SITE(4) && IN(4)) p4_fox_attn(C);
    if (DUP(4) && IN(4)) { __syncthreads(); p4_fox_attn(C); }
    SEAM(4);
    if (SITE(5) && IN(5)) ph_wout(C, 0);
    if (DUP(5) && IN(5)) { __syncthreads(); ph_wout(C, 0); }
    SEAM(5);
    if (SITE(6) && IN(6)) p6_router_mfma(C, 0);
    if (DUP(6) && IN(6)) { __syncthreads(); p6_router_mfma(C, 0, false); }
    SEAM(6);
    if (SITE(7) && IN(7)) p7_dispatch(C, 0);
    if (DUP(7) && IN(7)) { __syncthreads(); p7_dispatch(C, 0); }
    SEAM(7);
    if (SITE(8) && IN(8)) ph_gu(C, 0);
    if (DUP(8) && IN(8)) { __syncthreads(); ph_gu(C, 0); }
    SEAM(8);
    if (SITE(9) && IN(9)) ph_down(C, 0);
    if (DUP(9) && IN(9)) { __syncthreads(); ph_down(C, 0); }
    SEAM(9);
    if (SITE(10) && IN(10)) p_combine(C, WSP(float, WS_XB), WSP(float, WS_XA), C.in[4] + D);
    if (DUP(10) && IN(10)) { __syncthreads(); p_combine(C, WSP(float, WS_XB), WSP(float, WS_XA), C.in[4] + D); }
    SEAM(10);
    if (SITE(11) && IN(11)) dense_gemm_p(C, WSP(bf16, WS_HN), WSP(bf16, WS_WGLA), T, GLA_NP, D, WSP(bf16, WS_P), GLA_NP, WSP(float, WS_FL), GP_A / 256);
    if (DUP(11) && IN(11)) { __syncthreads(); dense_gemm_p(C, WSP(bf16, WS_HN), WSP(bf16, WS_WGLA), T, GLA_NP, D, WSP(bf16, WS_P), GLA_NP, WSP(float, WS_FL), GP_A / 256); }
    SEAM(11);
    if (SITE(12) && IN(12)) p12_gla_prep(C);
    if (DUP(12) && IN(12)) { __syncthreads(); p12_gla_prep(C); }
    SEAM(12);
    if (SITE(13) && IN(13)) p13a_gla_local(C);
    if (DUP(13) && IN(13)) { __syncthreads(); p13a_gla_local(C); }
    SEAM(13);
#if defined(NO_MEM14)
    if (SITE(14) && IN(14)) { p13b_gla_out(C); }
#elif defined(NO_GLA14)
    if (SITE(14) && IN(14)) { p13_mem_attn(C); }
#else
    if (SITE(14) && IN(14)) { p13b_gla_out(C); p13_mem_attn(C); }
#endif
    SEAM(14);
    if (SITE(15) && IN(15)) p14_gla_onorm(C);
    if (DUP(15) && IN(15)) { __syncthreads(); p14_gla_onorm(C); }
    SEAM(15);
    if (SITE(16) && IN(16)) ph_wout(C, 1);
    if (DUP(16) && IN(16)) { __syncthreads(); ph_wout(C, 1); }
    SEAM(16);
    if (SITE(17) && IN(17)) p6_router_mfma(C, 1);
    if (DUP(17) && IN(17)) { __syncthreads(); p6_router_mfma(C, 1, false); }
    SEAM(17);
    if (SITE(18) && IN(18)) p7_dispatch(C, 1);
    if (DUP(18) && IN(18)) { __syncthreads(); p7_dispatch(C, 1); }
    SEAM(18);
    if (SITE(19) && IN(19)) ph_gu(C, 1);
    if (DUP(19) && IN(19)) { __syncthreads(); ph_gu(C, 1); }
    SEAM(19);
    if (SITE(20) && IN(20)) ph_down(C, 1);
    if (DUP(20) && IN(20)) { __syncthreads(); ph_down(C, 1); }
    SEAM(20);
    if (SITE(21) && IN(21)) p_combine(C, WSP(float, WS_XB), C.out, nullptr);
    if (DUP(21) && IN(21)) { __syncthreads(); p_combine(C, WSP(float, WS_XB), C.out, nullptr); }
#undef IN
#undef SEAM
}

extern "C" void kernel_launch(void* const* d_in, const int* in_sizes, int n_in, void* d_out, int out_size, void* d_ws, size_t ws_size, hipStream_t stream) {
    static int grid = 0;
    if (grid == 0) {
        if (n_in != 24 || out_size != T * D || ws_size < WS_END) { fprintf(stderr, "kernel_launch: unexpected problem (n_in %d, out %d, ws %zu < %zu)\n", n_in, out_size, ws_size, (size_t)WS_END); grid = -1; return; }
        int dev = 0, cus = 0, per_cu = 0;
        if (hipGetDevice(&dev) != hipSuccess || hipDeviceGetAttribute(&cus, hipDeviceAttributeMultiprocessorCount, dev) != hipSuccess) { grid = -1; return; }
        if (hipFuncSetAttribute((const void*)fwd_kernel, hipFuncAttributeMaxDynamicSharedMemorySize, LDS_BYTES) != hipSuccess) { fprintf(stderr, "kernel_launch: hipFuncSetAttribute failed\n"); grid = -1; return; }
        if (hipOccupancyMaxActiveBlocksPerMultiprocessor(&per_cu, (const void*)fwd_kernel, NWAVES * 64, LDS_BYTES) != hipSuccess || per_cu < 1)
            fprintf(stderr, "kernel_launch: occupancy query reports %d workgroups per CU\n", per_cu);
        (void)hipGetLastError();
        grid = cus;
    }
    if (grid < 0) return;
    if (hipMemsetAsync((char*)d_ws + WS_CTL, 0, CTL_ZERO_BYTES, stream) != hipSuccess) return;
    Args a{};
    for (int i = 0; i < 24; ++i) a.in[i] = (const float*)d_in[i];
    a.out = (float*)d_out; a.ws = (unsigned char*)d_ws;
#if MK_N_LAUNCHES == 1
    a.ph_lo = 0; a.ph_hi = NPHASE;
    hipLaunchKernelGGL(fwd_kernel, dim3(grid), dim3(NWAVES * 64), LDS_BYTES, stream, a);
#else
    for (int p = 0; p < NPHASE; ++p) { a.ph_lo = p; a.ph_hi = p + 1; hipLaunchKernelGGL(fwd_kernel, dim3(grid), dim3(NWAVES * 64), LDS_BYTES, stream, a); }
#endif
}
```

```cpp
#include <hip/hip_runtime.h>
#include <cstdio>
#include <cstdint>
#ifndef MK_N_LAUNCHES
#define MK_N_LAUNCHES 1
#endif
namespace pg8 {
#define PG8_LAS __attribute__((address_space(3)))
typedef unsigned short bf16_t;
typedef short bf16x8 __attribute__((ext_vector_type(8)));
typedef float f32x4 __attribute__((ext_vector_type(4)));
typedef unsigned u32x4 __attribute__((ext_vector_type(4)));
constexpr int BM = 256, BK = 64, HALF = 128, HTB = HALF * BK * 2  , STAGE_BYTES = 8 * HTB, NXCD = 8, WGM = 8;

__host__ __device__ __forceinline__ int lds_byte(int r, int c) { const int st = (r >> 4) * 2 + (c >> 5), rr = r & 15, cc = c & 31, ob = rr * 64 + cc * 2; return st * 1024 + (ob ^ (((ob >> 9) & 1) << 5)); }
__host__ __device__ __forceinline__ void stage_rc(int b, int& R, int& C) { const int st = b / 1024, sb = b % 1024, swz = sb ^ (((sb >> 9) & 1) << 5); R = (st >> 1) * 16 + swz / 64; C = (st & 1) * 32 + (swz % 64) / 2; }
__host__ __device__ __forceinline__ int perm32(int rho) { const int n = rho >> 4, i = rho & 15; return 8 * (i >> 2) + 4 * n + (i & 3); }

struct Unit { int pm, pn; };
struct Gemm { const bf16_t* A; const bf16_t* Bt; int M, N, K; };

struct StaticOrder {
    int nM, nN, nwg, G, c;
    __host__ __device__ void init(int M, int N, int G_, int c_) { nM = M / BM; nN = N / BM; nwg = nM * nN; G = G_; c = c_; }
    __host__ __device__ bool next(int i, Unit& u) const {
        const long L = (long)i * G + c; if (L >= nwg) return false;
        int wgid = (int)L; { const int q = nwg / NXCD, r = nwg % NXCD, xcd = wgid % NXCD, off = wgid / NXCD; wgid = (xcd < r ? xcd * (q + 1) : r * (q + 1) + (xcd - r) * q) + off; }
        const int nig = WGM * nN, gid = wgid / nig, fm = gid * WGM, gsz = (nM - fm) < WGM ? (nM - fm) : WGM;
        u.pm = fm + ((wgid % nig) % gsz); u.pn = (wgid % nig) / gsz; return true;
    }
    __device__ __forceinline__ void a_ready(const Unit&) const {}
    __device__ __forceinline__ void done(const Unit&) const {}
};
template <class Epi, class Sched, bool ALIGN_EPI = false, bool SP2 = false>
__device__ __forceinline__ void gemm_phase(PG8_LAS unsigned char* lds, const Gemm g, const Sched& S, const Epi& E) {
    const int tid = threadIdx.x, wid = __builtin_amdgcn_readfirstlane(tid >> 6), lane = tid & 63, wr = wid >> 2, wc = wid & 3, fr = lane & 15, fq = lane >> 4;
    const int K = g.K, nt = K / BK;
    unsigned voffA[2], voffB[2];
#pragma unroll
    for (int i = 0; i < 2; ++i) { int R, C; stage_rc(tid * 16 + i * 8192, R, C); const int Rb = Epi::PERM ? ((R & ~31) + perm32(R & 31)) : R;
        voffA[i] = (unsigned)(R * K + C) * 2u; voffB[i] = (unsigned)(Rb * K + C) * 2u; }
    const size_t kstep = (size_t)(BK * 2);
    const size_t hstep = (size_t)HALF * K * 2;
    const size_t tstep = 2 * hstep;
    const unsigned ldsw = (unsigned)wid * 1024u;
    const int aoff = lds_byte(wr * 64 + fr, fq * 8), boff = lds_byte(wc * 32 + fr, fq * 8);
#define PG8_SA(b, h) (((b) * 2 + (h)) * HTB)
#define PG8_SB(b, h) ((4 + (b) * 2 + (h)) * HTB)
#define PG8_STAGE(bufoff, gbase, voff) do { _Pragma("unroll") for (int _i = 0; _i < 2; ++_i) \
        __builtin_amdgcn_global_load_lds((const unsigned*)((const char*)(gbase) + (voff)[_i]), (PG8_LAS unsigned*)(lds + (bufoff) + ldsw + _i * 8192), 16, 0, 0); } while (0)
#define PG8_LDA(dst, b, h) do { _Pragma("unroll") for (int m = 0; m < 4; ++m) _Pragma("unroll") for (int k = 0; k < 2; ++k) dst[m][k] = *(const PG8_LAS bf16x8*)(lds + PG8_SA(b, h) + aoff + m * 2048 + k * 1024); } while (0)
#define PG8_LDB(dst, b, h) do { _Pragma("unroll") for (int n = 0; n < 2; ++n) _Pragma("unroll") for (int k = 0; k < 2; ++k) dst[n][k] = *(const PG8_LAS bf16x8*)(lds + PG8_SB(b, h) + boff + n * 2048 + k * 1024); } while (0)
#define PG8_MMA(ai, bj, At, Bt) do { __builtin_amdgcn_s_setprio(1); _Pragma("unroll") for (int m = 0; m < 4; ++m) _Pragma("unroll") for (int n = 0; n < 2; ++n) _Pragma("unroll") for (int k = 0; k < 2; ++k) \
        acc[ai][bj][m][n] = __builtin_amdgcn_mfma_f32_16x16x32_bf16(Bt[n][k], At[m][k], acc[ai][bj][m][n], 0, 0, 0); __builtin_amdgcn_s_setprio(0); } while (0)
#define PG8_WAIT_V(n) asm volatile("s_waitcnt vmcnt(" #n ")" ::: "memory")
#define PG8_WAIT_L(n) asm volatile("s_waitcnt lgkmcnt(" #n ")" ::: "memory")
#define PG8_BAR __builtin_amdgcn_s_barrier()
#define PG8_SCHED __builtin_amdgcn_sched_barrier(0)
    Unit cur, nxt; int ui = 0;
    if (!S.next(0, cur)) return;
    f32x4 acc[2][2][4][2];
#pragma unroll
    for (int a = 0; a < 2; ++a)
#pragma unroll
        for (int b = 0; b < 2; ++b)
#pragma unroll
            for (int m = 0; m < 4; ++m)
#pragma unroll
                for (int n = 0; n < 2; ++n) acc[a][b][m][n] = (f32x4){0.f, 0.f, 0.f, 0.f};
    bf16x8 At[4][2], B0[2][2], B1[2][2];
    const char* cA = (const char*)g.A + (size_t)cur.pm * tstep; const char* cB = (const char*)g.Bt + (size_t)cur.pn * tstep;
    S.a_ready(cur);
    if constexpr (SP2) {
        PG8_STAGE(PG8_SB(0, 0), cB, voffB); PG8_STAGE(PG8_SB(0, 1), cB + hstep, voffB); PG8_STAGE(PG8_SA(0, 0), cA, voffA); PG8_STAGE(PG8_SA(0, 1), cA + hstep, voffA);
        if (wr == 1) PG8_BAR;
        PG8_WAIT_V(2); PG8_BAR;
        PG8_STAGE(PG8_SB(1, 0), cB + kstep, voffB); PG8_STAGE(PG8_SA(1, 0), cA + kstep, voffA); PG8_STAGE(PG8_SB(1, 1), cB + hstep + kstep, voffB);
        PG8_WAIT_V(6); PG8_BAR;
    } else {
        PG8_STAGE(PG8_SB(0, 0), cB, voffB); PG8_STAGE(PG8_SA(0, 0), cA, voffA); PG8_STAGE(PG8_SB(0, 1), cB + hstep, voffB); PG8_STAGE(PG8_SA(0, 1), cA + hstep, voffA);
        if (wr == 1) PG8_BAR;
        PG8_WAIT_V(4); PG8_BAR;
        PG8_STAGE(PG8_SB(1, 0), cB + kstep, voffB); PG8_STAGE(PG8_SA(1, 0), cA + kstep, voffA); PG8_STAGE(PG8_SB(1, 1), cB + hstep + kstep, voffB);
        PG8_WAIT_V(6); PG8_BAR;
    }
    for (;;) {
        const bool has_next = S.next(ui + 1, nxt);
        const char* nA = has_next ? (const char*)g.A + (size_t)nxt.pm * tstep : cA; const char* nB = has_next ? (const char*)g.Bt + (size_t)nxt.pn * tstep : cB;
        for (int t = 0; t < nt; t += 2) {
            const bool last = (t == nt - 2);
            const char* a1 = cA + (size_t)(t + 1) * kstep;
            const char* a2 = last ? nA : cA + (size_t)(t + 2) * kstep; const char* b2 = last ? nB : cB + (size_t)(t + 2) * kstep;
            const char* a3 = a2 + kstep; const char* b3 = b2 + kstep;
            if (last && has_next) S.a_ready(nxt);
            if constexpr (SP2) {
            PG8_LDB(B0, 0, 0); PG8_LDB(B1, 0, 1); PG8_SCHED; PG8_LDA(At, 0, 0); PG8_STAGE(PG8_SA(1, 1), a1 + hstep, voffA);
            PG8_WAIT_V(8); PG8_WAIT_L(0); PG8_BAR; PG8_MMA(0, 0, At, B0); PG8_MMA(0, 1, At, B1); PG8_BAR; PG8_SCHED;
            PG8_LDA(At, 0, 1); PG8_STAGE(PG8_SB(0, 0), b2, voffB); PG8_STAGE(PG8_SB(0, 1), b2 + hstep, voffB); PG8_STAGE(PG8_SA(0, 0), a2, voffA);
            PG8_WAIT_V(8); PG8_WAIT_L(0); PG8_BAR; PG8_MMA(1, 0, At, B0); PG8_MMA(1, 1, At, B1); PG8_BAR; PG8_SCHED;
            PG8_LDB(B0, 1, 0); PG8_LDB(B1, 1, 1); PG8_SCHED; PG8_LDA(At, 1, 0); PG8_STAGE(PG8_SA(0, 1), a2 + hstep, voffA);
            PG8_WAIT_V(8); PG8_WAIT_L(0); PG8_BAR; PG8_MMA(0, 0, At, B0); PG8_MMA(0, 1, At, B1); PG8_BAR; PG8_SCHED;
            PG8_LDA(At, 1, 1); PG8_STAGE(PG8_SB(1, 0), b3, voffB); PG8_STAGE(PG8_SB(1, 1), b3 + hstep, voffB); PG8_STAGE(PG8_SA(1, 0), a3, voffA);
            PG8_WAIT_V(8); PG8_WAIT_L(0); PG8_BAR; PG8_MMA(1, 0, At, B0); PG8_MMA(1, 1, At, B1); PG8_BAR; PG8_SCHED;
            } else {
            PG8_LDB(B0, 0, 0); PG8_SCHED; PG8_LDA(At, 0, 0); PG8_STAGE(PG8_SA(1, 1), a1 + hstep, voffA);
            PG8_WAIT_L(8); PG8_BAR; PG8_WAIT_L(0); PG8_MMA(0, 0, At, B0); PG8_BAR; PG8_SCHED;
            PG8_LDB(B1, 0, 1); PG8_STAGE(PG8_SB(0, 0), b2, voffB);
            PG8_BAR; PG8_WAIT_L(0); PG8_MMA(0, 1, At, B1); PG8_BAR;
            PG8_LDA(At, 0, 1); PG8_STAGE(PG8_SA(0, 0), a2, voffA);
            PG8_BAR; PG8_WAIT_L(0); PG8_MMA(1, 0, At, B0); PG8_BAR; PG8_SCHED;
            PG8_STAGE(PG8_SB(0, 1), b2 + hstep, voffB);
            PG8_WAIT_V(6); PG8_BAR; PG8_MMA(1, 1, At, B1); PG8_BAR;
            PG8_LDB(B0, 1, 0); PG8_SCHED; PG8_LDA(At, 1, 0); PG8_STAGE(PG8_SA(0, 1), a2 + hstep, voffA);
            PG8_WAIT_L(8); PG8_BAR; PG8_WAIT_L(0); PG8_MMA(0, 0, At, B0); PG8_BAR; PG8_SCHED;
            PG8_LDB(B1, 1, 1); PG8_STAGE(PG8_SB(1, 0), b3, voffB);
            PG8_BAR; PG8_WAIT_L(0); PG8_MMA(0, 1, At, B1); PG8_BAR;
            PG8_LDA(At, 1, 1); PG8_STAGE(PG8_SA(1, 0), a3, voffA);
            PG8_BAR; PG8_WAIT_L(0); PG8_MMA(1, 0, At, B0); PG8_BAR; PG8_SCHED;
            PG8_STAGE(PG8_SB(1, 1), b3 + hstep, voffB);
            PG8_WAIT_V(6); PG8_BAR; PG8_MMA(1, 1, At, B1); PG8_BAR;
            }
        }
        if constexpr (ALIGN_EPI) { if (wr == 0) PG8_BAR; }
        if constexpr (!Epi::AFTER_DRAIN) { E(acc, cur, wr, wc, fr, fq); S.done(cur); }
        if (!has_next) break;
#pragma unroll
        for (int a = 0; a < 2; ++a)
#pragma unroll
            for (int b = 0; b < 2; ++b)
#pragma unroll
                for (int m = 0; m < 4; ++m)
#pragma unroll
                    for (int n = 0; n < 2; ++n) acc[a][b][m][n] = (f32x4){0.f, 0.f, 0.f, 0.f};
        cur = nxt; cA = nA; cB = nB; ++ui;
        if constexpr (ALIGN_EPI) { if (wr == 1) PG8_BAR; }
    }
    PG8_WAIT_V(0);
    if constexpr (!ALIGN_EPI) { if (wr == 0) PG8_BAR; }
    PG8_BAR;
    if constexpr (Epi::AFTER_DRAIN) { E.fused(acc, cur, wr, wc, fr, fq, lds, wid, lane); S.done(cur); }
#undef PG8_SA
#undef PG8_SB
#undef PG8_STAGE
#undef PG8_LDA
#undef PG8_LDB
#undef PG8_MMA
#undef PG8_WAIT_V
#undef PG8_WAIT_L
#undef PG8_BAR
#undef PG8_SCHED
}
}

#define GAS __attribute__((address_space(1)))
#define LAS __attribute__((address_space(3)))
typedef unsigned short bf16;
typedef unsigned v4u __attribute__((ext_vector_type(4)));
typedef unsigned v2u __attribute__((ext_vector_type(2)));
typedef float f32x4 __attribute__((ext_vector_type(4)));
typedef float f32x2 __attribute__((ext_vector_type(2)));
typedef short bf16x8 __attribute__((ext_vector_type(8)));
typedef float f32x16 __attribute__((ext_vector_type(16)));
typedef short s16x4 __attribute__((ext_vector_type(4)));
typedef __bf16 bf16x2_t __attribute__((ext_vector_type(2)));
#define LDS_WAIT() asm volatile("s_waitcnt lgkmcnt(0)" ::: "memory")
#define VM_WAIT() asm volatile("s_waitcnt vmcnt(0)" ::: "memory")
__device__ __forceinline__ unsigned pk2(float lo, float hi) { f32x2 v = {lo, hi}; bf16x2_t r = __builtin_convertvector(v, bf16x2_t); return __builtin_bit_cast(unsigned, r); }
__device__ __forceinline__ float bflo(unsigned u) { return __builtin_bit_cast(float, u << 16); }
__device__ __forceinline__ float bfhi(unsigned u) { return __builtin_bit_cast(float, u & 0xffff0000u); }
__device__ __forceinline__ float bf2f(bf16 b) { return __builtin_bit_cast(float, ((unsigned)b) << 16); }
__device__ __forceinline__ float wave_sum(float v) {
#pragma unroll
    for (int o = 1; o < 64; o <<= 1) v += __shfl_xor(v, o);
    return v;
}
__device__ __forceinline__ float wave_max(float v) {
#pragma unroll
    for (int o = 1; o < 64; o <<= 1) v = fmaxf(v, __shfl_xor(v, o));
    return v;
}
#define XB_TMO      128
#define XB_XCNT(j)  (256  + 64 * (j))
#define XB_XSUB(j)  (1280 + 64 * (j))
#define XB_XGEN(j)  (2304 + 64 * (j))
#define XB_TOP      3328
#define XB_TOPGEN   3392
#define XCD_BAR_WORDS 3456
#define XB_SPIN_CAP (1u << 23)

__device__ __forceinline__ unsigned xb_ld(unsigned* p)              { return __hip_atomic_load(p, __ATOMIC_RELAXED, __HIP_MEMORY_SCOPE_AGENT); }
__device__ __forceinline__ unsigned xb_add(unsigned* p, unsigned v) { return __hip_atomic_fetch_add(p, v, __ATOMIC_RELAXED, __HIP_MEMORY_SCOPE_AGENT); }
__device__ __forceinline__ unsigned xb_xcc_id() { return (unsigned)__builtin_amdgcn_s_getreg((3 << 11) | 20) & 0xFu; }
#define XB_SPIN(cond, bar) do { unsigned _sp = 0; while (cond) { __builtin_amdgcn_s_sleep(1); \
    if ((++_sp & 255u) == 0u) { if (xb_ld(&(bar)[XB_TMO])) break; if (_sp > XB_SPIN_CAP) { atomicAdd(&(bar)[XB_TMO], 1u); break; } } } } while (0)

struct XcdBarrier {
    unsigned* bar; unsigned x;
    volatile LAS unsigned* st;
};

__device__ __forceinline__ XcdBarrier xcd_barrier_post(unsigned* bar, volatile LAS unsigned* st) {
    XcdBarrier b; b.bar = bar; b.x = xb_xcc_id(); b.st = st;
    if (threadIdx.x == 0) (void)xb_add(&bar[XB_XCNT(b.x)], 1u);
    return b;
}
__device__ __forceinline__ void xcd_barrier_complete(unsigned* bar, unsigned x, unsigned& nloc, unsigned& nx) {
    const unsigned G = gridDim.x * gridDim.y * gridDim.z;
    unsigned sum, cnt, mine, sp = 0u;
    for (;;) {
        sum = 0u; cnt = 0u; mine = 0u;
#pragma unroll
        for (unsigned j = 0; j < 16; ++j) { const unsigned c = xb_ld(&bar[XB_XCNT(j)]); sum += c; cnt += (c > 0u) ? 1u : 0u; mine = (j == x) ? c : mine; }
        if (sum == G) break;
        __builtin_amdgcn_s_sleep(1);
        if ((++sp & 255u) == 0u) { if (xb_ld(&bar[XB_TMO])) break; if (sp > XB_SPIN_CAP) { atomicAdd(&bar[XB_TMO], 1u); break; } }
    }
    nloc = mine > 0u ? mine : 1u; nx = cnt > 0u ? cnt : 1u;
}

__device__ __forceinline__ void xcd_barrier(const XcdBarrier& b) {
    asm volatile("s_waitcnt vmcnt(0)" ::: "memory");
    __syncthreads();
    if (threadIdx.x == 0) {
        unsigned* bar = b.bar;
        __builtin_amdgcn_s_waitcnt(0);
        unsigned nloc = b.st[0], nx = b.st[1];
        if (nloc == 0u) { xcd_barrier_complete(bar, b.x, nloc, nx); b.st[0] = nloc; b.st[1] = nx; }
        const unsigned old = xb_add(&bar[XB_XSUB(b.x)], 1u);
        const unsigned gen = old / nloc;
        if (old + 1u == (gen + 1u) * nloc) {
            __builtin_amdgcn_fence(__ATOMIC_RELEASE, "agent");
            asm volatile("s_waitcnt vmcnt(0)" ::: "memory");
            const unsigned og = xb_add(&bar[XB_TOP], 1u);
            const unsigned tg = og / nx;
            if (og + 1u == (tg + 1u) * nx) xb_add(&bar[XB_TOPGEN], 1u);
            else XB_SPIN(xb_ld(&bar[XB_TOPGEN]) == tg, bar);
            __builtin_amdgcn_fence(__ATOMIC_ACQUIRE, "agent");
            xb_add(&bar[XB_XGEN(b.x)], 1u);
            asm volatile("s_waitcnt vmcnt(0)" ::: "memory");
        } else {
            XB_SPIN(xb_ld(&bar[XB_XGEN(b.x)]) == gen, bar);
            __builtin_amdgcn_fence(__ATOMIC_ACQUIRE, "agent");
            asm volatile("s_waitcnt vmcnt(0)" ::: "memory");
        }
    }
    __syncthreads();
}

constexpr int D = 2048, NB = 4, S = 4096, T = NB * S;
constexpr int HD = 128, FH = 12, FW = 1536, MH = 4, MW = 512, ML = 256;
constexpr int FOX_IN = 6668, FOX_NP = 6912;
constexpr int GLA_IN = 5136, GLA_NP = 5376;
constexpr int GH = 4, GDK = 192, GDV = 384, GKW = 768, GVW = 1536;
constexpr int NE = 32, DE = 1024, MAXROWS = 40960, MAXTILES = 160;
constexpr int FP_Q = 0, FP_K = 1536, FP_V = 3072, FP_OG = 4608, FP_QM = 6144, FP_F = 6656;
constexpr int GP_Q = 0, GP_K = 768, GP_V = 1536, GP_R = 3072, GP_QM = 4608, GP_A = 5120;
constexpr float RMS_EPS = 1e-6f;
constexpr int NWAVES = 8;

constexpr size_t MiB = 1u << 20;
constexpr size_t WS_CTL = 0, CTL_ZERO_BYTES = 1 * MiB;
constexpr size_t WS_ROUTE = 1 * MiB;
constexpr size_t WS_WFOX = 4 * MiB;
constexpr size_t WS_WGLA = WS_WFOX + 27 * MiB;
constexpr size_t WS_WOUT = WS_WGLA + 21 * MiB;
constexpr size_t WS_WMKV = WS_WOUT + 16 * MiB;
constexpr size_t WS_WGU = WS_WMKV + 4 * MiB;
constexpr size_t WS_WD = WS_WGU + 512 * MiB;
constexpr size_t WS_HN = WS_WD + 256 * MiB;
constexpr size_t WS_P = WS_HN + 65 * MiB;
constexpr size_t WS_CAT = WS_P + 216 * MiB;
constexpr size_t WS_XA = WS_CAT + 64 * MiB;
constexpr size_t WS_XB = WS_XA + 128 * MiB;
constexpr size_t WS_XG = WS_XB + 128 * MiB;
constexpr size_t WS_H = WS_XG + 160 * MiB;
constexpr size_t WS_YB = WS_H + 80 * MiB;
constexpr size_t WS_MEMN = WS_YB + 128 * MiB;
constexpr size_t WS_MKV = WS_MEMN + 4 * MiB;
constexpr size_t WS_MK = WS_MKV + 2 * MiB;
constexpr size_t WS_C = WS_MK + 2 * MiB;
constexpr size_t WS_FL = WS_C + 1 * MiB;
constexpr size_t WS_WR = WS_FL + 1 * MiB;
constexpr size_t WS_INV = WS_WR + 1 * MiB;
constexpr size_t WS_END = WS_INV + 1 * MiB;
constexpr size_t WS_GO = WS_XG, WS_LA = WS_H;
constexpr size_t RT_TOKE = 0;
constexpr size_t RT_TOKS = RT_TOKE + 2 * T * 4;
constexpr size_t RT_TOKW = RT_TOKS + 2 * T * 4;
constexpr size_t RT_ROWDEST = RT_TOKW + 2 * T * 4;
constexpr size_t RT_ROWW = RT_ROWDEST + 2 * MAXROWS * 4;
constexpr size_t RT_TILEE = RT_ROWW + MAXROWS * 4;
constexpr size_t RT_END = RT_TILEE + 2 * 256 * 4;
static_assert(RT_END <= 3 * MiB, "routing arrays");
constexpr int CW_BAR = 4096;
constexpr int CW_CNT = 8192;
constexpr int CW_Q0 = 8320, CW_Q1 = 8384;
static_assert((CW_Q1 + 64) * 4 <= (int)CTL_ZERO_BYTES, "ctl");

constexpr int RING_OFF = 0, RING_BYTES = 131072;
constexpr int TR_PITCH = 65, TR_WAVE_BYTES = 64 * TR_PITCH * 4;
constexpr int LDSCTL_OFF = 8 * TR_WAVE_BYTES, MISC_OFF = LDSCTL_OFF + 320;
constexpr int LDS_BYTES = LDSCTL_OFF + 4096;
static_assert(LDSCTL_OFF >= RING_BYTES && LDS_BYTES <= 163840, "LDS map");

namespace pg8 {
struct EpiP {
    static constexpr bool PERM = true, AFTER_DRAIN = false;
    bf16_t* P; int ldp; float* FL; int ftile;
    __device__ __forceinline__ void operator()(const f32x4 (&acc)[2][2][4][2], const Unit& u, int wr, int wc, int fr, int fq) const {
        const int row0 = u.pm * BM + wr * 64 + fr, col0 = u.pn * BM + wc * 32 + 8 * fq;
#pragma unroll
        for (int ai = 0; ai < 2; ++ai)
#pragma unroll
            for (int m = 0; m < 4; ++m) { bf16_t* rowp = P + (size_t)(row0 + ai * HALF + m * 16) * ldp + col0;
#pragma unroll
                for (int bj = 0; bj < 2; ++bj) { const f32x4 v0 = acc[ai][bj][m][0], v1 = acc[ai][bj][m][1];
                    u32x4 w; w.x = pk2(v0[0], v0[1]); w.y = pk2(v0[2], v0[3]); w.z = pk2(v1[0], v1[1]); w.w = pk2(v1[2], v1[3]);
                    *(u32x4*)(rowp + bj * HALF) = w; } }
        if (u.pn == ftile && wc == 0 && fq < 2) {
#pragma unroll
            for (int ai = 0; ai < 2; ++ai)
#pragma unroll
                for (int m = 0; m < 4; ++m) { float* fp = FL + (size_t)(row0 + ai * HALF + m * 16) * 16 + 8 * fq;
                    *(f32x4*)(fp) = acc[ai][0][m][0]; *(f32x4*)(fp + 4) = acc[ai][0][m][1]; }
        }
    }
};
struct EpiRes {
    static constexpr bool PERM = false, AFTER_DRAIN = false;
    const float* R; float* C; int ldc;
    __device__ __forceinline__ void operator()(const f32x4 (&acc)[2][2][4][2], const Unit& u, int wr, int wc, int fr, int fq) const {
        const int row0 = u.pm * BM + wr * 64 + fr, col0 = u.pn * BM + wc * 32 + 4 * fq;
#pragma unroll
        for (int ai = 0; ai < 2; ++ai)
#pragma unroll
            for (int m = 0; m < 4; ++m) { const size_t ro = (size_t)(row0 + ai * HALF + m * 16) * ldc + col0;
#pragma unroll
                for (int bj = 0; bj < 2; ++bj)
#pragma unroll
                    for (int n = 0; n < 2; ++n) { const f32x4 r = *(const f32x4*)(R + ro + bj * HALF + n * 16); *(f32x4*)(C + ro + bj * HALF + n * 16) = acc[ai][bj][m][n] + r; } }
    }
};
struct EpiGU {
    static constexpr bool PERM = true, AFTER_DRAIN = false;
    bf16_t* H;
    __device__ __forceinline__ void operator()(const f32x4 (&acc)[2][2][4][2], const Unit& u, int wr, int wc, int fr, int fq) const {
        const int row0 = u.pm * BM + wr * 64 + fr, col0 = (u.pn & 7) * HALF + wc * 32 + 8 * fq;
#pragma unroll
        for (int ai = 0; ai < 2; ++ai)
#pragma unroll
            for (int m = 0; m < 4; ++m) { bf16_t* rowp = H + (size_t)(row0 + ai * HALF + m * 16) * 1024 + col0;
                float h[8];
#pragma unroll
                for (int n = 0; n < 2; ++n)
#pragma unroll
                    for (int j = 0; j < 4; ++j) { const float g = acc[ai][0][m][n][j], uu = acc[ai][1][m][n][j]; h[4 * n + j] = g * uu / (1.0f + __expf(-g)); }
                u32x4 w; w.x = pk2(h[0], h[1]); w.y = pk2(h[2], h[3]); w.z = pk2(h[4], h[5]); w.w = pk2(h[6], h[7]);
                *(u32x4*)rowp = w; }
    }
};
struct EpiDown {
    static constexpr bool PERM = true, AFTER_DRAIN = false;
    const int* rowdest; const float* roww; bf16_t* YB;
    __device__ __forceinline__ void operator()(const f32x4 (&acc)[2][2][4][2], const Unit& u, int wr, int wc, int fr, int fq) const {
        const int row0 = u.pm * BM + wr * 64 + fr, col0 = (u.pn & 7) * BM + wc * 32 + 8 * fq;
#pragma unroll
        for (int ai = 0; ai < 2; ++ai)
#pragma unroll
            for (int m = 0; m < 4; ++m) { const int row = row0 + ai * HALF + m * 16; const int dest = rowdest[row];
                if (dest >= 0) { const float w8 = roww[row]; bf16_t* rowp = YB + (size_t)dest * D + col0;
#pragma unroll
                    for (int bj = 0; bj < 2; ++bj) { const f32x4 v0 = acc[ai][bj][m][0] * w8, v1 = acc[ai][bj][m][1] * w8;
                        u32x4 w; w.x = pk2(v0[0], v0[1]); w.y = pk2(v0[2], v0[3]); w.z = pk2(v1[0], v1[1]); w.w = pk2(v1[2], v1[3]);
                        *(u32x4*)(rowp + bj * HALF) = w; } } }
    }
};
struct MoeOrder {
    const int* tile_e; int nunits, G, c;
    __device__ __forceinline__ bool next(int i, Unit& u) const {
        const long L = (long)i * G + c; if (L >= nunits) return false;
        const int tile = (int)(L >> 3), pn = (int)(L & 7); u.pm = tile; u.pn = tile_e[tile] * 8 + pn; return true;
    }
    __device__ __forceinline__ void a_ready(const Unit&) const {}
    __device__ __forceinline__ void done(const Unit&) const {}
};
}

struct Ctx {
    LAS unsigned char* lds;
    int tid, lane, wave, gw, NGW, G;
    const float* in[24]; float* out; unsigned char* ws;
};
#define WSP(type, off) ((type*)(C.ws + (off)))

__device__ __forceinline__ void load_row(const float* xrow, int lane, f32x4 (&v)[8]) {
#pragma unroll
    for (int j = 0; j < 8; ++j) v[j] = ((const f32x4*)xrow)[lane + 64 * j];
}
__device__ __forceinline__ float row_inv_rms(const f32x4 (&v)[8]) {
    float s = 0.f;
#pragma unroll
    for (int j = 0; j < 8; ++j) s += (v[j].x * v[j].x + v[j].y * v[j].y) + (v[j].z * v[j].z + v[j].w * v[j].w);
    s = wave_sum(s);
    return 1.0f / sqrtf(s * (1.0f / D) + RMS_EPS);
}
__device__ __forceinline__ void norm_store_row(bf16* orow, f32x4 (&v)[8], float inv, const float* g, int lane) {
#pragma unroll
    for (int j = 0; j < 8; ++j) { const f32x4 gg = ((const f32x4*)g)[lane + 64 * j]; v[j] = v[j] * inv * gg;
        v2u o; o.x = pk2(v[j].x, v[j].y); o.y = pk2(v[j].z, v[j].w); ((v2u*)orow)[lane + 64 * j] = o; }
}

__device__ __forceinline__ void tr_item(const float* W, int ldn, int K, bf16* WT, int drow, int k0, int n0, LAS float* scr, int lane) {
    f32x4 v[16];
#pragma unroll
    for (int i = 0; i < 16; ++i) v[i] = *(const f32x4*)(W + (size_t)(k0 + 4 * i + (lane >> 4)) * ldn + n0 + 4 * (lane & 15));
#pragma unroll
    for (int i = 0; i < 16; ++i) { LAS float* p = scr + (4 * i + (lane >> 4)) * TR_PITCH + 4 * (lane & 15); p[0] = v[i].x; p[1] = v[i].y; p[2] = v[i].z; p[3] = v[i].w; }
    LDS_WAIT(); asm volatile("" ::: "memory");
    const int c = lane >> 3;
#pragma unroll
    for (int j = 0; j < 8; ++j) { const int n = (lane & 7) + 8 * j; const LAS float* s = scr + (8 * c) * TR_PITCH + n;
        v4u o; o.x = pk2(s[0 * TR_PITCH], s[1 * TR_PITCH]); o.y = pk2(s[2 * TR_PITCH], s[3 * TR_PITCH]); o.z = pk2(s[4 * TR_PITCH], s[5 * TR_PITCH]); o.w = pk2(s[6 * TR_PITCH], s[7 * TR_PITCH]);
        *(v4u*)(WT + (size_t)(drow + n) * K + k0 + 8 * c) = o; }
    LDS_WAIT(); asm volatile("" ::: "memory");
}
__device__ __forceinline__ bool tr_group(int& r, const float* W, int ldn, int K, int c0, int nblk, bf16* WT, int drow0, LAS float* scr, int lane) {
    const int cnt = (K / 64) * nblk;
    if (r < cnt) { const int kb = r / nblk, nb = r % nblk; tr_item(W + c0, ldn, K, WT, drow0 + 64 * nb, 64 * kb, 64 * nb, scr, lane); return true; }
    r -= cnt; return false;
}
__device__ __forceinline__ void p0_prologue(const Ctx& C) {
    LAS float* scr = (LAS float*)(C.lds + C.wave * TR_WAVE_BYTES);
    const int lane = C.lane;
    constexpr int MOE_ITEMS = 64 * 3 * 512;
    for (int it = C.gw; it < MOE_ITEMS; it += C.NGW) {
        const int le = it / 1536, rem = it % 1536, kind = rem >> 9, r = rem & 511;
        if (kind < 2) {
            const float* W = (kind == 0 ? C.in[21] : C.in[22]) + (size_t)le * 2048 * 1024;
            const int kb = r >> 4, nb = r & 15, n0 = 64 * nb;
            bf16* WT = WSP(bf16, WS_WGU) + (size_t)le * 2048 * 2048;
            tr_item(W, 1024, 2048, WT, 256 * (n0 >> 7) + (n0 & 127) + 128 * kind, 64 * kb, n0, scr, lane);
        } else {
            const float* W = C.in[23] + (size_t)le * 1024 * 2048;
            const int kb = r >> 5, nb = r & 31;
            bf16* WT = WSP(bf16, WS_WD) + (size_t)le * 2048 * 1024;
            tr_item(W, 2048, 1024, WT, 64 * nb, 64 * kb, 64 * nb, scr, lane);
        }
    }
    constexpr int I_FOX = 32 * (96 + 8 + 1), I_GLA = 32 * (72 + 8 + 1), I_WO = 32 * 32, I_MKV = 32 * 16;
    constexpr int OTHER = I_FOX + I_GLA + 2 * I_WO + I_MKV;
    for (int it = C.gw; it < OTHER; it += C.NGW) {
        int r = it;
        if (tr_group(r, C.in[5], FOX_IN, D, 0, 96, WSP(bf16, WS_WFOX), 0, scr, lane)) continue;
        if (tr_group(r, C.in[5], FOX_IN, D, 6156, 8, WSP(bf16, WS_WFOX), FP_QM, scr, lane)) continue;
        if (tr_group(r, C.in[5], FOX_IN, D, 6144, 1, WSP(bf16, WS_WFOX), FP_F, scr, lane)) continue;
        if (tr_group(r, C.in[9], GLA_IN, D, 0, 72, WSP(bf16, WS_WGLA), 0, scr, lane)) continue;
        if (tr_group(r, C.in[9], GLA_IN, D, 4624, 8, WSP(bf16, WS_WGLA), GP_QM, scr, lane)) continue;
        if (tr_group(r, C.in[9], GLA_IN, D, 4608, 1, WSP(bf16, WS_WGLA), GP_A, scr, lane)) continue;
        if (tr_group(r, C.in[15], D, D, 0, 32, WSP(bf16, WS_WOUT), 0, scr, lane)) continue;
        if (tr_group(r, C.in[15] + (size_t)D * D, D, D, 0, 32, WSP(bf16, WS_WOUT) + (size_t)D * D, 0, scr, lane)) continue;
        tr_group(r, C.in[3], 1024, D, 0, 16, WSP(bf16, WS_WMKV), 0, scr, lane);
    }
    for (int m = C.gw; m < T + NB * ML; m += C.NGW) {
        f32x4 v[8];
        if (m < T) { load_row(C.in[0] + (size_t)m * D, lane, v); const float inv = row_inv_rms(v); norm_store_row(WSP(bf16, WS_HN) + (size_t)m * D, v, inv, C.in[4], lane); }
        else { const int r = m - T; load_row(C.in[1] + (size_t)r * D, lane, v); const float inv = row_inv_rms(v); norm_store_row(WSP(bf16, WS_MEMN) + (size_t)r * D, v, inv, C.in[2], lane); }
    }
    for (int i = blockIdx.x * 512 + C.tid; i < 2 * 64 * D; i += C.G * 512) {
        const int k = i & (D - 1), rho = (i >> 11) & 63, layer = i >> 17;
        float v = 0.f;
        if (rho < 32) { const int hh = (rho >> 2) & 1, reg = 4 * (rho >> 3) + (rho & 3), e = (2 * hh + (reg >> 3)) * 8 + (reg & 7); v = C.in[19][((size_t)layer * D + k) * 32 + e]; }
        else if (rho < 40) v = C.in[17][((size_t)layer * D + k) * 4 + (rho & 3)];
        const unsigned hi = pk2(v, 0.f) & 0xffffu; const float lo = v - bflo(hi);
        bf16* wr = WSP(bf16, WS_WR) + (size_t)layer * 2 * 64 * D;
        wr[(size_t)rho * D + k] = (bf16)hi; wr[(size_t)(64 + rho) * D + k] = (bf16)(pk2(lo, 0.f) & 0xffffu);
    }
    { int* rd = (int*)(C.ws + WS_ROUTE + RT_ROWDEST);
      for (int i = blockIdx.x * 512 + C.tid; i < 2 * MAXROWS; i += C.G * 512) rd[i] = -1; }
}

__device__ __forceinline__ float log_sigmoid(float x) { return fminf(x, 0.f) - log1pf(expf(-fabsf(x))); }

__device__ __forceinline__ void headnorm_inplace(bf16* rowp, int col0, int nh, const float* g, int lane) {
    const float g0 = g[2 * lane], g1 = g[2 * lane + 1];
    for (int h = 0; h < nh; ++h) {
        unsigned* p = (unsigned*)(rowp + col0 + h * HD) + lane; const unsigned u = *p; const float a = bflo(u), b = bfhi(u);
        const float ss = wave_sum(a * a + b * b); const float inv = 1.0f / sqrtf(ss * (1.0f / HD) + RMS_EPS);
        *p = pk2(a * inv * g0, b * inv * g1);
    }
}
__device__ __forceinline__ void p3_fox_thin(const Ctx& C) {
    bf16* P = WSP(bf16, WS_P);
    for (int m = C.gw; m < T; m += C.NGW) {
        bf16* rowp = P + (size_t)m * FOX_NP;
        headnorm_inplace(rowp, FP_Q, FH, C.in[7], C.lane);
        headnorm_inplace(rowp, FP_K, FH, C.in[8], C.lane);
        headnorm_inplace(rowp, FP_QM, MH, C.in[13], C.lane);
    }
    for (int it = C.gw; it < NB * ML * MH; it += C.NGW) {
        const int row = it >> 2, mh = it & 3;
        const unsigned u = *((const unsigned*)(WSP(bf16, WS_MKV) + (size_t)row * 1024 + mh * HD) + C.lane); const float a = bflo(u), b = bfhi(u);
        const float ss = wave_sum(a * a + b * b); const float inv = 1.0f / sqrtf(ss * (1.0f / HD) + RMS_EPS);
#pragma unroll
        for (int l = 0; l < 2; ++l) { const float* g = C.in[14] + l * HD;
            *((unsigned*)(WSP(bf16, WS_MK) + (size_t)l * 1024 * 512 + (size_t)row * 512 + mh * HD) + C.lane) = pk2(a * inv * g[2 * C.lane], b * inv * g[2 * C.lane + 1]); }
    }
    LAS float* sm = (LAS float*)(C.lds + RING_OFF);
    for (int bh = blockIdx.x; bh < NB * FH; bh += C.G) {
        const int b = bh / FH, h = bh % FH; const float bf = C.in[6][h];
        const float* fl = WSP(float, WS_FL) + (size_t)(b * S) * 16 + h;
        float ls[8], tot = 0.f;
#pragma unroll
        for (int i = 0; i < 8; ++i) { ls[i] = log_sigmoid(fl[(size_t)(8 * C.tid + i) * 16] + bf); tot += ls[i]; ls[i] = tot; }
        float inc = tot;
#pragma unroll
        for (int o = 1; o < 64; o <<= 1) { const float t = __shfl_up(inc, o); if (C.lane >= o) inc += t; }
        __syncthreads();
        if (C.lane == 63) sm[C.wave] = inc;
        __syncthreads();
        float woff = 0.f;
        for (int w = 0; w < C.wave; ++w) woff += sm[w];
        const float excl = woff + inc - tot;
        float* cp = WSP(float, WS_C) + (size_t)bh * S + 8 * C.tid;
#pragma unroll
        for (int i = 0; i < 8; ++i) cp[i] = excl + ls[i];
    }
}

__device__ __forceinline__ void naive_attn_row(const bf16* qptr, const bf16* Kb, int kstride, const bf16* Vb, int vstride, int nk, const float* cptr, float ct,
                                               LAS float* qs, int lane, float& o0, float& o1) {
    { const unsigned qq = *((const unsigned*)qptr + lane); qs[2 * lane] = bflo(qq); qs[2 * lane + 1] = bfhi(qq); }
    LDS_WAIT(); asm volatile("" ::: "memory");
    float m = -1e30f, l = 0.f, a0 = 0.f, a1 = 0.f;
    for (int j0 = 0; j0 < nk; j0 += 64) {
        const int j = j0 + lane; const bool valid = j < nk; const int jc = valid ? j : nk - 1;
        const bf16* kr = Kb + (size_t)jc * kstride;
        float s = 0.f;
#pragma unroll 4
        for (int d8 = 0; d8 < 16; ++d8) {
            const v4u kk = *(const v4u*)(kr + 8 * d8);
            const f32x4 qa = *(const LAS f32x4*)(qs + 8 * d8), qb = *(const LAS f32x4*)(qs + 8 * d8 + 4);
            s += bflo(kk.x) * qa.x + bfhi(kk.x) * qa.y + bflo(kk.y) * qa.z + bfhi(kk.y) * qa.w + bflo(kk.z) * qb.x + bfhi(kk.z) * qb.y + bflo(kk.w) * qb.z + bfhi(kk.w) * qb.w;
        }
        s *= 0.08838834764831845f;
        if (cptr) s += ct - cptr[jc];
        if (!valid) s = -__builtin_inff();
        const float mn = fmaxf(m, wave_max(s)); const float alpha = expf(m - mn); const float p = valid ? expf(s - mn) : 0.f;
        l = l * alpha + wave_sum(p); a0 *= alpha; a1 *= alpha; m = mn;
        const int cnt = (nk - j0) < 64 ? (nk - j0) : 64;
        for (int jj = 0; jj < cnt; ++jj) { const float pj = __shfl(p, jj); const unsigned vv = *((const unsigned*)(Vb + (size_t)(j0 + jj) * vstride) + lane); a0 += pj * bflo(vv); a1 += pj * bfhi(vv); }
    }
    o0 = a0 / l; o1 = a1 / l;
    asm volatile("" ::: "memory");
}
__device__ __forceinline__ void naive_mem_attn(const Ctx& C, const bf16* P, int ldp, int qcol, int layer, int row, int mh, LAS float* qs) {
    const int b = row / S; float o0, o1;
    naive_attn_row(P + (size_t)row * ldp + qcol + mh * HD, WSP(bf16, WS_MK) + (size_t)layer * 1024 * 512 + (size_t)(b * ML) * 512 + mh * HD, 512,
                   WSP(bf16, WS_MKV) + (size_t)(b * ML) * 1024 + 512 + mh * HD, 1024, ML, nullptr, 0.f, qs, C.lane, o0, o1);
    *((unsigned*)(WSP(bf16, WS_CAT) + (size_t)row * D + FW + mh * HD) + C.lane) = pk2(o0, o1);
}
__device__ __forceinline__ void p4_fox_attn_naive(const Ctx& C) {
    LAS float* qs = (LAS float*)(C.lds + RING_OFF + C.wave * 16384);
    const bf16* P = WSP(bf16, WS_P);
    for (int it = C.gw; it < T * 16; it += C.NGW) {
        const int hh = it / T, row = it % T;
        if (hh < FH) {
            const int b = row / S, t = row % S; float o0, o1;
            const float* cp = WSP(float, WS_C) + (size_t)(b * FH + hh) * S;
            naive_attn_row(P + (size_t)row * FOX_NP + FP_Q + hh * HD, P + (size_t)(b * S) * FOX_NP + FP_K + hh * HD, FOX_NP, P + (size_t)(b * S) * FOX_NP + FP_V + hh * HD, FOX_NP,
                           t + 1, cp, cp[t], qs, C.lane, o0, o1);
            const unsigned og = *((const unsigned*)(P + (size_t)row * FOX_NP + FP_OG + hh * HD) + C.lane);
            const float g0 = 1.0f / (1.0f + expf(-bflo(og))), g1 = 1.0f / (1.0f + expf(-bfhi(og)));
            *((unsigned*)(WSP(bf16, WS_CAT) + (size_t)row * D + hh * HD) + C.lane) = pk2(o0 * g0, o1 * g1);
        } else naive_mem_attn(C, P, FOX_NP, FP_QM, 0, row, hh - FH, qs);
    }
}

__device__ __forceinline__ void p12_gla_thin(const Ctx& C) {
    bf16* P = WSP(bf16, WS_P);
    const float* w2 = C.in[10]; const float* ba = C.in[11];
    for (int m = C.gw; m < T; m += C.NGW) {
        headnorm_inplace(P + (size_t)m * GLA_NP, GP_QM, MH, C.in[13] + HD, C.lane);
        const float* fl = WSP(float, WS_FL) + (size_t)m * 16;
        float al[16];
#pragma unroll
        for (int r = 0; r < 16; ++r) al[r] = fl[r];
        float* la = WSP(float, WS_LA) + (size_t)m * GKW;
#pragma unroll 1
        for (int j = 0; j < 12; ++j) { const int c = C.lane + 64 * j; float s = ba[c];
#pragma unroll
            for (int r = 0; r < 16; ++r) s += al[r] * w2[r * GKW + c];
            la[c] = expf(log_sigmoid(s) * (1.0f / 16.0f)); }
    }
}
__device__ __forceinline__ void p13_gla_naive(const Ctx& C) {
    const bf16* P = WSP(bf16, WS_P); const float* LA = WSP(float, WS_LA); float* GO = WSP(float, WS_GO);
    const int lane = C.lane;
    for (int it = C.gw; it < NB * GH * 128; it += C.NGW) {
        const int bh = it >> 7, e0 = (it & 127) * 3, b = bh >> 2, h = bh & 3;
        float st[3][3];
#pragma unroll
        for (int i = 0; i < 3; ++i)
#pragma unroll
            for (int e = 0; e < 3; ++e) st[i][e] = 0.f;
        const float qsc = 0.07216878364870322f;
        for (int t0 = 0; t0 < S; t0 += 4) {
            float a[4][3], k[4][3], q[4][3], v[4][3];
#pragma unroll
            for (int u = 0; u < 4; ++u) { const size_t row = (size_t)(b * S + t0 + u);
#pragma unroll
                for (int i = 0; i < 3; ++i) { const int d = lane + 64 * i;
                    a[u][i] = LA[row * GKW + h * GDK + d]; k[u][i] = bf2f(P[row * GLA_NP + GP_K + h * GDK + d]); q[u][i] = bf2f(P[row * GLA_NP + GP_Q + h * GDK + d]) * qsc; }
#pragma unroll
                for (int e = 0; e < 3; ++e) v[u][e] = bf2f(P[row * GLA_NP + GP_V + h * GDV + e0 + e]); }
#pragma unroll
            for (int u = 0; u < 4; ++u) { float o[3] = {0.f, 0.f, 0.f};
#pragma unroll
                for (int i = 0; i < 3; ++i)
#pragma unroll
                    for (int e = 0; e < 3; ++e) { st[i][e] = a[u][i] * st[i][e] + k[u][i] * v[u][e]; o[e] += q[u][i] * st[i][e]; }
#pragma unroll
                for (int e = 0; e < 3; ++e) o[e] = wave_sum(o[e]);
                if (lane < 3) GO[(size_t)(b * S + t0 + u) * GVW + h * GDV + e0 + lane] = lane == 0 ? o[0] : (lane == 1 ? o[1] : o[2]); }
        }
    }
}
__device__ __forceinline__ void p14_gla_onorm(const Ctx& C) {
    const bf16* P = WSP(bf16, WS_P); const float* GO = WSP(float, WS_GO); const float* og = C.in[12];
    for (int m = C.gw; m < T; m += C.NGW) {
#pragma unroll 1
        for (int h = 0; h < GH; ++h) {
            f32x2 x[3]; float ss = 0.f;
#pragma unroll
            for (int i = 0; i < 3; ++i) { x[i] = *((const f32x2*)(GO + (size_t)m * GVW + h * GDV + 128 * i) + C.lane); ss += x[i].x * x[i].x + x[i].y * x[i].y; }
            ss = wave_sum(ss); const float inv = 1.0f / sqrtf(ss * (1.0f / GDV) + RMS_EPS);
#pragma unroll
            for (int i = 0; i < 3; ++i) { const int e = 128 * i + 2 * C.lane;
                const unsigned ru = *((const unsigned*)(P + (size_t)m * GLA_NP + GP_R + h * GDV + 128 * i) + C.lane); const float r0 = bflo(ru), r1 = bfhi(ru);
                const float y0 = x[i].x * inv * og[e] * (r0 / (1.0f + expf(-r0))), y1 = x[i].y * inv * og[e + 1] * (r1 / (1.0f + expf(-r1)));
                *((unsigned*)(WSP(bf16, WS_CAT) + (size_t)m * D + h * GDV + 128 * i) + C.lane) = pk2(y0, y1); }
        }
    }
}

__device__ __forceinline__ void p6_router(const Ctx& C, int layer, bool commit = true) {
    const float* X = WSP(float, WS_XB); const float* g = C.in[16] + layer * D;
    const float* wg = C.in[17] + (size_t)layer * D * 4; const float* we = C.in[19] + (size_t)layer * D * 32;
    const float* bg = C.in[18] + layer * 4; const float* be = C.in[20] + layer * 32;
    unsigned* cnt = (unsigned*)(C.ws + WS_CTL) + CW_CNT + layer * 32;
    int* toke = (int*)(C.ws + WS_ROUTE + RT_TOKE); int* toks = (int*)(C.ws + WS_ROUTE + RT_TOKS); float* tokw = (float*)(C.ws + WS_ROUTE + RT_TOKW);
    const int lane = C.lane;
    LAS float* hs = (LAS float*)(C.lds + RING_OFF + C.wave * 16384);
    for (int pr = C.gw; pr < T / 2; pr += C.NGW) {
        {
            f32x4 x0[8], x1[8];
            load_row(X + (size_t)(2 * pr) * D, lane, x0); load_row(X + (size_t)(2 * pr + 1) * D, lane, x1);
            const float i0 = row_inv_rms(x0), i1 = row_inv_rms(x1);
            norm_store_row(WSP(bf16, WS_HN) + (size_t)(2 * pr) * D, x0, i0, g, lane);
            norm_store_row(WSP(bf16, WS_HN) + (size_t)(2 * pr + 1) * D, x1, i1, g, lane);
#pragma unroll
            for (int j = 0; j < 8; ++j) { ((LAS f32x4*)hs)[lane + 64 * j] = x0[j]; ((LAS f32x4*)(hs + D))[lane + 64 * j] = x1[j]; }
        }
        LDS_WAIT(); asm volatile("" ::: "memory");
        float a0[36], a1[36];
#pragma unroll
        for (int n = 0; n < 36; ++n) { a0[n] = 0.f; a1[n] = 0.f; }
#pragma unroll 2
        for (int kk = 0; kk < 32; ++kk) {
            const int k = lane + 64 * kk; const float h0 = hs[k], h1 = hs[D + k];
            const f32x4 w4 = *(const f32x4*)(wg + (size_t)k * 4);
#pragma unroll
            for (int n = 0; n < 4; ++n) { a0[n] += h0 * w4[n]; a1[n] += h1 * w4[n]; }
#pragma unroll
            for (int q = 0; q < 8; ++q) { const f32x4 w = *(const f32x4*)(we + (size_t)k * 32 + 4 * q);
#pragma unroll
                for (int n = 0; n < 4; ++n) { a0[4 + 4 * q + n] += h0 * w[n]; a1[4 + 4 * q + n] += h1 * w[n]; } }
        }
        asm volatile("" ::: "memory");
#pragma unroll
        for (int n = 0; n < 36; ++n) { a0[n] = wave_sum(a0[n]); a1[n] = wave_sum(a1[n]); }
#pragma unroll
        for (int rr = 0; rr < 2; ++rr) {
            float lg[36];
#pragma unroll
            for (int n = 0; n < 36; ++n) lg[n] = rr == 0 ? a0[n] : a1[n];
            float gl[4]; int gi = 0; float gm;
#pragma unroll
            for (int n = 0; n < 4; ++n) gl[n] = lg[n] + bg[n];
            gm = gl[0];
#pragma unroll
            for (int n = 1; n < 4; ++n) if (gl[n] > gm) { gm = gl[n]; gi = n; }
            float gs = 0.f;
#pragma unroll
            for (int n = 0; n < 4; ++n) gs += expf(gl[n] - gm);
            const float gp = 1.0f / gs;
            float ev[8];
#pragma unroll
            for (int j = 0; j < 8; ++j) { const float v0 = lg[4 + j] + be[j], v1 = lg[12 + j] + be[8 + j], v2 = lg[20 + j] + be[16 + j], v3 = lg[28 + j] + be[24 + j];
                ev[j] = gi == 0 ? v0 : (gi == 1 ? v1 : (gi == 2 ? v2 : v3)); }
            int e1 = 0; float m1 = ev[0];
#pragma unroll
            for (int j = 1; j < 8; ++j) if (ev[j] > m1) { m1 = ev[j]; e1 = j; }
            int e2 = -1; float m2 = -__builtin_inff();
#pragma unroll
            for (int j = 0; j < 8; ++j) if (j != e1 && ev[j] > m2) { m2 = ev[j]; e2 = j; }
            const float z = expf(m2 - m1); const float w1 = gp / (1.0f + z), w2 = gp * z / (1.0f + z);
            if (lane == 0) {
                const int tok = 2 * pr + rr; const int id1 = gi * 8 + e1, id2 = gi * 8 + e2;
                if (commit) { const unsigned s1 = atomicAdd(cnt + id1, 1u), s2 = atomicAdd(cnt + id2, 1u); toks[2 * tok] = (int)s1; toks[2 * tok + 1] = (int)s2; }
                toke[2 * tok] = id1; tokw[2 * tok] = w1;
                toke[2 * tok + 1] = id2; tokw[2 * tok + 1] = w2;
            }
        }
    }
}
__device__ __forceinline__ void p6_router_mfma(const Ctx& C, int layer, bool commit = true) {
    const float* X = WSP(float, WS_XB); const float* g = C.in[16] + layer * D;
    const bf16* WR = WSP(bf16, WS_WR) + (size_t)layer * 2 * 64 * D;
    const float* bg = C.in[18] + layer * 4; const float* be = C.in[20] + layer * 32;
    unsigned* cnt = (unsigned*)(C.ws + WS_CTL) + CW_CNT + layer * 32;
    int* toke = (int*)(C.ws + WS_ROUTE + RT_TOKE); int* toks = (int*)(C.ws + WS_ROUTE + RT_TOKS); float* tokw = (float*)(C.ws + WS_ROUTE + RT_TOKW);
    float* INV = WSP(float, WS_INV);
    const int lane = C.lane, r = lane & 31, h = lane >> 5;
    for (int task = C.wave * C.G + blockIdx.x; task < T / 32; task += C.NGW) {
        const int row = 32 * task + r;
        const float* xp = X + (size_t)row * D + 8 * h; const float* gp = g + 8 * h;
        const bf16* w0 = WR + (size_t)r * D + 8 * h;
        f32x16 acc0, acc1;
#pragma unroll
        for (int i = 0; i < 16; ++i) { acc0[i] = 0.f; acc1[i] = 0.f; }
        float ss = 0.f;
#pragma unroll 4
        for (int s = 0; s < D / 16; ++s) {
            const f32x4 xa = *(const f32x4*)(xp + 16 * s), xb = *(const f32x4*)(xp + 16 * s + 4);
            const f32x4 ga = *(const f32x4*)(gp + 16 * s), gb = *(const f32x4*)(gp + 16 * s + 4);
            ss += (xa.x * xa.x + xa.y * xa.y) + (xa.z * xa.z + xa.w * xa.w) + (xb.x * xb.x + xb.y * xb.y) + (xb.z * xb.z + xb.w * xb.w);
            const f32x4 va = xa * ga, vb = xb * gb;
            v4u hi; hi.x = pk2(va.x, va.y); hi.y = pk2(va.z, va.w); hi.z = pk2(vb.x, vb.y); hi.w = pk2(vb.z, vb.w);
            v4u lo; lo.x = pk2(va.x - bflo(hi.x), va.y - bfhi(hi.x)); lo.y = pk2(va.z - bflo(hi.y), va.w - bfhi(hi.y));
            lo.z = pk2(vb.x - bflo(hi.z), vb.y - bfhi(hi.z)); lo.w = pk2(vb.z - bflo(hi.w), vb.w - bfhi(hi.w));
            const bf16x8 xh = __builtin_bit_cast(bf16x8, hi), xl = __builtin_bit_cast(bf16x8, lo);
            const bf16x8 a0h = *(const bf16x8*)(w0 + 16 * s), a1h = *(const bf16x8*)(w0 + (size_t)32 * D + 16 * s);
            const bf16x8 a0l = *(const bf16x8*)(w0 + (size_t)64 * D + 16 * s), a1l = *(const bf16x8*)(w0 + (size_t)96 * D + 16 * s);
            acc0 = __builtin_amdgcn_mfma_f32_32x32x16_bf16(a0h, xh, acc0, 0, 0, 0); acc1 = __builtin_amdgcn_mfma_f32_32x32x16_bf16(a1h, xh, acc1, 0, 0, 0);
            acc0 = __builtin_amdgcn_mfma_f32_32x32x16_bf16(a0l, xh, acc0, 0, 0, 0); acc1 = __builtin_amdgcn_mfma_f32_32x32x16_bf16(a1l, xh, acc1, 0, 0, 0);
            acc0 = __builtin_amdgcn_mfma_f32_32x32x16_bf16(a0h, xl, acc0, 0, 0, 0); acc1 = __builtin_amdgcn_mfma_f32_32x32x16_bf16(a1h, xl, acc1, 0, 0, 0);
        }
        ss += __shfl_xor(ss, 32);
        const float inv = 1.0f / sqrtf(ss * (1.0f / D) + RMS_EPS);
        if (h == 0) INV[row] = inv;
        float gl[4]; int gi = 0;
#pragma unroll
        for (int n = 0; n < 4; ++n) gl[n] = acc1[n] * inv + bg[n];
        float gm = gl[0];
#pragma unroll
        for (int n = 1; n < 4; ++n) if (gl[n] > gm) { gm = gl[n]; gi = n; }
        float gs = 0.f;
#pragma unroll
        for (int n = 0; n < 4; ++n) gs += expf(gl[n] - gm);
        const float gpr = 1.0f / gs;
        float ev[8];
#pragma unroll
        for (int j = 0; j < 8; ++j) ev[j] = ((gi & 1) ? acc0[8 + j] : acc0[j]) * inv + be[gi * 8 + j];
        int e1 = 0; float m1 = ev[0];
#pragma unroll
        for (int j = 1; j < 8; ++j) if (ev[j] > m1) { m1 = ev[j]; e1 = j; }
        int e2 = -1; float m2 = -__builtin_inff();
#pragma unroll
        for (int j = 0; j < 8; ++j) if (j != e1 && ev[j] > m2) { m2 = ev[j]; e2 = j; }
        const float z = expf(m2 - m1); const float w1 = gpr / (1.0f + z), w2 = gpr * z / (1.0f + z);
        if (h == (gi >> 1)) {
            const int tok = row; const int id1 = gi * 8 + e1, id2 = gi * 8 + e2;
            if (commit) { const unsigned s1 = atomicAdd(cnt + id1, 1u), s2 = atomicAdd(cnt + id2, 1u); toks[2 * tok] = (int)s1; toks[2 * tok + 1] = (int)s2; }
            toke[2 * tok] = id1; tokw[2 * tok] = w1;
            toke[2 * tok + 1] = id2; tokw[2 * tok + 1] = w2;
        }
    }
}
__device__ __forceinline__ void p7_dispatch(const Ctx& C, int layer) {
    const unsigned* cnt = (const unsigned*)(C.ws + WS_CTL) + CW_CNT + layer * 32;
    const int* toke = (const int*)(C.ws + WS_ROUTE + RT_TOKE); const int* toks = (const int*)(C.ws + WS_ROUTE + RT_TOKS); const float* tokw = (const float*)(C.ws + WS_ROUTE + RT_TOKW);
    int* rowdest = (int*)(C.ws + WS_ROUTE + RT_ROWDEST) + layer * MAXROWS; float* roww = (float*)(C.ws + WS_ROUTE + RT_ROWW);
    int* tilee = (int*)(C.ws + WS_ROUTE + RT_TILEE) + layer * 256;
    const int lane = C.lane;
    const int c = lane < NE ? (int)__hip_atomic_load(cnt + lane, __ATOMIC_RELAXED, __HIP_MEMORY_SCOPE_AGENT) : 0;
    const int padded = (c + 255) & ~255;
    int inc = padded;
#pragma unroll
    for (int o = 1; o < 64; o <<= 1) { const int t = __shfl_up(inc, o); if (lane >= o) inc += t; }
    const int pstart = inc - padded;
    if (blockIdx.x == 0 && C.wave == 0) {
        if (lane < NE) for (int tl = pstart >> 8; tl < (pstart + padded) >> 8; ++tl) tilee[tl] = lane;
        if (lane == 63) tilee[255] = inc >> 8;
    }
    const float* X = WSP(float, WS_XB); const float* INV = WSP(float, WS_INV); const float* g = C.in[16] + layer * D; bf16* XG = WSP(bf16, WS_XG);
    for (int a = C.gw; a < 2 * T; a += C.NGW) {
        const int e = toke[a], slot = toks[a]; const int dest = __shfl(pstart, e) + slot; const int tok = a >> 1;
        f32x4 v[8]; load_row(X + (size_t)tok * D, lane, v);
        norm_store_row(XG + (size_t)dest * D, v, INV[tok], g, lane);
        if (lane == 0) { rowdest[dest] = a; roww[dest] = tokw[a]; }
    }
}
__device__ __forceinline__ void p_combine(const Ctx& C, const float* xi, float* xo, const float* g) {
    const bf16* YB = WSP(bf16, WS_YB);
    for (int m = C.gw; m < T; m += C.NGW) {
        f32x4 v[8]; load_row(xi + (size_t)m * D, C.lane, v);
#pragma unroll
        for (int j = 0; j < 8; ++j) {
            const v2u y0 = ((const v2u*)(YB + (size_t)(2 * m) * D))[C.lane + 64 * j], y1 = ((const v2u*)(YB + (size_t)(2 * m + 1) * D))[C.lane + 64 * j];
            v[j].x += bflo(y0.x) + bflo(y1.x); v[j].y += bfhi(y0.x) + bfhi(y1.x); v[j].z += bflo(y0.y) + bflo(y1.y); v[j].w += bfhi(y0.y) + bfhi(y1.y);
            ((f32x4*)(xo + (size_t)m * D))[C.lane + 64 * j] = v[j];
        }
        if (g) { const float inv = row_inv_rms(v); norm_store_row(WSP(bf16, WS_HN) + (size_t)m * D, v, inv, g, C.lane); }
    }
}

constexpr int AT_K = 0, AT_V = 32768, AT_C = 65536, AT_U = 66560, AT_F = 66624;
constexpr float LOG2E = 1.4426950408889634f;
constexpr float AT_C2 = 0.08838834764831845f * 1.4426950408889634f;
__device__ __forceinline__ unsigned off_b(unsigned row, unsigned ch) { return 256u * row + 16u * (ch ^ (((row & 3u) << 2) | ((row >> 2) & 3u))); }

template <bool FOX>
__device__ __forceinline__ void attn_unit(LAS unsigned char* lds, const bf16* Qb, int ldq, const bf16* Kb, int ldk, const bf16* Vb, int ldv, const float* cb, float B2, int qrow0, int nkt,
                                          bf16* Ob, int ldo, const bf16* OGb, int ldog, int tid, int lane, int wave) {
    const int r = lane & 31, h = lane >> 5;
    const int qpos = qrow0 + 32 * wave + r;
    bf16x8 qf[8];
    { const bf16* qp = Qb + (size_t)(32 * wave + r) * ldq + 8 * h;
#pragma unroll
      for (int s = 0; s < 8; ++s) qf[s] = *(const bf16x8*)(qp + 16 * s); }
    const float cq2 = FOX ? cb[qpos] * LOG2E : 0.f;
    f32x16 o[4];
#pragma unroll
    for (int c = 0; c < 4; ++c)
#pragma unroll
        for (int i = 0; i < 16; ++i) o[c][i] = 0.f;
    float m = -1e30f, l = 0.f;
    const int srow = tid >> 4, sch = tid & 15;
    const unsigned so0 = off_b(srow, sch), so1 = off_b(srow + 32, sch);
    const bf16* kg = Kb + (size_t)srow * ldk + 8 * sch; const bf16* vg = Vb + (size_t)srow * ldv + 8 * sch;
    v4u kr0, kr1, vr0, vr1; float cr = 0.f;
#define AT_LOAD(kt) do { const size_t ko = (size_t)(64 * (kt)) * ldk, vo = (size_t)(64 * (kt)) * ldv; \
        kr0 = *(const v4u*)(kg + ko); kr1 = *(const v4u*)(kg + ko + (size_t)32 * ldk); vr0 = *(const v4u*)(vg + vo); vr1 = *(const v4u*)(vg + vo + (size_t)32 * ldv); \
        if (FOX && tid < 64) cr = cb[64 * (kt) + tid] * LOG2E; } while (0)
#define AT_STORE(b) do { *(LAS v4u*)(lds + AT_K + (b) * 16384 + so0) = kr0; *(LAS v4u*)(lds + AT_K + (b) * 16384 + so1) = kr1; \
        *(LAS v4u*)(lds + AT_V + (b) * 16384 + so0) = vr0; *(LAS v4u*)(lds + AT_V + (b) * 16384 + so1) = vr1; \
        if (FOX && tid < 64) *(LAS float*)(lds + AT_C + (b) * 256 + 4 * tid) = cr; } while (0)
    const int kfirst = FOX ? nkt - 1 : 0, kdir = FOX ? -1 : 1;
    AT_LOAD(kfirst); AT_STORE(0);
    if (nkt > 1) AT_LOAD(kfirst + kdir);
    __syncthreads();
    unsigned kb0 = 256u * r + 16u * ((unsigned)h ^ (((r & 3u) << 2) | ((r >> 2) & 3u)));
    const unsigned tq = (lane & 15) >> 2, tp = lane & 3, tblk = (lane >> 4) & 1;
    unsigned vb0 = 1024u * h + 256u * tq + 64u * tq + 16u * ((2u * tblk + (tp >> 1)) ^ ((unsigned)h & 3u)) + 8u * (tp & 1);
    unsigned vb1 = 2048u + 1024u * h + 256u * tq + 64u * tq + 16u * ((2u * tblk + (tp >> 1)) ^ ((2u + (unsigned)h) & 3u)) + 8u * (tp & 1);
    const int minq = qrow0 + 32 * wave;
    bool wdone = false;
    volatile LAS unsigned* flags = (volatile LAS unsigned*)(lds + AT_F);
#pragma unroll 1
    for (int it = 0; it < nkt; ++it) {
        asm volatile("" : "+v"(kb0), "+v"(vb0), "+v"(vb1));
        const int kt = kfirst + it * kdir;
        const int b = it & 1;
        const bool active = !FOX || (64 * kt <= minq + 31);
        if (FOX && active && !wdone) {
            const float ub = B2 + cq2 - *(const LAS float*)(lds + AT_C + b * 256 + 63 * 4);
            if (__all(ub - m < -160.f)) wdone = true;
        }
        if (active && !wdone) {
            f32x16 p0, p1;
#pragma unroll
            for (int i = 0; i < 16; ++i) { p0[i] = 0.f; p1[i] = 0.f; }
            const LAS unsigned char* kbuf = lds + AT_K + b * 16384;
#pragma unroll
            for (int s = 0; s < 8; ++s) {
                const bf16x8 a0 = *(const LAS bf16x8*)(kbuf + (kb0 ^ (32u * s))), a1 = *(const LAS bf16x8*)(kbuf + (kb0 ^ (32u * s)) + 8192);
                p0 = __builtin_amdgcn_mfma_f32_32x32x16_bf16(a0, qf[s], p0, 0, 0, 0);
                p1 = __builtin_amdgcn_mfma_f32_32x32x16_bf16(a1, qf[s], p1, 0, 0, 0);
            }
            if (FOX) {
                const LAS float* cbuf = (const LAS float*)(lds + AT_C + b * 256);
#pragma unroll
                for (int g = 0; g < 4; ++g) { const f32x4 c0 = *(const LAS f32x4*)(cbuf + 8 * g + 4 * h), c1 = *(const LAS f32x4*)(cbuf + 32 + 8 * g + 4 * h);
#pragma unroll
                    for (int j = 0; j < 4; ++j) { p0[4 * g + j] = fmaf(p0[4 * g + j], AT_C2, cq2 - c0[j]); p1[4 * g + j] = fmaf(p1[4 * g + j], AT_C2, cq2 - c1[j]); } }
                if (64 * kt + 63 > minq) {
                    const int dq = qpos - 64 * kt - 4 * h;
#pragma unroll
                    for (int i = 0; i < 16; ++i) { const int ci = (i & 3) + 8 * (i >> 2);
                        if (ci > dq) p0[i] = -__builtin_inff();
                        if (ci + 32 > dq) p1[i] = -__builtin_inff(); }
                }
            } else {
#pragma unroll
                for (int i = 0; i < 16; ++i) { p0[i] *= AT_C2; p1[i] *= AT_C2; }
            }
            float pmax = p0[0];
#pragma unroll
            for (int i = 1; i < 16; ++i) pmax = fmaxf(pmax, p0[i]);
#pragma unroll
            for (int i = 0; i < 16; ++i) pmax = fmaxf(pmax, p1[i]);
            pmax = fmaxf(pmax, __shfl_xor(pmax, 32));
            const float mn = fmaxf(m, pmax), alpha = __builtin_amdgcn_exp2f(m - mn);
            const bool resc = __any(mn > m);
            m = mn;
            float ps = 0.f;
#pragma unroll
            for (int i = 0; i < 16; ++i) { p0[i] = __builtin_amdgcn_exp2f(p0[i] - mn); p1[i] = __builtin_amdgcn_exp2f(p1[i] - mn); ps += p0[i] + p1[i]; }
            ps += __shfl_xor(ps, 32);
            l = l * alpha + ps;
            if (resc) {
#pragma unroll
                for (int c = 0; c < 4; ++c)
#pragma unroll
                    for (int i = 0; i < 16; ++i) o[c][i] *= alpha;
            }
            bf16x8 pf[4];
#pragma unroll
            for (int s = 0; s < 2; ++s) {
                v4u w0, w1;
                w0.x = pk2(p0[8 * s], p0[8 * s + 1]); w0.y = pk2(p0[8 * s + 2], p0[8 * s + 3]); w0.z = pk2(p0[8 * s + 4], p0[8 * s + 5]); w0.w = pk2(p0[8 * s + 6], p0[8 * s + 7]);
                w1.x = pk2(p1[8 * s], p1[8 * s + 1]); w1.y = pk2(p1[8 * s + 2], p1[8 * s + 3]); w1.z = pk2(p1[8 * s + 4], p1[8 * s + 5]); w1.w = pk2(p1[8 * s + 6], p1[8 * s + 7]);
                pf[s] = __builtin_bit_cast(bf16x8, w0); pf[2 + s] = __builtin_bit_cast(bf16x8, w1);
            }
            const LAS unsigned char* vbuf = lds + AT_V + b * 16384;
#pragma unroll
            for (int ks = 0; ks < 4; ++ks)
#pragma unroll
                for (int c = 0; c < 4; ++c) {
                    const s16x4 lo = __builtin_amdgcn_ds_read_tr16_b64_v4i16((LAS s16x4*)(vbuf + ((vb0 ^ (64u * c)) + 4096u * ks)));
                    const s16x4 hi = __builtin_amdgcn_ds_read_tr16_b64_v4i16((LAS s16x4*)(vbuf + ((vb1 ^ (64u * c)) + 4096u * ks)));
                    const bf16x8 vf = __builtin_shufflevector(lo, hi, 0, 1, 2, 3, 4, 5, 6, 7);
                    o[c] = __builtin_amdgcn_mfma_f32_32x32x16_bf16(vf, pf[ks], o[c], 0, 0, 0);
                }
        }
        if (FOX && lane == 0) flags[8 * b + wave] = wdone ? 1u : 0u;
        if (it + 1 < nkt) { AT_STORE(b ^ 1); if (it + 2 < nkt) AT_LOAD(kfirst + (it + 2) * kdir); }
        __syncthreads();
        if (FOX) { const v4u f0 = *(const LAS v4u*)(lds + AT_F + 32 * b), f1 = *(const LAS v4u*)(lds + AT_F + 32 * b + 16);
            if ((f0.x & f0.y & f0.z & f0.w & f1.x & f1.y & f1.z & f1.w) != 0u) break; }
    }
#undef AT_LOAD
#undef AT_STORE
    const float il = 1.0f / l;
    bf16* orow = Ob + (size_t)(32 * wave + r) * ldo + 4 * h;
    const bf16* grow = FOX ? OGb + (size_t)(32 * wave + r) * ldog + 4 * h : nullptr;
#pragma unroll
    for (int c = 0; c < 4; ++c)
#pragma unroll
        for (int g = 0; g < 4; ++g) {
            float y0 = o[c][4 * g] * il, y1 = o[c][4 * g + 1] * il, y2 = o[c][4 * g + 2] * il, y3 = o[c][4 * g + 3] * il;
            if (FOX) { const v2u gg = *(const v2u*)(grow + 32 * c + 8 * g);
                y0 *= 1.0f / (1.0f + __expf(-bflo(gg.x))); y1 *= 1.0f / (1.0f + __expf(-bfhi(gg.x))); y2 *= 1.0f / (1.0f + __expf(-bflo(gg.y))); y3 *= 1.0f / (1.0f + __expf(-bfhi(gg.y))); }
            v2u w; w.x = pk2(y0, y1); w.y = pk2(y2, y3);
            *(v2u*)(orow + 32 * c + 8 * g) = w;
        }
}
__device__ __forceinline__ void mem_attn_unit(const Ctx& C, int v, const bf16* P, int ldp, int qcol, int layer) {
    const int qblk = v >> 2, mh = v & 3, b = qblk >> 4;
    attn_unit<false>(C.lds + RING_OFF, P + (size_t)(qblk * 256) * ldp + qcol + mh * HD, ldp,
                     WSP(bf16, WS_MK) + (size_t)layer * 1024 * 512 + (size_t)(b * ML) * 512 + mh * HD, 512, WSP(bf16, WS_MKV) + (size_t)(b * ML) * 1024 + 512 + mh * HD, 1024,
                     nullptr, 0.f, 0, ML / 64, WSP(bf16, WS_CAT) + (size_t)(qblk * 256) * D + FW + mh * HD, D, nullptr, 0, C.tid, C.lane, C.wave);
}
__device__ __forceinline__ void p4_fox_attn(const Ctx& C) {
    const bf16* P = WSP(bf16, WS_P);
    unsigned* ctr = (unsigned*)(C.ws + WS_CTL) + CW_Q0;
    volatile LAS unsigned* uw = (volatile LAS unsigned*)(C.lds + RING_OFF + AT_U);
    const float gqm = wave_max(fmaxf(fabsf(C.in[7][2 * C.lane]), fabsf(C.in[7][2 * C.lane + 1]))), gkm = wave_max(fmaxf(fabsf(C.in[8][2 * C.lane]), fabsf(C.in[8][2 * C.lane + 1])));
    const float B2 = 11.313708499f * gqm * gkm * LOG2E * 1.02f + 1.0f;
    for (;;) {
        __syncthreads();
        if (C.tid == 0) *uw = atomicAdd(ctr, 1u);
        __syncthreads();
        const int u = (int)*uw;
        if (u >= 768 + 256) break;
#if !defined(AT_ONLY_MEM)
        if (u < 768) {
            const int qb = 15 - u / 48, bh = u % 48, b = bh / FH, hh = bh % FH;
            const size_t rb = (size_t)(b * S + 256 * qb);
            attn_unit<true>(C.lds + RING_OFF, P + rb * FOX_NP + FP_Q + hh * HD, FOX_NP, P + (size_t)(b * S) * FOX_NP + FP_K + hh * HD, FOX_NP, P + (size_t)(b * S) * FOX_NP + FP_V + hh * HD, FOX_NP,
                           WSP(float, WS_C) + (size_t)bh * S, B2, 256 * qb, 4 * qb + 4, WSP(bf16, WS_CAT) + rb * D + hh * HD, D, P + rb * FOX_NP + FP_OG + hh * HD, FOX_NP, C.tid, C.lane, C.wave);
        } else
#endif
#if !defined(AT_ONLY_FOX)
        mem_attn_unit(C, u - 768, P, FOX_NP, FP_QM, 0);
#else
        {}
#endif
    }
}

__device__ __forceinline__ void p13_mem_attn(const Ctx& C) {
    const bf16* P = WSP(bf16, WS_P);
    unsigned* ctr = (unsigned*)(C.ws + WS_CTL) + CW_Q1;
    volatile LAS unsigned* uw = (volatile LAS unsigned*)(C.lds + RING_OFF + AT_U);
    for (;;) {
        __syncthreads();
        if (C.tid == 0) *uw = atomicAdd(ctr, 1u);
        __syncthreads();
        const int u = (int)*uw;
        if (u >= 256) break;
        mem_attn_unit(C, u, P, GLA_NP, GP_QM, 1);
    }
}

constexpr int GT_STRIDE = 400;
constexpr int GT_QE = 0, GT_KE = 25600, GT_V = 51200;
constexpr int GSEG = 8, GCH = 8;
constexpr size_t WS_QE = WS_H, WS_KE = WS_H + 24 * MiB, WS_DL = WS_H + 48 * MiB, WS_DSEG = WS_H + 49 * MiB;
constexpr size_t WS_SLOC = WS_XG + 96 * MiB;

__device__ __forceinline__ void p12_gla_prep(const Ctx& C) {
    bf16* P = WSP(bf16, WS_P);
    for (int m = C.gw; m < T; m += C.NGW) headnorm_inplace(P + (size_t)m * GLA_NP, GP_QM, MH, C.in[13] + HD, C.lane);
    const float* w2 = C.in[10]; const float* ba = C.in[11];
    bf16* QE = WSP(bf16, WS_QE); bf16* KE = WSP(bf16, WS_KE); float* DL = WSP(float, WS_DL);
    const float qsc = 0.07216878364870322f;
    for (int cg = blockIdx.x; cg < T / 64; cg += C.G) {
        for (int c = C.tid; c < GKW; c += 512) {
            float w[16];
#pragma unroll
            for (int r = 0; r < 16; ++r) w[r] = w2[r * GKW + c];
            const float bb = ba[c]; float bc = 0.f;
#pragma unroll 2
            for (int t = 0; t < 64; ++t) {
                const size_t row = (size_t)cg * 64 + t;
                const float* fl = WSP(float, WS_FL) + row * 16;
                float s = bb;
#pragma unroll
                for (int r = 0; r < 16; ++r) s += fl[r] * w[r];
                bc += log_sigmoid(s) * (1.0f / 16.0f);
                const float e = expf(bc);
                const float q = bf2f(P[row * GLA_NP + GP_Q + c]), k = bf2f(P[row * GLA_NP + GP_K + c]);
                QE[row * GKW + c] = (bf16)(pk2(q * e * qsc, 0.f) & 0xffffu);
                KE[row * GKW + c] = (bf16)(pk2(k / e, 0.f) & 0xffffu);
            }
            DL[(size_t)cg * GKW + c] = expf(bc);
        }
    }
}

__device__ __forceinline__ bf16x8 pack8(const f32x16& x, int s) {
    v4u w; w.x = pk2(x[8 * s], x[8 * s + 1]); w.y = pk2(x[8 * s + 2], x[8 * s + 3]); w.z = pk2(x[8 * s + 4], x[8 * s + 5]); w.w = pk2(x[8 * s + 6], x[8 * s + 7]);
    return __builtin_bit_cast(bf16x8, w);
}
__device__ __forceinline__ s16x4 tr4(const LAS unsigned char* tile, int r0, int c0, int lane) {
    const int q = (lane & 15) >> 2, p = lane & 3, blk = (lane >> 4) & 1;
    return __builtin_amdgcn_ds_read_tr16_b64_v4i16((LAS s16x4*)(tile + (r0 + q) * GT_STRIDE + 2 * (c0 + 16 * blk + 4 * p)));
}
template <bool OUT>
__device__ __forceinline__ void gla_unit(const Ctx& C, int u) {
    const int seg = u & 7, eh = (u >> 3) & 1, bh = u >> 4, b = bh >> 2, hd = bh & 3;
    const int tid = C.tid, lane = C.lane, w = C.wave, r = lane & 31, h = lane >> 5;
    LAS unsigned char* lds = C.lds + RING_OFF;
    const bf16* QE = WSP(bf16, WS_QE); const bf16* KE = WSP(bf16, WS_KE); const bf16* P = WSP(bf16, WS_P);
    const float* DL = WSP(float, WS_DL); float* DSEG = WSP(float, WS_DSEG); float* SLOC = WSP(float, WS_SLOC); float* GO = WSP(float, WS_GO);
    f32x16 Sx[6];
#pragma unroll
    for (int dt = 0; dt < 6; ++dt)
#pragma unroll
        for (int i = 0; i < 16; ++i) Sx[dt][i] = 0.f;
    if (OUT && w < 6) {
        for (int sp = 0; sp < seg; ++sp) {
            const float* sl = SLOC + ((((size_t)(bh * GSEG + sp) * 2 + eh) * 6 + w) * 6) * 1024;
            const float* dsg = DSEG + (size_t)(bh * GSEG + sp) * GDK;
#pragma unroll
            for (int dt = 0; dt < 6; ++dt)
#pragma unroll
                for (int g = 0; g < 4; ++g) { const f32x4 dv = *(const f32x4*)(dsg + 32 * dt + 8 * g + 4 * h);
#pragma unroll
                    for (int j = 0; j < 4; ++j) Sx[dt][4 * g + j] = dv[j] * Sx[dt][4 * g + j] + sl[(dt * 16 + 4 * g + j) * 64 + lane]; }
        }
    }
    float dacc[3] = {1.f, 1.f, 1.f};
#pragma unroll 1
    for (int cc = 0; cc < GCH; ++cc) {
        const int cs = seg * GCH + cc; const size_t row0 = (size_t)b * S + (size_t)cs * 64; const int cg = b * 64 + cs;
        __syncthreads();
#pragma unroll
        for (int i = 0; i < 3; ++i) { const int n = tid + 512 * i, row = n / 24, ch = n % 24;
            if (OUT) *(LAS v4u*)(lds + GT_QE + row * GT_STRIDE + 16 * ch) = *(const v4u*)(QE + (row0 + row) * GKW + hd * GDK + 8 * ch);
            *(LAS v4u*)(lds + GT_KE + row * GT_STRIDE + 16 * ch) = *(const v4u*)(KE + (row0 + row) * GKW + hd * GDK + 8 * ch);
            *(LAS v4u*)(lds + GT_V + row * GT_STRIDE + 16 * ch) = *(const v4u*)(P + (row0 + row) * GLA_NP + GP_V + hd * GDV + eh * 192 + 8 * ch); }
        __syncthreads();
        if (w < 6) {
            int lane = C.lane; asm volatile("" : "+v"(lane));
            const int r = lane & 31, h = lane >> 5;
            const LAS unsigned char* tq = lds + GT_QE; const LAS unsigned char* tk = lds + GT_KE; const LAS unsigned char* tv = lds + GT_V;
            if (OUT) {
#pragma unroll
                for (int it = 0; it < 2; ++it) {
                    f32x16 ao;
#pragma unroll
                    for (int i = 0; i < 16; ++i) ao[i] = 0.f;
#pragma unroll
                    for (int dt = 0; dt < 6; ++dt)
#pragma unroll
                        for (int s = 0; s < 2; ++s) {
                            const bf16x8 a = pack8(Sx[dt], s);
                            const LAS unsigned char* qp = tq + (32 * it + r) * GT_STRIDE + 2 * (32 * dt + 16 * s + 4 * h);
                            const s16x4 lo = *(const LAS s16x4*)qp, hi = *(const LAS s16x4*)(qp + 16);
                            const bf16x8 bq = __builtin_shufflevector(lo, hi, 0, 1, 2, 3, 4, 5, 6, 7);
                            ao = __builtin_amdgcn_mfma_f32_32x32x16_bf16(a, bq, ao, 0, 0, 0);
                        }
                    __builtin_amdgcn_sched_barrier(0);
#pragma unroll
                    for (int jt = 0; jt <= it; ++jt) {
                        f32x16 at;
#pragma unroll
                        for (int i = 0; i < 16; ++i) at[i] = 0.f;
#pragma unroll
                        for (int s = 0; s < 12; ++s) {
                            const bf16x8 a = *(const LAS bf16x8*)(tk + (32 * jt + r) * GT_STRIDE + 16 * (2 * s + h));
                            const bf16x8 bq = *(const LAS bf16x8*)(tq + (32 * it + r) * GT_STRIDE + 16 * (2 * s + h));
                            at = __builtin_amdgcn_mfma_f32_32x32x16_bf16(a, bq, at, 0, 0, 0);
                        }
                        if (jt == it) {
#pragma unroll
                            for (int i = 0; i < 16; ++i) if (((i & 3) + 8 * (i >> 2) + 4 * h) > r) at[i] = 0.f;
                        }
#pragma unroll
                        for (int s = 0; s < 2; ++s) {
                            const bf16x8 bp = pack8(at, s);
                            const s16x4 lo = tr4(tv, 32 * jt + 16 * s + 4 * h, 32 * w, lane), hi = tr4(tv, 32 * jt + 16 * s + 8 + 4 * h, 32 * w, lane);
                            const bf16x8 av = __builtin_shufflevector(lo, hi, 0, 1, 2, 3, 4, 5, 6, 7);
                            ao = __builtin_amdgcn_mfma_f32_32x32x16_bf16(av, bp, ao, 0, 0, 0);
                        }
                    }
                    __builtin_amdgcn_sched_barrier(0);
                    float* op = GO + (row0 + 32 * it + r) * GVW + hd * GDV + eh * 192 + 32 * w + 4 * h;
#pragma unroll
                    for (int g = 0; g < 4; ++g) *(f32x4*)(op + 8 * g) = (f32x4){ao[4 * g], ao[4 * g + 1], ao[4 * g + 2], ao[4 * g + 3]};
                }
            }
            __builtin_amdgcn_sched_barrier(0);
            bf16x8 bv[4];
#pragma unroll
            for (int ks = 0; ks < 4; ++ks) { const s16x4 lo = tr4(tv, 16 * ks + 8 * h, 32 * w, lane), hi = tr4(tv, 16 * ks + 8 * h + 4, 32 * w, lane);
                bv[ks] = __builtin_shufflevector(lo, hi, 0, 1, 2, 3, 4, 5, 6, 7); }
            const float* dlp = DL + (size_t)cg * GKW + hd * GDK;
#pragma unroll
            for (int dt = 0; dt < 6; ++dt) {
#pragma unroll
                for (int ks = 0; ks < 4; ++ks) { const s16x4 lo = tr4(tk, 16 * ks + 8 * h, 32 * dt, lane), hi = tr4(tk, 16 * ks + 8 * h + 4, 32 * dt, lane);
                    const bf16x8 ak = __builtin_shufflevector(lo, hi, 0, 1, 2, 3, 4, 5, 6, 7);
                    Sx[dt] = __builtin_amdgcn_mfma_f32_32x32x16_bf16(ak, bv[ks], Sx[dt], 0, 0, 0); }
#pragma unroll
                for (int g = 0; g < 4; ++g) { const f32x4 dv = *(const f32x4*)(dlp + 32 * dt + 8 * g + 4 * h);
#pragma unroll
                    for (int j = 0; j < 4; ++j) Sx[dt][4 * g + j] *= dv[j]; }
            }
        } else if (!OUT && w == 6) {
            const float* dlp = DL + (size_t)cg * GKW + hd * GDK;
#pragma unroll
            for (int i = 0; i < 3; ++i) dacc[i] *= dlp[lane + 64 * i];
        }
    }
    if (!OUT) {
        if (w < 6) { float* sl = SLOC + ((((size_t)(bh * GSEG + seg) * 2 + eh) * 6 + w) * 6) * 1024;
#pragma unroll
            for (int dt = 0; dt < 6; ++dt)
#pragma unroll
                for (int i = 0; i < 16; ++i) sl[(dt * 16 + i) * 64 + lane] = Sx[dt][i]; }
        else if (w == 6 && eh == 0) {
#pragma unroll
            for (int i = 0; i < 3; ++i) DSEG[(size_t)(bh * GSEG + seg) * GDK + lane + 64 * i] = dacc[i]; }
    }
}
__device__ __forceinline__ void p13a_gla_local(const Ctx& C) { for (int u = blockIdx.x; u < 256; u += C.G) if ((u & 7) != 7) gla_unit<false>(C, u); }
__device__ __forceinline__ void p13b_gla_out(const Ctx& C) { for (int u = blockIdx.x; u < 256; u += C.G) gla_unit<true>(C, u); }

constexpr int NPHASE = 22;
struct Args { const float* in[24]; float* out; unsigned char* ws; int ph_lo, ph_hi; };
#define PG8_ALIGN true
#define PG8_SP2 true

template <class Epi, class Sched>
__device__ __forceinline__ void run_gemm(const Ctx& C, const bf16* A, const bf16* Bt, int K, const Sched& Sd, const Epi& E) {
    pg8::Gemm g{A, Bt, 0, 0, K};
    pg8::gemm_phase<Epi, Sched, PG8_ALIGN, PG8_SP2>(C.lds + RING_OFF, g, Sd, E);
}
__device__ __forceinline__ void dense_gemm_p(const Ctx& C, const bf16* A, const bf16* Bt, int M, int N, int K, bf16* P, int ldp, float* FL, int ftile) {
    pg8::StaticOrder Sd; Sd.init(M, N, C.G, (int)blockIdx.x); pg8::EpiP E{P, ldp, FL, ftile}; run_gemm(C, A, Bt, K, Sd, E);
}
__device__ __forceinline__ void ph_wout(const Ctx& C, int layer) {
    pg8::StaticOrder Sd; Sd.init(T, D, C.G, (int)blockIdx.x);
    pg8::EpiRes E{layer == 0 ? C.in[0] : WSP(float, WS_XA), WSP(float, WS_XB), D};
    run_gemm(C, WSP(bf16, WS_CAT), WSP(bf16, WS_WOUT) + (size_t)layer * D * D, D, Sd, E);
}
__device__ __forceinline__ void ph_gu(const Ctx& C, int layer) {
    const int* tilee = (const int*)(C.ws + WS_ROUTE + RT_TILEE) + layer * 256;
    pg8::MoeOrder Sd{tilee, tilee[255] * 8, C.G, (int)blockIdx.x}; pg8::EpiGU E{WSP(bf16, WS_H)};
    run_gemm(C, WSP(bf16, WS_XG), WSP(bf16, WS_WGU) + (size_t)layer * NE * 2048 * 2048, D, Sd, E);
}
__device__ __forceinline__ void ph_down(const Ctx& C, int layer) {
    const int* tilee = (const int*)(C.ws + WS_ROUTE + RT_TILEE) + layer * 256;
    pg8::MoeOrder Sd{tilee, tilee[255] * 8, C.G, (int)blockIdx.x};
    pg8::EpiDown E{(const int*)(C.ws + WS_ROUTE + RT_ROWDEST) + layer * MAXROWS, (const float*)(C.ws + WS_ROUTE + RT_ROWW), WSP(bf16, WS_YB)};
    run_gemm(C, WSP(bf16, WS_H), WSP(bf16, WS_WD) + (size_t)layer * NE * 2048 * 1024, DE, Sd, E);
}

__global__ void __launch_bounds__(NWAVES * 64, 2) fwd_kernel(Args args) {
    extern __shared__ __attribute__((aligned(16))) unsigned char lds[];
    Ctx C;
    C.lds = (LAS unsigned char*)lds;
    C.tid = threadIdx.x; C.lane = C.tid & 63; C.wave = __builtin_amdgcn_readfirstlane(C.tid >> 6);
    C.G = gridDim.x; C.gw = blockIdx.x * NWAVES + C.wave; C.NGW = C.G * NWAVES;
#pragma unroll
    for (int i = 0; i < 24; ++i) C.in[i] = args.in[i];
    C.out = args.out; C.ws = args.ws;
    volatile LAS unsigned* MISC = (volatile LAS unsigned*)(C.lds + MISC_OFF);
    for (int u = C.tid; u < (LDS_BYTES - LDSCTL_OFF) / 4; u += NWAVES * 64) ((LAS unsigned*)(C.lds + LDSCTL_OFF))[u] = 0u;
    __syncthreads();
    const int lo = args.ph_lo, hi = args.ph_hi;
    XcdBarrier bar; bar.bar = (unsigned*)(C.ws + WS_CTL) + CW_BAR; bar.x = 0; bar.st = nullptr;
    if (hi - lo > 1) bar = xcd_barrier_post((unsigned*)(C.ws + WS_CTL) + CW_BAR, MISC + 8);
#ifndef PHSEL
#define PHSEL 0xFFFFFFFFu
#endif
#define SITE(s) ((PHSEL >> (s)) & 1u)
#ifndef DUPMASK
#define DUPMASK 0u
#endif
#define DUP(s) ((DUPMASK >> (s)) & 1u)
#define IN(k) (lo <= (k) && (k) < hi)
#define SEAM(k) do { if (IN(k) && IN((k) + 1)) xcd_barrier(bar); } while (0)

    if (SITE(0) && IN(0)) p0_prologue(C);
    if (DUP(0) && IN(0)) { __syncthreads(); p0_prologue(C); }
    SEAM(0);
    if (SITE(1) && IN(1)) dense_gemm_p(C, WSP(bf16, WS_MEMN), WSP(bf16, WS_WMKV), NB * ML, 1024, D, WSP(bf16, WS_MKV), 1024, nullptr, -1);
    if (DUP(1) && IN(1)) { __syncthreads(); dense_gemm_p(C, WSP(bf16, WS_MEMN), WSP(bf16, WS_WMKV), NB * ML, 1024, D, WSP(bf16, WS_MKV), 1024, nullptr, -1); }
    SEAM(1);
    if (SITE(2) && IN(2)) dense_gemm_p(C, WSP(bf16, WS_HN), WSP(bf16, WS_WFOX), T, FOX_NP, D, WSP(bf16, WS_P), FOX_NP, WSP(float, WS_FL), FP_F / 256);
    if (DUP(2) && IN(2)) { __syncthreads(); dense_gemm_p(C, WSP(bf16, WS_HN), WSP(bf16, WS_WFOX), T, FOX_NP, D, WSP(bf16, WS_P), FOX_NP, WSP(float, WS_FL), FP_F / 256); }
    SEAM(2);
    if (SITE(3) && IN(3)) p3_fox_thin(C);
    if (DUP(3) && IN(3)) { __syncthreads(); p3_fox_thin(C); }
    SEAM(3);
    if (SITE(4) && IN(4)) p4_fox_attn(C);
    if (DUP(4) && IN(4)) { __syncthreads(); p4_fox_attn(C); }
    SEAM(4);
    if (SITE(5) && IN(5)) ph_wout(C, 0);
    if (DUP(5) && IN(5)) { __syncthreads(); ph_wout(C, 0); }
    SEAM(5);
    if (SITE(6) && IN(6)) p6_router_mfma(C, 0);
    if (DUP(6) && IN(6)) { __syncthreads(); p6_router_mfma(C, 0, false); }
    SEAM(6);
    if (SITE(7) && IN(7)) p7_dispatch(C, 0);
    if (DUP(7) && IN(7)) { __syncthreads(); p7_dispatch(C, 0); }
    SEAM(7);
    if (SITE(8) && IN(8)) ph_gu(C, 0);
    if (DUP(8) && IN(8)) { __syncthreads(); ph_gu(C, 0); }
    SEAM(8);
    if (SITE(9) && IN(9)) ph_down(C, 0);
    if (DUP(9) && IN(9)) { __syncthreads(); ph_down(C, 0); }
    SEAM(9);
    if (SITE(10) && IN(10)) p_combine(C, WSP(float, WS_XB), WSP(float, WS_XA), C.in[4] + D);
    if (DUP(10) && IN(10)) { __syncthreads(); p_combine(C, WSP(float, WS_XB), WSP(float, WS_XA), C.in[4] + D); }
    SEAM(10);
    if (SITE(11) && IN(11)) dense_gemm_p(C, WSP(bf16, WS_HN), WSP(bf16, WS_WGLA), T, GLA_NP, D, WSP(bf16, WS_P), GLA_NP, WSP(float, WS_FL), GP_A / 256);
    if (DUP(11) && IN(11)) { __syncthreads(); dense_gemm_p(C, WSP(bf16, WS_HN), WSP(bf16, WS_WGLA), T, GLA_NP, D, WSP(bf16, WS_P), GLA_NP, WSP(float, WS_FL), GP_A / 256); }
    SEAM(11);
    if (SITE(12) && IN(12)) p12_gla_prep(C);
    if (DUP(12) && IN(12)) { __syncthreads(); p12_gla_prep(C); }
    SEAM(12);
    if (SITE(13) && IN(13)) p13a_gla_local(C);
    if (DUP(13) && IN(13)) { __syncthreads(); p13a_gla_local(C); }
    SEAM(13);
#if defined(NO_MEM14)
    if (SITE(14) && IN(14)) { p13b_gla_out(C); }
#elif defined(NO_GLA14)
    if (SITE(14) && IN(14)) { p13_mem_attn(C); }
#else
    if (SITE(14) && IN(14)) { p13b_gla_out(C); p13_mem_attn(C); }
#endif
    SEAM(14);
    if (SITE(15) && IN(15)) p14_gla_onorm(C);
    if (DUP(15) && IN(15)) { __syncthreads(); p14_gla_onorm(C); }
    SEAM(15);
    if (SITE(16) && IN(16)) ph_wout(C, 1);
    if (DUP(16) && IN(16)) { __syncthreads(); ph_wout(C, 1); }
    SEAM(16);
    if (SITE(17) && IN(17)) p6_router_mfma(C, 1);
    if (DUP(17) && IN(17)) { __syncthreads(); p6_router_mfma(C, 1, false); }
    SEAM(17);
    if (SITE(18) && IN(18)) p7_dispatch(C, 1);
    if (DUP(18) && IN(18)) { __syncthreads(); p7_dispatch(C, 1); }
    SEAM(18);
    if (SITE(19) && IN(19)) ph_gu(C, 1);
    if (DUP(19) && IN(19)) { __syncthreads(); ph_gu(C, 1); }
    SEAM(19);
    if (SITE(20) && IN(20)) ph_down(C, 1);
    if (DUP(20) && IN(20)) { __syncthreads(); ph_down(C, 1); }
    SEAM(20);
    if (SITE(21) && IN(21)) p_combine(C, WSP(float, WS_XB), C.out, nullptr);
    if (DUP(21) && IN(21)) { __syncthreads(); p_combine(C, WSP(float, WS_XB), C.out, nullptr); }
#undef IN
#undef SEAM
}

extern "C" void kernel_launch(void* const* d_in, const int* in_sizes, int n_in, void* d_out, int out_size, void* d_ws, size_t ws_size, hipStream_t stream) {
    static int grid = 0;
    if (grid == 0) {
        if (n_in != 24 || out_size != T * D || ws_size < WS_END) { fprintf(stderr, "kernel_launch: unexpected problem (n_in %d, out %d, ws %zu < %zu)\n", n_in, out_size, ws_size, (size_t)WS_END); grid = -1; return; }
        int dev = 0, cus = 0, per_cu = 0;
        if (hipGetDevice(&dev) != hipSuccess || hipDeviceGetAttribute(&cus, hipDeviceAttributeMultiprocessorCount, dev) != hipSuccess) { grid = -1; return; }
        if (hipFuncSetAttribute((const void*)fwd_kernel, hipFuncAttributeMaxDynamicSharedMemorySize, LDS_BYTES) != hipSuccess) { fprintf(stderr, "kernel_launch: hipFuncSetAttribute failed\n"); grid = -1; return; }
        if (hipOccupancyMaxActiveBlocksPerMultiprocessor(&per_cu, (const void*)fwd_kernel, NWAVES * 64, LDS_BYTES) != hipSuccess || per_cu < 1)
            fprintf(stderr, "kernel_launch: occupancy query reports %d workgroups per CU\n", per_cu);
        (void)hipGetLastError();
        grid = cus;
    }
    if (grid < 0) return;
    if (hipMemsetAsync((char*)d_ws + WS_CTL, 0, CTL_ZERO_BYTES, stream) != hipSuccess) return;
    Args a{};
    for (int i = 0; i < 24; ++i) a.in[i] = (const float*)d_in[i];
    a.out = (float*)d_out; a.ws = (unsigned char*)d_ws;
#if MK_N_LAUNCHES == 1
    a.ph_lo = 0; a.ph_hi = NPHASE;
    hipLaunchKernelGGL(fwd_kernel, dim3(grid), dim3(NWAVES * 64), LDS_BYTES, stream, a);
#else
    for (int p = 0; p < NPHASE; ++p) { a.ph_lo = p; a.ph_hi = p + 1; hipLaunchKernelGGL(fwd_kernel, dim3(grid), dim3(NWAVES * 64), LDS_BYTES, stream, a); }
#endif
}
```

```cpp
#include <hip/hip_runtime.h>
#include <cstdio>
#include <cstdint>
#ifndef MK_N_LAUNCHES
#define MK_N_LAUNCHES 1
#endif
namespace pg8 {
#define PG8_LAS __attribute__((address_space(3)))
typedef unsigned short bf16_t;
typedef short bf16x8 __attribute__((ext_vector_type(8)));
typedef float f32x4 __attribute__((ext_vector_type(4)));
typedef unsigned u32x4 __attribute__((ext_vector_type(4)));
constexpr int BM = 256, BK = 64, HALF = 128, HTB = HALF * BK * 2  , STAGE_BYTES = 8 * HTB, NXCD = 8, WGM = 8;

__host__ __device__ __forceinline__ int lds_byte(int r, int c) { const int st = (r >> 4) * 2 + (c >> 5), rr = r & 15, cc = c & 31, ob = rr * 64 + cc * 2; return st * 1024 + (ob ^ (((ob >> 9) & 1) << 5)); }
__host__ __device__ __forceinline__ void stage_rc(int b, int& R, int& C) { const int st = b / 1024, sb = b % 1024, swz = sb ^ (((sb >> 9) & 1) << 5); R = (st >> 1) * 16 + swz / 64; C = (st & 1) * 32 + (swz % 64) / 2; }
__host__ __device__ __forceinline__ int perm32(int rho) { const int n = rho >> 4, i = rho & 15; return 8 * (i >> 2) + 4 * n + (i & 3); }

struct Unit { int pm, pn; };
struct Gemm { const bf16_t* A; const bf16_t* Bt; int M, N, K; };

struct StaticOrder {
    int nM, nN, nwg, G, c;
    __host__ __device__ void init(int M, int N, int G_, int c_) { nM = M / BM; nN = N / BM; nwg = nM * nN; G = G_; c = c_; }
    __host__ __device__ bool next(int i, Unit& u) const {
        const long L = (long)i * G + c; if (L >= nwg) return false;
        int wgid = (int)L; { const int q = nwg / NXCD, r = nwg % NXCD, xcd = wgid % NXCD, off = wgid / NXCD; wgid = (xcd < r ? xcd * (q + 1) : r * (q + 1) + (xcd - r) * q) + off; }
        const int nig = WGM * nN, gid = wgid / nig, fm = gid * WGM, gsz = (nM - fm) < WGM ? (nM - fm) : WGM;
        u.pm = fm + ((wgid % nig) % gsz); u.pn = (wgid % nig) / gsz; return true;
    }
    __device__ __forceinline__ void a_ready(const Unit&) const {}
    __device__ __forceinline__ void done(const Unit&) const {}
};
template <class Epi, class Sched, bool ALIGN_EPI = false, bool SP2 = false>
__device__ __forceinline__ void gemm_phase(PG8_LAS unsigned char* lds, const Gemm g, const Sched& S, const Epi& E) {
    const int tid = threadIdx.x, wid = __builtin_amdgcn_readfirstlane(tid >> 6), lane = tid & 63, wr = wid >> 2, wc = wid & 3, fr = lane & 15, fq = lane >> 4;
    const int K = g.K, nt = K / BK;
    unsigned voffA[2], voffB[2];
#pragma unroll
    for (int i = 0; i < 2; ++i) { int R, C; stage_rc(tid * 16 + i * 8192, R, C); const int Rb = Epi::PERM ? ((R & ~31) + perm32(R & 31)) : R;
        voffA[i] = (unsigned)(R * K + C) * 2u; voffB[i] = (unsigned)(Rb * K + C) * 2u; }
    const size_t kstep = (size_t)(BK * 2);
    const size_t hstep = (size_t)HALF * K * 2;
    const size_t tstep = 2 * hstep;
    const unsigned ldsw = (unsigned)wid * 1024u;
    const int aoff = lds_byte(wr * 64 + fr, fq * 8), boff = lds_byte(wc * 32 + fr, fq * 8);
#define PG8_SA(b, h) (((b) * 2 + (h)) * HTB)
#define PG8_SB(b, h) ((4 + (b) * 2 + (h)) * HTB)
#define PG8_STAGE(bufoff, gbase, voff) do { _Pragma("unroll") for (int _i = 0; _i < 2; ++_i) \
        __builtin_amdgcn_global_load_lds((const unsigned*)((const char*)(gbase) + (voff)[_i]), (PG8_LAS unsigned*)(lds + (bufoff) + ldsw + _i * 8192), 16, 0, 0); } while (0)
#define PG8_LDA(dst, b, h) do { _Pragma("unroll") for (int m = 0; m < 4; ++m) _Pragma("unroll") for (int k = 0; k < 2; ++k) dst[m][k] = *(const PG8_LAS bf16x8*)(lds + PG8_SA(b, h) + aoff + m * 2048 + k * 1024); } while (0)
#define PG8_LDB(dst, b, h) do { _Pragma("unroll") for (int n = 0; n < 2; ++n) _Pragma("unroll") for (int k = 0; k < 2; ++k) dst[n][k] = *(const PG8_LAS bf16x8*)(lds + PG8_SB(b, h) + boff + n * 2048 + k * 1024); } while (0)
#define PG8_MMA(ai, bj, At, Bt) do { __builtin_amdgcn_s_setprio(1); _Pragma("unroll") for (int m = 0; m < 4; ++m) _Pragma("unroll") for (int n = 0; n < 2; ++n) _Pragma("unroll") for (int k = 0; k < 2; ++k) \
        acc[ai][bj][m][n] = __builtin_amdgcn_mfma_f32_16x16x32_bf16(Bt[n][k], At[m][k], acc[ai][bj][m][n], 0, 0, 0); __builtin_amdgcn_s_setprio(0); } while (0)
#define PG8_WAIT_V(n) asm volatile("s_waitcnt vmcnt(" #n ")" ::: "memory")
#define PG8_WAIT_L(n) asm volatile("s_waitcnt lgkmcnt(" #n ")" ::: "memory")
#define PG8_BAR __builtin_amdgcn_s_barrier()
#define PG8_SCHED __builtin_amdgcn_sched_barrier(0)
    Unit cur, nxt; int ui = 0;
    if (!S.next(0, cur)) return;
    f32x4 acc[2][2][4][2];
#pragma unroll
    for (int a = 0; a < 2; ++a)
#pragma unroll
        for (int b = 0; b < 2; ++b)
#pragma unroll
            for (int m = 0; m < 4; ++m)
#pragma unroll
                for (int n = 0; n < 2; ++n) acc[a][b][m][n] = (f32x4){0.f, 0.f, 0.f, 0.f};
    bf16x8 At[4][2], B0[2][2], B1[2][2];
    const char* cA = (const char*)g.A + (size_t)cur.pm * tstep; const char* cB = (const char*)g.Bt + (size_t)cur.pn * tstep;
    S.a_ready(cur);
    if constexpr (SP2) {
        PG8_STAGE(PG8_SB(0, 0), cB, voffB); PG8_STAGE(PG8_SB(0, 1), cB + hstep, voffB); PG8_STAGE(PG8_SA(0, 0), cA, voffA); PG8_STAGE(PG8_SA(0, 1), cA + hstep, voffA);
        if (wr == 1) PG8_BAR;
        PG8_WAIT_V(2); PG8_BAR;
        PG8_STAGE(PG8_SB(1, 0), cB + kstep, voffB); PG8_STAGE(PG8_SA(1, 0), cA + kstep, voffA); PG8_STAGE(PG8_SB(1, 1), cB + hstep + kstep, voffB);
        PG8_WAIT_V(6); PG8_BAR;
    } else {
        PG8_STAGE(PG8_SB(0, 0), cB, voffB); PG8_STAGE(PG8_SA(0, 0), cA, voffA); PG8_STAGE(PG8_SB(0, 1), cB + hstep, voffB); PG8_STAGE(PG8_SA(0, 1), cA + hstep, voffA);
        if (wr == 1) PG8_BAR;
        PG8_WAIT_V(4); PG8_BAR;
        PG8_STAGE(PG8_SB(1, 0), cB + kstep, voffB); PG8_STAGE(PG8_SA(1, 0), cA + kstep, voffA); PG8_STAGE(PG8_SB(1, 1), cB + hstep + kstep, voffB);
        PG8_WAIT_V(6); PG8_BAR;
    }
    for (;;) {
        const bool has_next = S.next(ui + 1, nxt);
        const char* nA = has_next ? (const char*)g.A + (size_t)nxt.pm * tstep : cA; const char* nB = has_next ? (const char*)g.Bt + (size_t)nxt.pn * tstep : cB;
        for (int t = 0; t < nt; t += 2) {
            const bool last = (t == nt - 2);
            const char* a1 = cA + (size_t)(t + 1) * kstep;
            const char* a2 = last ? nA : cA + (size_t)(t + 2) * kstep; const char* b2 = last ? nB : cB + (size_t)(t + 2) * kstep;
            const char* a3 = a2 + kstep; const char* b3 = b2 + kstep;
            if (last && has_next) S.a_ready(nxt);
            if constexpr (SP2) {
            PG8_LDB(B0, 0, 0); PG8_LDB(B1, 0, 1); PG8_SCHED; PG8_LDA(At, 0, 0); PG8_STAGE(PG8_SA(1, 1), a1 + hstep, voffA);
            PG8_WAIT_V(8); PG8_WAIT_L(0); PG8_BAR; PG8_MMA(0, 0, At, B0); PG8_MMA(0, 1, At, B1); PG8_BAR; PG8_SCHED;
            PG8_LDA(At, 0, 1); PG8_STAGE(PG8_SB(0, 0), b2, voffB); PG8_STAGE(PG8_SB(0, 1), b2 + hstep, voffB); PG8_STAGE(PG8_SA(0, 0), a2, voffA);
            PG8_WAIT_V(8); PG8_WAIT_L(0); PG8_BAR; PG8_MMA(1, 0, At, B0); PG8_MMA(1, 1, At, B1); PG8_BAR; PG8_SCHED;
            PG8_LDB(B0, 1, 0); PG8_LDB(B1, 1, 1); PG8_SCHED; PG8_LDA(At, 1, 0); PG8_STAGE(PG8_SA(0, 1), a2 + hstep, voffA);
            PG8_WAIT_V(8); PG8_WAIT_L(0); PG8_BAR; PG8_MMA(0, 0, At, B0); PG8_MMA(0, 1, At, B1); PG8_BAR; PG8_SCHED;
            PG8_LDA(At, 1, 1); PG8_STAGE(PG8_SB(1, 0), b3, voffB); PG8_STAGE(PG8_SB(1, 1), b3 + hstep, voffB); PG8_STAGE(PG8_SA(1, 0), a3, voffA);
            PG8_WAIT_V(8); PG8_WAIT_L(0); PG8_BAR; PG8_MMA(1, 0, At, B0); PG8_MMA(1, 1, At, B1); PG8_BAR; PG8_SCHED;
            } else {
            PG8_LDB(B0, 0, 0); PG8_SCHED; PG8_LDA(At, 0, 0); PG8_STAGE(PG8_SA(1, 1), a1 + hstep, voffA);
            PG8_WAIT_L(8); PG8_BAR; PG8_WAIT_L(0); PG8_MMA(0, 0, At, B0); PG8_BAR; PG8_SCHED;
            PG8_LDB(B1, 0, 1); PG8_STAGE(PG8_SB(0, 0), b2, voffB);
            PG8_BAR; PG8_WAIT_L(0); PG8_MMA(0, 1, At, B1); PG8_BAR;
            PG8_LDA(At, 0, 1); PG8_STAGE(PG8_SA(0, 0), a2, voffA);
            PG8_BAR; PG8_WAIT_L(0); PG8_MMA(1, 0, At, B0); PG8_BAR; PG8_SCHED;
            PG8_STAGE(PG8_SB(0, 1), b2 + hstep, voffB);
            PG8_WAIT_V(6); PG8_BAR; PG8_MMA(1, 1, At, B1); PG8_BAR;
            PG8_LDB(B0, 1, 0); PG8_SCHED; PG8_LDA(At, 1, 0); PG8_STAGE(PG8_SA(0, 1), a2 + hstep, voffA);
            PG8_WAIT_L(8); PG8_BAR; PG8_WAIT_L(0); PG8_MMA(0, 0, At, B0); PG8_BAR; PG8_SCHED;
            PG8_LDB(B1, 1, 1); PG8_STAGE(PG8_SB(1, 0), b3, voffB);
            PG8_BAR; PG8_WAIT_L(0); PG8_MMA(0, 1, At, B1); PG8_BAR;
            PG8_LDA(At, 1, 1); PG8_STAGE(PG8_SA(1, 0), a3, voffA);
            PG8_BAR; PG8_WAIT_L(0); PG8_MMA(1, 0, At, B0); PG8_BAR; PG8_SCHED;
            PG8_STAGE(PG8_SB(1, 1), b3 + hstep, voffB);
            PG8_WAIT_V(6); PG8_BAR; PG8_MMA(1, 1, At, B1); PG8_BAR;
            }
        }
        if constexpr (ALIGN_EPI) { if (wr == 0) PG8_BAR; }
        if constexpr (!Epi::AFTER_DRAIN) { E(acc, cur, wr, wc, fr, fq); S.done(cur); }
        if (!has_next) break;
#pragma unroll
        for (int a = 0; a < 2; ++a)
#pragma unroll
            for (int b = 0; b < 2; ++b)
#pragma unroll
                for (int m = 0; m < 4; ++m)
#pragma unroll
                    for (int n = 0; n < 2; ++n) acc[a][b][m][n] = (f32x4){0.f, 0.f, 0.f, 0.f};
        cur = nxt; cA = nA; cB = nB; ++ui;
        if constexpr (ALIGN_EPI) { if (wr == 1) PG8_BAR; }
    }
    PG8_WAIT_V(0);
    if constexpr (!ALIGN_EPI) { if (wr == 0) PG8_BAR; }
    PG8_BAR;
    if constexpr (Epi::AFTER_DRAIN) { E.fused(acc, cur, wr, wc, fr, fq, lds, wid, lane); S.done(cur); }
#undef PG8_SA
#undef PG8_SB
#undef PG8_STAGE
#undef PG8_LDA
#undef PG8_LDB
#undef PG8_MMA
#undef PG8_WAIT_V
#undef PG8_WAIT_L
#undef PG8_BAR
#undef PG8_SCHED
}
}

#define GAS __attribute__((address_space(1)))
#define LAS __attribute__((address_space(3)))
typedef unsigned short bf16;
typedef unsigned v4u __attribute__((ext_vector_type(4)));
typedef unsigned v2u __attribute__((ext_vector_type(2)));
typedef float f32x4 __attribute__((ext_vector_type(4)));
typedef float f32x2 __attribute__((ext_vector_type(2)));
typedef short bf16x8 __attribute__((ext_vector_type(8)));
typedef float f32x16 __attribute__((ext_vector_type(16)));
typedef short s16x4 __attribute__((ext_vector_type(4)));
typedef __bf16 bf16x2_t __attribute__((ext_vector_type(2)));
#define LDS_WAIT() asm volatile("s_waitcnt lgkmcnt(0)" ::: "memory")
#define VM_WAIT() asm volatile("s_waitcnt vmcnt(0)" ::: "memory")
__device__ __forceinline__ unsigned pk2(float lo, float hi) { f32x2 v = {lo, hi}; bf16x2_t r = __builtin_convertvector(v, bf16x2_t); return __builtin_bit_cast(unsigned, r); }
__device__ __forceinline__ float bflo(unsigned u) { return __builtin_bit_cast(float, u << 16); }
__device__ __forceinline__ float bfhi(unsigned u) { return __builtin_bit_cast(float, u & 0xffff0000u); }
__device__ __forceinline__ float bf2f(bf16 b) { return __builtin_bit_cast(float, ((unsigned)b) << 16); }
__device__ __forceinline__ float wave_sum(float v) {
#pragma unroll
    for (int o = 1; o < 64; o <<= 1) v += __shfl_xor(v, o);
    return v;
}
__device__ __forceinline__ float wave_max(float v) {
#pragma unroll
    for (int o = 1; o < 64; o <<= 1) v = fmaxf(v, __shfl_xor(v, o));
    return v;
}
#define XB_TMO      128
#define XB_XCNT(j)  (256  + 64 * (j))
#define XB_XSUB(j)  (1280 + 64 * (j))
#define XB_XGEN(j)  (2304 + 64 * (j))
#define XB_TOP      3328
#define XB_TOPGEN   3392
#define XCD_BAR_WORDS 3456
#define XB_SPIN_CAP (1u << 23)

__device__ __forceinline__ unsigned xb_ld(unsigned* p)              { return __hip_atomic_load(p, __ATOMIC_RELAXED, __HIP_MEMORY_SCOPE_AGENT); }
__device__ __forceinline__ unsigned xb_add(unsigned* p, unsigned v) { return __hip_atomic_fetch_add(p, v, __ATOMIC_RELAXED, __HIP_MEMORY_SCOPE_AGENT); }
__device__ __forceinline__ unsigned xb_xcc_id() { return (unsigned)__builtin_amdgcn_s_getreg((3 << 11) | 20) & 0xFu; }
#define XB_SPIN(cond, bar) do { unsigned _sp = 0; while (cond) { __builtin_amdgcn_s_sleep(1); \
    if ((++_sp & 255u) == 0u) { if (xb_ld(&(bar)[XB_TMO])) break; if (_sp > XB_SPIN_CAP) { atomicAdd(&(bar)[XB_TMO], 1u); break; } } } } while (0)

struct XcdBarrier {
    unsigned* bar; unsigned x;
    volatile LAS unsigned* st;
};

__device__ __forceinline__ XcdBarrier xcd_barrier_post(unsigned* bar, volatile LAS unsigned* st) {
    XcdBarrier b; b.bar = bar; b.x = xb_xcc_id(); b.st = st;
    if (threadIdx.x == 0) (void)xb_add(&bar[XB_XCNT(b.x)], 1u);
    return b;
}
__device__ __forceinline__ void xcd_barrier_complete(unsigned* bar, unsigned x, unsigned& nloc, unsigned& nx) {
    const unsigned G = gridDim.x * gridDim.y * gridDim.z;
    unsigned sum, cnt, mine, sp = 0u;
    for (;;) {
        sum = 0u; cnt = 0u; mine = 0u;
#pragma unroll
        for (unsigned j = 0; j < 16; ++j) { const unsigned c = xb_ld(&bar[XB_XCNT(j)]); sum += c; cnt += (c > 0u) ? 1u : 0u; mine = (j == x) ? c : mine; }
        if (sum == G) break;
        __builtin_amdgcn_s_sleep(1);
        if ((++sp & 255u) == 0u) { if (xb_ld(&bar[XB_TMO])) break; if (sp > XB_SPIN_CAP) { atomicAdd(&bar[XB_TMO], 1u); break; } }
    }
    nloc = mine > 0u ? mine : 1u; nx = cnt > 0u ? cnt : 1u;
}

__device__ __forceinline__ void xcd_barrier(const XcdBarrier& b) {
    asm volatile("s_waitcnt vmcnt(0)" ::: "memory");
    __syncthreads();
    if (threadIdx.x == 0) {
        unsigned* bar = b.bar;
        __builtin_amdgcn_s_waitcnt(0);
        unsigned nloc = b.st[0], nx = b.st[1];
        if (nloc == 0u) { xcd_barrier_complete(bar, b.x, nloc, nx); b.st[0] = nloc; b.st[1] = nx; }
        const unsigned old = xb_add(&bar[XB_XSUB(b.x)], 1u);
        const unsigned gen = old / nloc;
        if (old + 1u == (gen + 1u) * nloc) {
            __builtin_amdgcn_fence(__ATOMIC_RELEASE, "agent");
            asm volatile("s_waitcnt vmcnt(0)" ::: "memory");
            const unsigned og = xb_add(&bar[XB_TOP], 1u);
            const unsigned tg = og / nx;
            if (og + 1u == (tg + 1u) * nx) xb_add(&bar[XB_TOPGEN], 1u);
            else XB_SPIN(xb_ld(&bar[XB_TOPGEN]) == tg, bar);
            __builtin_amdgcn_fence(__ATOMIC_ACQUIRE, "agent");
            xb_add(&bar[XB_XGEN(b.x)], 1u);
            asm volatile("s_waitcnt vmcnt(0)" ::: "memory");
        } else {
            XB_SPIN(xb_ld(&bar[XB_XGEN(b.x)]) == gen, bar);
            __builtin_amdgcn_fence(__ATOMIC_ACQUIRE, "agent");
            asm volatile("s_waitcnt vmcnt(0)" ::: "memory");
        }
    }
    __syncthreads();
}

constexpr int D = 2048, NB = 4, S = 4096, T = NB * S;
constexpr int HD = 128, FH = 12, FW = 1536, MH = 4, MW = 512, ML = 256;
constexpr int FOX_IN = 6668, FOX_NP = 6912;
constexpr int GLA_IN = 5136, GLA_NP = 5376;
constexpr int GH = 4, GDK = 192, GDV = 384, GKW = 768, GVW = 1536;
constexpr int NE = 32, DE = 1024, MAXROWS = 40960, MAXTILES = 160;
constexpr int FP_Q = 0, FP_K = 1536, FP_V = 3072, FP_OG = 4608, FP_QM = 6144, FP_F = 6656;
constexpr int GP_Q = 0, GP_K = 768, GP_V = 1536, GP_R = 3072, GP_QM = 4608, GP_A = 5120;
constexpr float RMS_EPS = 1e-6f;
constexpr int NWAVES = 8;

constexpr size_t MiB = 1u << 20;
constexpr size_t WS_CTL = 0, CTL_ZERO_BYTES = 1 * MiB;
constexpr size_t WS_ROUTE = 1 * MiB;
constexpr size_t WS_WFOX = 4 * MiB;
constexpr size_t WS_WGLA = WS_WFOX + 27 * MiB;
constexpr size_t WS_WOUT = WS_WGLA + 21 * MiB;
constexpr size_t WS_WMKV = WS_WOUT + 16 * MiB;
constexpr size_t WS_WGU = WS_WMKV + 4 * MiB;
constexpr size_t WS_WD = WS_WGU + 512 * MiB;
constexpr size_t WS_HN = WS_WD + 256 * MiB;
constexpr size_t WS_P = WS_HN + 65 * MiB;
constexpr size_t WS_CAT = WS_P + 216 * MiB;
constexpr size_t WS_XA = WS_CAT + 64 * MiB;
constexpr size_t WS_XB = WS_XA + 128 * MiB;
constexpr size_t WS_XG = WS_XB + 128 * MiB;
constexpr size_t WS_H = WS_XG + 160 * MiB;
constexpr size_t WS_YB = WS_H + 80 * MiB;
constexpr size_t WS_MEMN = WS_YB + 128 * MiB;
constexpr size_t WS_MKV = WS_MEMN + 4 * MiB;
constexpr size_t WS_MK = WS_MKV + 2 * MiB;
constexpr size_t WS_C = WS_MK + 2 * MiB;
constexpr size_t WS_FL = WS_C + 1 * MiB;
constexpr size_t WS_WR = WS_FL + 1 * MiB;
constexpr size_t WS_INV = WS_WR + 1 * MiB;
constexpr size_t WS_END = WS_INV + 1 * MiB;
constexpr size_t WS_GO = WS_XG, WS_LA = WS_H;
constexpr size_t RT_TOKE = 0;
constexpr size_t RT_TOKS = RT_TOKE + 2 * T * 4;
constexpr size_t RT_TOKW = RT_TOKS + 2 * T * 4;
constexpr size_t RT_ROWDEST = RT_TOKW + 2 * T * 4;
constexpr size_t RT_ROWW = RT_ROWDEST + 2 * MAXROWS * 4;
constexpr size_t RT_TILEE = RT_ROWW + MAXROWS * 4;
constexpr size_t RT_END = RT_TILEE + 2 * 256 * 4;
static_assert(RT_END <= 3 * MiB, "routing arrays");
constexpr int CW_BAR = 4096;
constexpr int CW_CNT = 8192;
constexpr int CW_Q0 = 8320, CW_Q1 = 8384;
constexpr int CW_CVQ = 9216, CW_PD = 9280;
static_assert((CW_PD + 64 * 16) * 4 <= (int)CTL_ZERO_BYTES, "ctl");

constexpr int RING_OFF = 0, RING_BYTES = 131072;
constexpr int TR_PITCH = 65, TR_WAVE_BYTES = 64 * TR_PITCH * 4;
constexpr int LDSCTL_OFF = 8 * TR_WAVE_BYTES, MISC_OFF = LDSCTL_OFF + 320;
constexpr int LDS_BYTES = LDSCTL_OFF + 4096;
static_assert(LDSCTL_OFF >= RING_BYTES && LDS_BYTES <= 163840, "LDS map");

namespace pg8 {
struct EpiP {
    static constexpr bool PERM = true, AFTER_DRAIN = false;
    bf16_t* P; int ldp; float* FL; int ftile; bf16_t* P2; int ldp2, pm2, pn2;
    __device__ __forceinline__ void operator()(const f32x4 (&acc)[2][2][4][2], const Unit& u, int wr, int wc, int fr, int fq) const {
        const bool second = u.pm >= pm2;
        bf16_t* O = second ? P2 : P; const int ld = second ? ldp2 : ldp;
        const int row0 = (second ? u.pm - pm2 : u.pm) * BM + wr * 64 + fr, col0 = (second ? u.pn - pn2 : u.pn) * BM + wc * 32 + 8 * fq;
#pragma unroll
        for (int ai = 0; ai < 2; ++ai)
#pragma unroll
            for (int m = 0; m < 4; ++m) { bf16_t* rowp = O + (size_t)(row0 + ai * HALF + m * 16) * ld + col0;
#pragma unroll
                for (int bj = 0; bj < 2; ++bj) { const f32x4 v0 = acc[ai][bj][m][0], v1 = acc[ai][bj][m][1];
                    u32x4 w; w.x = pk2(v0[0], v0[1]); w.y = pk2(v0[2], v0[3]); w.z = pk2(v1[0], v1[1]); w.w = pk2(v1[2], v1[3]);
                    *(u32x4*)(rowp + bj * HALF) = w; } }
        if (!second && u.pn == ftile && wc == 0 && fq < 2) {
#pragma unroll
            for (int ai = 0; ai < 2; ++ai)
#pragma unroll
                for (int m = 0; m < 4; ++m) { float* fp = FL + (size_t)(row0 + ai * HALF + m * 16) * 16 + 8 * fq;
                    *(f32x4*)(fp) = acc[ai][0][m][0]; *(f32x4*)(fp + 4) = acc[ai][0][m][1]; }
        }
    }
};
struct TwoGemmOrder {
    StaticOrder S; int nx2, n2, pm2, pn2;
    __device__ __forceinline__ bool next(int i, Unit& u) const {
        if (S.next(i, u)) return true;
        const long L = (long)i * S.G + S.c - S.nwg; if (L < 0 || L >= n2) return false;
        u.pm = pm2 + (int)(L % nx2); u.pn = pn2 + (int)(L / nx2); return true;
    }
    __device__ __forceinline__ void a_ready(const Unit&) const {}
    __device__ __forceinline__ void done(const Unit&) const {}
};
template <bool RF32> struct EpiRes {
    static constexpr bool PERM = true, AFTER_DRAIN = false;
    const void* R; bf16_t* C; int ldc;
    __device__ __forceinline__ void operator()(const f32x4 (&acc)[2][2][4][2], const Unit& u, int wr, int wc, int fr, int fq) const {
        const int row0 = u.pm * BM + wr * 64 + fr, col0 = u.pn * BM + wc * 32 + 8 * fq;
#pragma unroll
        for (int ai = 0; ai < 2; ++ai)
#pragma unroll
            for (int m = 0; m < 4; ++m) { const size_t ro = (size_t)(row0 + ai * HALF + m * 16) * ldc + col0;
#pragma unroll
                for (int bj = 0; bj < 2; ++bj) { f32x4 r0, r1;
                    if (RF32) { r0 = *(const f32x4*)((const float*)R + ro + bj * HALF); r1 = *(const f32x4*)((const float*)R + ro + bj * HALF + 4); }
                    else { const u32x4 rb = *(const u32x4*)((const bf16_t*)R + ro + bj * HALF);
                        r0 = (f32x4){bflo(rb.x), bfhi(rb.x), bflo(rb.y), bfhi(rb.y)}; r1 = (f32x4){bflo(rb.z), bfhi(rb.z), bflo(rb.w), bfhi(rb.w)}; }
                    const f32x4 v0 = acc[ai][bj][m][0] + r0, v1 = acc[ai][bj][m][1] + r1;
                    u32x4 w; w.x = pk2(v0[0], v0[1]); w.y = pk2(v0[2], v0[3]); w.z = pk2(v1[0], v1[1]); w.w = pk2(v1[2], v1[3]);
                    *(u32x4*)(C + ro + bj * HALF) = w; } }
    }
};
struct EpiGU {
    static constexpr bool PERM = true, AFTER_DRAIN = false;
    bf16_t* H;
    __device__ __forceinline__ void operator()(const f32x4 (&acc)[2][2][4][2], const Unit& u, int wr, int wc, int fr, int fq) const {
        const int row0 = u.pm * BM + wr * 64 + fr, col0 = (u.pn & 7) * HALF + wc * 32 + 8 * fq;
#pragma unroll
        for (int ai = 0; ai < 2; ++ai)
#pragma unroll
            for (int m = 0; m < 4; ++m) { bf16_t* rowp = H + (size_t)(row0 + ai * HALF + m * 16) * 1024 + col0;
                float h[8];
#pragma unroll
                for (int n = 0; n < 2; ++n)
#pragma unroll
                    for (int j = 0; j < 4; ++j) { const float g = acc[ai][0][m][n][j], uu = acc[ai][1][m][n][j]; h[4 * n + j] = g * uu / (1.0f + __expf(-g)); }
                u32x4 w; w.x = pk2(h[0], h[1]); w.y = pk2(h[2], h[3]); w.z = pk2(h[4], h[5]); w.w = pk2(h[6], h[7]);
                *(u32x4*)rowp = w; }
    }
};
struct EpiDown {
    static constexpr bool PERM = true, AFTER_DRAIN = false;
    const int* rowdest; const float* roww; bf16_t* YB;
    __device__ __forceinline__ void operator()(const f32x4 (&acc)[2][2][4][2], const Unit& u, int wr, int wc, int fr, int fq) const {
        const int row0 = u.pm * BM + wr * 64 + fr, col0 = (u.pn & 7) * BM + wc * 32 + 8 * fq;
#pragma unroll
        for (int ai = 0; ai < 2; ++ai)
#pragma unroll
            for (int m = 0; m < 4; ++m) { const int row = row0 + ai * HALF + m * 16; const int dest = rowdest[row];
                if (dest >= 0) { const float w8 = roww[row]; bf16_t* rowp = YB + (size_t)dest * D + col0;
#pragma unroll
                    for (int bj = 0; bj < 2; ++bj) { const f32x4 v0 = acc[ai][bj][m][0] * w8, v1 = acc[ai][bj][m][1] * w8;
                        u32x4 w; w.x = pk2(v0[0], v0[1]); w.y = pk2(v0[2], v0[3]); w.z = pk2(v1[0], v1[1]); w.w = pk2(v1[2], v1[3]);
                        *(u32x4*)(rowp + bj * HALF) = w; } } }
    }
};
struct MoeOrder {
    const int* tile_e; int nunits, G, c;
    __device__ __forceinline__ bool next(int i, Unit& u) const {
        const long L = (long)i * G + c; if (L >= nunits) return false;
        const int tile = (int)(L >> 3), pn = (int)(L & 7); u.pm = tile; u.pn = tile_e[tile] * 8 + pn; return true;
    }
    __device__ __forceinline__ void a_ready(const Unit&) const {}
    __device__ __forceinline__ void done(const Unit&) const {}
};
}

struct Ctx {
    LAS unsigned char* lds;
    int tid, lane, wave, gw, NGW, G;
    const float* in[24]; float* out; unsigned char* ws;
};
#define WSP(type, off) ((type*)(C.ws + (off)))

__device__ __forceinline__ void load_row(const float* xrow, int lane, f32x4 (&v)[8]) {
#pragma unroll
    for (int j = 0; j < 8; ++j) v[j] = ((const f32x4*)xrow)[lane + 64 * j];
}
__device__ __forceinline__ void load_row_bf16(const bf16* xrow, int lane, f32x4 (&v)[8]) {
#pragma unroll
    for (int j = 0; j < 8; ++j) { const v2u u = ((const v2u*)xrow)[lane + 64 * j]; v[j] = (f32x4){bflo(u.x), bfhi(u.x), bflo(u.y), bfhi(u.y)}; }
}
__device__ __forceinline__ float row_inv_rms(const f32x4 (&v)[8]) {
    float s = 0.f;
#pragma unroll
    for (int j = 0; j < 8; ++j) s += (v[j].x * v[j].x + v[j].y * v[j].y) + (v[j].z * v[j].z + v[j].w * v[j].w);
    s = wave_sum(s);
    return 1.0f / sqrtf(s * (1.0f / D) + RMS_EPS);
}
__device__ __forceinline__ void norm_store_row(bf16* orow, f32x4 (&v)[8], float inv, const float* g, int lane) {
#pragma unroll
    for (int j = 0; j < 8; ++j) { const f32x4 gg = ((const f32x4*)g)[lane + 64 * j]; v[j] = v[j] * inv * gg;
        v2u o; o.x = pk2(v[j].x, v[j].y); o.y = pk2(v[j].z, v[j].w); ((v2u*)orow)[lane + 64 * j] = o; }
}

__device__ __forceinline__ void tr_item(const float* W, int ldn, int K, bf16* WT, int drow, int k0, int n0, LAS float* scr, int lane) {
    f32x4 v[16];
#pragma unroll
    for (int i = 0; i < 16; ++i) v[i] = *(const f32x4*)(W + (size_t)(k0 + 4 * i + (lane >> 4)) * ldn + n0 + 4 * (lane & 15));
#pragma unroll
    for (int i = 0; i < 16; ++i) { LAS float* p = scr + (4 * i + (lane >> 4)) * TR_PITCH + 4 * (lane & 15); p[0] = v[i].x; p[1] = v[i].y; p[2] = v[i].z; p[3] = v[i].w; }
    LDS_WAIT(); asm volatile("" ::: "memory");
    const int c = lane >> 3;
#pragma unroll
    for (int j = 0; j < 8; ++j) { const int n = (lane & 7) + 8 * j; const LAS float* s = scr + (8 * c) * TR_PITCH + n;
        v4u o; o.x = pk2(s[0 * TR_PITCH], s[1 * TR_PITCH]); o.y = pk2(s[2 * TR_PITCH], s[3 * TR_PITCH]); o.z = pk2(s[4 * TR_PITCH], s[5 * TR_PITCH]); o.w = pk2(s[6 * TR_PITCH], s[7 * TR_PITCH]);
        *(v4u*)(WT + (size_t)(drow + n) * K + k0 + 8 * c) = o; }
    LDS_WAIT(); asm volatile("" ::: "memory");
}
__device__ __forceinline__ bool tr_group(int& r, const float* W, int ldn, int K, int c0, int nblk, bf16* WT, int drow0, LAS float* scr, int lane) {
    const int cnt = (K / 64) * nblk;
    if (r < cnt) { const int kb = r / nblk, nb = r % nblk; tr_item(W + c0, ldn, K, WT, drow0 + 64 * nb, 64 * kb, 64 * nb, scr, lane); return true; }
    r -= cnt; return false;
}
__device__ __forceinline__ void moe_cv_item(const Ctx& C, int it, LAS float* scr, int lane) {
    const int le = it / 1536, rem = it % 1536, kind = rem >> 9, r = rem & 511;
    if (kind < 2) {
        const float* W = (kind == 0 ? C.in[21] : C.in[22]) + (size_t)le * 2048 * 1024;
        const int kb = r >> 4, nb = r & 15, n0 = 64 * nb;
        bf16* WT = WSP(bf16, WS_WGU) + (size_t)le * 2048 * 2048;
        tr_item(W, 1024, 2048, WT, 256 * (n0 >> 7) + (n0 & 127) + 128 * kind, 64 * kb, n0, scr, lane);
    } else {
        const float* W = C.in[23] + (size_t)le * 1024 * 2048;
        const int kb = r >> 5, nb = r & 31;
        bf16* WT = WSP(bf16, WS_WD) + (size_t)le * 2048 * 1024;
        tr_item(W, 2048, 1024, WT, 64 * nb, 64 * kb, 64 * nb, scr, lane);
    }
}
#ifndef CV_STEAL
#define CV_STEAL 0
#endif
constexpr int CVQ_FIRST = CV_STEAL ? 32 * 1536 : 64 * 1536, CVQ_TOTAL = 64 * 1536 - CVQ_FIRST;
__device__ __forceinline__ void cv_steal(const Ctx& C, int maxn, unsigned* pd) {
    unsigned* q = (unsigned*)(C.ws + WS_CTL) + CW_CVQ;
    LAS float* scr = (LAS float*)(C.lds + C.wave * TR_WAVE_BYTES);
    for (int n = 0; n < maxn; ++n) {
        unsigned idx = 0;
        if (C.lane == 0) { if (pd && __hip_atomic_load(pd, __ATOMIC_RELAXED, __HIP_MEMORY_SCOPE_AGENT) >= (unsigned)C.G) idx = 0xffffffffu; else idx = atomicAdd(q, 1u); }
        idx = (unsigned)__builtin_amdgcn_readfirstlane((int)idx);
        if (idx >= (unsigned)CVQ_TOTAL) break;
        moe_cv_item(C, CVQ_FIRST + (int)idx, scr, C.lane);
    }
}
__device__ __forceinline__ void cv_steal_tail(const Ctx& C, int k) {
    unsigned* pd = (unsigned*)(C.ws + WS_CTL) + CW_PD + 64 * k;
    if (C.tid == 0) atomicAdd(pd, 1u);
    cv_steal(C, 1 << 20, pd);
}
__device__ __forceinline__ void p0_prologue(const Ctx& C) {
    LAS float* scr = (LAS float*)(C.lds + C.wave * TR_WAVE_BYTES);
    const int lane = C.lane;
    for (int it = C.gw; it < CVQ_FIRST; it += C.NGW) moe_cv_item(C, it, scr, lane);
    constexpr int I_FOX = 32 * (96 + 8 + 1), I_GLA = 32 * (72 + 8 + 1), I_WO = 32 * 32, I_MKV = 32 * 16;
    constexpr int OTHER = I_FOX + I_GLA + 2 * I_WO + I_MKV;
    for (int it = C.gw; it < OTHER; it += C.NGW) {
        int r = it;
        if (tr_group(r, C.in[5], FOX_IN, D, 0, 96, WSP(bf16, WS_WFOX), 0, scr, lane)) continue;
        if (tr_group(r, C.in[5], FOX_IN, D, 6156, 8, WSP(bf16, WS_WFOX), FP_QM, scr, lane)) continue;
        if (tr_group(r, C.in[5], FOX_IN, D, 6144, 1, WSP(bf16, WS_WFOX), FP_F, scr, lane)) continue;
        if (tr_group(r, C.in[9], GLA_IN, D, 0, 72, WSP(bf16, WS_WGLA), 0, scr, lane)) continue;
        if (tr_group(r, C.in[9], GLA_IN, D, 4624, 8, WSP(bf16, WS_WGLA), GP_QM, scr, lane)) continue;
        if (tr_group(r, C.in[9], GLA_IN, D, 4608, 1, WSP(bf16, WS_WGLA), GP_A, scr, lane)) continue;
        if (tr_group(r, C.in[15], D, D, 0, 32, WSP(bf16, WS_WOUT), 0, scr, lane)) continue;
        if (tr_group(r, C.in[15] + (size_t)D * D, D, D, 0, 32, WSP(bf16, WS_WOUT) + (size_t)D * D, 0, scr, lane)) continue;
        tr_group(r, C.in[3], 1024, D, 0, 16, WSP(bf16, WS_WMKV), 0, scr, lane);
    }
    for (int m = C.gw; m < T + NB * ML; m += C.NGW) {
        f32x4 v[8];
        if (m < T) { load_row(C.in[0] + (size_t)m * D, lane, v); const float inv = row_inv_rms(v); norm_store_row(WSP(bf16, WS_HN) + (size_t)m * D, v, inv, C.in[4], lane); }
        else { const int r = m - T; load_row(C.in[1] + (size_t)r * D, lane, v); const float inv = row_inv_rms(v); norm_store_row(WSP(bf16, WS_MEMN) + (size_t)r * D, v, inv, C.in[2], lane); }
    }
    for (int i = blockIdx.x * 512 + C.tid; i < 2 * 64 * D; i += C.G * 512) {
        const int k = i & (D - 1), rho = (i >> 11) & 63, layer = i >> 17;
        float v = 0.f;
        if (rho < 32) { const int hh = (rho >> 2) & 1, reg = 4 * (rho >> 3) + (rho & 3), e = (2 * hh + (reg >> 3)) * 8 + (reg & 7); v = C.in[19][((size_t)layer * D + k) * 32 + e]; }
        else if (rho < 40) v = C.in[17][((size_t)layer * D + k) * 4 + (rho & 3)];
        const unsigned hi = pk2(v, 0.f) & 0xffffu; const float lo = v - bflo(hi);
        bf16* wr = WSP(bf16, WS_WR) + (size_t)layer * 2 * 64 * D;
        wr[(size_t)rho * D + k] = (bf16)hi; wr[(size_t)(64 + rho) * D + k] = (bf16)(pk2(lo, 0.f) & 0xffffu);
    }
    { int* rd = (int*)(C.ws + WS_ROUTE + RT_ROWDEST);
      for (int i = blockIdx.x * 512 + C.tid; i < 2 * MAXROWS; i += C.G * 512) rd[i] = -1; }
}

__device__ __forceinline__ float log_sigmoid(float x) { return fminf(x, 0.f) - log1pf(expf(-fabsf(x))); }

__device__ __forceinline__ void headnorm_inplace(bf16* rowp, int col0, int nh, const float* g, int lane) {
    const float g0 = g[2 * lane], g1 = g[2 * lane + 1];
    for (int h = 0; h < nh; ++h) {
        unsigned* p = (unsigned*)(rowp + col0 + h * HD) + lane; const unsigned u = *p; const float a = bflo(u), b = bfhi(u);
        const float ss = wave_sum(a * a + b * b); const float inv = 1.0f / sqrtf(ss * (1.0f / HD) + RMS_EPS);
        *p = pk2(a * inv * g0, b * inv * g1);
    }
}
__device__ __forceinline__ void p3_fox_thin(const Ctx& C) {
    bf16* P = WSP(bf16, WS_P);
    {
        const int lane = C.lane;
        const float gq0 = C.in[7][2 * lane], gq1 = C.in[7][2 * lane + 1], gk0 = C.in[8][2 * lane], gk1 = C.in[8][2 * lane + 1], gm0 = C.in[13][2 * lane], gm1 = C.in[13][2 * lane + 1];
        for (int m = C.gw; m < T; m += C.NGW) {
            unsigned* rowp = (unsigned*)(P + (size_t)m * FOX_NP) + lane;
            unsigned u[28]; float ss[28];
#pragma unroll
            for (int i = 0; i < 28; ++i) { const int col = i < 24 ? i * HD : FP_QM + (i - 24) * HD; u[i] = rowp[col / 2]; const float a = bflo(u[i]), b = bfhi(u[i]); ss[i] = a * a + b * b; }
#pragma unroll
            for (int o = 1; o < 64; o <<= 1)
#pragma unroll
                for (int i = 0; i < 28; ++i) ss[i] += __shfl_xor(ss[i], o);
#pragma unroll
            for (int i = 0; i < 28; ++i) { const int col = i < 24 ? i * HD : FP_QM + (i - 24) * HD; const float inv = 1.0f / sqrtf(ss[i] * (1.0f / HD) + RMS_EPS);
                const float g0 = i < 12 ? gq0 : (i < 24 ? gk0 : gm0), g1 = i < 12 ? gq1 : (i < 24 ? gk1 : gm1);
                rowp[col / 2] = pk2(bflo(u[i]) * inv * g0, bfhi(u[i]) * inv * g1); }
        }
    }
    for (int it = C.gw; it < NB * ML * MH; it += C.NGW) {
        const int row = it >> 2, mh = it & 3;
        const unsigned u = *((const unsigned*)(WSP(bf16, WS_MKV) + (size_t)row * 1024 + mh * HD) + C.lane); const float a = bflo(u), b = bfhi(u);
        const float ss = wave_sum(a * a + b * b); const float inv = 1.0f / sqrtf(ss * (1.0f / HD) + RMS_EPS);
#pragma unroll
        for (int l = 0; l < 2; ++l) { const float* g = C.in[14] + l * HD;
            *((unsigned*)(WSP(bf16, WS_MK) + (size_t)l * 1024 * 512 + (size_t)row * 512 + mh * HD) + C.lane) = pk2(a * inv * g[2 * C.lane], b * inv * g[2 * C.lane + 1]); }
    }
    LAS float* sm = (LAS float*)(C.lds + RING_OFF);
    for (int bh = blockIdx.x; bh < NB * FH; bh += C.G) {
        const int b = bh / FH, h = bh % FH; const float bf = C.in[6][h];
        const float* fl = WSP(float, WS_FL) + (size_t)(b * S) * 16 + h;
        float ls[8], tot = 0.f;
#pragma unroll
        for (int i = 0; i < 8; ++i) { ls[i] = log_sigmoid(fl[(size_t)(8 * C.tid + i) * 16] + bf); tot += ls[i]; ls[i] = tot; }
        float inc = tot;
#pragma unroll
        for (int o = 1; o < 64; o <<= 1) { const float t = __shfl_up(inc, o); if (C.lane >= o) inc += t; }
        __syncthreads();
        if (C.lane == 63) sm[C.wave] = inc;
        __syncthreads();
        float woff = 0.f;
        for (int w = 0; w < C.wave; ++w) woff += sm[w];
        const float excl = woff + inc - tot;
        float* cp = WSP(float, WS_C) + (size_t)bh * S + 8 * C.tid;
#pragma unroll
        for (int i = 0; i < 8; ++i) cp[i] = excl + ls[i];
    }
}

__device__ __forceinline__ void naive_attn_row(const bf16* qptr, const bf16* Kb, int kstride, const bf16* Vb, int vstride, int nk, const float* cptr, float ct,
                                               LAS float* qs, int lane, float& o0, float& o1) {
    { const unsigned qq = *((const unsigned*)qptr + lane); qs[2 * lane] = bflo(qq); qs[2 * lane + 1] = bfhi(qq); }
    LDS_WAIT(); asm volatile("" ::: "memory");
    float m = -1e30f, l = 0.f, a0 = 0.f, a1 = 0.f;
    for (int j0 = 0; j0 < nk; j0 += 64) {
        const int j = j0 + lane; const bool valid = j < nk; const int jc = valid ? j : nk - 1;
        const bf16* kr = Kb + (size_t)jc * kstride;
        float s = 0.f;
#pragma unroll 4
        for (int d8 = 0; d8 < 16; ++d8) {
            const v4u kk = *(const v4u*)(kr + 8 * d8);
            const f32x4 qa = *(const LAS f32x4*)(qs + 8 * d8), qb = *(const LAS f32x4*)(qs + 8 * d8 + 4);
            s += bflo(kk.x) * qa.x + bfhi(kk.x) * qa.y + bflo(kk.y) * qa.z + bfhi(kk.y) * qa.w + bflo(kk.z) * qb.x + bfhi(kk.z) * qb.y + bflo(kk.w) * qb.z + bfhi(kk.w) * qb.w;
        }
        s *= 0.08838834764831845f;
        if (cptr) s += ct - cptr[jc];
        if (!valid) s = -__builtin_inff();
        const float mn = fmaxf(m, wave_max(s)); const float alpha = expf(m - mn); const float p = valid ? expf(s - mn) : 0.f;
        l = l * alpha + wave_sum(p); a0 *= alpha; a1 *= alpha; m = mn;
        const int cnt = (nk - j0) < 64 ? (nk - j0) : 64;
        for (int jj = 0; jj < cnt; ++jj) { const float pj = __shfl(p, jj); const unsigned vv = *((const unsigned*)(Vb + (size_t)(j0 + jj) * vstride) + lane); a0 += pj * bflo(vv); a1 += pj * bfhi(vv); }
    }
    o0 = a0 / l; o1 = a1 / l;
    asm volatile("" ::: "memory");
}
__device__ __forceinline__ void naive_mem_attn(const Ctx& C, const bf16* P, int ldp, int qcol, int layer, int row, int mh, LAS float* qs) {
    const int b = row / S; float o0, o1;
    naive_attn_row(P + (size_t)row * ldp + qcol + mh * HD, WSP(bf16, WS_MK) + (size_t)layer * 1024 * 512 + (size_t)(b * ML) * 512 + mh * HD, 512,
                   WSP(bf16, WS_MKV) + (size_t)(b * ML) * 1024 + 512 + mh * HD, 1024, ML, nullptr, 0.f, qs, C.lane, o0, o1);
    *((unsigned*)(WSP(bf16, WS_CAT) + (size_t)row * D + FW + mh * HD) + C.lane) = pk2(o0, o1);
}
__device__ __forceinline__ void p4_fox_attn_naive(const Ctx& C) {
    LAS float* qs = (LAS float*)(C.lds + RING_OFF + C.wave * 16384);
    const bf16* P = WSP(bf16, WS_P);
    for (int it = C.gw; it < T * 16; it += C.NGW) {
        const int hh = it / T, row = it % T;
        if (hh < FH) {
            const int b = row / S, t = row % S; float o0, o1;
            const float* cp = WSP(float, WS_C) + (size_t)(b * FH + hh) * S;
            naive_attn_row(P + (size_t)row * FOX_NP + FP_Q + hh * HD, P + (size_t)(b * S) * FOX_NP + FP_K + hh * HD, FOX_NP, P + (size_t)(b * S) * FOX_NP + FP_V + hh * HD, FOX_NP,
                           t + 1, cp, cp[t], qs, C.lane, o0, o1);
            const unsigned og = *((const unsigned*)(P + (size_t)row * FOX_NP + FP_OG + hh * HD) + C.lane);
            const float g0 = 1.0f / (1.0f + expf(-bflo(og))), g1 = 1.0f / (1.0f + expf(-bfhi(og)));
            *((unsigned*)(WSP(bf16, WS_CAT) + (size_t)row * D + hh * HD) + C.lane) = pk2(o0 * g0, o1 * g1);
        } else naive_mem_attn(C, P, FOX_NP, FP_QM, 0, row, hh - FH, qs);
    }
}

__device__ __forceinline__ void p12_gla_thin(const Ctx& C) {
    bf16* P = WSP(bf16, WS_P);
    const float* w2 = C.in[10]; const float* ba = C.in[11];
    for (int m = C.gw; m < T; m += C.NGW) {
        headnorm_inplace(P + (size_t)m * GLA_NP, GP_QM, MH, C.in[13] + HD, C.lane);
        const float* fl = WSP(float, WS_FL) + (size_t)m * 16;
        float al[16];
#pragma unroll
        for (int r = 0; r < 16; ++r) al[r] = fl[r];
        float* la = WSP(float, WS_LA) + (size_t)m * GKW;
#pragma unroll 1
        for (int j = 0; j < 12; ++j) { const int c = C.lane + 64 * j; float s = ba[c];
#pragma unroll
            for (int r = 0; r < 16; ++r) s += al[r] * w2[r * GKW + c];
            la[c] = expf(log_sigmoid(s) * (1.0f / 16.0f)); }
    }
}
__device__ __forceinline__ void p13_gla_naive(const Ctx& C) {
    const bf16* P = WSP(bf16, WS_P); const float* LA = WSP(float, WS_LA); float* GO = WSP(float, WS_GO);
    const int lane = C.lane;
    for (int it = C.gw; it < NB * GH * 128; it += C.NGW) {
        const int bh = it >> 7, e0 = (it & 127) * 3, b = bh >> 2, h = bh & 3;
        float st[3][3];
#pragma unroll
        for (int i = 0; i < 3; ++i)
#pragma unroll
            for (int e = 0; e < 3; ++e) st[i][e] = 0.f;
        const float qsc = 0.07216878364870322f;
        for (int t0 = 0; t0 < S; t0 += 4) {
            float a[4][3], k[4][3], q[4][3], v[4][3];
#pragma unroll
            for (int u = 0; u < 4; ++u) { const size_t row = (size_t)(b * S + t0 + u);
#pragma unroll
                for (int i = 0; i < 3; ++i) { const int d = lane + 64 * i;
                    a[u][i] = LA[row * GKW + h * GDK + d]; k[u][i] = bf2f(P[row * GLA_NP + GP_K + h * GDK + d]); q[u][i] = bf2f(P[row * GLA_NP + GP_Q + h * GDK + d]) * qsc; }
#pragma unroll
                for (int e = 0; e < 3; ++e) v[u][e] = bf2f(P[row * GLA_NP + GP_V + h * GDV + e0 + e]); }
#pragma unroll
            for (int u = 0; u < 4; ++u) { float o[3] = {0.f, 0.f, 0.f};
#pragma unroll
                for (int i = 0; i < 3; ++i)
#pragma unroll
                    for (int e = 0; e < 3; ++e) { st[i][e] = a[u][i] * st[i][e] + k[u][i] * v[u][e]; o[e] += q[u][i] * st[i][e]; }
#pragma unroll
                for (int e = 0; e < 3; ++e) o[e] = wave_sum(o[e]);
                if (lane < 3) GO[(size_t)(b * S + t0 + u) * GVW + h * GDV + e0 + lane] = lane == 0 ? o[0] : (lane == 1 ? o[1] : o[2]); }
        }
    }
}
__device__ __forceinline__ void p14_gla_onorm(const Ctx& C) {
    const bf16* __restrict__ P = WSP(bf16, WS_P); const float* __restrict__ GO = WSP(float, WS_GO); const float* __restrict__ og = C.in[12]; bf16* __restrict__ CAT = WSP(bf16, WS_CAT);
    const int lane = C.lane;
    float g0[3], g1[3];
#pragma unroll
    for (int i = 0; i < 3; ++i) { g0[i] = og[128 * i + 2 * lane]; g1[i] = og[128 * i + 2 * lane + 1]; }
    for (int m = C.gw; m < T; m += C.NGW) {
        f32x2 x[4][3]; unsigned ru[4][3]; float ss[4];
#pragma unroll
        for (int h = 0; h < GH; ++h) { ss[h] = 0.f;
#pragma unroll
            for (int i = 0; i < 3; ++i) { x[h][i] = *((const f32x2*)(GO + (size_t)m * GVW + h * GDV + 128 * i) + lane); ss[h] += x[h][i].x * x[h][i].x + x[h][i].y * x[h][i].y;
                ru[h][i] = *((const unsigned*)(P + (size_t)m * GLA_NP + GP_R + h * GDV + 128 * i) + lane); } }
#pragma unroll
        for (int o = 1; o < 64; o <<= 1)
#pragma unroll
            for (int h = 0; h < GH; ++h) ss[h] += __shfl_xor(ss[h], o);
#pragma unroll
        for (int h = 0; h < GH; ++h) { const float inv = 1.0f / sqrtf(ss[h] * (1.0f / GDV) + RMS_EPS);
#pragma unroll
            for (int i = 0; i < 3; ++i) { const float r0 = bflo(ru[h][i]), r1 = bfhi(ru[h][i]);
                const float y0 = x[h][i].x * inv * g0[i] * (r0 / (1.0f + __expf(-r0))), y1 = x[h][i].y * inv * g1[i] * (r1 / (1.0f + __expf(-r1)));
                *((unsigned*)(CAT + (size_t)m * D + h * GDV + 128 * i) + lane) = pk2(y0, y1); } }
    }
}

__device__ __forceinline__ void p6_router(const Ctx& C, int layer, bool commit = true) {
    const float* X = WSP(float, WS_XB); const float* g = C.in[16] + layer * D;
    const float* wg = C.in[17] + (size_t)layer * D * 4; const float* we = C.in[19] + (size_t)layer * D * 32;
    const float* bg = C.in[18] + layer * 4; const float* be = C.in[20] + layer * 32;
    unsigned* cnt = (unsigned*)(C.ws + WS_CTL) + CW_CNT + layer * 32;
    int* toke = (int*)(C.ws + WS_ROUTE + RT_TOKE); int* toks = (int*)(C.ws + WS_ROUTE + RT_TOKS); float* tokw = (float*)(C.ws + WS_ROUTE + RT_TOKW);
    const int lane = C.lane;
    LAS float* hs = (LAS float*)(C.lds + RING_OFF + C.wave * 16384);
    for (int pr = C.gw; pr < T / 2; pr += C.NGW) {
        {
            f32x4 x0[8], x1[8];
            load_row(X + (size_t)(2 * pr) * D, lane, x0); load_row(X + (size_t)(2 * pr + 1) * D, lane, x1);
            const float i0 = row_inv_rms(x0), i1 = row_inv_rms(x1);
            norm_store_row(WSP(bf16, WS_HN) + (size_t)(2 * pr) * D, x0, i0, g, lane);
            norm_store_row(WSP(bf16, WS_HN) + (size_t)(2 * pr + 1) * D, x1, i1, g, lane);
#pragma unroll
            for (int j = 0; j < 8; ++j) { ((LAS f32x4*)hs)[lane + 64 * j] = x0[j]; ((LAS f32x4*)(hs + D))[lane + 64 * j] = x1[j]; }
        }
        LDS_WAIT(); asm volatile("" ::: "memory");
        float a0[36], a1[36];
#pragma unroll
        for (int n = 0; n < 36; ++n) { a0[n] = 0.f; a1[n] = 0.f; }
#pragma unroll 2
        for (int kk = 0; kk < 32; ++kk) {
            const int k = lane + 64 * kk; const float h0 = hs[k], h1 = hs[D + k];
            const f32x4 w4 = *(const f32x4*)(wg + (size_t)k * 4);
#pragma unroll
            for (int n = 0; n < 4; ++n) { a0[n] += h0 * w4[n]; a1[n] += h1 * w4[n]; }
#pragma unroll
            for (int q = 0; q < 8; ++q) { const f32x4 w = *(const f32x4*)(we + (size_t)k * 32 + 4 * q);
#pragma unroll
                for (int n = 0; n < 4; ++n) { a0[4 + 4 * q + n] += h0 * w[n]; a1[4 + 4 * q + n] += h1 * w[n]; } }
        }
        asm volatile("" ::: "memory");
#pragma unroll
        for (int n = 0; n < 36; ++n) { a0[n] = wave_sum(a0[n]); a1[n] = wave_sum(a1[n]); }
#pragma unroll
        for (int rr = 0; rr < 2; ++rr) {
            float lg[36];
#pragma unroll
            for (int n = 0; n < 36; ++n) lg[n] = rr == 0 ? a0[n] : a1[n];
            float gl[4]; int gi = 0; float gm;
#pragma unroll
            for (int n = 0; n < 4; ++n) gl[n] = lg[n] + bg[n];
            gm = gl[0];
#pragma unroll
            for (int n = 1; n < 4; ++n) if (gl[n] > gm) { gm = gl[n]; gi = n; }
            float gs = 0.f;
#pragma unroll
            for (int n = 0; n < 4; ++n) gs += expf(gl[n] - gm);
            const float gp = 1.0f / gs;
            float ev[8];
#pragma unroll
            for (int j = 0; j < 8; ++j) { const float v0 = lg[4 + j] + be[j], v1 = lg[12 + j] + be[8 + j], v2 = lg[20 + j] + be[16 + j], v3 = lg[28 + j] + be[24 + j];
                ev[j] = gi == 0 ? v0 : (gi == 1 ? v1 : (gi == 2 ? v2 : v3)); }
            int e1 = 0; float m1 = ev[0];
#pragma unroll
            for (int j = 1; j < 8; ++j) if (ev[j] > m1) { m1 = ev[j]; e1 = j; }
            int e2 = -1; float m2 = -__builtin_inff();
#pragma unroll
            for (int j = 0; j < 8; ++j) if (j != e1 && ev[j] > m2) { m2 = ev[j]; e2 = j; }
            const float z = expf(m2 - m1); const float w1 = gp / (1.0f + z), w2 = gp * z / (1.0f + z);
            if (lane == 0) {
                const int tok = 2 * pr + rr; const int id1 = gi * 8 + e1, id2 = gi * 8 + e2;
                if (commit) { const unsigned s1 = atomicAdd(cnt + id1, 1u), s2 = atomicAdd(cnt + id2, 1u); toks[2 * tok] = (int)s1; toks[2 * tok + 1] = (int)s2; }
                toke[2 * tok] = id1; tokw[2 * tok] = w1;
                toke[2 * tok + 1] = id2; tokw[2 * tok + 1] = w2;
            }
        }
    }
}
__device__ __forceinline__ void p6_router_mfma(const Ctx& C, int layer, bool commit = true) {
    const bf16* X = WSP(bf16, WS_XB); const float* g = C.in[16] + layer * D;
    const bf16* WR = WSP(bf16, WS_WR) + (size_t)layer * 2 * 64 * D;
    const float* bg = C.in[18] + layer * 4; const float* be = C.in[20] + layer * 32;
    unsigned* cnt = (unsigned*)(C.ws + WS_CTL) + CW_CNT + layer * 32;
    int* toke = (int*)(C.ws + WS_ROUTE + RT_TOKE); int* toks = (int*)(C.ws + WS_ROUTE + RT_TOKS); float* tokw = (float*)(C.ws + WS_ROUTE + RT_TOKW);
    float* INV = WSP(float, WS_INV);
    const int lane = C.lane, r = lane & 31, h = lane >> 5;
    for (int task = C.wave * C.G + blockIdx.x; task < T / 32; task += C.NGW) {
        const int row = 32 * task + r;
        const bf16* xp = X + (size_t)row * D + 8 * h; const float* gp = g + 8 * h;
        const bf16* w0 = WR + (size_t)r * D + 8 * h;
        f32x16 acc0, acc1;
#pragma unroll
        for (int i = 0; i < 16; ++i) { acc0[i] = 0.f; acc1[i] = 0.f; }
        float ss = 0.f;
#pragma unroll 4
        for (int s = 0; s < D / 16; ++s) {
            const v4u xr = *(const v4u*)(xp + 16 * s);
            const f32x4 xa = (f32x4){bflo(xr.x), bfhi(xr.x), bflo(xr.y), bfhi(xr.y)}, xb = (f32x4){bflo(xr.z), bfhi(xr.z), bflo(xr.w), bfhi(xr.w)};
            const f32x4 ga = *(const f32x4*)(gp + 16 * s), gb = *(const f32x4*)(gp + 16 * s + 4);
            ss += (xa.x * xa.x + xa.y * xa.y) + (xa.z * xa.z + xa.w * xa.w) + (xb.x * xb.x + xb.y * xb.y) + (xb.z * xb.z + xb.w * xb.w);
            const f32x4 va = xa * ga, vb = xb * gb;
            v4u hi; hi.x = pk2(va.x, va.y); hi.y = pk2(va.z, va.w); hi.z = pk2(vb.x, vb.y); hi.w = pk2(vb.z, vb.w);
            v4u lo; lo.x = pk2(va.x - bflo(hi.x), va.y - bfhi(hi.x)); lo.y = pk2(va.z - bflo(hi.y), va.w - bfhi(hi.y));
            lo.z = pk2(vb.x - bflo(hi.z), vb.y - bfhi(hi.z)); lo.w = pk2(vb.z - bflo(hi.w), vb.w - bfhi(hi.w));
            const bf16x8 xh = __builtin_bit_cast(bf16x8, hi), xl = __builtin_bit_cast(bf16x8, lo);
            const bf16x8 a0h = *(const bf16x8*)(w0 + 16 * s), a1h = *(const bf16x8*)(w0 + (size_t)32 * D + 16 * s);
            const bf16x8 a0l = *(const bf16x8*)(w0 + (size_t)64 * D + 16 * s), a1l = *(const bf16x8*)(w0 + (size_t)96 * D + 16 * s);
            acc0 = __builtin_amdgcn_mfma_f32_32x32x16_bf16(a0h, xh, acc0, 0, 0, 0); acc1 = __builtin_amdgcn_mfma_f32_32x32x16_bf16(a1h, xh, acc1, 0, 0, 0);
            acc0 = __builtin_amdgcn_mfma_f32_32x32x16_bf16(a0l, xh, acc0, 0, 0, 0); acc1 = __builtin_amdgcn_mfma_f32_32x32x16_bf16(a1l, xh, acc1, 0, 0, 0);
            acc0 = __builtin_amdgcn_mfma_f32_32x32x16_bf16(a0h, xl, acc0, 0, 0, 0); acc1 = __builtin_amdgcn_mfma_f32_32x32x16_bf16(a1h, xl, acc1, 0, 0, 0);
        }
        ss += __shfl_xor(ss, 32);
        const float inv = 1.0f / sqrtf(ss * (1.0f / D) + RMS_EPS);
        if (h == 0) INV[row] = inv;
        float gl[4]; int gi = 0;
#pragma unroll
        for (int n = 0; n < 4; ++n) gl[n] = acc1[n] * inv + bg[n];
        float gm = gl[0];
#pragma unroll
        for (int n = 1; n < 4; ++n) if (gl[n] > gm) { gm = gl[n]; gi = n; }
        float gs = 0.f;
#pragma unroll
        for (int n = 0; n < 4; ++n) gs += expf(gl[n] - gm);
        const float gpr = 1.0f / gs;
        float ev[8];
#pragma unroll
        for (int j = 0; j < 8; ++j) ev[j] = ((gi & 1) ? acc0[8 + j] : acc0[j]) * inv + be[gi * 8 + j];
        int e1 = 0; float m1 = ev[0];
#pragma unroll
        for (int j = 1; j < 8; ++j) if (ev[j] > m1) { m1 = ev[j]; e1 = j; }
        int e2 = -1; float m2 = -__builtin_inff();
#pragma unroll
        for (int j = 0; j < 8; ++j) if (j != e1 && ev[j] > m2) { m2 = ev[j]; e2 = j; }
        const float z = expf(m2 - m1); const float w1 = gpr / (1.0f + z), w2 = gpr * z / (1.0f + z);
        if (h == (gi >> 1)) {
            const int tok = row; const int id1 = gi * 8 + e1, id2 = gi * 8 + e2;
            if (commit) { const unsigned s1 = atomicAdd(cnt + id1, 1u), s2 = atomicAdd(cnt + id2, 1u); toks[2 * tok] = (int)s1; toks[2 * tok + 1] = (int)s2; }
            toke[2 * tok] = id1; tokw[2 * tok] = w1;
            toke[2 * tok + 1] = id2; tokw[2 * tok + 1] = w2;
        }
    }
    if (CV_STEAL && commit) {
        if (layer == 0) { if (C.wave * C.G + (int)blockIdx.x >= T / 32) cv_steal(C, 4, nullptr); }
        else cv_steal(C, 1 << 20, nullptr);
    }
}
__device__ __forceinline__ void p7_dispatch(const Ctx& C, int layer) {
    const unsigned* cnt = (const unsigned*)(C.ws + WS_CTL) + CW_CNT + layer * 32;
    const int* toke = (const int*)(C.ws + WS_ROUTE + RT_TOKE); const int* toks = (const int*)(C.ws + WS_ROUTE + RT_TOKS); const float* tokw = (const float*)(C.ws + WS_ROUTE + RT_TOKW);
    int* rowdest = (int*)(C.ws + WS_ROUTE + RT_ROWDEST) + layer * MAXROWS; float* roww = (float*)(C.ws + WS_ROUTE + RT_ROWW);
    int* tilee = (int*)(C.ws + WS_ROUTE + RT_TILEE) + layer * 256;
    const int lane = C.lane;
    const int c = lane < NE ? (int)__hip_atomic_load(cnt + lane, __ATOMIC_RELAXED, __HIP_MEMORY_SCOPE_AGENT) : 0;
    const int padded = (c + 255) & ~255;
    int inc = padded;
#pragma unroll
    for (int o = 1; o < 64; o <<= 1) { const int t = __shfl_up(inc, o); if (lane >= o) inc += t; }
    const int pstart = inc - padded;
    if (blockIdx.x == 0 && C.wave == 0) {
        if (lane < NE) for (int tl = pstart >> 8; tl < (pstart + padded) >> 8; ++tl) tilee[tl] = lane;
        if (lane == 63) tilee[255] = inc >> 8;
    }
    const bf16* __restrict__ X = WSP(bf16, WS_XB); const float* __restrict__ INV = WSP(float, WS_INV); const float* __restrict__ g = C.in[16] + layer * D; bf16* __restrict__ XG = WSP(bf16, WS_XG);
    f32x4 gg[8];
#pragma unroll
    for (int j = 0; j < 8; ++j) gg[j] = ((const f32x4*)g)[lane + 64 * j];
    for (int tb = C.gw * 8; tb < T; tb += C.NGW * 8) {
        int e = 0, slot = 0; float w = 0.f; const int a = 2 * tb + lane;
        if (lane < 16) { e = toke[a]; slot = toks[a]; w = tokw[a]; }
        const int dest_l = __shfl(pstart, e) + slot;
        if (lane < 16) { rowdest[dest_l] = a; roww[dest_l] = w; }
#pragma unroll 1
        for (int i = 0; i < 8; i += 2) {
            const int t0 = tb + i, t1 = tb + i + 1;
            v2u x0[8], x1[8];
#pragma unroll
            for (int j = 0; j < 8; ++j) { x0[j] = ((const v2u*)(X + (size_t)t0 * D))[lane + 64 * j]; x1[j] = ((const v2u*)(X + (size_t)t1 * D))[lane + 64 * j]; }
            const float i0 = INV[t0], i1 = INV[t1];
            const int d00 = __shfl(dest_l, 2 * i), d01 = __shfl(dest_l, 2 * i + 1), d10 = __shfl(dest_l, 2 * i + 2), d11 = __shfl(dest_l, 2 * i + 3);
#pragma unroll
            for (int j = 0; j < 8; ++j) {
                v2u o0, o1;
                o0.x = pk2(bflo(x0[j].x) * i0 * gg[j].x, bfhi(x0[j].x) * i0 * gg[j].y); o0.y = pk2(bflo(x0[j].y) * i0 * gg[j].z, bfhi(x0[j].y) * i0 * gg[j].w);
                o1.x = pk2(bflo(x1[j].x) * i1 * gg[j].x, bfhi(x1[j].x) * i1 * gg[j].y); o1.y = pk2(bflo(x1[j].y) * i1 * gg[j].z, bfhi(x1[j].y) * i1 * gg[j].w);
                ((v2u*)(XG + (size_t)d00 * D))[lane + 64 * j] = o0; ((v2u*)(XG + (size_t)d01 * D))[lane + 64 * j] = o0;
                ((v2u*)(XG + (size_t)d10 * D))[lane + 64 * j] = o1; ((v2u*)(XG + (size_t)d11 * D))[lane + 64 * j] = o1;
            }
        }
    }
}
__device__ __forceinline__ void p_combine(const Ctx& C, bf16* __restrict__ xo, float* __restrict__ fo, const float* __restrict__ g) {
    const bf16* __restrict__ YB = WSP(bf16, WS_YB); const bf16* __restrict__ xi = WSP(bf16, WS_XB); bf16* __restrict__ HN = WSP(bf16, WS_HN);
    const int lane = C.lane;
    for (int m0 = 2 * C.gw; m0 < T; m0 += 2 * C.NGW) {
        v2u xr[2][8], ya[2][8], yb[2][8];
#pragma unroll
        for (int q = 0; q < 2; ++q)
#pragma unroll
            for (int j = 0; j < 8; ++j) { const size_t m = (size_t)(m0 + q);
                xr[q][j] = ((const v2u*)(xi + m * D))[lane + 64 * j]; ya[q][j] = ((const v2u*)(YB + 2 * m * D))[lane + 64 * j]; yb[q][j] = ((const v2u*)(YB + (2 * m + 1) * D))[lane + 64 * j]; }
#pragma unroll
        for (int q = 0; q < 2; ++q) { const size_t m = (size_t)(m0 + q);
            f32x4 v[8];
#pragma unroll
            for (int j = 0; j < 8; ++j) {
                v[j].x = bflo(xr[q][j].x) + (bflo(ya[q][j].x) + bflo(yb[q][j].x)); v[j].y = bfhi(xr[q][j].x) + (bfhi(ya[q][j].x) + bfhi(yb[q][j].x));
                v[j].z = bflo(xr[q][j].y) + (bflo(ya[q][j].y) + bflo(yb[q][j].y)); v[j].w = bfhi(xr[q][j].y) + (bfhi(ya[q][j].y) + bfhi(yb[q][j].y));
                if (fo) ((f32x4*)(fo + m * D))[lane + 64 * j] = v[j];
                else { v2u o; o.x = pk2(v[j].x, v[j].y); o.y = pk2(v[j].z, v[j].w); ((v2u*)(xo + m * D))[lane + 64 * j] = o; }
            }
            if (g) { const float inv = row_inv_rms(v); norm_store_row(HN + m * D, v, inv, g, lane); }
        }
    }
}

constexpr int AT_K = 0, AT_V = 32768, AT_C = 65536, AT_U = 66560, AT_F = 66624;
constexpr float LOG2E = 1.4426950408889634f;
constexpr float AT_C2 = 0.08838834764831845f * 1.4426950408889634f;
__device__ __forceinline__ unsigned off_b(unsigned row, unsigned ch) { return 256u * row + 16u * (ch ^ (((row & 3u) << 2) | ((row >> 2) & 3u))); }

template <bool FOX>
__device__ __forceinline__ void attn_unit(LAS unsigned char* lds, const bf16* Qb, int ldq, const bf16* Kb, int ldk, const bf16* Vb, int ldv, const float* cb, float B2, int qrow0, int nkt,
                                          bf16* Ob, int ldo, const bf16* OGb, int ldog, int tid, int lane, int wave) {
    const int r = lane & 31, h = lane >> 5;
    const int qpos = qrow0 + 32 * wave + r;
    bf16x8 qf[8];
    { const bf16* qp = Qb + (size_t)(32 * wave + r) * ldq + 8 * h;
#pragma unroll
      for (int s = 0; s < 8; ++s) qf[s] = *(const bf16x8*)(qp + 16 * s); }
    const float cq2 = FOX ? cb[qpos] * LOG2E : 0.f;
    f32x16 o[4];
#pragma unroll
    for (int c = 0; c < 4; ++c)
#pragma unroll
        for (int i = 0; i < 16; ++i) o[c][i] = 0.f;
    float m = -1e30f, l = 0.f;
    const int srow = tid >> 4, sch = tid & 15;
    const unsigned so0 = off_b(srow, sch), so1 = off_b(srow + 32, sch);
    const bf16* kg = Kb + (size_t)srow * ldk + 8 * sch; const bf16* vg = Vb + (size_t)srow * ldv + 8 * sch;
    v4u kr0, kr1, vr0, vr1; float cr = 0.f;
#define AT_LOAD(kt) do { const size_t ko = (size_t)(64 * (kt)) * ldk, vo = (size_t)(64 * (kt)) * ldv; \
        kr0 = *(const v4u*)(kg + ko); kr1 = *(const v4u*)(kg + ko + (size_t)32 * ldk); vr0 = *(const v4u*)(vg + vo); vr1 = *(const v4u*)(vg + vo + (size_t)32 * ldv); \
        if (FOX && tid < 64) cr = cb[64 * (kt) + tid] * LOG2E; } while (0)
#define AT_STORE(b) do { *(LAS v4u*)(lds + AT_K + (b) * 16384 + so0) = kr0; *(LAS v4u*)(lds + AT_K + (b) * 16384 + so1) = kr1; \
        *(LAS v4u*)(lds + AT_V + (b) * 16384 + so0) = vr0; *(LAS v4u*)(lds + AT_V + (b) * 16384 + so1) = vr1; \
        if (FOX && tid < 64) *(LAS float*)(lds + AT_C + (b) * 256 + 4 * tid) = cr; } while (0)
    const int kfirst = FOX ? nkt - 1 : 0, kdir = FOX ? -1 : 1;
    AT_LOAD(kfirst); AT_STORE(0);
    if (nkt > 1) AT_LOAD(kfirst + kdir);
    __syncthreads();
    unsigned kb0 = 256u * r + 16u * ((unsigned)h ^ (((r & 3u) << 2) | ((r >> 2) & 3u)));
    const unsigned tq = (lane & 15) >> 2, tp = lane & 3, tblk = (lane >> 4) & 1;
    unsigned vb0 = 1024u * h + 256u * tq + 64u * tq + 16u * ((2u * tblk + (tp >> 1)) ^ ((unsigned)h & 3u)) + 8u * (tp & 1);
    unsigned vb1 = 2048u + 1024u * h + 256u * tq + 64u * tq + 16u * ((2u * tblk + (tp >> 1)) ^ ((2u + (unsigned)h) & 3u)) + 8u * (tp & 1);
    const int minq = qrow0 + 32 * wave;
    bool wdone = false;
    volatile LAS unsigned* flags = (volatile LAS unsigned*)(lds + AT_F);
#pragma unroll 1
    for (int it = 0; it < nkt; ++it) {
        asm volatile("" : "+v"(kb0), "+v"(vb0), "+v"(vb1));
        const int kt = kfirst + it * kdir;
        const int b = it & 1;
        const bool active = !FOX || (64 * kt <= minq + 31);
        if (FOX && active && !wdone) {
            const float ub = B2 + cq2 - *(const LAS float*)(lds + AT_C + b * 256 + 63 * 4);
            if (__all(ub - m < -160.f)) wdone = true;
        }
        if (active && !wdone) {
            f32x16 p0, p1;
#pragma unroll
            for (int i = 0; i < 16; ++i) { p0[i] = 0.f; p1[i] = 0.f; }
            const LAS unsigned char* kbuf = lds + AT_K + b * 16384;
#pragma unroll
            for (int s = 0; s < 8; ++s) {
                const bf16x8 a0 = *(const LAS bf16x8*)(kbuf + (kb0 ^ (32u * s))), a1 = *(const LAS bf16x8*)(kbuf + (kb0 ^ (32u * s)) + 8192);
                p0 = __builtin_amdgcn_mfma_f32_32x32x16_bf16(a0, qf[s], p0, 0, 0, 0);
                p1 = __builtin_amdgcn_mfma_f32_32x32x16_bf16(a1, qf[s], p1, 0, 0, 0);
            }
            if (FOX) {
                const LAS float* cbuf = (const LAS float*)(lds + AT_C + b * 256);
#pragma unroll
                for (int g = 0; g < 4; ++g) { const f32x4 c0 = *(const LAS f32x4*)(cbuf + 8 * g + 4 * h), c1 = *(const LAS f32x4*)(cbuf + 32 + 8 * g + 4 * h);
#pragma unroll
                    for (int j = 0; j < 4; ++j) { p0[4 * g + j] = fmaf(p0[4 * g + j], AT_C2, cq2 - c0[j]); p1[4 * g + j] = fmaf(p1[4 * g + j], AT_C2, cq2 - c1[j]); } }
                if (64 * kt + 63 > minq) {
                    const int dq = qpos - 64 * kt - 4 * h;
#pragma unroll
                    for (int i = 0; i < 16; ++i) { const int ci = (i & 3) + 8 * (i >> 2);
                        if (ci > dq) p0[i] = -__builtin_inff();
                        if (ci + 32 > dq) p1[i] = -__builtin_inff(); }
                }
            } else {
#pragma unroll
                for (int i = 0; i < 16; ++i) { p0[i] *= AT_C2; p1[i] *= AT_C2; }
            }
            float pmax = p0[0];
#pragma unroll
            for (int i = 1; i < 16; ++i) pmax = fmaxf(pmax, p0[i]);
#pragma unroll
            for (int i = 0; i < 16; ++i) pmax = fmaxf(pmax, p1[i]);
            pmax = fmaxf(pmax, __shfl_xor(pmax, 32));
            const float mn = fmaxf(m, pmax), alpha = __builtin_amdgcn_exp2f(m - mn);
            const bool resc = __any(mn > m);
            m = mn;
            float ps = 0.f;
#pragma unroll
            for (int i = 0; i < 16; ++i) { p0[i] = __builtin_amdgcn_exp2f(p0[i] - mn); p1[i] = __builtin_amdgcn_exp2f(p1[i] - mn); ps += p0[i] + p1[i]; }
            ps += __shfl_xor(ps, 32);
            l = l * alpha + ps;
            if (resc) {
#pragma unroll
                for (int c = 0; c < 4; ++c)
#pragma unroll
                    for (int i = 0; i < 16; ++i) o[c][i] *= alpha;
            }
            bf16x8 pf[4];
#pragma unroll
            for (int s = 0; s < 2; ++s) {
                v4u w0, w1;
                w0.x = pk2(p0[8 * s], p0[8 * s + 1]); w0.y = pk2(p0[8 * s + 2], p0[8 * s + 3]); w0.z = pk2(p0[8 * s + 4], p0[8 * s + 5]); w0.w = pk2(p0[8 * s + 6], p0[8 * s + 7]);
                w1.x = pk2(p1[8 * s], p1[8 * s + 1]); w1.y = pk2(p1[8 * s + 2], p1[8 * s + 3]); w1.z = pk2(p1[8 * s + 4], p1[8 * s + 5]); w1.w = pk2(p1[8 * s + 6], p1[8 * s + 7]);
                pf[s] = __builtin_bit_cast(bf16x8, w0); pf[2 + s] = __builtin_bit_cast(bf16x8, w1);
            }
            const LAS unsigned char* vbuf = lds + AT_V + b * 16384;
#pragma unroll
            for (int ks = 0; ks < 4; ++ks)
#pragma unroll
                for (int c = 0; c < 4; ++c) {
                    const s16x4 lo = __builtin_amdgcn_ds_read_tr16_b64_v4i16((LAS s16x4*)(vbuf + ((vb0 ^ (64u * c)) + 4096u * ks)));
                    const s16x4 hi = __builtin_amdgcn_ds_read_tr16_b64_v4i16((LAS s16x4*)(vbuf + ((vb1 ^ (64u * c)) + 4096u * ks)));
                    const bf16x8 vf = __builtin_shufflevector(lo, hi, 0, 1, 2, 3, 4, 5, 6, 7);
                    o[c] = __builtin_amdgcn_mfma_f32_32x32x16_bf16(vf, pf[ks], o[c], 0, 0, 0);
                }
        }
        if (FOX && lane == 0) flags[8 * b + wave] = wdone ? 1u : 0u;
        if (it + 1 < nkt) { AT_STORE(b ^ 1); if (it + 2 < nkt) AT_LOAD(kfirst + (it + 2) * kdir); }
        __syncthreads();
        if (FOX) { const v4u f0 = *(const LAS v4u*)(lds + AT_F + 32 * b), f1 = *(const LAS v4u*)(lds + AT_F + 32 * b + 16);
            if ((f0.x & f0.y & f0.z & f0.w & f1.x & f1.y & f1.z & f1.w) != 0u) break; }
    }
#undef AT_LOAD
#undef AT_STORE
    const float il = 1.0f / l;
    bf16* orow = Ob + (size_t)(32 * wave + r) * ldo + 4 * h;
    const bf16* grow = FOX ? OGb + (size_t)(32 * wave + r) * ldog + 4 * h : nullptr;
#pragma unroll
    for (int c = 0; c < 4; ++c)
#pragma unroll
        for (int g = 0; g < 4; ++g) {
            float y0 = o[c][4 * g] * il, y1 = o[c][4 * g + 1] * il, y2 = o[c][4 * g + 2] * il, y3 = o[c][4 * g + 3] * il;
            if (FOX) { const v2u gg = *(const v2u*)(grow + 32 * c + 8 * g);
                y0 *= 1.0f / (1.0f + __expf(-bflo(gg.x))); y1 *= 1.0f / (1.0f + __expf(-bfhi(gg.x))); y2 *= 1.0f / (1.0f + __expf(-bflo(gg.y))); y3 *= 1.0f / (1.0f + __expf(-bfhi(gg.y))); }
            v2u w; w.x = pk2(y0, y1); w.y = pk2(y2, y3);
            *(v2u*)(orow + 32 * c + 8 * g) = w;
        }
}
__device__ __forceinline__ void mem_attn_unit(const Ctx& C, int v, const bf16* P, int ldp, int qcol, int layer) {
    const int qblk = v >> 2, mh = v & 3, b = qblk >> 4;
    attn_unit<false>(C.lds + RING_OFF, P + (size_t)(qblk * 256) * ldp + qcol + mh * HD, ldp,
                     WSP(bf16, WS_MK) + (size_t)layer * 1024 * 512 + (size_t)(b * ML) * 512 + mh * HD, 512, WSP(bf16, WS_MKV) + (size_t)(b * ML) * 1024 + 512 + mh * HD, 1024,
                     nullptr, 0.f, 0, ML / 64, WSP(bf16, WS_CAT) + (size_t)(qblk * 256) * D + FW + mh * HD, D, nullptr, 0, C.tid, C.lane, C.wave);
}
__device__ __forceinline__ void p4_fox_attn(const Ctx& C, int qsel = 0) {
    const bf16* P = WSP(bf16, WS_P);
    unsigned* ctr = (unsigned*)(C.ws + WS_CTL) + CW_Q0 + 128 * qsel;
    volatile LAS unsigned* uw = (volatile LAS unsigned*)(C.lds + RING_OFF + AT_U);
    const float gqm = wave_max(fmaxf(fabsf(C.in[7][2 * C.lane]), fabsf(C.in[7][2 * C.lane + 1]))), gkm = wave_max(fmaxf(fabsf(C.in[8][2 * C.lane]), fabsf(C.in[8][2 * C.lane + 1])));
    const float B2 = 11.313708499f * gqm * gkm * LOG2E * 1.02f + 1.0f;
    for (;;) {
        __syncthreads();
        if (C.tid == 0) *uw = atomicAdd(ctr, 1u);
        __syncthreads();
        const int u = (int)*uw;
        if (u >= 768 + 256) break;
#if !defined(AT_ONLY_MEM)
        if (u < 768) {
            const int qb = 15 - u / 48, bh = u % 48, b = bh / FH, hh = bh % FH;
            const size_t rb = (size_t)(b * S + 256 * qb);
            attn_unit<true>(C.lds + RING_OFF, P + rb * FOX_NP + FP_Q + hh * HD, FOX_NP, P + (size_t)(b * S) * FOX_NP + FP_K + hh * HD, FOX_NP, P + (size_t)(b * S) * FOX_NP + FP_V + hh * HD, FOX_NP,
                           WSP(float, WS_C) + (size_t)bh * S, B2, 256 * qb, 4 * qb + 4, WSP(bf16, WS_CAT) + rb * D + hh * HD, D, P + rb * FOX_NP + FP_OG + hh * HD, FOX_NP, C.tid, C.lane, C.wave);
        } else
#endif
#if !defined(AT_ONLY_FOX)
        mem_attn_unit(C, u - 768, P, FOX_NP, FP_QM, 0);
#else
        {}
#endif
    }
}

__device__ __forceinline__ void p13_mem_attn(const Ctx& C, int qsel = 0) {
    const bf16* P = WSP(bf16, WS_P);
    unsigned* ctr = (unsigned*)(C.ws + WS_CTL) + CW_Q1 + 128 * qsel;
    volatile LAS unsigned* uw = (volatile LAS unsigned*)(C.lds + RING_OFF + AT_U);
    for (;;) {
        __syncthreads();
        if (C.tid == 0) *uw = atomicAdd(ctr, 1u);
        __syncthreads();
        const int u = (int)*uw;
        if (u >= 256) break;
        mem_attn_unit(C, u, P, GLA_NP, GP_QM, 1);
    }
}

constexpr int GT_STRIDE = 400;
constexpr int GT_QE = 0, GT_KE = 25600, GT_V = 51200;
constexpr int GSEG = 8, GCH = 8;
constexpr size_t WS_QE = WS_H, WS_KE = WS_H + 24 * MiB, WS_DL = WS_H + 48 * MiB, WS_DSEG = WS_H + 49 * MiB;
constexpr size_t WS_SLOC = WS_XG + 96 * MiB;

__device__ __forceinline__ void p12_gla_prep(const Ctx& C) {
    bf16* P = WSP(bf16, WS_P);
    for (int m = C.gw; m < T; m += C.NGW) headnorm_inplace(P + (size_t)m * GLA_NP, GP_QM, MH, C.in[13] + HD, C.lane);
    const float* __restrict__ w2 = C.in[10]; const float* __restrict__ ba = C.in[11]; const float* __restrict__ FLp = WSP(float, WS_FL); const bf16* __restrict__ Pc = P;
    bf16* __restrict__ QE = WSP(bf16, WS_QE); bf16* __restrict__ KE = WSP(bf16, WS_KE); float* __restrict__ DL = WSP(float, WS_DL);
    const float qsc = 0.07216878364870322f;
    for (int cg = blockIdx.x; cg < T / 64; cg += C.G) {
        for (int c = C.tid; c < GKW; c += 512) {
            float w[16];
#pragma unroll
            for (int r = 0; r < 16; ++r) w[r] = w2[r * GKW + c];
            const float bb = ba[c]; float bc = 0.f;
#pragma unroll 1
            for (int t0 = 0; t0 < 64; t0 += 8) {
                float gl[8], qv[8], kv[8];
#pragma unroll
                for (int u = 0; u < 8; ++u) {
                    const size_t row = (size_t)cg * 64 + t0 + u;
                    const float* fl = FLp + row * 16;
                    float s = bb;
#pragma unroll
                    for (int r = 0; r < 16; ++r) s += fl[r] * w[r];
                    gl[u] = log_sigmoid(s) * (1.0f / 16.0f);
                    qv[u] = bf2f(Pc[row * GLA_NP + GP_Q + c]); kv[u] = bf2f(Pc[row * GLA_NP + GP_K + c]);
                }
#pragma unroll
                for (int u = 0; u < 8; ++u) {
                    const size_t row = (size_t)cg * 64 + t0 + u;
                    bc += gl[u];
                    const float e = expf(bc);
                    QE[row * GKW + c] = (bf16)(pk2(qv[u] * e * qsc, 0.f) & 0xffffu);
                    KE[row * GKW + c] = (bf16)(pk2(kv[u] / e, 0.f) & 0xffffu);
                }
            }
            DL[(size_t)cg * GKW + c] = expf(bc);
        }
    }
}

__device__ __forceinline__ bf16x8 pack8(const f32x16& x, int s) {
    v4u w; w.x = pk2(x[8 * s], x[8 * s + 1]); w.y = pk2(x[8 * s + 2], x[8 * s + 3]); w.z = pk2(x[8 * s + 4], x[8 * s + 5]); w.w = pk2(x[8 * s + 6], x[8 * s + 7]);
    return __builtin_bit_cast(bf16x8, w);
}
__device__ __forceinline__ s16x4 tr4(const LAS unsigned char* tile, int r0, int c0, int lane) {
    const int q = (lane & 15) >> 2, p = lane & 3, blk = (lane >> 4) & 1;
    return __builtin_amdgcn_ds_read_tr16_b64_v4i16((LAS s16x4*)(tile + (r0 + q) * GT_STRIDE + 2 * (c0 + 16 * blk + 4 * p)));
}
template <bool OUT>
__device__ __forceinline__ void gla_unit(const Ctx& C, int u) {
    const int seg = u & 7, eh = (u >> 3) & 1, bh = u >> 4, b = bh >> 2, hd = bh & 3;
    const int tid = C.tid, lane = C.lane, w = C.wave, r = lane & 31, h = lane >> 5;
    LAS unsigned char* lds = C.lds + RING_OFF;
    const bf16* QE = WSP(bf16, WS_QE); const bf16* KE = WSP(bf16, WS_KE); const bf16* P = WSP(bf16, WS_P);
    const float* DL = WSP(float, WS_DL); float* DSEG = WSP(float, WS_DSEG); float* SLOC = WSP(float, WS_SLOC); float* GO = WSP(float, WS_GO);
    f32x16 Sx[6];
#pragma unroll
    for (int dt = 0; dt < 6; ++dt)
#pragma unroll
        for (int i = 0; i < 16; ++i) Sx[dt][i] = 0.f;
    if (OUT && w < 6) {
        for (int sp = 0; sp < seg; ++sp) {
            const float* sl = SLOC + ((((size_t)(bh * GSEG + sp) * 2 + eh) * 6 + w) * 6) * 1024;
            const float* dsg = DSEG + (size_t)(bh * GSEG + sp) * GDK;
#pragma unroll
            for (int dt = 0; dt < 6; ++dt)
#pragma unroll
                for (int g = 0; g < 4; ++g) { const f32x4 dv = *(const f32x4*)(dsg + 32 * dt + 8 * g + 4 * h);
#pragma unroll
                    for (int j = 0; j < 4; ++j) Sx[dt][4 * g + j] = dv[j] * Sx[dt][4 * g + j] + sl[(dt * 16 + 4 * g + j) * 64 + lane]; }
        }
    }
    float dacc[3] = {1.f, 1.f, 1.f};
#pragma unroll 1
    for (int cc = 0; cc < GCH; ++cc) {
        const int cs = seg * GCH + cc; const size_t row0 = (size_t)b * S + (size_t)cs * 64; const int cg = b * 64 + cs;
        __syncthreads();
#pragma unroll
        for (int i = 0; i < 3; ++i) { const int n = tid + 512 * i, row = n / 24, ch = n % 24;
            if (OUT) *(LAS v4u*)(lds + GT_QE + row * GT_STRIDE + 16 * ch) = *(const v4u*)(QE + (row0 + row) * GKW + hd * GDK + 8 * ch);
            *(LAS v4u*)(lds + GT_KE + row * GT_STRIDE + 16 * ch) = *(const v4u*)(KE + (row0 + row) * GKW + hd * GDK + 8 * ch);
            *(LAS v4u*)(lds + GT_V + row * GT_STRIDE + 16 * ch) = *(const v4u*)(P + (row0 + row) * GLA_NP + GP_V + hd * GDV + eh * 192 + 8 * ch); }
        __syncthreads();
        if (w < 6) {
            int lane = C.lane; asm volatile("" : "+v"(lane));
            const int r = lane & 31, h = lane >> 5;
            const LAS unsigned char* tq = lds + GT_QE; const LAS unsigned char* tk = lds + GT_KE; const LAS unsigned char* tv = lds + GT_V;
            if (OUT) {
#pragma unroll
                for (int it = 0; it < 2; ++it) {
                    f32x16 ao;
#pragma unroll
                    for (int i = 0; i < 16; ++i) ao[i] = 0.f;
#pragma unroll
                    for (int dt = 0; dt < 6; ++dt)
#pragma unroll
                        for (int s = 0; s < 2; ++s) {
                            const bf16x8 a = pack8(Sx[dt], s);
                            const LAS unsigned char* qp = tq + (32 * it + r) * GT_STRIDE + 2 * (32 * dt + 16 * s + 4 * h);
                            const s16x4 lo = *(const LAS s16x4*)qp, hi = *(const LAS s16x4*)(qp + 16);
                            const bf16x8 bq = __builtin_shufflevector(lo, hi, 0, 1, 2, 3, 4, 5, 6, 7);
                            ao = __builtin_amdgcn_mfma_f32_32x32x16_bf16(a, bq, ao, 0, 0, 0);
                        }
                    __builtin_amdgcn_sched_barrier(0);
#pragma unroll
                    for (int jt = 0; jt <= it; ++jt) {
                        f32x16 at;
#pragma unroll
                        for (int i = 0; i < 16; ++i) at[i] = 0.f;
#pragma unroll
                        for (int s = 0; s < 12; ++s) {
                            const bf16x8 a = *(const LAS bf16x8*)(tk + (32 * jt + r) * GT_STRIDE + 16 * (2 * s + h));
                            const bf16x8 bq = *(const LAS bf16x8*)(tq + (32 * it + r) * GT_STRIDE + 16 * (2 * s + h));
                            at = __builtin_amdgcn_mfma_f32_32x32x16_bf16(a, bq, at, 0, 0, 0);
                        }
                        if (jt == it) {
#pragma unroll
                            for (int i = 0; i < 16; ++i) if (((i & 3) + 8 * (i >> 2) + 4 * h) > r) at[i] = 0.f;
                        }
#pragma unroll
                        for (int s = 0; s < 2; ++s) {
                            const bf16x8 bp = pack8(at, s);
                            const s16x4 lo = tr4(tv, 32 * jt + 16 * s + 4 * h, 32 * w, lane), hi = tr4(tv, 32 * jt + 16 * s + 8 + 4 * h, 32 * w, lane);
                            const bf16x8 av = __builtin_shufflevector(lo, hi, 0, 1, 2, 3, 4, 5, 6, 7);
                            ao = __builtin_amdgcn_mfma_f32_32x32x16_bf16(av, bp, ao, 0, 0, 0);
                        }
                    }
                    __builtin_amdgcn_sched_barrier(0);
                    float* op = GO + (row0 + 32 * it + r) * GVW + hd * GDV + eh * 192 + 32 * w + 4 * h;
#pragma unroll
                    for (int g = 0; g < 4; ++g) *(f32x4*)(op + 8 * g) = (f32x4){ao[4 * g], ao[4 * g + 1], ao[4 * g + 2], ao[4 * g + 3]};
                }
            }
            __builtin_amdgcn_sched_barrier(0);
            bf16x8 bv[4];
#pragma unroll
            for (int ks = 0; ks < 4; ++ks) { const s16x4 lo = tr4(tv, 16 * ks + 8 * h, 32 * w, lane), hi = tr4(tv, 16 * ks + 8 * h + 4, 32 * w, lane);
                bv[ks] = __builtin_shufflevector(lo, hi, 0, 1, 2, 3, 4, 5, 6, 7); }
            const float* dlp = DL + (size_t)cg * GKW + hd * GDK;
#pragma unroll
            for (int dt = 0; dt < 6; ++dt) {
#pragma unroll
                for (int ks = 0; ks < 4; ++ks) { const s16x4 lo = tr4(tk, 16 * ks + 8 * h, 32 * dt, lane), hi = tr4(tk, 16 * ks + 8 * h + 4, 32 * dt, lane);
                    const bf16x8 ak = __builtin_shufflevector(lo, hi, 0, 1, 2, 3, 4, 5, 6, 7);
                    Sx[dt] = __builtin_amdgcn_mfma_f32_32x32x16_bf16(ak, bv[ks], Sx[dt], 0, 0, 0); }
#pragma unroll
                for (int g = 0; g < 4; ++g) { const f32x4 dv = *(const f32x4*)(dlp + 32 * dt + 8 * g + 4 * h);
#pragma unroll
                    for (int j = 0; j < 4; ++j) Sx[dt][4 * g + j] *= dv[j]; }
            }
        } else if (!OUT && w == 6) {
            const float* dlp = DL + (size_t)cg * GKW + hd * GDK;
#pragma unroll
            for (int i = 0; i < 3; ++i) dacc[i] *= dlp[lane + 64 * i];
        }
    }
    if (!OUT) {
        if (w < 6) { float* sl = SLOC + ((((size_t)(bh * GSEG + seg) * 2 + eh) * 6 + w) * 6) * 1024;
#pragma unroll
            for (int dt = 0; dt < 6; ++dt)
#pragma unroll
                for (int i = 0; i < 16; ++i) sl[(dt * 16 + i) * 64 + lane] = Sx[dt][i]; }
        else if (w == 6 && eh == 0) {
#pragma unroll
            for (int i = 0; i < 3; ++i) DSEG[(size_t)(bh * GSEG + seg) * GDK + lane + 64 * i] = dacc[i]; }
    }
}
__device__ __forceinline__ void p13a_gla_local(const Ctx& C) { for (int u = blockIdx.x; u < 256; u += C.G) if ((u & 7) != 7) gla_unit<false>(C, u); }
__device__ __forceinline__ void p13b_gla_out(const Ctx& C) { for (int u = blockIdx.x; u < 256; u += C.G) gla_unit<true>(C, u); }

constexpr int NPHASE = 22;
struct Args { const float* in[24]; float* out; unsigned char* ws; int ph_lo, ph_hi; };
#define PG8_ALIGN true
#define PG8_SP2 true

template <class Epi, class Sched>
__device__ __forceinline__ void run_gemm(const Ctx& C, const bf16* A, const bf16* Bt, int K, const Sched& Sd, const Epi& E) {
    pg8::Gemm g{A, Bt, 0, 0, K};
    pg8::gemm_phase<Epi, Sched, PG8_ALIGN, PG8_SP2>(C.lds + RING_OFF, g, Sd, E);
}
__device__ __forceinline__ void dense_gemm_p(const Ctx& C, const bf16* A, const bf16* Bt, int M, int N, int K, bf16* P, int ldp, float* FL, int ftile) {
    pg8::StaticOrder Sd; Sd.init(M, N, C.G, (int)blockIdx.x); pg8::EpiP E{P, ldp, FL, ftile, nullptr, 0, 1 << 30, 0}; run_gemm(C, A, Bt, K, Sd, E);
}
__device__ __forceinline__ void ph_proj0(const Ctx& C) {
    static_assert((WS_MEMN - WS_HN) % MiB == 0 && (WS_WMKV - WS_WFOX) % MiB == 0 && WS_MEMN > WS_HN && WS_WMKV > WS_WFOX, "tile-offset addressing of the second GEMM");
    constexpr int PM2 = (int)((WS_MEMN - WS_HN) / MiB), PN2 = (int)((WS_WMKV - WS_WFOX) / MiB);
    pg8::TwoGemmOrder Sd; Sd.S.init(T, FOX_NP, C.G, (int)blockIdx.x); Sd.nx2 = 4; Sd.n2 = 16; Sd.pm2 = PM2; Sd.pn2 = PN2;
    pg8::EpiP E{WSP(bf16, WS_P), FOX_NP, WSP(float, WS_FL), FP_F / 256, WSP(bf16, WS_MKV), 1024, PM2, PN2};
    run_gemm(C, WSP(bf16, WS_HN), WSP(bf16, WS_WFOX), D, Sd, E);
}
__device__ __forceinline__ void ph_wout(const Ctx& C, int layer) {
    pg8::StaticOrder Sd; Sd.init(T, D, C.G, (int)blockIdx.x);
    if (layer == 0) { pg8::EpiRes<true> E{C.in[0], WSP(bf16, WS_XB), D}; run_gemm(C, WSP(bf16, WS_CAT), WSP(bf16, WS_WOUT), D, Sd, E); }
    else { pg8::EpiRes<false> E{WSP(bf16, WS_XA), WSP(bf16, WS_XB), D}; run_gemm(C, WSP(bf16, WS_CAT), WSP(bf16, WS_WOUT) + (size_t)D * D, D, Sd, E); }
}
__device__ __forceinline__ void ph_gu(const Ctx& C, int layer) {
    const int* tilee = (const int*)(C.ws + WS_ROUTE + RT_TILEE) + layer * 256;
    pg8::MoeOrder Sd{tilee, tilee[255] * 8, C.G, (int)blockIdx.x}; pg8::EpiGU E{WSP(bf16, WS_H)};
    run_gemm(C, WSP(bf16, WS_XG), WSP(bf16, WS_WGU) + (size_t)layer * NE * 2048 * 2048, D, Sd, E);
}
__device__ __forceinline__ void ph_down(const Ctx& C, int layer) {
    const int* tilee = (const int*)(C.ws + WS_ROUTE + RT_TILEE) + layer * 256;
    pg8::MoeOrder Sd{tilee, tilee[255] * 8, C.G, (int)blockIdx.x};
    pg8::EpiDown E{(const int*)(C.ws + WS_ROUTE + RT_ROWDEST) + layer * MAXROWS, (const float*)(C.ws + WS_ROUTE + RT_ROWW), WSP(bf16, WS_YB)};
    run_gemm(C, WSP(bf16, WS_H), WSP(bf16, WS_WD) + (size_t)layer * NE * 2048 * 1024, DE, Sd, E);
}

__global__ void __launch_bounds__(NWAVES * 64, 2) fwd_kernel(Args args) {
    extern __shared__ __attribute__((aligned(16))) unsigned char lds[];
    Ctx C;
    C.lds = (LAS unsigned char*)lds;
    C.tid = threadIdx.x; C.lane = C.tid & 63; C.wave = __builtin_amdgcn_readfirstlane(C.tid >> 6);
    C.G = gridDim.x; C.gw = blockIdx.x * NWAVES + C.wave; C.NGW = C.G * NWAVES;
#pragma unroll
    for (int i = 0; i < 24; ++i) C.in[i] = args.in[i];
    C.out = args.out; C.ws = args.ws;
    volatile LAS unsigned* MISC = (volatile LAS unsigned*)(C.lds + MISC_OFF);
    for (int u = C.tid; u < (LDS_BYTES - LDSCTL_OFF) / 4; u += NWAVES * 64) ((LAS unsigned*)(C.lds + LDSCTL_OFF))[u] = 0u;
    __syncthreads();
    const int lo = args.ph_lo, hi = args.ph_hi;
    XcdBarrier bar; bar.bar = (unsigned*)(C.ws + WS_CTL) + CW_BAR; bar.x = 0; bar.st = nullptr;
    if (hi - lo > 1) bar = xcd_barrier_post((unsigned*)(C.ws + WS_CTL) + CW_BAR, MISC + 8);
#ifndef PHSEL
#define PHSEL 0xFFFFFFFFu
#endif
#define SITE(s) ((PHSEL >> (s)) & 1u)
#ifndef DUPMASK
#define DUPMASK 0u
#endif
#define DUP(s) ((DUPMASK >> (s)) & 1u)
#define IN(k) (lo <= (k) && (k) < hi)
#define SEAM(k) do { if (IN(k) && IN((k) + 1)) xcd_barrier(bar); } while (0)

    if (SITE(0) && IN(0)) p0_prologue(C);
    if (DUP(0) && IN(0)) { __syncthreads(); p0_prologue(C); }
    do { if (IN(0) && IN(2)) xcd_barrier(bar); } while (0);
#ifdef XTRA_BARRIERS
    if (hi - lo > 1) { for (int xb = 0; xb < XTRA_BARRIERS; ++xb) xcd_barrier(bar); }
#endif
    if (SITE(2) && IN(2)) ph_proj0(C);
    if (DUP(2) && IN(2)) { __syncthreads(); ph_proj0(C); }
    if (CV_STEAL && SITE(2) && IN(2) && IN(2 + 1)) cv_steal_tail(C, 0);
    SEAM(2);
    if (SITE(3) && IN(3)) p3_fox_thin(C);
    if (DUP(3) && IN(3)) { __syncthreads(); p3_fox_thin(C); }
    SEAM(3);
    if (SITE(4) && IN(4)) p4_fox_attn(C);
    if (DUP(4) && IN(4)) { __syncthreads(); p4_fox_attn(C, 1); }
    if (CV_STEAL && SITE(4) && IN(4) && IN(4 + 1)) cv_steal_tail(C, 1);
    SEAM(4);
    if (SITE(5) && IN(5)) ph_wout(C, 0);
    if (DUP(5) && IN(5)) { __syncthreads(); ph_wout(C, 0); }
    SEAM(5);
    if (SITE(6) && IN(6)) p6_router_mfma(C, 0);
    if (DUP(6) && IN(6)) { __syncthreads(); p6_router_mfma(C, 0, false); }
    SEAM(6);
    if (SITE(7) && IN(7)) p7_dispatch(C, 0);
    if (DUP(7) && IN(7)) { __syncthreads(); p7_dispatch(C, 0); }
    SEAM(7);
    if (SITE(8) && IN(8)) ph_gu(C, 0);
    if (DUP(8) && IN(8)) { __syncthreads(); ph_gu(C, 0); }
    if (CV_STEAL && SITE(8) && IN(8) && IN(8 + 1)) cv_steal_tail(C, 2);
    SEAM(8);
    if (SITE(9) && IN(9)) ph_down(C, 0);
    if (DUP(9) && IN(9)) { __syncthreads(); ph_down(C, 0); }
    if (CV_STEAL && SITE(9) && IN(9) && IN(9 + 1)) cv_steal_tail(C, 3);
    SEAM(9);
    if (SITE(10) && IN(10)) p_combine(C, WSP(bf16, WS_XA), nullptr, C.in[4] + D);
    if (DUP(10) && IN(10)) { __syncthreads(); p_combine(C, WSP(bf16, WS_XA), nullptr, C.in[4] + D); }
    SEAM(10);
    if (SITE(11) && IN(11)) dense_gemm_p(C, WSP(bf16, WS_HN), WSP(bf16, WS_WGLA), T, GLA_NP, D, WSP(bf16, WS_P), GLA_NP, WSP(float, WS_FL), GP_A / 256);
    if (DUP(11) && IN(11)) { __syncthreads(); dense_gemm_p(C, WSP(bf16, WS_HN), WSP(bf16, WS_WGLA), T, GLA_NP, D, WSP(bf16, WS_P), GLA_NP, WSP(float, WS_FL), GP_A / 256); }
    if (CV_STEAL && SITE(11) && IN(11) && IN(11 + 1)) cv_steal_tail(C, 4);
    SEAM(11);
    if (SITE(12) && IN(12)) p12_gla_prep(C);
    if (DUP(12) && IN(12)) { __syncthreads(); p12_gla_prep(C); }
    SEAM(12);
    if (SITE(13) && IN(13)) p13a_gla_local(C);
    if (DUP(13) && IN(13)) { __syncthreads(); p13a_gla_local(C); }
    SEAM(13);
#if defined(NO_MEM14)
    if (SITE(14) && IN(14)) { p13b_gla_out(C); }
#elif defined(NO_GLA14)
    if (SITE(14) && IN(14)) { p13_mem_attn(C); }
#else
    if (SITE(14) && IN(14)) { p13b_gla_out(C); p13_mem_attn(C); }
#endif
    if (DUP(14) && IN(14)) { __syncthreads(); p13b_gla_out(C); p13_mem_attn(C, 1); }
    SEAM(14);
    if (SITE(15) && IN(15)) p14_gla_onorm(C);
    if (DUP(15) && IN(15)) { __syncthreads(); p14_gla_onorm(C); }
    SEAM(15);
    if (SITE(16) && IN(16)) ph_wout(C, 1);
    if (DUP(16) && IN(16)) { __syncthreads(); ph_wout(C, 1); }
    SEAM(16);
    if (SITE(17) && IN(17)) p6_router_mfma(C, 1);
    if (DUP(17) && IN(17)) { __syncthreads(); p6_router_mfma(C, 1, false); }
    SEAM(17);
    if (SITE(18) && IN(18)) p7_dispatch(C, 1);
    if (DUP(18) && IN(18)) { __syncthreads(); p7_dispatch(C, 1); }
    SEAM(18);
    if (SITE(19) && IN(19)) ph_gu(C, 1);
    if (DUP(19) && IN(19)) { __syncthreads(); ph_gu(C, 1); }
    SEAM(19);
    if (SITE(20) && IN(20)) ph_down(C, 1);
    if (DUP(20) && IN(20)) { __syncthreads(); ph_down(C, 1); }
    SEAM(20);
    if (SITE(21) && IN(21)) p_combine(C, nullptr, C.out, nullptr);
    if (DUP(21) && IN(21)) { __syncthreads(); p_combine(C, nullptr, C.out, nullptr); }
#undef IN
#undef SEAM
}

extern "C" void kernel_launch(void* const* d_in, const int* in_sizes, int n_in, void* d_out, int out_size, void* d_ws, size_t ws_size, hipStream_t stream) {
    static int grid = 0;
    if (grid == 0) {
        if (n_in != 24 || out_size != T * D || ws_size < WS_END) { fprintf(stderr, "kernel_launch: unexpected problem (n_in %d, out %d, ws %zu < %zu)\n", n_in, out_size, ws_size, (size_t)WS_END); grid = -1; return; }
        int dev = 0, cus = 0, per_cu = 0;
        if (hipGetDevice(&dev) != hipSuccess || hipDeviceGetAttribute(&cus, hipDeviceAttributeMultiprocessorCount, dev) != hipSuccess) { grid = -1; return; }
        if (hipFuncSetAttribute((const void*)fwd_kernel, hipFuncAttributeMaxDynamicSharedMemorySize, LDS_BYTES) != hipSuccess) { fprintf(stderr, "kernel_launch: hipFuncSetAttribute failed\n"); grid = -1; return; }
        if (hipOccupancyMaxActiveBlocksPerMultiprocessor(&per_cu, (const void*)fwd_kernel, NWAVES * 64, LDS_BYTES) != hipSuccess || per_cu < 1)
            fprintf(stderr, "kernel_launch: occupancy query reports %d workgroups per CU\n", per_cu);
        (void)hipGetLastError();
        grid = cus;
    }
    if (grid < 0) return;
    if (hipMemsetAsync((char*)d_ws + WS_CTL, 0, CTL_ZERO_BYTES, stream) != hipSuccess) return;
    Args a{};
    for (int i = 0; i < 24; ++i) a.in[i] = (const float*)d_in[i];
    a.out = (float*)d_out; a.ws = (unsigned char*)d_ws;
#if MK_N_LAUNCHES == 1
    a.ph_lo = 0; a.ph_hi = NPHASE;
    hipLaunchKernelGGL(fwd_kernel, dim3(grid), dim3(NWAVES * 64), LDS_BYTES, stream, a);
#else
    for (int p = 0; p < NPHASE; ++p) { a.ph_lo = p; a.ph_hi = p + 1; hipLaunchKernelGGL(fwd_kernel, dim3(grid), dim3(NWAVES * 64), LDS_BYTES, stream, a); }
#endif
}
```

```cpp
#include <hip/hip_runtime.h>
#include <cstdio>
#include <cstdint>
#ifndef MK_N_LAUNCHES
#define MK_N_LAUNCHES 1
#endif
namespace pg8 {
#define PG8_LAS __attribute__((address_space(3)))
typedef unsigned short bf16_t;
typedef short bf16x8 __attribute__((ext_vector_type(8)));
typedef float f32x4 __attribute__((ext_vector_type(4)));
typedef unsigned u32x4 __attribute__((ext_vector_type(4)));
constexpr int BM = 256, BK = 64, HALF = 128, HTB = HALF * BK * 2  , STAGE_BYTES = 8 * HTB, NXCD = 8, WGM = 8;

__host__ __device__ __forceinline__ int lds_byte(int r, int c) { const int st = (r >> 4) * 2 + (c >> 5), rr = r & 15, cc = c & 31, ob = rr * 64 + cc * 2; return st * 1024 + (ob ^ (((ob >> 9) & 1) << 5)); }
__host__ __device__ __forceinline__ void stage_rc(int b, int& R, int& C) { const int st = b / 1024, sb = b % 1024, swz = sb ^ (((sb >> 9) & 1) << 5); R = (st >> 1) * 16 + swz / 64; C = (st & 1) * 32 + (swz % 64) / 2; }
__host__ __device__ __forceinline__ int perm32(int rho) { const int n = rho >> 4, i = rho & 15; return 8 * (i >> 2) + 4 * n + (i & 3); }

struct Unit { int pm, pn; };
struct Gemm { const bf16_t* A; const bf16_t* Bt; int M, N, K; };

struct StaticOrder {
    int nM, nN, nwg, G, c;
    __host__ __device__ void init(int M, int N, int G_, int c_) { nM = M / BM; nN = N / BM; nwg = nM * nN; G = G_; c = c_; }
    __host__ __device__ bool next(int i, Unit& u) const {
        const long L = (long)i * G + c; if (L >= nwg) return false;
        int wgid = (int)L; { const int q = nwg / NXCD, r = nwg % NXCD, xcd = wgid % NXCD, off = wgid / NXCD; wgid = (xcd < r ? xcd * (q + 1) : r * (q + 1) + (xcd - r) * q) + off; }
        const int nig = WGM * nN, gid = wgid / nig, fm = gid * WGM, gsz = (nM - fm) < WGM ? (nM - fm) : WGM;
        u.pm = fm + ((wgid % nig) % gsz); u.pn = (wgid % nig) / gsz; return true;
    }
    __device__ __forceinline__ void a_ready(const Unit&) const {}
    __device__ __forceinline__ void done(const Unit&) const {}
};
template <class Epi, class Sched, bool ALIGN_EPI = false, bool SP2 = false>
__device__ __forceinline__ void gemm_phase(PG8_LAS unsigned char* lds, const Gemm g, const Sched& S, const Epi& E) {
    const int tid = threadIdx.x, wid = __builtin_amdgcn_readfirstlane(tid >> 6), lane = tid & 63, wr = wid >> 2, wc = wid & 3, fr = lane & 15, fq = lane >> 4;
    const int K = g.K, nt = K / BK;
    unsigned voffA[2], voffB[2];
#pragma unroll
    for (int i = 0; i < 2; ++i) { int R, C; stage_rc(tid * 16 + i * 8192, R, C); const int Rb = Epi::PERM ? ((R & ~31) + perm32(R & 31)) : R;
        voffA[i] = (unsigned)(R * K + C) * 2u; voffB[i] = (unsigned)(Rb * K + C) * 2u; }
    const size_t kstep = (size_t)(BK * 2);
    const size_t hstep = (size_t)HALF * K * 2;
    const size_t tstep = 2 * hstep;
    const unsigned ldsw = (unsigned)wid * 1024u;
    const int aoff = lds_byte(wr * 64 + fr, fq * 8), boff = lds_byte(wc * 32 + fr, fq * 8);
#define PG8_SA(b, h) (((b) * 2 + (h)) * HTB)
#define PG8_SB(b, h) ((4 + (b) * 2 + (h)) * HTB)
#define PG8_STAGE(bufoff, gbase, voff) do { _Pragma("unroll") for (int _i = 0; _i < 2; ++_i) \
        __builtin_amdgcn_global_load_lds((const unsigned*)((const char*)(gbase) + (voff)[_i]), (PG8_LAS unsigned*)(lds + (bufoff) + ldsw + _i * 8192), 16, 0, 0); } while (0)
#define PG8_LDA(dst, b, h) do { _Pragma("unroll") for (int m = 0; m < 4; ++m) _Pragma("unroll") for (int k = 0; k < 2; ++k) dst[m][k] = *(const PG8_LAS bf16x8*)(lds + PG8_SA(b, h) + aoff + m * 2048 + k * 1024); } while (0)
#define PG8_LDB(dst, b, h) do { _Pragma("unroll") for (int n = 0; n < 2; ++n) _Pragma("unroll") for (int k = 0; k < 2; ++k) dst[n][k] = *(const PG8_LAS bf16x8*)(lds + PG8_SB(b, h) + boff + n * 2048 + k * 1024); } while (0)
#define PG8_MMA(ai, bj, At, Bt) do { __builtin_amdgcn_s_setprio(1); _Pragma("unroll") for (int m = 0; m < 4; ++m) _Pragma("unroll") for (int n = 0; n < 2; ++n) _Pragma("unroll") for (int k = 0; k < 2; ++k) \
        acc[ai][bj][m][n] = __builtin_amdgcn_mfma_f32_16x16x32_bf16(Bt[n][k], At[m][k], acc[ai][bj][m][n], 0, 0, 0); __builtin_amdgcn_s_setprio(0); } while (0)
#define PG8_WAIT_V(n) asm volatile("s_waitcnt vmcnt(" #n ")" ::: "memory")
#define PG8_WAIT_L(n) asm volatile("s_waitcnt lgkmcnt(" #n ")" ::: "memory")
#define PG8_BAR __builtin_amdgcn_s_barrier()
#define PG8_SCHED __builtin_amdgcn_sched_barrier(0)
    Unit cur, nxt; int ui = 0;
    if (!S.next(0, cur)) return;
    f32x4 acc[2][2][4][2];
#pragma unroll
    for (int a = 0; a < 2; ++a)
#pragma unroll
        for (int b = 0; b < 2; ++b)
#pragma unroll
            for (int m = 0; m < 4; ++m)
#pragma unroll
                for (int n = 0; n < 2; ++n) acc[a][b][m][n] = (f32x4){0.f, 0.f, 0.f, 0.f};
    bf16x8 At[4][2], B0[2][2], B1[2][2];
    const char* cA = (const char*)g.A + (size_t)cur.pm * tstep; const char* cB = (const char*)g.Bt + (size_t)cur.pn * tstep;
    S.a_ready(cur);
    if constexpr (SP2) {
        PG8_STAGE(PG8_SB(0, 0), cB, voffB); PG8_STAGE(PG8_SB(0, 1), cB + hstep, voffB); PG8_STAGE(PG8_SA(0, 0), cA, voffA); PG8_STAGE(PG8_SA(0, 1), cA + hstep, voffA);
        if (wr == 1) PG8_BAR;
        PG8_WAIT_V(2); PG8_BAR;
        PG8_STAGE(PG8_SB(1, 0), cB + kstep, voffB); PG8_STAGE(PG8_SA(1, 0), cA + kstep, voffA); PG8_STAGE(PG8_SB(1, 1), cB + hstep + kstep, voffB);
        PG8_WAIT_V(6); PG8_BAR;
    } else {
        PG8_STAGE(PG8_SB(0, 0), cB, voffB); PG8_STAGE(PG8_SA(0, 0), cA, voffA); PG8_STAGE(PG8_SB(0, 1), cB + hstep, voffB); PG8_STAGE(PG8_SA(0, 1), cA + hstep, voffA);
        if (wr == 1) PG8_BAR;
        PG8_WAIT_V(4); PG8_BAR;
        PG8_STAGE(PG8_SB(1, 0), cB + kstep, voffB); PG8_STAGE(PG8_SA(1, 0), cA + kstep, voffA); PG8_STAGE(PG8_SB(1, 1), cB + hstep + kstep, voffB);
        PG8_WAIT_V(6); PG8_BAR;
    }
    for (;;) {
        const bool has_next = S.next(ui + 1, nxt);
        const char* nA = has_next ? (const char*)g.A + (size_t)nxt.pm * tstep : cA; const char* nB = has_next ? (const char*)g.Bt + (size_t)nxt.pn * tstep : cB;
        for (int t = 0; t < nt; t += 2) {
            const bool last = (t == nt - 2);
            const char* a1 = cA + (size_t)(t + 1) * kstep;
            const char* a2 = last ? nA : cA + (size_t)(t + 2) * kstep; const char* b2 = last ? nB : cB + (size_t)(t + 2) * kstep;
            const char* a3 = a2 + kstep; const char* b3 = b2 + kstep;
            if (last && has_next) S.a_ready(nxt);
            if constexpr (SP2) {
            PG8_LDB(B0, 0, 0); PG8_LDB(B1, 0, 1); PG8_SCHED; PG8_LDA(At, 0, 0); PG8_STAGE(PG8_SA(1, 1), a1 + hstep, voffA);
            PG8_WAIT_V(8); PG8_WAIT_L(0); PG8_BAR; PG8_MMA(0, 0, At, B0); PG8_MMA(0, 1, At, B1); PG8_BAR; PG8_SCHED;
            PG8_LDA(At, 0, 1); PG8_STAGE(PG8_SB(0, 0), b2, voffB); PG8_STAGE(PG8_SB(0, 1), b2 + hstep, voffB); PG8_STAGE(PG8_SA(0, 0), a2, voffA);
            PG8_WAIT_V(8); PG8_WAIT_L(0); PG8_BAR; PG8_MMA(1, 0, At, B0); PG8_MMA(1, 1, At, B1); PG8_BAR; PG8_SCHED;
            PG8_LDB(B0, 1, 0); PG8_LDB(B1, 1, 1); PG8_SCHED; PG8_LDA(At, 1, 0); PG8_STAGE(PG8_SA(0, 1), a2 + hstep, voffA);
            PG8_WAIT_V(8); PG8_WAIT_L(0); PG8_BAR; PG8_MMA(0, 0, At, B0); PG8_MMA(0, 1, At, B1); PG8_BAR; PG8_SCHED;
            PG8_LDA(At, 1, 1); PG8_STAGE(PG8_SB(1, 0), b3, voffB); PG8_STAGE(PG8_SB(1, 1), b3 + hstep, voffB); PG8_STAGE(PG8_SA(1, 0), a3, voffA);
            PG8_WAIT_V(8); PG8_WAIT_L(0); PG8_BAR; PG8_MMA(1, 0, At, B0); PG8_MMA(1, 1, At, B1); PG8_BAR; PG8_SCHED;
            } else {
            PG8_LDB(B0, 0, 0); PG8_SCHED; PG8_LDA(At, 0, 0); PG8_STAGE(PG8_SA(1, 1), a1 + hstep, voffA);
            PG8_WAIT_L(8); PG8_BAR; PG8_WAIT_L(0); PG8_MMA(0, 0, At, B0); PG8_BAR; PG8_SCHED;
            PG8_LDB(B1, 0, 1); PG8_STAGE(PG8_SB(0, 0), b2, voffB);
            PG8_BAR; PG8_WAIT_L(0); PG8_MMA(0, 1, At, B1); PG8_BAR;
            PG8_LDA(At, 0, 1); PG8_STAGE(PG8_SA(0, 0), a2, voffA);
            PG8_BAR; PG8_WAIT_L(0); PG8_MMA(1, 0, At, B0); PG8_BAR; PG8_SCHED;
            PG8_STAGE(PG8_SB(0, 1), b2 + hstep, voffB);
            PG8_WAIT_V(6); PG8_BAR; PG8_MMA(1, 1, At, B1); PG8_BAR;
            PG8_LDB(B0, 1, 0); PG8_SCHED; PG8_LDA(At, 1, 0); PG8_STAGE(PG8_SA(0, 1), a2 + hstep, voffA);
            PG8_WAIT_L(8); PG8_BAR; PG8_WAIT_L(0); PG8_MMA(0, 0, At, B0); PG8_BAR; PG8_SCHED;
            PG8_LDB(B1, 1, 1); PG8_STAGE(PG8_SB(1, 0), b3, voffB);
            PG8_BAR; PG8_WAIT_L(0); PG8_MMA(0, 1, At, B1); PG8_BAR;
            PG8_LDA(At, 1, 1); PG8_STAGE(PG8_SA(1, 0), a3, voffA);
            PG8_BAR; PG8_WAIT_L(0); PG8_MMA(1, 0, At, B0); PG8_BAR; PG8_SCHED;
            PG8_STAGE(PG8_SB(1, 1), b3 + hstep, voffB);
            PG8_WAIT_V(6); PG8_BAR; PG8_MMA(1, 1, At, B1); PG8_BAR;
            }
        }
        if constexpr (ALIGN_EPI) { if (wr == 0) PG8_BAR; }
        if constexpr (!Epi::AFTER_DRAIN) { E(acc, cur, wr, wc, fr, fq); S.done(cur); }
        if (!has_next) break;
#pragma unroll
        for (int a = 0; a < 2; ++a)
#pragma unroll
            for (int b = 0; b < 2; ++b)
#pragma unroll
                for (int m = 0; m < 4; ++m)
#pragma unroll
                    for (int n = 0; n < 2; ++n) acc[a][b][m][n] = (f32x4){0.f, 0.f, 0.f, 0.f};
        cur = nxt; cA = nA; cB = nB; ++ui;
        if constexpr (ALIGN_EPI) { if (wr == 1) PG8_BAR; }
    }
    PG8_WAIT_V(0);
    if constexpr (!ALIGN_EPI) { if (wr == 0) PG8_BAR; }
    PG8_BAR;
    if constexpr (Epi::AFTER_DRAIN) { E.fused(acc, cur, wr, wc, fr, fq, lds, wid, lane); S.done(cur); }
#undef PG8_SA
#undef PG8_SB
#undef PG8_STAGE
#undef PG8_LDA
#undef PG8_LDB
#undef PG8_MMA
#undef PG8_WAIT_V
#undef PG8_WAIT_L
#undef PG8_BAR
#undef PG8_SCHED
}
}

#define GAS __attribute__((address_space(1)))
#define LAS __attribute__((address_space(3)))
typedef unsigned short bf16;
typedef unsigned v4u __attribute__((ext_vector_type(4)));
typedef unsigned v2u __attribute__((ext_vector_type(2)));
typedef float f32x4 __attribute__((ext_vector_type(4)));
typedef float f32x2 __attribute__((ext_vector_type(2)));
typedef short bf16x8 __attribute__((ext_vector_type(8)));
typedef float f32x16 __attribute__((ext_vector_type(16)));
typedef short s16x4 __attribute__((ext_vector_type(4)));
typedef __bf16 bf16x2_t __attribute__((ext_vector_type(2)));
#define LDS_WAIT() asm volatile("s_waitcnt lgkmcnt(0)" ::: "memory")
#define VM_WAIT() asm volatile("s_waitcnt vmcnt(0)" ::: "memory")
__device__ __forceinline__ unsigned pk2(float lo, float hi) { f32x2 v = {lo, hi}; bf16x2_t r = __builtin_convertvector(v, bf16x2_t); return __builtin_bit_cast(unsigned, r); }
__device__ __forceinline__ float bflo(unsigned u) { return __builtin_bit_cast(float, u << 16); }
__device__ __forceinline__ float bfhi(unsigned u) { return __builtin_bit_cast(float, u & 0xffff0000u); }
__device__ __forceinline__ float bf2f(bf16 b) { return __builtin_bit_cast(float, ((unsigned)b) << 16); }
__device__ __forceinline__ float wave_sum(float v) {
#pragma unroll
    for (int o = 1; o < 64; o <<= 1) v += __shfl_xor(v, o);
    return v;
}
__device__ __forceinline__ float wave_max(float v) {
#pragma unroll
    for (int o = 1; o < 64; o <<= 1) v = fmaxf(v, __shfl_xor(v, o));
    return v;
}
#define XB_TMO      128
#define XB_XCNT(j)  (256  + 64 * (j))
#define XB_XSUB(j)  (1280 + 64 * (j))
#define XB_XGEN(j)  (2304 + 64 * (j))
#define XB_TOP      3328
#define XB_TOPGEN   3392
#define XCD_BAR_WORDS 3456
#define XB_SPIN_CAP (1u << 23)

__device__ __forceinline__ unsigned xb_ld(unsigned* p)              { return __hip_atomic_load(p, __ATOMIC_RELAXED, __HIP_MEMORY_SCOPE_AGENT); }
__device__ __forceinline__ unsigned xb_add(unsigned* p, unsigned v) { return __hip_atomic_fetch_add(p, v, __ATOMIC_RELAXED, __HIP_MEMORY_SCOPE_AGENT); }
__device__ __forceinline__ unsigned xb_xcc_id() { return (unsigned)__builtin_amdgcn_s_getreg((3 << 11) | 20) & 0xFu; }
#define XB_SPIN(cond, bar) do { unsigned _sp = 0; while (cond) { __builtin_amdgcn_s_sleep(1); \
    if ((++_sp & 255u) == 0u) { if (xb_ld(&(bar)[XB_TMO])) break; if (_sp > XB_SPIN_CAP) { atomicAdd(&(bar)[XB_TMO], 1u); break; } } } } while (0)

struct XcdBarrier {
    unsigned* bar; unsigned x;
    volatile LAS unsigned* st;
};

__device__ __forceinline__ XcdBarrier xcd_barrier_post(unsigned* bar, volatile LAS unsigned* st) {
    XcdBarrier b; b.bar = bar; b.x = xb_xcc_id(); b.st = st;
    if (threadIdx.x == 0) (void)xb_add(&bar[XB_XCNT(b.x)], 1u);
    return b;
}
__device__ __forceinline__ void xcd_barrier_complete(unsigned* bar, unsigned x, unsigned& nloc, unsigned& nx) {
    const unsigned G = gridDim.x * gridDim.y * gridDim.z;
    unsigned sum, cnt, mine, sp = 0u;
    for (;;) {
        sum = 0u; cnt = 0u; mine = 0u;
#pragma unroll
        for (unsigned j = 0; j < 16; ++j) { const unsigned c = xb_ld(&bar[XB_XCNT(j)]); sum += c; cnt += (c > 0u) ? 1u : 0u; mine = (j == x) ? c : mine; }
        if (sum == G) break;
        __builtin_amdgcn_s_sleep(1);
        if ((++sp & 255u) == 0u) { if (xb_ld(&bar[XB_TMO])) break; if (sp > XB_SPIN_CAP) { atomicAdd(&bar[XB_TMO], 1u); break; } }
    }
    nloc = mine > 0u ? mine : 1u; nx = cnt > 0u ? cnt : 1u;
}

__device__ __forceinline__ void xcd_barrier(const XcdBarrier& b) {
    asm volatile("s_waitcnt vmcnt(0)" ::: "memory");
    __syncthreads();
    if (threadIdx.x == 0) {
        unsigned* bar = b.bar;
        __builtin_amdgcn_s_waitcnt(0);
        unsigned nloc = b.st[0], nx = b.st[1];
        if (nloc == 0u) { xcd_barrier_complete(bar, b.x, nloc, nx); b.st[0] = nloc; b.st[1] = nx; }
        const unsigned old = xb_add(&bar[XB_XSUB(b.x)], 1u);
        const unsigned gen = old / nloc;
        if (old + 1u == (gen + 1u) * nloc) {
            __builtin_amdgcn_fence(__ATOMIC_RELEASE, "agent");
            asm volatile("s_waitcnt vmcnt(0)" ::: "memory");
            const unsigned og = xb_add(&bar[XB_TOP], 1u);
            const unsigned tg = og / nx;
            if (og + 1u == (tg + 1u) * nx) xb_add(&bar[XB_TOPGEN], 1u);
            else XB_SPIN(xb_ld(&bar[XB_TOPGEN]) == tg, bar);
            __builtin_amdgcn_fence(__ATOMIC_ACQUIRE, "agent");
            xb_add(&bar[XB_XGEN(b.x)], 1u);
            asm volatile("s_waitcnt vmcnt(0)" ::: "memory");
        } else {
            XB_SPIN(xb_ld(&bar[XB_XGEN(b.x)]) == gen, bar);
            __builtin_amdgcn_fence(__ATOMIC_ACQUIRE, "agent");
            asm volatile("s_waitcnt vmcnt(0)" ::: "memory");
        }
    }
    __syncthreads();
}

constexpr int D = 2048, NB = 4, S = 4096, T = NB * S;
constexpr int HD = 128, FH = 12, FW = 1536, MH = 4, MW = 512, ML = 256;
constexpr int FOX_IN = 6668, FOX_NP = 6912;
constexpr int GLA_IN = 5136, GLA_NP = 5376;
constexpr int GH = 4, GDK = 192, GDV = 384, GKW = 768, GVW = 1536;
constexpr int NE = 32, DE = 1024, MAXROWS = 40960, MAXTILES = 160;
constexpr int FP_Q = 0, FP_K = 1536, FP_V = 3072, FP_OG = 4608, FP_QM = 6144, FP_F = 6656;
constexpr int GP_Q = 0, GP_K = 768, GP_V = 1536, GP_R = 3072, GP_QM = 4608, GP_A = 5120;
constexpr float RMS_EPS = 1e-6f;
constexpr int NWAVES = 8;

constexpr size_t MiB = 1u << 20;
constexpr size_t WS_CTL = 0, CTL_ZERO_BYTES = 1 * MiB;
constexpr size_t WS_ROUTE = 1 * MiB;
constexpr size_t WS_WFOX = 4 * MiB;
constexpr size_t WS_WGLA = WS_WFOX + 27 * MiB;
constexpr size_t WS_WOUT = WS_WGLA + 21 * MiB;
constexpr size_t WS_WMKV = WS_WOUT + 16 * MiB;
constexpr size_t WS_WGU = WS_WMKV + 4 * MiB;
constexpr size_t WS_WD = WS_WGU + 512 * MiB;
constexpr size_t WS_HN = WS_WD + 256 * MiB;
constexpr size_t WS_P = WS_HN + 65 * MiB;
constexpr size_t WS_CAT = WS_P + 216 * MiB;
constexpr size_t WS_XA = WS_CAT + 64 * MiB;
constexpr size_t WS_XB = WS_XA + 128 * MiB;
constexpr size_t WS_XG = WS_XB + 128 * MiB;
constexpr size_t WS_H = WS_XG + 160 * MiB;
constexpr size_t WS_YB = WS_H + 80 * MiB;
constexpr size_t WS_MEMN = WS_YB + 128 * MiB;
constexpr size_t WS_MKV = WS_MEMN + 4 * MiB;
constexpr size_t WS_MK = WS_MKV + 2 * MiB;
constexpr size_t WS_C = WS_MK + 2 * MiB;
constexpr size_t WS_FL = WS_C + 1 * MiB;
constexpr size_t WS_WR = WS_FL + 1 * MiB;
constexpr size_t WS_INV = WS_WR + 1 * MiB;
constexpr size_t WS_END = WS_INV + 1 * MiB;
constexpr size_t WS_GO = WS_XG, WS_LA = WS_H;
constexpr size_t RT_TOKE = 0;
constexpr size_t RT_TOKS = RT_TOKE + 2 * T * 4;
constexpr size_t RT_TOKW = RT_TOKS + 2 * T * 4;
constexpr size_t RT_ROWDEST = RT_TOKW + 2 * T * 4;
constexpr size_t RT_ROWW = RT_ROWDEST + 2 * MAXROWS * 4;
constexpr size_t RT_TILEE = RT_ROWW + MAXROWS * 4;
constexpr size_t RT_END = RT_TILEE + 2 * 256 * 4;
static_assert(RT_END <= 3 * MiB, "routing arrays");
constexpr int CW_BAR = 4096;
constexpr int CW_CNT = 8192;
constexpr int CW_Q0 = 8320, CW_Q1 = 8384;
constexpr int CW_CVQ = 9216, CW_PD = 9280;
static_assert((CW_PD + 64 * 16) * 4 <= (int)CTL_ZERO_BYTES, "ctl");

constexpr int RING_OFF = 0, RING_BYTES = 131072;
constexpr int TR_PITCH = 65, TR_WAVE_BYTES = 64 * TR_PITCH * 4;
constexpr int LDSCTL_OFF = 8 * TR_WAVE_BYTES, MISC_OFF = LDSCTL_OFF + 320;
constexpr int LDS_BYTES = LDSCTL_OFF + 4096;
static_assert(LDSCTL_OFF >= RING_BYTES && LDS_BYTES <= 163840, "LDS map");

namespace pg8 {
struct EpiP {
    static constexpr bool PERM = true, AFTER_DRAIN = false;
    bf16_t* P; int ldp; float* FL; int ftile; bf16_t* P2; int ldp2, pm2, pn2;
    __device__ __forceinline__ void operator()(const f32x4 (&acc)[2][2][4][2], const Unit& u, int wr, int wc, int fr, int fq) const {
        const bool second = u.pm >= pm2;
        bf16_t* O = second ? P2 : P; const int ld = second ? ldp2 : ldp;
        const int row0 = (second ? u.pm - pm2 : u.pm) * BM + wr * 64 + fr, col0 = (second ? u.pn - pn2 : u.pn) * BM + wc * 32 + 8 * fq;
#pragma unroll
        for (int ai = 0; ai < 2; ++ai)
#pragma unroll
            for (int m = 0; m < 4; ++m) { bf16_t* rowp = O + (size_t)(row0 + ai * HALF + m * 16) * ld + col0;
#pragma unroll
                for (int bj = 0; bj < 2; ++bj) { const f32x4 v0 = acc[ai][bj][m][0], v1 = acc[ai][bj][m][1];
                    u32x4 w; w.x = pk2(v0[0], v0[1]); w.y = pk2(v0[2], v0[3]); w.z = pk2(v1[0], v1[1]); w.w = pk2(v1[2], v1[3]);
                    *(u32x4*)(rowp + bj * HALF) = w; } }
        if (!second && u.pn == ftile && wc == 0 && fq < 2) {
#pragma unroll
            for (int ai = 0; ai < 2; ++ai)
#pragma unroll
                for (int m = 0; m < 4; ++m) { float* fp = FL + (size_t)(row0 + ai * HALF + m * 16) * 16 + 8 * fq;
                    *(f32x4*)(fp) = acc[ai][0][m][0]; *(f32x4*)(fp + 4) = acc[ai][0][m][1]; }
        }
    }
};
struct TwoGemmOrder {
    StaticOrder S; int nx2, n2, pm2, pn2;
    __device__ __forceinline__ bool next(int i, Unit& u) const {
        if (S.next(i, u)) return true;
        const long L = (long)i * S.G + S.c - S.nwg; if (L < 0 || L >= n2) return false;
        u.pm = pm2 + (int)(L % nx2); u.pn = pn2 + (int)(L / nx2); return true;
    }
    __device__ __forceinline__ void a_ready(const Unit&) const {}
    __device__ __forceinline__ void done(const Unit&) const {}
};
template <bool RF32> struct EpiRes {
    static constexpr bool PERM = true, AFTER_DRAIN = false;
    const void* R; bf16_t* C; int ldc;
    __device__ __forceinline__ void operator()(const f32x4 (&acc)[2][2][4][2], const Unit& u, int wr, int wc, int fr, int fq) const {
        const int row0 = u.pm * BM + wr * 64 + fr, col0 = u.pn * BM + wc * 32 + 8 * fq;
#pragma unroll
        for (int ai = 0; ai < 2; ++ai)
#pragma unroll
            for (int m = 0; m < 4; ++m) { const size_t ro = (size_t)(row0 + ai * HALF + m * 16) * ldc + col0;
#pragma unroll
                for (int bj = 0; bj < 2; ++bj) { f32x4 r0, r1;
                    if (RF32) { r0 = *(const f32x4*)((const float*)R + ro + bj * HALF); r1 = *(const f32x4*)((const float*)R + ro + bj * HALF + 4); }
                    else { const u32x4 rb = *(const u32x4*)((const bf16_t*)R + ro + bj * HALF);
                        r0 = (f32x4){bflo(rb.x), bfhi(rb.x), bflo(rb.y), bfhi(rb.y)}; r1 = (f32x4){bflo(rb.z), bfhi(rb.z), bflo(rb.w), bfhi(rb.w)}; }
                    const f32x4 v0 = acc[ai][bj][m][0] + r0, v1 = acc[ai][bj][m][1] + r1;
                    u32x4 w; w.x = pk2(v0[0], v0[1]); w.y = pk2(v0[2], v0[3]); w.z = pk2(v1[0], v1[1]); w.w = pk2(v1[2], v1[3]);
                    *(u32x4*)(C + ro + bj * HALF) = w; } }
    }
};
struct EpiGU {
    static constexpr bool PERM = true, AFTER_DRAIN = false;
    bf16_t* H;
    __device__ __forceinline__ void operator()(const f32x4 (&acc)[2][2][4][2], const Unit& u, int wr, int wc, int fr, int fq) const {
        const int row0 = u.pm * BM + wr * 64 + fr, col0 = (u.pn & 7) * HALF + wc * 32 + 8 * fq;
#pragma unroll
        for (int ai = 0; ai < 2; ++ai)
#pragma unroll
            for (int m = 0; m < 4; ++m) { bf16_t* rowp = H + (size_t)(row0 + ai * HALF + m * 16) * 1024 + col0;
                float h[8];
#pragma unroll
                for (int n = 0; n < 2; ++n)
#pragma unroll
                    for (int j = 0; j < 4; ++j) { const float g = acc[ai][0][m][n][j], uu = acc[ai][1][m][n][j]; h[4 * n + j] = g * uu / (1.0f + __expf(-g)); }
                u32x4 w; w.x = pk2(h[0], h[1]); w.y = pk2(h[2], h[3]); w.z = pk2(h[4], h[5]); w.w = pk2(h[6], h[7]);
                *(u32x4*)rowp = w; }
    }
};
struct EpiDown {
    static constexpr bool PERM = true, AFTER_DRAIN = false;
    const int* rowdest; const float* roww; bf16_t* YB;
    __device__ __forceinline__ void operator()(const f32x4 (&acc)[2][2][4][2], const Unit& u, int wr, int wc, int fr, int fq) const {
        const int row0 = u.pm * BM + wr * 64 + fr, col0 = (u.pn & 7) * BM + wc * 32 + 8 * fq;
#pragma unroll
        for (int ai = 0; ai < 2; ++ai)
#pragma unroll
            for (int m = 0; m < 4; ++m) { const int row = row0 + ai * HALF + m * 16; const int dest = rowdest[row];
                if (dest >= 0) { const float w8 = roww[row]; bf16_t* rowp = YB + (size_t)dest * D + col0;
#pragma unroll
                    for (int bj = 0; bj < 2; ++bj) { const f32x4 v0 = acc[ai][bj][m][0] * w8, v1 = acc[ai][bj][m][1] * w8;
                        u32x4 w; w.x = pk2(v0[0], v0[1]); w.y = pk2(v0[2], v0[3]); w.z = pk2(v1[0], v1[1]); w.w = pk2(v1[2], v1[3]);
                        *(u32x4*)(rowp + bj * HALF) = w; } } }
    }
};
struct MoeOrder {
    const int* tile_e; int nunits, G, c;
    __device__ __forceinline__ bool next(int i, Unit& u) const {
        const long L = (long)i * G + c; if (L >= nunits) return false;
        const int tile = (int)(L >> 3), pn = (int)(L & 7); u.pm = tile; u.pn = tile_e[tile] * 8 + pn; return true;
    }
    __device__ __forceinline__ void a_ready(const Unit&) const {}
    __device__ __forceinline__ void done(const Unit&) const {}
};
}

struct Ctx {
    LAS unsigned char* lds;
    int tid, lane, wave, gw, NGW, G;
    const float* in[24]; float* out; unsigned char* ws;
};
#define WSP(type, off) ((type*)(C.ws + (off)))

__device__ __forceinline__ void load_row(const float* xrow, int lane, f32x4 (&v)[8]) {
#pragma unroll
    for (int j = 0; j < 8; ++j) v[j] = ((const f32x4*)xrow)[lane + 64 * j];
}
__device__ __forceinline__ void load_row_bf16(const bf16* xrow, int lane, f32x4 (&v)[8]) {
#pragma unroll
    for (int j = 0; j < 8; ++j) { const v2u u = ((const v2u*)xrow)[lane + 64 * j]; v[j] = (f32x4){bflo(u.x), bfhi(u.x), bflo(u.y), bfhi(u.y)}; }
}
__device__ __forceinline__ float row_inv_rms(const f32x4 (&v)[8]) {
    float s = 0.f;
#pragma unroll
    for (int j = 0; j < 8; ++j) s += (v[j].x * v[j].x + v[j].y * v[j].y) + (v[j].z * v[j].z + v[j].w * v[j].w);
    s = wave_sum(s);
    return 1.0f / sqrtf(s * (1.0f / D) + RMS_EPS);
}
__device__ __forceinline__ void norm_store_row(bf16* orow, f32x4 (&v)[8], float inv, const float* g, int lane) {
#pragma unroll
    for (int j = 0; j < 8; ++j) { const f32x4 gg = ((const f32x4*)g)[lane + 64 * j]; v[j] = v[j] * inv * gg;
        v2u o; o.x = pk2(v[j].x, v[j].y); o.y = pk2(v[j].z, v[j].w); ((v2u*)orow)[lane + 64 * j] = o; }
}

__device__ __forceinline__ void tr_item(const float* W, int ldn, int K, bf16* WT, int drow, int k0, int n0, LAS float* scr, int lane) {
    f32x4 v[16];
#pragma unroll
    for (int i = 0; i < 16; ++i) v[i] = *(const f32x4*)(W + (size_t)(k0 + 4 * i + (lane >> 4)) * ldn + n0 + 4 * (lane & 15));
#pragma unroll
    for (int i = 0; i < 16; ++i) { LAS float* p = scr + (4 * i + (lane >> 4)) * TR_PITCH + 4 * (lane & 15); p[0] = v[i].x; p[1] = v[i].y; p[2] = v[i].z; p[3] = v[i].w; }
    LDS_WAIT(); asm volatile("" ::: "memory");
    const int c = lane >> 3;
#pragma unroll
    for (int j = 0; j < 8; ++j) { const int n = (lane & 7) + 8 * j; const LAS float* s = scr + (8 * c) * TR_PITCH + n;
        v4u o; o.x = pk2(s[0 * TR_PITCH], s[1 * TR_PITCH]); o.y = pk2(s[2 * TR_PITCH], s[3 * TR_PITCH]); o.z = pk2(s[4 * TR_PITCH], s[5 * TR_PITCH]); o.w = pk2(s[6 * TR_PITCH], s[7 * TR_PITCH]);
        *(v4u*)(WT + (size_t)(drow + n) * K + k0 + 8 * c) = o; }
    LDS_WAIT(); asm volatile("" ::: "memory");
}
__device__ __forceinline__ bool tr_group(int& r, const float* W, int ldn, int K, int c0, int nblk, bf16* WT, int drow0, LAS float* scr, int lane) {
    const int cnt = (K / 64) * nblk;
    if (r < cnt) { const int kb = r / nblk, nb = r % nblk; tr_item(W + c0, ldn, K, WT, drow0 + 64 * nb, 64 * kb, 64 * nb, scr, lane); return true; }
    r -= cnt; return false;
}
__device__ __forceinline__ void moe_cv_item(const Ctx& C, int it, LAS float* scr, int lane) {
    const int le = it / 1536, rem = it % 1536, kind = rem >> 9, r = rem & 511;
    if (kind < 2) {
        const float* W = (kind == 0 ? C.in[21] : C.in[22]) + (size_t)le * 2048 * 1024;
        const int kb = r >> 4, nb = r & 15, n0 = 64 * nb;
        bf16* WT = WSP(bf16, WS_WGU) + (size_t)le * 2048 * 2048;
        tr_item(W, 1024, 2048, WT, 256 * (n0 >> 7) + (n0 & 127) + 128 * kind, 64 * kb, n0, scr, lane);
    } else {
        const float* W = C.in[23] + (size_t)le * 1024 * 2048;
        const int kb = r >> 5, nb = r & 31;
        bf16* WT = WSP(bf16, WS_WD) + (size_t)le * 2048 * 1024;
        tr_item(W, 2048, 1024, WT, 64 * nb, 64 * kb, 64 * nb, scr, lane);
    }
}
#ifndef CV_STEAL
#define CV_STEAL 0
#endif
constexpr int CVQ_FIRST = CV_STEAL ? 32 * 1536 : 64 * 1536, CVQ_TOTAL = 64 * 1536 - CVQ_FIRST;
__device__ __forceinline__ void cv_steal(const Ctx& C, int maxn, unsigned* pd) {
    unsigned* q = (unsigned*)(C.ws + WS_CTL) + CW_CVQ;
    LAS float* scr = (LAS float*)(C.lds + C.wave * TR_WAVE_BYTES);
    for (int n = 0; n < maxn; ++n) {
        unsigned idx = 0;
        if (C.lane == 0) { if (pd && __hip_atomic_load(pd, __ATOMIC_RELAXED, __HIP_MEMORY_SCOPE_AGENT) >= (unsigned)C.G) idx = 0xffffffffu; else idx = atomicAdd(q, 1u); }
        idx = (unsigned)__builtin_amdgcn_readfirstlane((int)idx);
        if (idx >= (unsigned)CVQ_TOTAL) break;
        moe_cv_item(C, CVQ_FIRST + (int)idx, scr, C.lane);
    }
}
__device__ __forceinline__ void cv_steal_tail(const Ctx& C, int k) {
    unsigned* pd = (unsigned*)(C.ws + WS_CTL) + CW_PD + 64 * k;
    if (C.tid == 0) atomicAdd(pd, 1u);
    cv_steal(C, 1 << 20, pd);
}
__device__ __forceinline__ void p0_prologue(const Ctx& C) {
    LAS float* scr = (LAS float*)(C.lds + C.wave * TR_WAVE_BYTES);
    const int lane = C.lane;
    for (int it = C.gw; it < CVQ_FIRST; it += C.NGW) moe_cv_item(C, it, scr, lane);
    constexpr int I_FOX = 32 * (96 + 8 + 1), I_GLA = 32 * (72 + 8 + 1), I_WO = 32 * 32, I_MKV = 32 * 16;
    constexpr int OTHER = I_FOX + I_GLA + 2 * I_WO + I_MKV;
    for (int it = C.gw; it < OTHER; it += C.NGW) {
        int r = it;
        if (tr_group(r, C.in[5], FOX_IN, D, 0, 96, WSP(bf16, WS_WFOX), 0, scr, lane)) continue;
        if (tr_group(r, C.in[5], FOX_IN, D, 6156, 8, WSP(bf16, WS_WFOX), FP_QM, scr, lane)) continue;
        if (tr_group(r, C.in[5], FOX_IN, D, 6144, 1, WSP(bf16, WS_WFOX), FP_F, scr, lane)) continue;
        if (tr_group(r, C.in[9], GLA_IN, D, 0, 72, WSP(bf16, WS_WGLA), 0, scr, lane)) continue;
        if (tr_group(r, C.in[9], GLA_IN, D, 4624, 8, WSP(bf16, WS_WGLA), GP_QM, scr, lane)) continue;
        if (tr_group(r, C.in[9], GLA_IN, D, 4608, 1, WSP(bf16, WS_WGLA), GP_A, scr, lane)) continue;
        if (tr_group(r, C.in[15], D, D, 0, 32, WSP(bf16, WS_WOUT), 0, scr, lane)) continue;
        if (tr_group(r, C.in[15] + (size_t)D * D, D, D, 0, 32, WSP(bf16, WS_WOUT) + (size_t)D * D, 0, scr, lane)) continue;
        tr_group(r, C.in[3], 1024, D, 0, 16, WSP(bf16, WS_WMKV), 0, scr, lane);
    }
    for (int m = C.gw; m < T + NB * ML; m += C.NGW) {
        f32x4 v[8];
        if (m < T) { load_row(C.in[0] + (size_t)m * D, lane, v); const float inv = row_inv_rms(v); norm_store_row(WSP(bf16, WS_HN) + (size_t)m * D, v, inv, C.in[4], lane); }
        else { const int r = m - T; load_row(C.in[1] + (size_t)r * D, lane, v); const float inv = row_inv_rms(v); norm_store_row(WSP(bf16, WS_MEMN) + (size_t)r * D, v, inv, C.in[2], lane); }
    }
    for (int i = blockIdx.x * 512 + C.tid; i < 2 * 64 * D; i += C.G * 512) {
        const int k = i & (D - 1), rho = (i >> 11) & 63, layer = i >> 17;
        float v = 0.f;
        if (rho < 32) { const int hh = (rho >> 2) & 1, reg = 4 * (rho >> 3) + (rho & 3), e = (2 * hh + (reg >> 3)) * 8 + (reg & 7); v = C.in[19][((size_t)layer * D + k) * 32 + e]; }
        else if (rho < 40) v = C.in[17][((size_t)layer * D + k) * 4 + (rho & 3)];
        const unsigned hi = pk2(v, 0.f) & 0xffffu; const float lo = v - bflo(hi);
        bf16* wr = WSP(bf16, WS_WR) + (size_t)layer * 2 * 64 * D;
        wr[(size_t)rho * D + k] = (bf16)hi; wr[(size_t)(64 + rho) * D + k] = (bf16)(pk2(lo, 0.f) & 0xffffu);
    }
    { int* rd = (int*)(C.ws + WS_ROUTE + RT_ROWDEST);
      for (int i = blockIdx.x * 512 + C.tid; i < 2 * MAXROWS; i += C.G * 512) rd[i] = -1; }
}

__device__ __forceinline__ float log_sigmoid(float x) { return fminf(x, 0.f) - log1pf(expf(-fabsf(x))); }

__device__ __forceinline__ void headnorm_inplace(bf16* rowp, int col0, int nh, const float* g, int lane) {
    const float g0 = g[2 * lane], g1 = g[2 * lane + 1];
    for (int h = 0; h < nh; ++h) {
        unsigned* p = (unsigned*)(rowp + col0 + h * HD) + lane; const unsigned u = *p; const float a = bflo(u), b = bfhi(u);
        const float ss = wave_sum(a * a + b * b); const float inv = 1.0f / sqrtf(ss * (1.0f / HD) + RMS_EPS);
        *p = pk2(a * inv * g0, b * inv * g1);
    }
}
__device__ __forceinline__ void p3_fox_thin(const Ctx& C) {
    bf16* P = WSP(bf16, WS_P);
    {
        const int lane = C.lane;
        const float gq0 = C.in[7][2 * lane], gq1 = C.in[7][2 * lane + 1], gk0 = C.in[8][2 * lane], gk1 = C.in[8][2 * lane + 1], gm0 = C.in[13][2 * lane], gm1 = C.in[13][2 * lane + 1];
        for (int m = C.gw; m < T; m += C.NGW) {
            unsigned* rowp = (unsigned*)(P + (size_t)m * FOX_NP) + lane;
            unsigned u[28]; float ss[28];
#pragma unroll
            for (int i = 0; i < 28; ++i) { const int col = i < 24 ? i * HD : FP_QM + (i - 24) * HD; u[i] = rowp[col / 2]; const float a = bflo(u[i]), b = bfhi(u[i]); ss[i] = a * a + b * b; }
#pragma unroll
            for (int o = 1; o < 64; o <<= 1)
#pragma unroll
                for (int i = 0; i < 28; ++i) ss[i] += __shfl_xor(ss[i], o);
#pragma unroll
            for (int i = 0; i < 28; ++i) { const int col = i < 24 ? i * HD : FP_QM + (i - 24) * HD; const float inv = 1.0f / sqrtf(ss[i] * (1.0f / HD) + RMS_EPS);
                const float g0 = i < 12 ? gq0 : (i < 24 ? gk0 : gm0), g1 = i < 12 ? gq1 : (i < 24 ? gk1 : gm1);
                rowp[col / 2] = pk2(bflo(u[i]) * inv * g0, bfhi(u[i]) * inv * g1); }
        }
    }
    for (int it = C.gw; it < NB * ML * MH; it += C.NGW) {
        const int row = it >> 2, mh = it & 3;
        const unsigned u = *((const unsigned*)(WSP(bf16, WS_MKV) + (size_t)row * 1024 + mh * HD) + C.lane); const float a = bflo(u), b = bfhi(u);
        const float ss = wave_sum(a * a + b * b); const float inv = 1.0f / sqrtf(ss * (1.0f / HD) + RMS_EPS);
#pragma unroll
        for (int l = 0; l < 2; ++l) { const float* g = C.in[14] + l * HD;
            *((unsigned*)(WSP(bf16, WS_MK) + (size_t)l * 1024 * 512 + (size_t)row * 512 + mh * HD) + C.lane) = pk2(a * inv * g[2 * C.lane], b * inv * g[2 * C.lane + 1]); }
    }
    LAS float* sm = (LAS float*)(C.lds + RING_OFF);
    for (int bh = blockIdx.x; bh < NB * FH; bh += C.G) {
        const int b = bh / FH, h = bh % FH; const float bf = C.in[6][h];
        const float* fl = WSP(float, WS_FL) + (size_t)(b * S) * 16 + h;
        float ls[8], tot = 0.f;
#pragma unroll
        for (int i = 0; i < 8; ++i) { ls[i] = log_sigmoid(fl[(size_t)(8 * C.tid + i) * 16] + bf); tot += ls[i]; ls[i] = tot; }
        float inc = tot;
#pragma unroll
        for (int o = 1; o < 64; o <<= 1) { const float t = __shfl_up(inc, o); if (C.lane >= o) inc += t; }
        __syncthreads();
        if (C.lane == 63) sm[C.wave] = inc;
        __syncthreads();
        float woff = 0.f;
        for (int w = 0; w < C.wave; ++w) woff += sm[w];
        const float excl = woff + inc - tot;
        float* cp = WSP(float, WS_C) + (size_t)bh * S + 8 * C.tid;
#pragma unroll
        for (int i = 0; i < 8; ++i) cp[i] = excl + ls[i];
    }
}

__device__ __forceinline__ void naive_attn_row(const bf16* qptr, const bf16* Kb, int kstride, const bf16* Vb, int vstride, int nk, const float* cptr, float ct,
                                               LAS float* qs, int lane, float& o0, float& o1) {
    { const unsigned qq = *((const unsigned*)qptr + lane); qs[2 * lane] = bflo(qq); qs[2 * lane + 1] = bfhi(qq); }
    LDS_WAIT(); asm volatile("" ::: "memory");
    float m = -1e30f, l = 0.f, a0 = 0.f, a1 = 0.f;
    for (int j0 = 0; j0 < nk; j0 += 64) {
        const int j = j0 + lane; const bool valid = j < nk; const int jc = valid ? j : nk - 1;
        const bf16* kr = Kb + (size_t)jc * kstride;
        float s = 0.f;
#pragma unroll 4
        for (int d8 = 0; d8 < 16; ++d8) {
            const v4u kk = *(const v4u*)(kr + 8 * d8);
            const f32x4 qa = *(const LAS f32x4*)(qs + 8 * d8), qb = *(const LAS f32x4*)(qs + 8 * d8 + 4);
            s += bflo(kk.x) * qa.x + bfhi(kk.x) * qa.y + bflo(kk.y) * qa.z + bfhi(kk.y) * qa.w + bflo(kk.z) * qb.x + bfhi(kk.z) * qb.y + bflo(kk.w) * qb.z + bfhi(kk.w) * qb.w;
        }
        s *= 0.08838834764831845f;
        if (cptr) s += ct - cptr[jc];
        if (!valid) s = -__builtin_inff();
        const float mn = fmaxf(m, wave_max(s)); const float alpha = expf(m - mn); const float p = valid ? expf(s - mn) : 0.f;
        l = l * alpha + wave_sum(p); a0 *= alpha; a1 *= alpha; m = mn;
        const int cnt = (nk - j0) < 64 ? (nk - j0) : 64;
        for (int jj = 0; jj < cnt; ++jj) { const float pj = __shfl(p, jj); const unsigned vv = *((const unsigned*)(Vb + (size_t)(j0 + jj) * vstride) + lane); a0 += pj * bflo(vv); a1 += pj * bfhi(vv); }
    }
    o0 = a0 / l; o1 = a1 / l;
    asm volatile("" ::: "memory");
}
__device__ __forceinline__ void naive_mem_attn(const Ctx& C, const bf16* P, int ldp, int qcol, int layer, int row, int mh, LAS float* qs) {
    const int b = row / S; float o0, o1;
    naive_attn_row(P + (size_t)row * ldp + qcol + mh * HD, WSP(bf16, WS_MK) + (size_t)layer * 1024 * 512 + (size_t)(b * ML) * 512 + mh * HD, 512,
                   WSP(bf16, WS_MKV) + (size_t)(b * ML) * 1024 + 512 + mh * HD, 1024, ML, nullptr, 0.f, qs, C.lane, o0, o1);
    *((unsigned*)(WSP(bf16, WS_CAT) + (size_t)row * D + FW + mh * HD) + C.lane) = pk2(o0, o1);
}
__device__ __forceinline__ void p4_fox_attn_naive(const Ctx& C) {
    LAS float* qs = (LAS float*)(C.lds + RING_OFF + C.wave * 16384);
    const bf16* P = WSP(bf16, WS_P);
    for (int it = C.gw; it < T * 16; it += C.NGW) {
        const int hh = it / T, row = it % T;
        if (hh < FH) {
            const int b = row / S, t = row % S; float o0, o1;
            const float* cp = WSP(float, WS_C) + (size_t)(b * FH + hh) * S;
            naive_attn_row(P + (size_t)row * FOX_NP + FP_Q + hh * HD, P + (size_t)(b * S) * FOX_NP + FP_K + hh * HD, FOX_NP, P + (size_t)(b * S) * FOX_NP + FP_V + hh * HD, FOX_NP,
                           t + 1, cp, cp[t], qs, C.lane, o0, o1);
            const unsigned og = *((const unsigned*)(P + (size_t)row * FOX_NP + FP_OG + hh * HD) + C.lane);
            const float g0 = 1.0f / (1.0f + expf(-bflo(og))), g1 = 1.0f / (1.0f + expf(-bfhi(og)));
            *((unsigned*)(WSP(bf16, WS_CAT) + (size_t)row * D + hh * HD) + C.lane) = pk2(o0 * g0, o1 * g1);
        } else naive_mem_attn(C, P, FOX_NP, FP_QM, 0, row, hh - FH, qs);
    }
}

__device__ __forceinline__ void p12_gla_thin(const Ctx& C) {
    bf16* P = WSP(bf16, WS_P);
    const float* w2 = C.in[10]; const float* ba = C.in[11];
    for (int m = C.gw; m < T; m += C.NGW) {
        headnorm_inplace(P + (size_t)m * GLA_NP, GP_QM, MH, C.in[13] + HD, C.lane);
        const float* fl = WSP(float, WS_FL) + (size_t)m * 16;
        float al[16];
#pragma unroll
        for (int r = 0; r < 16; ++r) al[r] = fl[r];
        float* la = WSP(float, WS_LA) + (size_t)m * GKW;
#pragma unroll 1
        for (int j = 0; j < 12; ++j) { const int c = C.lane + 64 * j; float s = ba[c];
#pragma unroll
            for (int r = 0; r < 16; ++r) s += al[r] * w2[r * GKW + c];
            la[c] = expf(log_sigmoid(s) * (1.0f / 16.0f)); }
    }
}
__device__ __forceinline__ void p13_gla_naive(const Ctx& C) {
    const bf16* P = WSP(bf16, WS_P); const float* LA = WSP(float, WS_LA); float* GO = WSP(float, WS_GO);
    const int lane = C.lane;
    for (int it = C.gw; it < NB * GH * 128; it += C.NGW) {
        const int bh = it >> 7, e0 = (it & 127) * 3, b = bh >> 2, h = bh & 3;
        float st[3][3];
#pragma unroll
        for (int i = 0; i < 3; ++i)
#pragma unroll
            for (int e = 0; e < 3; ++e) st[i][e] = 0.f;
        const float qsc = 0.07216878364870322f;
        for (int t0 = 0; t0 < S; t0 += 4) {
            float a[4][3], k[4][3], q[4][3], v[4][3];
#pragma unroll
            for (int u = 0; u < 4; ++u) { const size_t row = (size_t)(b * S + t0 + u);
#pragma unroll
                for (int i = 0; i < 3; ++i) { const int d = lane + 64 * i;
                    a[u][i] = LA[row * GKW + h * GDK + d]; k[u][i] = bf2f(P[row * GLA_NP + GP_K + h * GDK + d]); q[u][i] = bf2f(P[row * GLA_NP + GP_Q + h * GDK + d]) * qsc; }
#pragma unroll
                for (int e = 0; e < 3; ++e) v[u][e] = bf2f(P[row * GLA_NP + GP_V + h * GDV + e0 + e]); }
#pragma unroll
            for (int u = 0; u < 4; ++u) { float o[3] = {0.f, 0.f, 0.f};
#pragma unroll
                for (int i = 0; i < 3; ++i)
#pragma unroll
                    for (int e = 0; e < 3; ++e) { st[i][e] = a[u][i] * st[i][e] + k[u][i] * v[u][e]; o[e] += q[u][i] * st[i][e]; }
#pragma unroll
                for (int e = 0; e < 3; ++e) o[e] = wave_sum(o[e]);
                if (lane < 3) GO[(size_t)(b * S + t0 + u) * GVW + h * GDV + e0 + lane] = lane == 0 ? o[0] : (lane == 1 ? o[1] : o[2]); }
        }
    }
}
__device__ __forceinline__ void p14_gla_onorm(const Ctx& C) {
    const bf16* __restrict__ P = WSP(bf16, WS_P); const float* __restrict__ GO = WSP(float, WS_GO); const float* __restrict__ og = C.in[12]; bf16* __restrict__ CAT = WSP(bf16, WS_CAT);
    const int lane = C.lane;
    float g0[3], g1[3];
#pragma unroll
    for (int i = 0; i < 3; ++i) { g0[i] = og[128 * i + 2 * lane]; g1[i] = og[128 * i + 2 * lane + 1]; }
    for (int m = C.gw; m < T; m += C.NGW) {
        f32x2 x[4][3]; unsigned ru[4][3]; float ss[4];
#pragma unroll
        for (int h = 0; h < GH; ++h) { ss[h] = 0.f;
#pragma unroll
            for (int i = 0; i < 3; ++i) { x[h][i] = *((const f32x2*)(GO + (size_t)m * GVW + h * GDV + 128 * i) + lane); ss[h] += x[h][i].x * x[h][i].x + x[h][i].y * x[h][i].y;
                ru[h][i] = *((const unsigned*)(P + (size_t)m * GLA_NP + GP_R + h * GDV + 128 * i) + lane); } }
#pragma unroll
        for (int o = 1; o < 64; o <<= 1)
#pragma unroll
            for (int h = 0; h < GH; ++h) ss[h] += __shfl_xor(ss[h], o);
#pragma unroll
        for (int h = 0; h < GH; ++h) { const float inv = 1.0f / sqrtf(ss[h] * (1.0f / GDV) + RMS_EPS);
#pragma unroll
            for (int i = 0; i < 3; ++i) { const float r0 = bflo(ru[h][i]), r1 = bfhi(ru[h][i]);
                const float y0 = x[h][i].x * inv * g0[i] * (r0 / (1.0f + __expf(-r0))), y1 = x[h][i].y * inv * g1[i] * (r1 / (1.0f + __expf(-r1)));
                *((unsigned*)(CAT + (size_t)m * D + h * GDV + 128 * i) + lane) = pk2(y0, y1); } }
    }
}

__device__ __forceinline__ void p6_router(const Ctx& C, int layer, bool commit = true) {
    const float* X = WSP(float, WS_XB); const float* g = C.in[16] + layer * D;
    const float* wg = C.in[17] + (size_t)layer * D * 4; const float* we = C.in[19] + (size_t)layer * D * 32;
    const float* bg = C.in[18] + layer * 4; const float* be = C.in[20] + layer * 32;
    unsigned* cnt = (unsigned*)(C.ws + WS_CTL) + CW_CNT + layer * 32;
    int* toke = (int*)(C.ws + WS_ROUTE + RT_TOKE); int* toks = (int*)(C.ws + WS_ROUTE + RT_TOKS); float* tokw = (float*)(C.ws + WS_ROUTE + RT_TOKW);
    const int lane = C.lane;
    LAS float* hs = (LAS float*)(C.lds + RING_OFF + C.wave * 16384);
    for (int pr = C.gw; pr < T / 2; pr += C.NGW) {
        {
            f32x4 x0[8], x1[8];
            load_row(X + (size_t)(2 * pr) * D, lane, x0); load_row(X + (size_t)(2 * pr + 1) * D, lane, x1);
            const float i0 = row_inv_rms(x0), i1 = row_inv_rms(x1);
            norm_store_row(WSP(bf16, WS_HN) + (size_t)(2 * pr) * D, x0, i0, g, lane);
            norm_store_row(WSP(bf16, WS_HN) + (size_t)(2 * pr + 1) * D, x1, i1, g, lane);
#pragma unroll
            for (int j = 0; j < 8; ++j) { ((LAS f32x4*)hs)[lane + 64 * j] = x0[j]; ((LAS f32x4*)(hs + D))[lane + 64 * j] = x1[j]; }
        }
        LDS_WAIT(); asm volatile("" ::: "memory");
        float a0[36], a1[36];
#pragma unroll
        for (int n = 0; n < 36; ++n) { a0[n] = 0.f; a1[n] = 0.f; }
#pragma unroll 2
        for (int kk = 0; kk < 32; ++kk) {
            const int k = lane + 64 * kk; const float h0 = hs[k], h1 = hs[D + k];
            const f32x4 w4 = *(const f32x4*)(wg + (size_t)k * 4);
#pragma unroll
            for (int n = 0; n < 4; ++n) { a0[n] += h0 * w4[n]; a1[n] += h1 * w4[n]; }
#pragma unroll
            for (int q = 0; q < 8; ++q) { const f32x4 w = *(const f32x4*)(we + (size_t)k * 32 + 4 * q);
#pragma unroll
                for (int n = 0; n < 4; ++n) { a0[4 + 4 * q + n] += h0 * w[n]; a1[4 + 4 * q + n] += h1 * w[n]; } }
        }
        asm volatile("" ::: "memory");
#pragma unroll
        for (int n = 0; n < 36; ++n) { a0[n] = wave_sum(a0[n]); a1[n] = wave_sum(a1[n]); }
#pragma unroll
        for (int rr = 0; rr < 2; ++rr) {
            float lg[36];
#pragma unroll
            for (int n = 0; n < 36; ++n) lg[n] = rr == 0 ? a0[n] : a1[n];
            float gl[4]; int gi = 0; float gm;
#pragma unroll
            for (int n = 0; n < 4; ++n) gl[n] = lg[n] + bg[n];
            gm = gl[0];
#pragma unroll
            for (int n = 1; n < 4; ++n) if (gl[n] > gm) { gm = gl[n]; gi = n; }
            float gs = 0.f;
#pragma unroll
            for (int n = 0; n < 4; ++n) gs += expf(gl[n] - gm);
            const float gp = 1.0f / gs;
            float ev[8];
#pragma unroll
            for (int j = 0; j < 8; ++j) { const float v0 = lg[4 + j] + be[j], v1 = lg[12 + j] + be[8 + j], v2 = lg[20 + j] + be[16 + j], v3 = lg[28 + j] + be[24 + j];
                ev[j] = gi == 0 ? v0 : (gi == 1 ? v1 : (gi == 2 ? v2 : v3)); }
            int e1 = 0; float m1 = ev[0];
#pragma unroll
            for (int j = 1; j < 8; ++j) if (ev[j] > m1) { m1 = ev[j]; e1 = j; }
            int e2 = -1; float m2 = -__builtin_inff();
#pragma unroll
            for (int j = 0; j < 8; ++j) if (j != e1 && ev[j] > m2) { m2 = ev[j]; e2 = j; }
            const float z = expf(m2 - m1); const float w1 = gp / (1.0f + z), w2 = gp * z / (1.0f + z);
            if (lane == 0) {
                const int tok = 2 * pr + rr; const int id1 = gi * 8 + e1, id2 = gi * 8 + e2;
                if (commit) { const unsigned s1 = atomicAdd(cnt + id1, 1u), s2 = atomicAdd(cnt + id2, 1u); toks[2 * tok] = (int)s1; toks[2 * tok + 1] = (int)s2; }
                toke[2 * tok] = id1; tokw[2 * tok] = w1;
                toke[2 * tok + 1] = id2; tokw[2 * tok + 1] = w2;
            }
        }
    }
}
__device__ __forceinline__ void p6_router_mfma(const Ctx& C, int layer, bool commit = true) {
    const bf16* X = WSP(bf16, WS_XB); const float* g = C.in[16] + layer * D;
    const bf16* WR = WSP(bf16, WS_WR) + (size_t)layer * 2 * 64 * D;
    const float* bg = C.in[18] + layer * 4; const float* be = C.in[20] + layer * 32;
    unsigned* cnt = (unsigned*)(C.ws + WS_CTL) + CW_CNT + layer * 32;
    int* toke = (int*)(C.ws + WS_ROUTE + RT_TOKE); int* toks = (int*)(C.ws + WS_ROUTE + RT_TOKS); float* tokw = (float*)(C.ws + WS_ROUTE + RT_TOKW);
    float* INV = WSP(float, WS_INV);
    const int lane = C.lane, r = lane & 31, h = lane >> 5;
    for (int task = C.wave * C.G + blockIdx.x; task < T / 32; task += C.NGW) {
        const int row = 32 * task + r;
        const bf16* xp = X + (size_t)row * D + 8 * h; const float* gp = g + 8 * h;
        const bf16* w0 = WR + (size_t)r * D + 8 * h;
        f32x16 acc0, acc1;
#pragma unroll
        for (int i = 0; i < 16; ++i) { acc0[i] = 0.f; acc1[i] = 0.f; }
        float ss = 0.f;
#pragma unroll 4
        for (int s = 0; s < D / 16; ++s) {
            const v4u xr = *(const v4u*)(xp + 16 * s);
            const f32x4 xa = (f32x4){bflo(xr.x), bfhi(xr.x), bflo(xr.y), bfhi(xr.y)}, xb = (f32x4){bflo(xr.z), bfhi(xr.z), bflo(xr.w), bfhi(xr.w)};
            const f32x4 ga = *(const f32x4*)(gp + 16 * s), gb = *(const f32x4*)(gp + 16 * s + 4);
            ss += (xa.x * xa.x + xa.y * xa.y) + (xa.z * xa.z + xa.w * xa.w) + (xb.x * xb.x + xb.y * xb.y) + (xb.z * xb.z + xb.w * xb.w);
            const f32x4 va = xa * ga, vb = xb * gb;
            v4u hi; hi.x = pk2(va.x, va.y); hi.y = pk2(va.z, va.w); hi.z = pk2(vb.x, vb.y); hi.w = pk2(vb.z, vb.w);
            v4u lo; lo.x = pk2(va.x - bflo(hi.x), va.y - bfhi(hi.x)); lo.y = pk2(va.z - bflo(hi.y), va.w - bfhi(hi.y));
            lo.z = pk2(vb.x - bflo(hi.z), vb.y - bfhi(hi.z)); lo.w = pk2(vb.z - bflo(hi.w), vb.w - bfhi(hi.w));
            const bf16x8 xh = __builtin_bit_cast(bf16x8, hi), xl = __builtin_bit_cast(bf16x8, lo);
            const bf16x8 a0h = *(const bf16x8*)(w0 + 16 * s), a1h = *(const bf16x8*)(w0 + (size_t)32 * D + 16 * s);
            const bf16x8 a0l = *(const bf16x8*)(w0 + (size_t)64 * D + 16 * s), a1l = *(const bf16x8*)(w0 + (size_t)96 * D + 16 * s);
            acc0 = __builtin_amdgcn_mfma_f32_32x32x16_bf16(a0h, xh, acc0, 0, 0, 0); acc1 = __builtin_amdgcn_mfma_f32_32x32x16_bf16(a1h, xh, acc1, 0, 0, 0);
            acc0 = __builtin_amdgcn_mfma_f32_32x32x16_bf16(a0l, xh, acc0, 0, 0, 0); acc1 = __builtin_amdgcn_mfma_f32_32x32x16_bf16(a1l, xh, acc1, 0, 0, 0);
            acc0 = __builtin_amdgcn_mfma_f32_32x32x16_bf16(a0h, xl, acc0, 0, 0, 0); acc1 = __builtin_amdgcn_mfma_f32_32x32x16_bf16(a1h, xl, acc1, 0, 0, 0);
        }
        ss += __shfl_xor(ss, 32);
        const float inv = 1.0f / sqrtf(ss * (1.0f / D) + RMS_EPS);
        if (h == 0) INV[row] = inv;
        float gl[4]; int gi = 0;
#pragma unroll
        for (int n = 0; n < 4; ++n) gl[n] = acc1[n] * inv + bg[n];
        float gm = gl[0];
#pragma unroll
        for (int n = 1; n < 4; ++n) if (gl[n] > gm) { gm = gl[n]; gi = n; }
        float gs = 0.f;
#pragma unroll
        for (int n = 0; n < 4; ++n) gs += expf(gl[n] - gm);
        const float gpr = 1.0f / gs;
        float ev[8];
#pragma unroll
        for (int j = 0; j < 8; ++j) ev[j] = ((gi & 1) ? acc0[8 + j] : acc0[j]) * inv + be[gi * 8 + j];
        int e1 = 0; float m1 = ev[0];
#pragma unroll
        for (int j = 1; j < 8; ++j) if (ev[j] > m1) { m1 = ev[j]; e1 = j; }
        int e2 = -1; float m2 = -__builtin_inff();
#pragma unroll
        for (int j = 0; j < 8; ++j) if (j != e1 && ev[j] > m2) { m2 = ev[j]; e2 = j; }
        const float z = expf(m2 - m1); const float w1 = gpr / (1.0f + z), w2 = gpr * z / (1.0f + z);
        if (h == (gi >> 1)) {
            const int tok = row; const int id1 = gi * 8 + e1, id2 = gi * 8 + e2;
            if (commit) { const unsigned s1 = atomicAdd(cnt + id1, 1u), s2 = atomicAdd(cnt + id2, 1u); toks[2 * tok] = (int)s1; toks[2 * tok + 1] = (int)s2; }
            toke[2 * tok] = id1; tokw[2 * tok] = w1;
            toke[2 * tok + 1] = id2; tokw[2 * tok + 1] = w2;
        }
    }
    if (CV_STEAL && commit) {
        if (layer == 0) { if (C.wave * C.G + (int)blockIdx.x >= T / 32) cv_steal(C, 4, nullptr); }
        else cv_steal(C, 1 << 20, nullptr);
    }
}
__device__ __forceinline__ void p7_dispatch(const Ctx& C, int layer) {
    const unsigned* cnt = (const unsigned*)(C.ws + WS_CTL) + CW_CNT + layer * 32;
    const int* toke = (const int*)(C.ws + WS_ROUTE + RT_TOKE); const int* toks = (const int*)(C.ws + WS_ROUTE + RT_TOKS); const float* tokw = (const float*)(C.ws + WS_ROUTE + RT_TOKW);
    int* rowdest = (int*)(C.ws + WS_ROUTE + RT_ROWDEST) + layer * MAXROWS; float* roww = (float*)(C.ws + WS_ROUTE + RT_ROWW);
    int* tilee = (int*)(C.ws + WS_ROUTE + RT_TILEE) + layer * 256;
    const int lane = C.lane;
    const int c = lane < NE ? (int)__hip_atomic_load(cnt + lane, __ATOMIC_RELAXED, __HIP_MEMORY_SCOPE_AGENT) : 0;
    const int padded = (c + 255) & ~255;
    int inc = padded;
#pragma unroll
    for (int o = 1; o < 64; o <<= 1) { const int t = __shfl_up(inc, o); if (lane >= o) inc += t; }
    const int pstart = inc - padded;
    if (blockIdx.x == 0 && C.wave == 0) {
        if (lane < NE) for (int tl = pstart >> 8; tl < (pstart + padded) >> 8; ++tl) tilee[tl] = lane;
        if (lane == 63) tilee[255] = inc >> 8;
    }
    const bf16* __restrict__ X = WSP(bf16, WS_XB); const float* __restrict__ INV = WSP(float, WS_INV); const float* __restrict__ g = C.in[16] + layer * D; bf16* __restrict__ XG = WSP(bf16, WS_XG);
    f32x4 gg[8];
#pragma unroll
    for (int j = 0; j < 8; ++j) gg[j] = ((const f32x4*)g)[lane + 64 * j];
    for (int tb = C.gw * 8; tb < T; tb += C.NGW * 8) {
        int e = 0, slot = 0; float w = 0.f; const int a = 2 * tb + lane;
        if (lane < 16) { e = toke[a]; slot = toks[a]; w = tokw[a]; }
        const int dest_l = __shfl(pstart, e) + slot;
        if (lane < 16) { rowdest[dest_l] = a; roww[dest_l] = w; }
#pragma unroll 1
        for (int i = 0; i < 8; i += 2) {
            const int t0 = tb + i, t1 = tb + i + 1;
            v2u x0[8], x1[8];
#pragma unroll
            for (int j = 0; j < 8; ++j) { x0[j] = ((const v2u*)(X + (size_t)t0 * D))[lane + 64 * j]; x1[j] = ((const v2u*)(X + (size_t)t1 * D))[lane + 64 * j]; }
            const float i0 = INV[t0], i1 = INV[t1];
            const int d00 = __shfl(dest_l, 2 * i), d01 = __shfl(dest_l, 2 * i + 1), d10 = __shfl(dest_l, 2 * i + 2), d11 = __shfl(dest_l, 2 * i + 3);
#pragma unroll
            for (int j = 0; j < 8; ++j) {
                v2u o0, o1;
                o0.x = pk2(bflo(x0[j].x) * i0 * gg[j].x, bfhi(x0[j].x) * i0 * gg[j].y); o0.y = pk2(bflo(x0[j].y) * i0 * gg[j].z, bfhi(x0[j].y) * i0 * gg[j].w);
                o1.x = pk2(bflo(x1[j].x) * i1 * gg[j].x, bfhi(x1[j].x) * i1 * gg[j].y); o1.y = pk2(bflo(x1[j].y) * i1 * gg[j].z, bfhi(x1[j].y) * i1 * gg[j].w);
                ((v2u*)(XG + (size_t)d00 * D))[lane + 64 * j] = o0; ((v2u*)(XG + (size_t)d01 * D))[lane + 64 * j] = o0;
                ((v2u*)(XG + (size_t)d10 * D))[lane + 64 * j] = o1; ((v2u*)(XG + (size_t)d11 * D))[lane + 64 * j] = o1;
            }
        }
    }
}
__device__ __forceinline__ void p_combine(const Ctx& C, bf16* __restrict__ xo, float* __restrict__ fo, const float* __restrict__ g) {
    const bf16* __restrict__ YB = WSP(bf16, WS_YB); const bf16* __restrict__ xi = WSP(bf16, WS_XB); bf16* __restrict__ HN = WSP(bf16, WS_HN);
    const int lane = C.lane;
    for (int m0 = 2 * C.gw; m0 < T; m0 += 2 * C.NGW) {
        v2u xr[2][8], ya[2][8], yb[2][8];
#pragma unroll
        for (int q = 0; q < 2; ++q)
#pragma unroll
            for (int j = 0; j < 8; ++j) { const size_t m = (size_t)(m0 + q);
                xr[q][j] = ((const v2u*)(xi + m * D))[lane + 64 * j]; ya[q][j] = ((const v2u*)(YB + 2 * m * D))[lane + 64 * j]; yb[q][j] = ((const v2u*)(YB + (2 * m + 1) * D))[lane + 64 * j]; }
#pragma unroll
        for (int q = 0; q < 2; ++q) { const size_t m = (size_t)(m0 + q);
            f32x4 v[8];
#pragma unroll
            for (int j = 0; j < 8; ++j) {
                v[j].x = bflo(xr[q][j].x) + (bflo(ya[q][j].x) + bflo(yb[q][j].x)); v[j].y = bfhi(xr[q][j].x) + (bfhi(ya[q][j].x) + bfhi(yb[q][j].x));
                v[j].z = bflo(xr[q][j].y) + (bflo(ya[q][j].y) + bflo(yb[q][j].y)); v[j].w = bfhi(xr[q][j].y) + (bfhi(ya[q][j].y) + bfhi(yb[q][j].y));
                if (fo) ((f32x4*)(fo + m * D))[lane + 64 * j] = v[j];
                else { v2u o; o.x = pk2(v[j].x, v[j].y); o.y = pk2(v[j].z, v[j].w); ((v2u*)(xo + m * D))[lane + 64 * j] = o; }
            }
            if (g) { const float inv = row_inv_rms(v); norm_store_row(HN + m * D, v, inv, g, lane); }
        }
    }
}

constexpr int AT_K = 0, AT_V = 32768, AT_C = 65536, AT_U = 66560, AT_F = 66624;
constexpr float LOG2E = 1.4426950408889634f;
constexpr float AT_C2 = 0.08838834764831845f * 1.4426950408889634f;
__device__ __forceinline__ unsigned off_b(unsigned row, unsigned ch) { return 256u * row + 16u * (ch ^ (((row & 3u) << 2) | ((row >> 2) & 3u))); }

template <bool FOX>
__device__ __forceinline__ void attn_unit(LAS unsigned char* lds, const bf16* Qb, int ldq, const bf16* Kb, int ldk, const bf16* Vb, int ldv, const float* cb, float B2, int qrow0, int nkt,
                                          bf16* Ob, int ldo, const bf16* OGb, int ldog, int tid, int lane, int wave) {
    const int r = lane & 31, h = lane >> 5;
    const int qpos = qrow0 + 32 * wave + r;
    bf16x8 qf[8];
    { const bf16* qp = Qb + (size_t)(32 * wave + r) * ldq + 8 * h;
#pragma unroll
      for (int s = 0; s < 8; ++s) qf[s] = *(const bf16x8*)(qp + 16 * s); }
    const float cq2 = FOX ? cb[qpos] * LOG2E : 0.f;
    f32x16 o[4];
#pragma unroll
    for (int c = 0; c < 4; ++c)
#pragma unroll
        for (int i = 0; i < 16; ++i) o[c][i] = 0.f;
    float m = -1e30f, l = 0.f;
    const int srow = tid >> 4, sch = tid & 15;
    const unsigned so0 = off_b(srow, sch), so1 = off_b(srow + 32, sch);
    const bf16* kg = Kb + (size_t)srow * ldk + 8 * sch; const bf16* vg = Vb + (size_t)srow * ldv + 8 * sch;
    v4u kr0, kr1, vr0, vr1; float cr = 0.f;
#define AT_LOAD(kt) do { const size_t ko = (size_t)(64 * (kt)) * ldk, vo = (size_t)(64 * (kt)) * ldv; \
        kr0 = *(const v4u*)(kg + ko); kr1 = *(const v4u*)(kg + ko + (size_t)32 * ldk); vr0 = *(const v4u*)(vg + vo); vr1 = *(const v4u*)(vg + vo + (size_t)32 * ldv); \
        if (FOX && tid < 64) cr = cb[64 * (kt) + tid] * LOG2E; } while (0)
#define AT_STORE(b) do { *(LAS v4u*)(lds + AT_K + (b) * 16384 + so0) = kr0; *(LAS v4u*)(lds + AT_K + (b) * 16384 + so1) = kr1; \
        *(LAS v4u*)(lds + AT_V + (b) * 16384 + so0) = vr0; *(LAS v4u*)(lds + AT_V + (b) * 16384 + so1) = vr1; \
        if (FOX && tid < 64) *(LAS float*)(lds + AT_C + (b) * 256 + 4 * tid) = cr; } while (0)
    const int kfirst = FOX ? nkt - 1 : 0, kdir = FOX ? -1 : 1;
    AT_LOAD(kfirst); AT_STORE(0);
    if (nkt > 1) AT_LOAD(kfirst + kdir);
    __syncthreads();
    unsigned kb0 = 256u * r + 16u * ((unsigned)h ^ (((r & 3u) << 2) | ((r >> 2) & 3u)));
    const unsigned tq = (lane & 15) >> 2, tp = lane & 3, tblk = (lane >> 4) & 1;
    unsigned vb0 = 1024u * h + 256u * tq + 64u * tq + 16u * ((2u * tblk + (tp >> 1)) ^ ((unsigned)h & 3u)) + 8u * (tp & 1);
    unsigned vb1 = 2048u + 1024u * h + 256u * tq + 64u * tq + 16u * ((2u * tblk + (tp >> 1)) ^ ((2u + (unsigned)h) & 3u)) + 8u * (tp & 1);
    const int minq = qrow0 + 32 * wave;
    bool wdone = false;
    volatile LAS unsigned* flags = (volatile LAS unsigned*)(lds + AT_F);
#pragma unroll 1
    for (int it = 0; it < nkt; ++it) {
        asm volatile("" : "+v"(kb0), "+v"(vb0), "+v"(vb1));
        const int kt = kfirst + it * kdir;
        const int b = it & 1;
        const bool active = !FOX || (64 * kt <= minq + 31);
        if (FOX && active && !wdone) {
            const float ub = B2 + cq2 - *(const LAS float*)(lds + AT_C + b * 256 + 63 * 4);
            if (__all(ub - m < -160.f)) wdone = true;
        }
        if (active && !wdone) {
            f32x16 p0, p1;
#pragma unroll
            for (int i = 0; i < 16; ++i) { p0[i] = 0.f; p1[i] = 0.f; }
            const LAS unsigned char* kbuf = lds + AT_K + b * 16384;
#pragma unroll
            for (int s = 0; s < 8; ++s) {
                const bf16x8 a0 = *(const LAS bf16x8*)(kbuf + (kb0 ^ (32u * s))), a1 = *(const LAS bf16x8*)(kbuf + (kb0 ^ (32u * s)) + 8192);
                p0 = __builtin_amdgcn_mfma_f32_32x32x16_bf16(a0, qf[s], p0, 0, 0, 0);
                p1 = __builtin_amdgcn_mfma_f32_32x32x16_bf16(a1, qf[s], p1, 0, 0, 0);
            }
            if (FOX) {
                const LAS float* cbuf = (const LAS float*)(lds + AT_C + b * 256);
#pragma unroll
                for (int g = 0; g < 4; ++g) { const f32x4 c0 = *(const LAS f32x4*)(cbuf + 8 * g + 4 * h), c1 = *(const LAS f32x4*)(cbuf + 32 + 8 * g + 4 * h);
#pragma unroll
                    for (int j = 0; j < 4; ++j) { p0[4 * g + j] = fmaf(p0[4 * g + j], AT_C2, cq2 - c0[j]); p1[4 * g + j] = fmaf(p1[4 * g + j], AT_C2, cq2 - c1[j]); } }
                if (64 * kt + 63 > minq) {
                    const int dq = qpos - 64 * kt - 4 * h;
#pragma unroll
                    for (int i = 0; i < 16; ++i) { const int ci = (i & 3) + 8 * (i >> 2);
                        if (ci > dq) p0[i] = -__builtin_inff();
                        if (ci + 32 > dq) p1[i] = -__builtin_inff(); }
                }
            } else {
#pragma unroll
                for (int i = 0; i < 16; ++i) { p0[i] *= AT_C2; p1[i] *= AT_C2; }
            }
            float pmax = p0[0];
#pragma unroll
            for (int i = 1; i < 16; ++i) pmax = fmaxf(pmax, p0[i]);
#pragma unroll
            for (int i = 0; i < 16; ++i) pmax = fmaxf(pmax, p1[i]);
            pmax = fmaxf(pmax, __shfl_xor(pmax, 32));
            const float mn = fmaxf(m, pmax), alpha = __builtin_amdgcn_exp2f(m - mn);
            const bool resc = __any(mn > m);
            m = mn;
            float ps = 0.f;
#pragma unroll
            for (int i = 0; i < 16; ++i) { p0[i] = __builtin_amdgcn_exp2f(p0[i] - mn); p1[i] = __builtin_amdgcn_exp2f(p1[i] - mn); ps += p0[i] + p1[i]; }
            ps += __shfl_xor(ps, 32);
            l = l * alpha + ps;
            if (resc) {
#pragma unroll
                for (int c = 0; c < 4; ++c)
#pragma unroll
                    for (int i = 0; i < 16; ++i) o[c][i] *= alpha;
            }
            bf16x8 pf[4];
#pragma unroll
            for (int s = 0; s < 2; ++s) {
                v4u w0, w1;
                w0.x = pk2(p0[8 * s], p0[8 * s + 1]); w0.y = pk2(p0[8 * s + 2], p0[8 * s + 3]); w0.z = pk2(p0[8 * s + 4], p0[8 * s + 5]); w0.w = pk2(p0[8 * s + 6], p0[8 * s + 7]);
                w1.x = pk2(p1[8 * s], p1[8 * s + 1]); w1.y = pk2(p1[8 * s + 2], p1[8 * s + 3]); w1.z = pk2(p1[8 * s + 4], p1[8 * s + 5]); w1.w = pk2(p1[8 * s + 6], p1[8 * s + 7]);
                pf[s] = __builtin_bit_cast(bf16x8, w0); pf[2 + s] = __builtin_bit_cast(bf16x8, w1);
            }
            const LAS unsigned char* vbuf = lds + AT_V + b * 16384;
#pragma unroll
            for (int ks = 0; ks < 4; ++ks)
#pragma unroll
                for (int c = 0; c < 4; ++c) {
                    const s16x4 lo = __builtin_amdgcn_ds_read_tr16_b64_v4i16((LAS s16x4*)(vbuf + ((vb0 ^ (64u * c)) + 4096u * ks)));
                    const s16x4 hi = __builtin_amdgcn_ds_read_tr16_b64_v4i16((LAS s16x4*)(vbuf + ((vb1 ^ (64u * c)) + 4096u * ks)));
                    const bf16x8 vf = __builtin_shufflevector(lo, hi, 0, 1, 2, 3, 4, 5, 6, 7);
                    o[c] = __builtin_amdgcn_mfma_f32_32x32x16_bf16(vf, pf[ks], o[c], 0, 0, 0);
                }
        }
        if (FOX && lane == 0) flags[8 * b + wave] = wdone ? 1u : 0u;
        if (it + 1 < nkt) { AT_STORE(b ^ 1); if (it + 2 < nkt) AT_LOAD(kfirst + (it + 2) * kdir); }
        __syncthreads();
        if (FOX) { const v4u f0 = *(const LAS v4u*)(lds + AT_F + 32 * b), f1 = *(const LAS v4u*)(lds + AT_F + 32 * b + 16);
            if ((f0.x & f0.y & f0.z & f0.w & f1.x & f1.y & f1.z & f1.w) != 0u) break; }
    }
#undef AT_LOAD
#undef AT_STORE
    const float il = 1.0f / l;
    bf16* orow = Ob + (size_t)(32 * wave + r) * ldo + 4 * h;
    const bf16* grow = FOX ? OGb + (size_t)(32 * wave + r) * ldog + 4 * h : nullptr;
#pragma unroll
    for (int c = 0; c < 4; ++c)
#pragma unroll
        for (int g = 0; g < 4; ++g) {
            float y0 = o[c][4 * g] * il, y1 = o[c][4 * g + 1] * il, y2 = o[c][4 * g + 2] * il, y3 = o[c][4 * g + 3] * il;
            if (FOX) { const v2u gg = *(const v2u*)(grow + 32 * c + 8 * g);
                y0 *= 1.0f / (1.0f + __expf(-bflo(gg.x))); y1 *= 1.0f / (1.0f + __expf(-bfhi(gg.x))); y2 *= 1.0f / (1.0f + __expf(-bflo(gg.y))); y3 *= 1.0f / (1.0f + __expf(-bfhi(gg.y))); }
            v2u w; w.x = pk2(y0, y1); w.y = pk2(y2, y3);
            *(v2u*)(orow + 32 * c + 8 * g) = w;
        }
}
__device__ __forceinline__ void mem_attn_unit(const Ctx& C, int v, const bf16* P, int ldp, int qcol, int layer) {
    const int qblk = v >> 2, mh = v & 3, b = qblk >> 4;
    attn_unit<false>(C.lds + RING_OFF, P + (size_t)(qblk * 256) * ldp + qcol + mh * HD, ldp,
                     WSP(bf16, WS_MK) + (size_t)layer * 1024 * 512 + (size_t)(b * ML) * 512 + mh * HD, 512, WSP(bf16, WS_MKV) + (size_t)(b * ML) * 1024 + 512 + mh * HD, 1024,
                     nullptr, 0.f, 0, ML / 64, WSP(bf16, WS_CAT) + (size_t)(qblk * 256) * D + FW + mh * HD, D, nullptr, 0, C.tid, C.lane, C.wave);
}
__device__ __forceinline__ void p4_fox_attn(const Ctx& C, int qsel = 0) {
    const bf16* P = WSP(bf16, WS_P);
    unsigned* ctr = (unsigned*)(C.ws + WS_CTL) + CW_Q0 + 128 * qsel;
    volatile LAS unsigned* uw = (volatile LAS unsigned*)(C.lds + RING_OFF + AT_U);
    const float gqm = wave_max(fmaxf(fabsf(C.in[7][2 * C.lane]), fabsf(C.in[7][2 * C.lane + 1]))), gkm = wave_max(fmaxf(fabsf(C.in[8][2 * C.lane]), fabsf(C.in[8][2 * C.lane + 1])));
    const float B2 = 11.313708499f * gqm * gkm * LOG2E * 1.02f + 1.0f;
    for (;;) {
        __syncthreads();
        if (C.tid == 0) *uw = atomicAdd(ctr, 1u);
        __syncthreads();
        const int u = (int)*uw;
        if (u >= 768 + 256) break;
#if !defined(AT_ONLY_MEM)
        if (u < 768) {
            const int qb = 15 - u / 48, bh = u % 48, b = bh / FH, hh = bh % FH;
            const size_t rb = (size_t)(b * S + 256 * qb);
            attn_unit<true>(C.lds + RING_OFF, P + rb * FOX_NP + FP_Q + hh * HD, FOX_NP, P + (size_t)(b * S) * FOX_NP + FP_K + hh * HD, FOX_NP, P + (size_t)(b * S) * FOX_NP + FP_V + hh * HD, FOX_NP,
                           WSP(float, WS_C) + (size_t)bh * S, B2, 256 * qb, 4 * qb + 4, WSP(bf16, WS_CAT) + rb * D + hh * HD, D, P + rb * FOX_NP + FP_OG + hh * HD, FOX_NP, C.tid, C.lane, C.wave);
        } else
#endif
#if !defined(AT_ONLY_FOX)
        mem_attn_unit(C, u - 768, P, FOX_NP, FP_QM, 0);
#else
        {}
#endif
    }
}

__device__ __forceinline__ void p13_mem_attn(const Ctx& C, int qsel = 0) {
    const bf16* P = WSP(bf16, WS_P);
    unsigned* ctr = (unsigned*)(C.ws + WS_CTL) + CW_Q1 + 128 * qsel;
    volatile LAS unsigned* uw = (volatile LAS unsigned*)(C.lds + RING_OFF + AT_U);
    for (;;) {
        __syncthreads();
        if (C.tid == 0) *uw = atomicAdd(ctr, 1u);
        __syncthreads();
        const int u = (int)*uw;
        if (u >= 256) break;
        mem_attn_unit(C, u, P, GLA_NP, GP_QM, 1);
    }
}

constexpr int GT_STRIDE = 400;
constexpr int GT_QE = 0, GT_KE = 25600, GT_V = 51200;
constexpr int GSEG = 8, GCH = 8;
constexpr size_t WS_QE = WS_H, WS_KE = WS_H + 24 * MiB, WS_DL = WS_H + 48 * MiB, WS_DSEG = WS_H + 49 * MiB;
constexpr size_t WS_SLOC = WS_XG + 96 * MiB;

__device__ __forceinline__ void p12_gla_prep(const Ctx& C) {
    bf16* P = WSP(bf16, WS_P);
    for (int m = C.gw; m < T; m += C.NGW) headnorm_inplace(P + (size_t)m * GLA_NP, GP_QM, MH, C.in[13] + HD, C.lane);
    const float* __restrict__ w2 = C.in[10]; const float* __restrict__ ba = C.in[11]; const bf16* __restrict__ Pc = P;
    bf16* __restrict__ QE = WSP(bf16, WS_QE); bf16* __restrict__ KE = WSP(bf16, WS_KE); float* __restrict__ DL = WSP(float, WS_DL);
    const float qsc = 0.07216878364870322f;
    const bf16* __restrict__ HN = WSP(bf16, WS_HN); const bf16* __restrict__ WA = WSP(bf16, WS_WGLA) + (size_t)GP_A * D;
    LAS float* al = (LAS float*)(C.lds + RING_OFF);
    for (int cg = blockIdx.x; cg < T / 64; cg += C.G) {
        __syncthreads();
        if (C.wave < 2) {
            const int r = C.lane & 31, h = C.lane >> 5;
            const bf16* ap = WA + (size_t)r * D + 8 * h; const bf16* bp = HN + ((size_t)cg * 64 + 32 * C.wave + r) * D + 8 * h;
            f32x16 acc;
#pragma unroll
            for (int i = 0; i < 16; ++i) acc[i] = 0.f;
#pragma unroll 8
            for (int s = 0; s < D / 16; ++s) acc = __builtin_amdgcn_mfma_f32_32x32x16_bf16(*(const bf16x8*)(ap + 16 * s), *(const bf16x8*)(bp + 16 * s), acc, 0, 0, 0);
            LAS float* o = al + (32 * C.wave + r) * 16 + 4 * h;
            *(LAS f32x4*)o = (f32x4){acc[0], acc[1], acc[2], acc[3]}; *(LAS f32x4*)(o + 8) = (f32x4){acc[4], acc[5], acc[6], acc[7]};
        }
        __syncthreads();
        for (int c = C.tid; c < GKW; c += 512) {
            float w[16];
#pragma unroll
            for (int r = 0; r < 16; ++r) w[r] = w2[r * GKW + c];
            const float bb = ba[c]; float bc = 0.f;
#pragma unroll 1
            for (int t0 = 0; t0 < 64; t0 += 8) {
                float gl[8], qv[8], kv[8];
#pragma unroll
                for (int u = 0; u < 8; ++u) {
                    const size_t row = (size_t)cg * 64 + t0 + u;
                    const LAS float* fl = al + (t0 + u) * 16;
                    float s = bb;
#pragma unroll
                    for (int r = 0; r < 16; ++r) s += fl[r] * w[r];
                    gl[u] = log_sigmoid(s) * (1.0f / 16.0f);
                    qv[u] = bf2f(Pc[row * GLA_NP + GP_Q + c]); kv[u] = bf2f(Pc[row * GLA_NP + GP_K + c]);
                }
#pragma unroll
                for (int u = 0; u < 8; ++u) {
                    const size_t row = (size_t)cg * 64 + t0 + u;
                    bc += gl[u];
                    const float e = expf(bc);
                    QE[row * GKW + c] = (bf16)(pk2(qv[u] * e * qsc, 0.f) & 0xffffu);
                    KE[row * GKW + c] = (bf16)(pk2(kv[u] / e, 0.f) & 0xffffu);
                }
            }
            DL[(size_t)cg * GKW + c] = expf(bc);
        }
    }
}

__device__ __forceinline__ bf16x8 pack8(const f32x16& x, int s) {
    v4u w; w.x = pk2(x[8 * s], x[8 * s + 1]); w.y = pk2(x[8 * s + 2], x[8 * s + 3]); w.z = pk2(x[8 * s + 4], x[8 * s + 5]); w.w = pk2(x[8 * s + 6], x[8 * s + 7]);
    return __builtin_bit_cast(bf16x8, w);
}
__device__ __forceinline__ s16x4 tr4(const LAS unsigned char* tile, int r0, int c0, int lane) {
    const int q = (lane & 15) >> 2, p = lane & 3, blk = (lane >> 4) & 1;
    return __builtin_amdgcn_ds_read_tr16_b64_v4i16((LAS s16x4*)(tile + (r0 + q) * GT_STRIDE + 2 * (c0 + 16 * blk + 4 * p)));
}
template <bool OUT>
__device__ __forceinline__ void gla_unit(const Ctx& C, int u) {
    const int seg = u & 7, eh = (u >> 3) & 1, bh = u >> 4, b = bh >> 2, hd = bh & 3;
    const int tid = C.tid, lane = C.lane, w = C.wave, r = lane & 31, h = lane >> 5;
    LAS unsigned char* lds = C.lds + RING_OFF;
    const bf16* QE = WSP(bf16, WS_QE); const bf16* KE = WSP(bf16, WS_KE); const bf16* P = WSP(bf16, WS_P);
    const float* DL = WSP(float, WS_DL); float* DSEG = WSP(float, WS_DSEG); float* SLOC = WSP(float, WS_SLOC); float* GO = WSP(float, WS_GO);
    f32x16 Sx[6];
#pragma unroll
    for (int dt = 0; dt < 6; ++dt)
#pragma unroll
        for (int i = 0; i < 16; ++i) Sx[dt][i] = 0.f;
    if (OUT && w < 6) {
        for (int sp = 0; sp < seg; ++sp) {
            const float* sl = SLOC + ((((size_t)(bh * GSEG + sp) * 2 + eh) * 6 + w) * 6) * 1024;
            const float* dsg = DSEG + (size_t)(bh * GSEG + sp) * GDK;
#pragma unroll
            for (int dt = 0; dt < 6; ++dt)
#pragma unroll
                for (int g = 0; g < 4; ++g) { const f32x4 dv = *(const f32x4*)(dsg + 32 * dt + 8 * g + 4 * h);
#pragma unroll
                    for (int j = 0; j < 4; ++j) Sx[dt][4 * g + j] = dv[j] * Sx[dt][4 * g + j] + sl[(dt * 16 + 4 * g + j) * 64 + lane]; }
        }
    }
    float dacc[3] = {1.f, 1.f, 1.f};
#pragma unroll 1
    for (int cc = 0; cc < GCH; ++cc) {
        const int cs = seg * GCH + cc; const size_t row0 = (size_t)b * S + (size_t)cs * 64; const int cg = b * 64 + cs;
        __syncthreads();
#pragma unroll
        for (int i = 0; i < 3; ++i) { const int n = tid + 512 * i, row = n / 24, ch = n % 24;
            if (OUT) *(LAS v4u*)(lds + GT_QE + row * GT_STRIDE + 16 * ch) = *(const v4u*)(QE + (row0 + row) * GKW + hd * GDK + 8 * ch);
            *(LAS v4u*)(lds + GT_KE + row * GT_STRIDE + 16 * ch) = *(const v4u*)(KE + (row0 + row) * GKW + hd * GDK + 8 * ch);
            *(LAS v4u*)(lds + GT_V + row * GT_STRIDE + 16 * ch) = *(const v4u*)(P + (row0 + row) * GLA_NP + GP_V + hd * GDV + eh * 192 + 8 * ch); }
        __syncthreads();
        if (w < 6) {
            int lane = C.lane; asm volatile("" : "+v"(lane));
            const int r = lane & 31, h = lane >> 5;
            const LAS unsigned char* tq = lds + GT_QE; const LAS unsigned char* tk = lds + GT_KE; const LAS unsigned char* tv = lds + GT_V;
            if (OUT) {
#pragma unroll
                for (int it = 0; it < 2; ++it) {
                    f32x16 ao;
#pragma unroll
                    for (int i = 0; i < 16; ++i) ao[i] = 0.f;
#pragma unroll
                    for (int dt = 0; dt < 6; ++dt)
#pragma unroll
                        for (int s = 0; s < 2; ++s) {
                            const bf16x8 a = pack8(Sx[dt], s);
                            const LAS unsigned char* qp = tq + (32 * it + r) * GT_STRIDE + 2 * (32 * dt + 16 * s + 4 * h);
                            const s16x4 lo = *(const LAS s16x4*)qp, hi = *(const LAS s16x4*)(qp + 16);
                            const bf16x8 bq = __builtin_shufflevector(lo, hi, 0, 1, 2, 3, 4, 5, 6, 7);
                            ao = __builtin_amdgcn_mfma_f32_32x32x16_bf16(a, bq, ao, 0, 0, 0);
                        }
                    __builtin_amdgcn_sched_barrier(0);
#pragma unroll
                    for (int jt = 0; jt <= it; ++jt) {
                        f32x16 at;
#pragma unroll
                        for (int i = 0; i < 16; ++i) at[i] = 0.f;
#pragma unroll
                        for (int s = 0; s < 12; ++s) {
                            const bf16x8 a = *(const LAS bf16x8*)(tk + (32 * jt + r) * GT_STRIDE + 16 * (2 * s + h));
                            const bf16x8 bq = *(const LAS bf16x8*)(tq + (32 * it + r) * GT_STRIDE + 16 * (2 * s + h));
                            at = __builtin_amdgcn_mfma_f32_32x32x16_bf16(a, bq, at, 0, 0, 0);
                        }
                        if (jt == it) {
#pragma unroll
                            for (int i = 0; i < 16; ++i) if (((i & 3) + 8 * (i >> 2) + 4 * h) > r) at[i] = 0.f;
                        }
#pragma unroll
                        for (int s = 0; s < 2; ++s) {
                            const bf16x8 bp = pack8(at, s);
                            const s16x4 lo = tr4(tv, 32 * jt + 16 * s + 4 * h, 32 * w, lane), hi = tr4(tv, 32 * jt + 16 * s + 8 + 4 * h, 32 * w, lane);
                            const bf16x8 av = __builtin_shufflevector(lo, hi, 0, 1, 2, 3, 4, 5, 6, 7);
                            ao = __builtin_amdgcn_mfma_f32_32x32x16_bf16(av, bp, ao, 0, 0, 0);
                        }
                    }
                    __builtin_amdgcn_sched_barrier(0);
                    float* op = GO + (row0 + 32 * it + r) * GVW + hd * GDV + eh * 192 + 32 * w + 4 * h;
#pragma unroll
                    for (int g = 0; g < 4; ++g) *(f32x4*)(op + 8 * g) = (f32x4){ao[4 * g], ao[4 * g + 1], ao[4 * g + 2], ao[4 * g + 3]};
                }
            }
            __builtin_amdgcn_sched_barrier(0);
            bf16x8 bv[4];
#pragma unroll
            for (int ks = 0; ks < 4; ++ks) { const s16x4 lo = tr4(tv, 16 * ks + 8 * h, 32 * w, lane), hi = tr4(tv, 16 * ks + 8 * h + 4, 32 * w, lane);
                bv[ks] = __builtin_shufflevector(lo, hi, 0, 1, 2, 3, 4, 5, 6, 7); }
            const float* dlp = DL + (size_t)cg * GKW + hd * GDK;
#pragma unroll
            for (int dt = 0; dt < 6; ++dt) {
#pragma unroll
                for (int ks = 0; ks < 4; ++ks) { const s16x4 lo = tr4(tk, 16 * ks + 8 * h, 32 * dt, lane), hi = tr4(tk, 16 * ks + 8 * h + 4, 32 * dt, lane);
                    const bf16x8 ak = __builtin_shufflevector(lo, hi, 0, 1, 2, 3, 4, 5, 6, 7);
                    Sx[dt] = __builtin_amdgcn_mfma_f32_32x32x16_bf16(ak, bv[ks], Sx[dt], 0, 0, 0); }
#pragma unroll
                for (int g = 0; g < 4; ++g) { const f32x4 dv = *(const f32x4*)(dlp + 32 * dt + 8 * g + 4 * h);
#pragma unroll
                    for (int j = 0; j < 4; ++j) Sx[dt][4 * g + j] *= dv[j]; }
            }
        } else if (!OUT && w == 6) {
            const float* dlp = DL + (size_t)cg * GKW + hd * GDK;
#pragma unroll
            for (int i = 0; i < 3; ++i) dacc[i] *= dlp[lane + 64 * i];
        }
    }
    if (!OUT) {
        if (w < 6) { float* sl = SLOC + ((((size_t)(bh * GSEG + seg) * 2 + eh) * 6 + w) * 6) * 1024;
#pragma unroll
            for (int dt = 0; dt < 6; ++dt)
#pragma unroll
                for (int i = 0; i < 16; ++i) sl[(dt * 16 + i) * 64 + lane] = Sx[dt][i]; }
        else if (w == 6 && eh == 0) {
#pragma unroll
            for (int i = 0; i < 3; ++i) DSEG[(size_t)(bh * GSEG + seg) * GDK + lane + 64 * i] = dacc[i]; }
    }
}
__device__ __forceinline__ void p13a_gla_local(const Ctx& C) { for (int u = blockIdx.x; u < 256; u += C.G) if ((u & 7) != 7) gla_unit<false>(C, u); }
__device__ __forceinline__ void p13b_gla_out(const Ctx& C) { for (int u = blockIdx.x; u < 256; u += C.G) gla_unit<true>(C, u); }

constexpr int NPHASE = 22;
struct Args { const float* in[24]; float* out; unsigned char* ws; int ph_lo, ph_hi; };
#define PG8_ALIGN true
#define PG8_SP2 true

template <class Epi, class Sched>
__device__ __forceinline__ void run_gemm(const Ctx& C, const bf16* A, const bf16* Bt, int K, const Sched& Sd, const Epi& E) {
    pg8::Gemm g{A, Bt, 0, 0, K};
    pg8::gemm_phase<Epi, Sched, PG8_ALIGN, PG8_SP2>(C.lds + RING_OFF, g, Sd, E);
}
__device__ __forceinline__ void dense_gemm_p(const Ctx& C, const bf16* A, const bf16* Bt, int M, int N, int K, bf16* P, int ldp, float* FL, int ftile) {
    pg8::StaticOrder Sd; Sd.init(M, N, C.G, (int)blockIdx.x); pg8::EpiP E{P, ldp, FL, ftile, nullptr, 0, 1 << 30, 0}; run_gemm(C, A, Bt, K, Sd, E);
}
__device__ __forceinline__ void ph_proj0(const Ctx& C) {
    static_assert((WS_MEMN - WS_HN) % MiB == 0 && (WS_WMKV - WS_WFOX) % MiB == 0 && WS_MEMN > WS_HN && WS_WMKV > WS_WFOX, "tile-offset addressing of the second GEMM");
    constexpr int PM2 = (int)((WS_MEMN - WS_HN) / MiB), PN2 = (int)((WS_WMKV - WS_WFOX) / MiB);
    pg8::TwoGemmOrder Sd; Sd.S.init(T, FOX_NP, C.G, (int)blockIdx.x); Sd.nx2 = 4; Sd.n2 = 16; Sd.pm2 = PM2; Sd.pn2 = PN2;
    pg8::EpiP E{WSP(bf16, WS_P), FOX_NP, WSP(float, WS_FL), FP_F / 256, WSP(bf16, WS_MKV), 1024, PM2, PN2};
    run_gemm(C, WSP(bf16, WS_HN), WSP(bf16, WS_WFOX), D, Sd, E);
}
__device__ __forceinline__ void ph_wout(const Ctx& C, int layer) {
    pg8::StaticOrder Sd; Sd.init(T, D, C.G, (int)blockIdx.x);
    if (layer == 0) { pg8::EpiRes<true> E{C.in[0], WSP(bf16, WS_XB), D}; run_gemm(C, WSP(bf16, WS_CAT), WSP(bf16, WS_WOUT), D, Sd, E); }
    else { pg8::EpiRes<false> E{WSP(bf16, WS_XA), WSP(bf16, WS_XB), D}; run_gemm(C, WSP(bf16, WS_CAT), WSP(bf16, WS_WOUT) + (size_t)D * D, D, Sd, E); }
}
__device__ __forceinline__ void ph_gu(const Ctx& C, int layer) {
    const int* tilee = (const int*)(C.ws + WS_ROUTE + RT_TILEE) + layer * 256;
    pg8::MoeOrder Sd{tilee, tilee[255] * 8, C.G, (int)blockIdx.x}; pg8::EpiGU E{WSP(bf16, WS_H)};
    run_gemm(C, WSP(bf16, WS_XG), WSP(bf16, WS_WGU) + (size_t)layer * NE * 2048 * 2048, D, Sd, E);
}
__device__ __forceinline__ void ph_down(const Ctx& C, int layer) {
    const int* tilee = (const int*)(C.ws + WS_ROUTE + RT_TILEE) + layer * 256;
    pg8::MoeOrder Sd{tilee, tilee[255] * 8, C.G, (int)blockIdx.x};
    pg8::EpiDown E{(const int*)(C.ws + WS_ROUTE + RT_ROWDEST) + layer * MAXROWS, (const float*)(C.ws + WS_ROUTE + RT_ROWW), WSP(bf16, WS_YB)};
    run_gemm(C, WSP(bf16, WS_H), WSP(bf16, WS_WD) + (size_t)layer * NE * 2048 * 1024, DE, Sd, E);
}

__global__ void __launch_bounds__(NWAVES * 64, 2) fwd_kernel(Args args) {
    extern __shared__ __attribute__((aligned(16))) unsigned char lds[];
    Ctx C;
    C.lds = (LAS unsigned char*)lds;
    C.tid = threadIdx.x; C.lane = C.tid & 63; C.wave = __builtin_amdgcn_readfirstlane(C.tid >> 6);
    C.G = gridDim.x; C.gw = blockIdx.x * NWAVES + C.wave; C.NGW = C.G * NWAVES;
#pragma unroll
    for (int i = 0; i < 24; ++i) C.in[i] = args.in[i];
    C.out = args.out; C.ws = args.ws;
    volatile LAS unsigned* MISC = (volatile LAS unsigned*)(C.lds + MISC_OFF);
    for (int u = C.tid; u < (LDS_BYTES - LDSCTL_OFF) / 4; u += NWAVES * 64) ((LAS unsigned*)(C.lds + LDSCTL_OFF))[u] = 0u;
    __syncthreads();
    const int lo = args.ph_lo, hi = args.ph_hi;
    XcdBarrier bar; bar.bar = (unsigned*)(C.ws + WS_CTL) + CW_BAR; bar.x = 0; bar.st = nullptr;
    if (hi - lo > 1) bar = xcd_barrier_post((unsigned*)(C.ws + WS_CTL) + CW_BAR, MISC + 8);
#ifndef PHSEL
#define PHSEL 0xFFFFFFFFu
#endif
#define SITE(s) ((PHSEL >> (s)) & 1u)
#ifndef DUPMASK
#define DUPMASK 0u
#endif
#define DUP(s) ((DUPMASK >> (s)) & 1u)
#define IN(k) (lo <= (k) && (k) < hi)
#define SEAM(k) do { if (IN(k) && IN((k) + 1)) xcd_barrier(bar); } while (0)

    if (SITE(0) && IN(0)) p0_prologue(C);
    if (DUP(0) && IN(0)) { __syncthreads(); p0_prologue(C); }
    do { if (IN(0) && IN(2)) xcd_barrier(bar); } while (0);
#ifdef XTRA_BARRIERS
    if (hi - lo > 1) { for (int xb = 0; xb < XTRA_BARRIERS; ++xb) xcd_barrier(bar); }
#endif
    if (SITE(2) && IN(2)) ph_proj0(C);
    if (DUP(2) && IN(2)) { __syncthreads(); ph_proj0(C); }
    if (CV_STEAL && SITE(2) && IN(2) && IN(2 + 1)) cv_steal_tail(C, 0);
    SEAM(2);
    if (SITE(3) && IN(3)) p3_fox_thin(C);
    if (DUP(3) && IN(3)) { __syncthreads(); p3_fox_thin(C); }
    SEAM(3);
    if (SITE(4) && IN(4)) p4_fox_attn(C);
    if (DUP(4) && IN(4)) { __syncthreads(); p4_fox_attn(C, 1); }
    if (CV_STEAL && SITE(4) && IN(4) && IN(4 + 1)) cv_steal_tail(C, 1);
    SEAM(4);
    if (SITE(5) && IN(5)) ph_wout(C, 0);
    if (DUP(5) && IN(5)) { __syncthreads(); ph_wout(C, 0); }
    SEAM(5);
    if (SITE(6) && IN(6)) p6_router_mfma(C, 0);
    if (DUP(6) && IN(6)) { __syncthreads(); p6_router_mfma(C, 0, false); }
    SEAM(6);
    if (SITE(7) && IN(7)) p7_dispatch(C, 0);
    if (DUP(7) && IN(7)) { __syncthreads(); p7_dispatch(C, 0); }
    SEAM(7);
    if (SITE(8) && IN(8)) ph_gu(C, 0);
    if (DUP(8) && IN(8)) { __syncthreads(); ph_gu(C, 0); }
    if (CV_STEAL && SITE(8) && IN(8) && IN(8 + 1)) cv_steal_tail(C, 2);
    SEAM(8);
    if (SITE(9) && IN(9)) ph_down(C, 0);
    if (DUP(9) && IN(9)) { __syncthreads(); ph_down(C, 0); }
    if (CV_STEAL && SITE(9) && IN(9) && IN(9 + 1)) cv_steal_tail(C, 3);
    SEAM(9);
    if (SITE(10) && IN(10)) p_combine(C, WSP(bf16, WS_XA), nullptr, C.in[4] + D);
    if (DUP(10) && IN(10)) { __syncthreads(); p_combine(C, WSP(bf16, WS_XA), nullptr, C.in[4] + D); }
    SEAM(10);
    if (SITE(11) && IN(11)) dense_gemm_p(C, WSP(bf16, WS_HN), WSP(bf16, WS_WGLA), T, GP_A, D, WSP(bf16, WS_P), GLA_NP, nullptr, -1);
    if (DUP(11) && IN(11)) { __syncthreads(); dense_gemm_p(C, WSP(bf16, WS_HN), WSP(bf16, WS_WGLA), T, GP_A, D, WSP(bf16, WS_P), GLA_NP, nullptr, -1); }
    if (CV_STEAL && SITE(11) && IN(11) && IN(11 + 1)) cv_steal_tail(C, 4);
    SEAM(11);
    if (SITE(12) && IN(12)) p12_gla_prep(C);
    if (DUP(12) && IN(12)) { __syncthreads(); p12_gla_prep(C); }
    SEAM(12);
    if (SITE(13) && IN(13)) p13a_gla_local(C);
    if (DUP(13) && IN(13)) { __syncthreads(); p13a_gla_local(C); }
    SEAM(13);
#if defined(NO_MEM14)
    if (SITE(14) && IN(14)) { p13b_gla_out(C); }
#elif defined(NO_GLA14)
    if (SITE(14) && IN(14)) { p13_mem_attn(C); }
#else
    if (SITE(14) && IN(14)) { p13b_gla_out(C); p13_mem_attn(C); }
#endif
    if (DUP(14) && IN(14)) { __syncthreads(); p13b_gla_out(C); p13_mem_attn(C, 1); }
    SEAM(14);
    if (SITE(15) && IN(15)) p14_gla_onorm(C);
    if (DUP(15) && IN(15)) { __syncthreads(); p14_gla_onorm(C); }
    SEAM(15);
    if (SITE(16) && IN(16)) ph_wout(C, 1);
    if (DUP(16) && IN(16)) { __syncthreads(); ph_wout(C, 1); }
    SEAM(16);
    if (SITE(17) && IN(17)) p6_router_mfma(C, 1);
    if (DUP(17) && IN(17)) { __syncthreads(); p6_router_mfma(C, 1, false); }
    SEAM(17);
    if (SITE(18) && IN(18)) p7_dispatch(C, 1);
    if (DUP(18) && IN(18)) { __syncthreads(); p7_dispatch(C, 1); }
    SEAM(18);
    if (SITE(19) && IN(19)) ph_gu(C, 1);
    if (DUP(19) && IN(19)) { __syncthreads(); ph_gu(C, 1); }
    SEAM(19);
    if (SITE(20) && IN(20)) ph_down(C, 1);
    if (DUP(20) && IN(20)) { __syncthreads(); ph_down(C, 1); }
    SEAM(20);
    if (SITE(21) && IN(21)) p_combine(C, nullptr, C.out, nullptr);
    if (DUP(21) && IN(21)) { __syncthreads(); p_combine(C, nullptr, C.out, nullptr); }
#undef IN
#undef SEAM
}

extern "C" void kernel_launch(void* const* d_in, const int* in_sizes, int n_in, void* d_out, int out_size, void* d_ws, size_t ws_size, hipStream_t stream) {
    static int grid = 0;
    if (grid == 0) {
        if (n_in != 24 || out_size != T * D || ws_size < WS_END) { fprintf(stderr, "kernel_launch: unexpected problem (n_in %d, out %d, ws %zu < %zu)\n", n_in, out_size, ws_size, (size_t)WS_END); grid = -1; return; }
        int dev = 0, cus = 0, per_cu = 0;
        if (hipGetDevice(&dev) != hipSuccess || hipDeviceGetAttribute(&cus, hipDeviceAttributeMultiprocessorCount, dev) != hipSuccess) { grid = -1; return; }
        if (hipFuncSetAttribute((const void*)fwd_kernel, hipFuncAttributeMaxDynamicSharedMemorySize, LDS_BYTES) != hipSuccess) { fprintf(stderr, "kernel_launch: hipFuncSetAttribute failed\n"); grid = -1; return; }
        if (hipOccupancyMaxActiveBlocksPerMultiprocessor(&per_cu, (const void*)fwd_kernel, NWAVES * 64, LDS_BYTES) != hipSuccess || per_cu < 1)
            fprintf(stderr, "kernel_launch: occupancy query reports %d workgroups per CU\n", per_cu);
        (void)hipGetLastError();
        grid = cus;
    }
    if (grid < 0) return;
    if (hipMemsetAsync((char*)d_ws + WS_CTL, 0, CTL_ZERO_BYTES, stream) != hipSuccess) return;
    Args a{};
    for (int i = 0; i < 24; ++i) a.in[i] = (const float*)d_in[i];
    a.out = (float*)d_out; a.ws = (unsigned char*)d_ws;
#if MK_N_LAUNCHES == 1
    a.ph_lo = 0; a.ph_hi = NPHASE;
    hipLaunchKernelGGL(fwd_kernel, dim3(grid), dim3(NWAVES * 64), LDS_BYTES, stream, a);
#else
    for (int p = 0; p < NPHASE; ++p) { a.ph_lo = p; a.ph_hi = p + 1; hipLaunchKernelGGL(fwd_kernel, dim3(grid), dim3(NWAVES * 64), LDS_BYTES, stream, a); }
#endif
}
```

```cpp
#include <hip/hip_runtime.h>
#include <cstdio>
#include <cstdint>
#ifndef MK_N_LAUNCHES
#define MK_N_LAUNCHES 1
#endif
namespace pg8 {
#define PG8_LAS __attribute__((address_space(3)))
typedef unsigned short bf16_t;
typedef short bf16x8 __attribute__((ext_vector_type(8)));
typedef float f32x4 __attribute__((ext_vector_type(4)));
typedef unsigned u32x4 __attribute__((ext_vector_type(4)));
typedef int pg8_v4i __attribute__((ext_vector_type(4)));
constexpr int F8_SCALE_W = 121, F8_SCALE_X = 124;
constexpr int BM = 256, BK = 64, HALF = 128, HTB = HALF * BK * 2  , STAGE_BYTES = 8 * HTB, NXCD = 8, WGM = 8;

__host__ __device__ __forceinline__ int lds_byte(int r, int c) { const int st = (r >> 4) * 2 + (c >> 5), rr = r & 15, cc = c & 31, ob = rr * 64 + cc * 2; return st * 1024 + (ob ^ (((ob >> 9) & 1) << 5)); }
__host__ __device__ __forceinline__ void stage_rc(int b, int& R, int& C) { const int st = b / 1024, sb = b % 1024, swz = sb ^ (((sb >> 9) & 1) << 5); R = (st >> 1) * 16 + swz / 64; C = (st & 1) * 32 + (swz % 64) / 2; }
__host__ __device__ __forceinline__ int perm32(int rho) { const int n = rho >> 4, i = rho & 15; return 8 * (i >> 2) + 4 * n + (i & 3); }

struct Unit { int pm, pn, lb = 0, nv = 256; };
struct Gemm { const bf16_t* A; const bf16_t* Bt; int M, N, K; };

struct StaticOrder {
    int nM, nN, nwg, G, c;
    __host__ __device__ void init(int M, int N, int G_, int c_) { nM = M / BM; nN = N / BM; nwg = nM * nN; G = G_; c = c_; }
    __host__ __device__ bool next(int i, Unit& u) const {
        const long L = (long)i * G + c; if (L >= nwg) return false;
        int wgid = (int)L; { const int q = nwg / NXCD, r = nwg % NXCD, xcd = wgid % NXCD, off = wgid / NXCD; wgid = (xcd < r ? xcd * (q + 1) : r * (q + 1) + (xcd - r) * q) + off; }
        const int nig = WGM * nN, gid = wgid / nig, fm = gid * WGM, gsz = (nM - fm) < WGM ? (nM - fm) : WGM;
        u.pm = fm + ((wgid % nig) % gsz); u.pn = (wgid % nig) / gsz; return true;
    }
    __device__ __forceinline__ void a_ready(const Unit&) const {}
    __device__ __forceinline__ void done(const Unit&) const {}
};
template <class Epi, class Sched, bool ALIGN_EPI = false, bool SP2 = false, bool F8 = false, bool I8 = false, bool GATHER = false>
__device__ __forceinline__ void gemm_phase(PG8_LAS unsigned char* lds, const Gemm g, const Sched& S, const Epi& E, PG8_LAS unsigned char* gofs = nullptr) {
    const int tid = threadIdx.x, wid = __builtin_amdgcn_readfirstlane(tid >> 6), lane = tid & 63, wr = wid >> 2, wc = wid & 3, fr = lane & 15, fq = lane >> 4;
    const int K = g.K, nt = K / BK;
    unsigned voffA[2], voffB[2];
#pragma unroll
    for (int i = 0; i < 2; ++i) { int R, C; stage_rc(tid * 16 + i * 8192, R, C); const int Rb = Epi::PERM ? ((R & ~31) + perm32(R & 31)) : R;
        voffA[i] = (unsigned)(R * K + C) * 2u; voffB[i] = (unsigned)(Rb * K + C) * 2u; }
    const size_t kstep = (size_t)(BK * 2);
    const size_t hstep = (size_t)HALF * K * 2;
    const size_t tstep = 2 * hstep;
    const unsigned ldsw = (unsigned)wid * 1024u;
    const int aoff = lds_byte(wr * 64 + fr, fq * 8), boff = lds_byte(wc * 32 + fr, fq * 8);
#define PG8_SA(b, h) (((b) * 2 + (h)) * HTB)
#define PG8_SB(b, h) ((4 + (b) * 2 + (h)) * HTB)
#define PG8_STAGE(bufoff, gbase, voff) do { _Pragma("unroll") for (int _i = 0; _i < 2; ++_i) \
        __builtin_amdgcn_global_load_lds((const unsigned*)((const char*)(gbase) + (voff)[_i]), (PG8_LAS unsigned*)(lds + (bufoff) + ldsw + _i * 8192), 16, 0, 0); } while (0)
#define PG8_STAGE_A(bufoff, gbase, h) do { if constexpr (GATHER) PG8_STAGE(bufoff, gbase, voffG[h]); else PG8_STAGE(bufoff, (gbase) + (h) * hstep, voffA); } while (0)
#define PG8_LDA(dst, b, h) do { _Pragma("unroll") for (int m = 0; m < 4; ++m) _Pragma("unroll") for (int k = 0; k < 2; ++k) dst[m][k] = *(const PG8_LAS bf16x8*)(lds + PG8_SA(b, h) + aoff + m * 2048 + k * 1024); } while (0)
#define PG8_LDB(dst, b, h) do { _Pragma("unroll") for (int n = 0; n < 2; ++n) _Pragma("unroll") for (int k = 0; k < 2; ++k) dst[n][k] = *(const PG8_LAS bf16x8*)(lds + PG8_SB(b, h) + boff + n * 2048 + k * 1024); } while (0)
#define PG8_CAT(x0, x1) __builtin_shufflevector(__builtin_bit_cast(pg8_v4i, x0), __builtin_bit_cast(pg8_v4i, x1), 0, 1, 2, 3, 4, 5, 6, 7)
#define PG8_MMA(ai, bj, At, Bt) do { __builtin_amdgcn_s_setprio(1); \
        if constexpr (F8) { _Pragma("unroll") for (int m = 0; m < 4; ++m) _Pragma("unroll") for (int n = 0; n < 2; ++n) \
            asm volatile("v_mfma_scale_f32_16x16x128_f8f6f4 %0, %1, %2, %0, %3, %4 op_sel_hi:[0,0,0]" : "+v"(acc[ai][bj][m][n]) : "v"(PG8_CAT(Bt[n][0], Bt[n][1])), "v"(PG8_CAT(At[m][0], At[m][1])), "v"(f8sw), "v"(f8sx)); } \
        else if constexpr (I8) { _Pragma("unroll") for (int m = 0; m < 4; ++m) _Pragma("unroll") for (int n = 0; n < 2; ++n) _Pragma("unroll") for (int k = 0; k < 2; ++k) \
            acc[ai][bj][m][n] = __builtin_bit_cast(f32x4, __builtin_amdgcn_mfma_i32_16x16x64_i8(__builtin_bit_cast(pg8_v4i, Bt[n][k]), __builtin_bit_cast(pg8_v4i, At[m][k]), __builtin_bit_cast(pg8_v4i, acc[ai][bj][m][n]), 0, 0, 0)); } \
        else { _Pragma("unroll") for (int m = 0; m < 4; ++m) _Pragma("unroll") for (int n = 0; n < 2; ++n) _Pragma("unroll") for (int k = 0; k < 2; ++k) \
            acc[ai][bj][m][n] = __builtin_amdgcn_mfma_f32_16x16x32_bf16(Bt[n][k], At[m][k], acc[ai][bj][m][n], 0, 0, 0); } \
        __builtin_amdgcn_s_setprio(0); } while (0)
#define PG8_WAIT_V(n) asm volatile("s_waitcnt vmcnt(" #n ")" ::: "memory")
#define PG8_WAIT_L(n) asm volatile("s_waitcnt lgkmcnt(" #n ")" ::: "memory")
#define PG8_BAR __builtin_amdgcn_s_barrier()
#define PG8_SCHED __builtin_amdgcn_sched_barrier(0)
    Unit cur, nxt; int ui = 0;
    if (!S.next(0, cur)) return;
    f32x4 acc[2][2][4][2];
#pragma unroll
    for (int a = 0; a < 2; ++a)
#pragma unroll
        for (int b = 0; b < 2; ++b)
#pragma unroll
            for (int m = 0; m < 4; ++m)
#pragma unroll
                for (int n = 0; n < 2; ++n) acc[a][b][m][n] = (f32x4){0.f, 0.f, 0.f, 0.f};
    bf16x8 At[4][2], B0[2][2], B1[2][2];
    const int f8sw = g.M, f8sx = g.N; (void)f8sw; (void)f8sx;
    const char* cA = (const char*)g.A + (GATHER ? (size_t)0 : (size_t)cur.pm * tstep); const char* cB = (const char*)g.Bt + (size_t)cur.pn * tstep;
    S.a_ready(cur);
    static_assert(!GATHER || SP2, "gather staging is written for the SP2 loop");
    unsigned voffG[2][2]; int gR[2]; unsigned gC[2];
#pragma unroll
    for (int i = 0; i < 2; ++i) { int R, Cc; stage_rc(tid * 16 + i * 8192, R, Cc); gR[i] = R; gC[i] = (unsigned)Cc * 2u; voffG[0][i] = voffG[1][i] = 0u; }
#define PG8_GLOAD(dst, u) do { _Pragma("unroll") for (int _h = 0; _h < 2; ++_h) _Pragma("unroll") for (int _i = 0; _i < 2; ++_i) { const int _r = HALF * _h + gR[_i]; dst[_h][_i] = _r < (u).nv ? (unsigned)S.la[(u).lb + _r] : 0u; } } while (0)
#define PG8_GCONV(dst) do { _Pragma("unroll") for (int _h = 0; _h < 2; ++_h) _Pragma("unroll") for (int _i = 0; _i < 2; ++_i) dst[_h][_i] = (dst[_h][_i] >> 1) * ((unsigned)K * 2u) + gC[_i]; } while (0)
#define PG8_GLOAD_ASM(dst, u) do { _Pragma("unroll") for (int _h = 0; _h < 2; ++_h) _Pragma("unroll") for (int _i = 0; _i < 2; ++_i) { const int _r = HALF * _h + gR[_i]; \
        const int* _p = S.la + (u).lb + (_r < (u).nv ? _r : 0); asm volatile("global_load_dword %0, %1, off" : "=v"(dst[_h][_i]) : "v"(_p) : "memory"); } } while (0)
    if constexpr (GATHER) { PG8_GLOAD(voffG, cur); PG8_GCONV(voffG); }
    if constexpr (SP2) {
        PG8_STAGE(PG8_SB(0, 0), cB, voffB); PG8_STAGE(PG8_SB(0, 1), cB + hstep, voffB); PG8_STAGE_A(PG8_SA(0, 0), cA, 0); PG8_STAGE_A(PG8_SA(0, 1), cA, 1);
        if (wr == 1) PG8_BAR;
        PG8_WAIT_V(2); PG8_BAR;
        PG8_STAGE(PG8_SB(1, 0), cB + kstep, voffB); PG8_STAGE_A(PG8_SA(1, 0), cA + kstep, 0); PG8_STAGE(PG8_SB(1, 1), cB + hstep + kstep, voffB);
        PG8_WAIT_V(6); PG8_BAR;
    } else {
        PG8_STAGE(PG8_SB(0, 0), cB, voffB); PG8_STAGE(PG8_SA(0, 0), cA, voffA); PG8_STAGE(PG8_SB(0, 1), cB + hstep, voffB); PG8_STAGE(PG8_SA(0, 1), cA + hstep, voffA);
        if (wr == 1) PG8_BAR;
        PG8_WAIT_V(4); PG8_BAR;
        PG8_STAGE(PG8_SB(1, 0), cB + kstep, voffB); PG8_STAGE(PG8_SA(1, 0), cA + kstep, voffA); PG8_STAGE(PG8_SB(1, 1), cB + hstep + kstep, voffB);
        PG8_WAIT_V(6); PG8_BAR;
    }
    for (;;) {
        const bool has_next = S.next(ui + 1, nxt);
        const char* nA = (has_next && !GATHER) ? (const char*)g.A + (size_t)nxt.pm * tstep : cA; const char* nB = has_next ? (const char*)g.Bt + (size_t)nxt.pn * tstep : cB;
#pragma unroll 1
        for (int t = 0; t < nt; t += 2) {
            const bool last = (t == nt - 2);
            const char* a1 = cA + (size_t)(t + 1) * kstep;
            const char* a2 = last ? nA : cA + (size_t)(t + 2) * kstep; const char* b2 = last ? nB : cB + (size_t)(t + 2) * kstep;
            const char* a3 = a2 + kstep; const char* b3 = b2 + kstep;
            if (last && has_next) S.a_ready(nxt);
            if constexpr (SP2) {
            PG8_LDB(B0, 0, 0); PG8_LDB(B1, 0, 1); PG8_SCHED; PG8_LDA(At, 0, 0); PG8_STAGE_A(PG8_SA(1, 1), a1, 1);
            unsigned gtmp[2][2];
            if constexpr (GATHER) { PG8_SCHED;
                if (last && has_next) {
                    const u32x4 o = *(const PG8_LAS u32x4*)(gofs + tid * 16); voffG[0][0] = o.x; voffG[0][1] = o.y; voffG[1][0] = o.z; voffG[1][1] = o.w; }
                if (t == 0 && has_next) PG8_GLOAD_ASM(gtmp, nxt);
                PG8_SCHED; }
            PG8_WAIT_V(8); PG8_WAIT_L(0); PG8_BAR; PG8_MMA(0, 0, At, B0); PG8_MMA(0, 1, At, B1); PG8_BAR; PG8_SCHED;
            PG8_LDA(At, 0, 1); PG8_STAGE(PG8_SB(0, 0), b2, voffB); PG8_STAGE(PG8_SB(0, 1), b2 + hstep, voffB); PG8_STAGE_A(PG8_SA(0, 0), a2, 0);
            PG8_WAIT_V(8); PG8_WAIT_L(0); PG8_BAR; PG8_MMA(1, 0, At, B0); PG8_MMA(1, 1, At, B1); PG8_BAR; PG8_SCHED;
            PG8_LDB(B0, 1, 0); PG8_LDB(B1, 1, 1); PG8_SCHED; PG8_LDA(At, 1, 0); PG8_STAGE_A(PG8_SA(0, 1), a2, 1);
            PG8_WAIT_V(8); PG8_WAIT_L(0); PG8_BAR; PG8_MMA(0, 0, At, B0); PG8_MMA(0, 1, At, B1); PG8_BAR; PG8_SCHED;
            PG8_LDA(At, 1, 1); PG8_STAGE(PG8_SB(1, 0), b3, voffB); PG8_STAGE(PG8_SB(1, 1), b3 + hstep, voffB); PG8_STAGE_A(PG8_SA(1, 0), a3, 0);
            PG8_WAIT_V(8); PG8_WAIT_L(0); PG8_BAR;
            if constexpr (GATHER) { if (t == 0 && has_next) { PG8_GCONV(gtmp); u32x4 o; o.x = gtmp[0][0]; o.y = gtmp[0][1]; o.z = gtmp[1][0]; o.w = gtmp[1][1]; *(PG8_LAS u32x4*)(gofs + tid * 16) = o; } PG8_SCHED; }
            PG8_MMA(1, 0, At, B0); PG8_MMA(1, 1, At, B1); PG8_BAR; PG8_SCHED;
            } else {
            PG8_LDB(B0, 0, 0); PG8_SCHED; PG8_LDA(At, 0, 0); PG8_STAGE(PG8_SA(1, 1), a1 + hstep, voffA);
            PG8_WAIT_L(8); PG8_BAR; PG8_WAIT_L(0); PG8_MMA(0, 0, At, B0); PG8_BAR; PG8_SCHED;
            PG8_LDB(B1, 0, 1); PG8_STAGE(PG8_SB(0, 0), b2, voffB);
            PG8_BAR; PG8_WAIT_L(0); PG8_MMA(0, 1, At, B1); PG8_BAR;
            PG8_LDA(At, 0, 1); PG8_STAGE(PG8_SA(0, 0), a2, voffA);
            PG8_BAR; PG8_WAIT_L(0); PG8_MMA(1, 0, At, B0); PG8_BAR; PG8_SCHED;
            PG8_STAGE(PG8_SB(0, 1), b2 + hstep, voffB);
            PG8_WAIT_V(6); PG8_BAR; PG8_MMA(1, 1, At, B1); PG8_BAR;
            PG8_LDB(B0, 1, 0); PG8_SCHED; PG8_LDA(At, 1, 0); PG8_STAGE(PG8_SA(0, 1), a2 + hstep, voffA);
            PG8_WAIT_L(8); PG8_BAR; PG8_WAIT_L(0); PG8_MMA(0, 0, At, B0); PG8_BAR; PG8_SCHED;
            PG8_LDB(B1, 1, 1); PG8_STAGE(PG8_SB(1, 0), b3, voffB);
            PG8_BAR; PG8_WAIT_L(0); PG8_MMA(0, 1, At, B1); PG8_BAR;
            PG8_LDA(At, 1, 1); PG8_STAGE(PG8_SA(1, 0), a3, voffA);
            PG8_BAR; PG8_WAIT_L(0); PG8_MMA(1, 0, At, B0); PG8_BAR; PG8_SCHED;
            PG8_STAGE(PG8_SB(1, 1), b3 + hstep, voffB);
            PG8_WAIT_V(6); PG8_BAR; PG8_MMA(1, 1, At, B1); PG8_BAR;
            }
        }
        if constexpr (F8) asm volatile("s_nop 15\n\ts_nop 15" ::: "memory");
        if constexpr (ALIGN_EPI) { if (wr == 0) PG8_BAR; }
        if constexpr (!Epi::AFTER_DRAIN) { E(acc, cur, wr, wc, fr, fq); S.done(cur); }
        if (!has_next) break;
#pragma unroll
        for (int a = 0; a < 2; ++a)
#pragma unroll
            for (int b = 0; b < 2; ++b)
#pragma unroll
                for (int m = 0; m < 4; ++m)
#pragma unroll
                    for (int n = 0; n < 2; ++n) acc[a][b][m][n] = (f32x4){0.f, 0.f, 0.f, 0.f};
        cur = nxt; cA = nA; cB = nB; ++ui;
        if constexpr (ALIGN_EPI) { if (wr == 1) PG8_BAR; }
    }
    PG8_WAIT_V(0);
    if constexpr (!ALIGN_EPI) { if (wr == 0) PG8_BAR; }
    PG8_BAR;
    if constexpr (Epi::AFTER_DRAIN) { E.fused(acc, cur, wr, wc, fr, fq, lds, wid, lane); S.done(cur); }
#undef PG8_SA
#undef PG8_SB
#undef PG8_STAGE
#undef PG8_STAGE_A
#undef PG8_GLOAD
#undef PG8_GLOAD_ASM
#undef PG8_GCONV
#undef PG8_LDA
#undef PG8_LDB
#undef PG8_MMA
#undef PG8_CAT
#undef PG8_WAIT_V
#undef PG8_WAIT_L
#undef PG8_BAR
#undef PG8_SCHED
}
}

#define GAS __attribute__((address_space(1)))
#define LAS __attribute__((address_space(3)))
typedef unsigned short bf16;
typedef unsigned v4u __attribute__((ext_vector_type(4)));
typedef unsigned v2u __attribute__((ext_vector_type(2)));
typedef float f32x4 __attribute__((ext_vector_type(4)));
typedef float f32x2 __attribute__((ext_vector_type(2)));
typedef short bf16x8 __attribute__((ext_vector_type(8)));
typedef float f32x16 __attribute__((ext_vector_type(16)));
typedef short s16x4 __attribute__((ext_vector_type(4)));
typedef int i32x4 __attribute__((ext_vector_type(4)));
typedef int i32x16 __attribute__((ext_vector_type(16)));
typedef __bf16 bf16x2_t __attribute__((ext_vector_type(2)));
#define LDS_WAIT() asm volatile("s_waitcnt lgkmcnt(0)" ::: "memory")
#define VM_WAIT() asm volatile("s_waitcnt vmcnt(0)" ::: "memory")
__device__ __forceinline__ unsigned pk2(float lo, float hi) { f32x2 v = {lo, hi}; bf16x2_t r = __builtin_convertvector(v, bf16x2_t); return __builtin_bit_cast(unsigned, r); }
__device__ __forceinline__ float bflo(unsigned u) { return __builtin_bit_cast(float, u << 16); }
__device__ __forceinline__ float bfhi(unsigned u) { return __builtin_bit_cast(float, u & 0xffff0000u); }
__device__ __forceinline__ float bf2f(bf16 b) { return __builtin_bit_cast(float, ((unsigned)b) << 16); }
__device__ __forceinline__ float wave_sum(float v) {
#pragma unroll
    for (int o = 1; o < 64; o <<= 1) v += __shfl_xor(v, o);
    return v;
}
__device__ __forceinline__ float wave_max(float v) {
#pragma unroll
    for (int o = 1; o < 64; o <<= 1) v = fmaxf(v, __shfl_xor(v, o));
    return v;
}

__device__ __forceinline__ unsigned pk4_fp8(float a, float b, float c, float d) {
    a = __builtin_amdgcn_fmed3f(a, -448.f, 448.f); b = __builtin_amdgcn_fmed3f(b, -448.f, 448.f); c = __builtin_amdgcn_fmed3f(c, -448.f, 448.f); d = __builtin_amdgcn_fmed3f(d, -448.f, 448.f);
    int r = __builtin_amdgcn_cvt_pk_fp8_f32(a, b, 0, false);
    r = __builtin_amdgcn_cvt_pk_fp8_f32(c, d, r, true);
    return (unsigned)r;
}
#define XB_TMO      128
#define XB_XCNT(j)  (256  + 64 * (j))
#define XB_XSUB(j)  (1280 + 64 * (j))
#define XB_XGEN(j)  (2304 + 64 * (j))
#define XB_TOP      3328
#define XB_TOPGEN   3392
#define XCD_BAR_WORDS 3456
#define XB_SPIN_CAP (1u << 23)

__device__ __forceinline__ unsigned xb_ld(unsigned* p)              { return __hip_atomic_load(p, __ATOMIC_RELAXED, __HIP_MEMORY_SCOPE_AGENT); }
__device__ __forceinline__ unsigned xb_add(unsigned* p, unsigned v) { return __hip_atomic_fetch_add(p, v, __ATOMIC_RELAXED, __HIP_MEMORY_SCOPE_AGENT); }
__device__ __forceinline__ unsigned xb_xcc_id() { return (unsigned)__builtin_amdgcn_s_getreg((3 << 11) | 20) & 0xFu; }
#define XB_SPIN(cond, bar) do { unsigned _sp = 0; while (cond) { __builtin_amdgcn_s_sleep(1); \
    if ((++_sp & 255u) == 0u) { if (xb_ld(&(bar)[XB_TMO])) break; if (_sp > XB_SPIN_CAP) { atomicAdd(&(bar)[XB_TMO], 1u); break; } } } } while (0)

struct XcdBarrier {
    unsigned* bar; unsigned x;
    volatile LAS unsigned* st;
};

__device__ __forceinline__ XcdBarrier xcd_barrier_post(unsigned* bar, volatile LAS unsigned* st) {
    XcdBarrier b; b.bar = bar; b.x = xb_xcc_id(); b.st = st;
    if (threadIdx.x == 0) (void)xb_add(&bar[XB_XCNT(b.x)], 1u);
    return b;
}
__device__ __forceinline__ void xcd_barrier_complete(unsigned* bar, unsigned x, unsigned& nloc, unsigned& nx) {
    const unsigned G = gridDim.x * gridDim.y * gridDim.z;
    unsigned sum, cnt, mine, sp = 0u;
    for (;;) {
        sum = 0u; cnt = 0u; mine = 0u;
#pragma unroll
        for (unsigned j = 0; j < 16; ++j) { const unsigned c = xb_ld(&bar[XB_XCNT(j)]); sum += c; cnt += (c > 0u) ? 1u : 0u; mine = (j == x) ? c : mine; }
        if (sum == G) break;
        __builtin_amdgcn_s_sleep(1);
        if ((++sp & 255u) == 0u) { if (xb_ld(&bar[XB_TMO])) break; if (sp > XB_SPIN_CAP) { atomicAdd(&bar[XB_TMO], 1u); break; } }
    }
    nloc = mine > 0u ? mine : 1u; nx = cnt > 0u ? cnt : 1u;
}

__device__ __forceinline__ void xcd_barrier(const XcdBarrier& b) {
    asm volatile("s_waitcnt vmcnt(0)" ::: "memory");
    __syncthreads();
    if (threadIdx.x == 0) {
        unsigned* bar = b.bar;
        __builtin_amdgcn_s_waitcnt(0);
        unsigned nloc = b.st[0], nx = b.st[1];
        if (nloc == 0u) { xcd_barrier_complete(bar, b.x, nloc, nx); b.st[0] = nloc; b.st[1] = nx; }
        const unsigned old = xb_add(&bar[XB_XSUB(b.x)], 1u);
        const unsigned gen = old / nloc;
        if (old + 1u == (gen + 1u) * nloc) {
            __builtin_amdgcn_fence(__ATOMIC_RELEASE, "agent");
            asm volatile("s_waitcnt vmcnt(0)" ::: "memory");
            const unsigned og = xb_add(&bar[XB_TOP], 1u);
            const unsigned tg = og / nx;
            if (og + 1u == (tg + 1u) * nx) xb_add(&bar[XB_TOPGEN], 1u);
            else XB_SPIN(xb_ld(&bar[XB_TOPGEN]) == tg, bar);
            __builtin_amdgcn_fence(__ATOMIC_ACQUIRE, "agent");
            xb_add(&bar[XB_XGEN(b.x)], 1u);
            asm volatile("s_waitcnt vmcnt(0)" ::: "memory");
        } else {
            XB_SPIN(xb_ld(&bar[XB_XGEN(b.x)]) == gen, bar);
            __builtin_amdgcn_fence(__ATOMIC_ACQUIRE, "agent");
            asm volatile("s_waitcnt vmcnt(0)" ::: "memory");
        }
    }
    __syncthreads();
}

constexpr int D = 2048, NB = 4, S = 4096, T = NB * S;
constexpr int HD = 128, FH = 12, FW = 1536, MH = 4, MW = 512, ML = 256;
constexpr int FOX_IN = 6668, FOX_NP = 6912;
constexpr int GLA_IN = 5136, GLA_NP = 5376;
constexpr int GH = 4, GDK = 192, GDV = 384, GKW = 768, GVW = 1536;
constexpr int NE = 32, DE = 1024, MAXROWS = 40960, MAXTILES = 160;
constexpr int FP_Q = 0, FP_K = 1536, FP_V = 3072, FP_OG = 4608, FP_QM = 6144, FP_F = 6656;
constexpr int GP_Q = 0, GP_K = 768, GP_V = 1536, GP_R = 3072, GP_QM = 4608, GP_A = 5120;
constexpr float RMS_EPS = 1e-6f;
constexpr int NWAVES = 8;

constexpr size_t MiB = 1u << 20;
constexpr size_t WS_CTL = 0, CTL_ZERO_BYTES = 1 * MiB;
constexpr size_t WS_ROUTE = 1 * MiB;
constexpr size_t WS_WFOX = 4 * MiB;
constexpr size_t WS_WGLA = WS_WFOX + 27 * MiB;
constexpr size_t WS_WOUT = WS_WGLA + 21 * MiB;
constexpr size_t WS_WMKV = WS_WOUT + 16 * MiB;
constexpr size_t WS_WGU = WS_WMKV + 4 * MiB;
constexpr size_t WS_WD = WS_WGU + 512 * MiB;
constexpr size_t WS_HN = WS_WD + 256 * MiB;
constexpr size_t WS_P = WS_HN + 65 * MiB;
constexpr size_t WS_CAT = WS_P + 216 * MiB;
constexpr size_t WS_XA = WS_CAT + 64 * MiB;
constexpr size_t WS_XB = WS_XA + 128 * MiB;
constexpr size_t WS_XG = WS_XB + 128 * MiB;
constexpr size_t WS_H = WS_XG + 160 * MiB;
constexpr size_t WS_YB = WS_H + 80 * MiB;
constexpr size_t WS_MEMN = WS_YB + 128 * MiB;
constexpr size_t WS_MKV = WS_MEMN + 4 * MiB;
constexpr size_t WS_MK = WS_MKV + 2 * MiB;
constexpr size_t WS_C = WS_MK + 2 * MiB;
constexpr size_t WS_FL = WS_C + 1 * MiB;
constexpr size_t WS_WR = WS_FL + 1 * MiB;
constexpr size_t WS_INV = WS_WR + 1 * MiB;
constexpr size_t WS_END = WS_INV + 1 * MiB;
constexpr size_t WS_SWC_FOX = WS_INV, WS_SWC_GLA = WS_INV + 32 * 1024, WS_SWC_MKV = WS_INV + 64 * 1024, WS_SWC_WO1 = WS_INV + 72 * 1024;
constexpr size_t WS_GO = WS_XG, WS_LA = WS_H;
constexpr size_t WS_XN8 = WS_XG, WS_LSTA = WS_XG + 32 * MiB, WS_LSTW = WS_XG + 34 * MiB;
constexpr size_t WS_SA = WS_HN + 48 * MiB, WS_SAM = WS_MEMN + 3 * MiB;
constexpr size_t RT_TOKE = 0;
constexpr size_t RT_TOKS = RT_TOKE + 2 * T * 4;
constexpr size_t RT_TOKW = RT_TOKS + 2 * T * 4;
constexpr size_t RT_ROWDEST = RT_TOKW + 2 * T * 4;
constexpr size_t RT_ROWW = RT_ROWDEST + 2 * MAXROWS * 4;
constexpr size_t RT_TILEE = RT_ROWW + MAXROWS * 4;
constexpr size_t RT_END = RT_TILEE + 2 * 256 * 4;
static_assert(RT_END <= 3 * MiB, "routing arrays");
constexpr int CW_BAR = 4096;
constexpr int CW_CNT = 8192;
constexpr int CW_Q0 = 8320, CW_Q1 = 8384;
constexpr int CW_AMAX = 12416;
constexpr int CW_PROBE = 12288;
constexpr int CW_CVQ = 9216, CW_PD = 9280;
static_assert((CW_PD + 64 * 16) * 4 <= (int)CTL_ZERO_BYTES, "ctl");

constexpr int RING_OFF = 0, RING_BYTES = 131072;
constexpr int TR_PITCH = 65, TR_WAVE_BYTES = 64 * TR_PITCH * 4;
constexpr int LDSCTL_OFF = 8 * TR_WAVE_BYTES, MISC_OFF = LDSCTL_OFF + 320;
constexpr int GOFF_OFF = LDSCTL_OFF + 4096;
constexpr int LDS_BYTES = GOFF_OFF + 8192;
static_assert(LDSCTL_OFF >= RING_BYTES && LDS_BYTES <= 163840, "LDS map");

namespace pg8 {
template <bool I8> struct EpiPT {
    static constexpr bool PERM = true, AFTER_DRAIN = false;
    bf16_t* P; int ldp; float* FL; int ftile; bf16_t* P2; int ldp2, pm2, pn2; const float* SA; const float* SWC; const float* SA2; const float* SWC2;
    int nq0, nq1, nk0, nk1, nm0, nm1; const float* GQ; const float* GK; const float* GM; PG8_LAS float* nscr;
    __device__ __forceinline__ f32x4 val(const f32x4& a, float s, const f32x4& c) const {
        if (!I8) return a;
        const pg8_v4i i = __builtin_bit_cast(pg8_v4i, a); return (f32x4){(float)i.x * (s * c.x), (float)i.y * (s * c.y), (float)i.z * (s * c.z), (float)i.w * (s * c.w)};
    }
    __device__ __forceinline__ void operator()(const f32x4 (&acc)[2][2][4][2], const Unit& u, int wr, int wc, int fr, int fq) const {
        const bool second = u.pm >= pm2;
        bf16_t* O = second ? P2 : P; const int ld = second ? ldp2 : ldp;
        const int row0 = (second ? u.pm - pm2 : u.pm) * BM + wr * 64 + fr, col0 = (second ? u.pn - pn2 : u.pn) * BM + wc * 32 + 8 * fq;
        f32x4 cs[2][2];
        { const float* cp = (second ? SWC2 : SWC) + col0;
#pragma unroll
          for (int bj = 0; bj < 2; ++bj) { cs[bj][0] = I8 ? *(const f32x4*)(cp + bj * HALF) : (f32x4){1.f, 1.f, 1.f, 1.f}; cs[bj][1] = I8 ? *(const f32x4*)(cp + bj * HALF + 4) : (f32x4){1.f, 1.f, 1.f, 1.f}; } }
        const float* G = nullptr;
        if (!second) { if (u.pn >= nq0 && u.pn < nq1) G = GQ; else if (u.pn >= nk0 && u.pn < nk1) G = GK; else if (u.pn >= nm0 && u.pn < nm1) G = GM; }
        if (G != nullptr) {
            PG8_LAS float* sp = nscr + ((wr * 8) * 16 + fr) * 8 + wc;
#pragma unroll
            for (int ai = 0; ai < 2; ++ai)
#pragma unroll
                for (int m = 0; m < 4; ++m) { const float s = I8 ? SA[row0 + ai * HALF + m * 16] : 1.0f;
#pragma unroll
                    for (int bj = 0; bj < 2; ++bj) { const f32x4 v0 = val(acc[ai][bj][m][0], s, cs[bj][0]), v1 = val(acc[ai][bj][m][1], s, cs[bj][1]);
                        float ss = (v0[0] * v0[0] + v0[1] * v0[1]) + (v0[2] * v0[2] + v0[3] * v0[3]) + (v1[0] * v1[0] + v1[1] * v1[1]) + (v1[2] * v1[2] + v1[3] * v1[3]);
                        ss += __shfl_xor(ss, 16); ss += __shfl_xor(ss, 32);
                        if (fq == 0) sp[((ai * 4 + m) * 16) * 8 + bj * 4] = ss; } }
            asm volatile("s_waitcnt lgkmcnt(0)" ::: "memory");
            __builtin_amdgcn_s_barrier();
            const f32x4 g0 = *(const f32x4*)(G + wc * 32 + 8 * fq), g1 = *(const f32x4*)(G + wc * 32 + 8 * fq + 4);
#pragma unroll
            for (int ai = 0; ai < 2; ++ai)
#pragma unroll
                for (int m = 0; m < 4; ++m) { const int row = row0 + ai * HALF + m * 16; bf16_t* rowp = O + (size_t)row * ld + col0; const float s = I8 ? SA[row] : 1.0f;
#pragma unroll
                    for (int bj = 0; bj < 2; ++bj) { const f32x4 pp = *(const PG8_LAS f32x4*)(nscr + (((wr * 8) + ai * 4 + m) * 16 + fr) * 8 + bj * 4);
                        const float inv = 1.0f / sqrtf(((pp[0] + pp[1]) + (pp[2] + pp[3])) * (1.0f / 128.0f) + 1e-6f);
                        f32x4 a0 = acc[ai][bj][m][0], a1 = acc[ai][bj][m][1]; asm volatile("" : "+v"(a0), "+v"(a1));
                        const f32x4 v0 = val(a0, s, cs[bj][0]) * inv * g0, v1 = val(a1, s, cs[bj][1]) * inv * g1;
                        u32x4 w; w.x = pk2(v0[0], v0[1]); w.y = pk2(v0[2], v0[3]); w.z = pk2(v1[0], v1[1]); w.w = pk2(v1[2], v1[3]);
                        *(u32x4*)(rowp + bj * HALF) = w; } }
            return;
        }
#pragma unroll
        for (int ai = 0; ai < 2; ++ai)
#pragma unroll
            for (int m = 0; m < 4; ++m) { const int row = row0 + ai * HALF + m * 16; bf16_t* rowp = O + (size_t)row * ld + col0;
                const float s = I8 ? (second ? SA2[row] : SA[row]) : 1.0f;
#pragma unroll
                for (int bj = 0; bj < 2; ++bj) { const f32x4 v0 = val(acc[ai][bj][m][0], s, cs[bj][0]), v1 = val(acc[ai][bj][m][1], s, cs[bj][1]);
                    u32x4 w; w.x = pk2(v0[0], v0[1]); w.y = pk2(v0[2], v0[3]); w.z = pk2(v1[0], v1[1]); w.w = pk2(v1[2], v1[3]);
                    *(u32x4*)(rowp + bj * HALF) = w; }
                if (!second && u.pn == ftile && wc == 0 && fq < 2) { float* fp = FL + (size_t)row * 16 + 8 * fq;
                    *(f32x4*)(fp) = val(acc[ai][0][m][0], s, cs[0][0]); *(f32x4*)(fp + 4) = val(acc[ai][0][m][1], s, cs[0][1]); } }
    }
};
typedef EpiPT<false> EpiP;
struct TwoGemmOrder {
    StaticOrder S; int nx2, n2, pm2, pn2;
    __device__ __forceinline__ bool next(int i, Unit& u) const {
        if (S.next(i, u)) return true;
        const long L = (long)i * S.G + S.c - S.nwg; if (L < 0 || L >= n2) return false;
        u.pm = pm2 + (int)(L % nx2); u.pn = pn2 + (int)(L / nx2); return true;
    }
    __device__ __forceinline__ void a_ready(const Unit&) const {}
    __device__ __forceinline__ void done(const Unit&) const {}
};
template <bool RF32> struct EpiRes {
    static constexpr bool PERM = true, AFTER_DRAIN = false;
    const void* R; bf16_t* C; int ldc; const float* SC; const float* SWC;
    __device__ __forceinline__ void operator()(const f32x4 (&acc)[2][2][4][2], const Unit& u, int wr, int wc, int fr, int fq) const {
        const int row0 = u.pm * BM + wr * 64 + fr, col0 = u.pn * BM + wc * 32 + 8 * fq;
#pragma unroll
        for (int ai = 0; ai < 2; ++ai)
#pragma unroll
            for (int m = 0; m < 4; ++m) { const int row = row0 + ai * HALF + m * 16; const size_t ro = (size_t)row * ldc + col0; const float s = SC[row];
#pragma unroll
                for (int bj = 0; bj < 2; ++bj) { f32x4 r0, r1;
                    if (RF32) { r0 = *(const f32x4*)((const float*)R + ro + bj * HALF); r1 = *(const f32x4*)((const float*)R + ro + bj * HALF + 4); }
                    else { const u32x4 rb = *(const u32x4*)((const bf16_t*)R + ro + bj * HALF);
                        r0 = (f32x4){bflo(rb.x), bfhi(rb.x), bflo(rb.y), bfhi(rb.y)}; r1 = (f32x4){bflo(rb.z), bfhi(rb.z), bflo(rb.w), bfhi(rb.w)}; }
                    const pg8_v4i i0 = __builtin_bit_cast(pg8_v4i, acc[ai][bj][m][0]), i1 = __builtin_bit_cast(pg8_v4i, acc[ai][bj][m][1]);
                    const f32x4 c0 = *(const f32x4*)(SWC + col0 + bj * HALF) * s, c1 = *(const f32x4*)(SWC + col0 + bj * HALF + 4) * s;
                    const f32x4 v0 = (f32x4){(float)i0.x, (float)i0.y, (float)i0.z, (float)i0.w} * c0 + r0, v1 = (f32x4){(float)i1.x, (float)i1.y, (float)i1.z, (float)i1.w} * c1 + r1;
                    u32x4 w; w.x = pk2(v0[0], v0[1]); w.y = pk2(v0[2], v0[3]); w.z = pk2(v1[0], v1[1]); w.w = pk2(v1[2], v1[3]);
                    *(u32x4*)(C + ro + bj * HALF) = w; } }
    }
};
template <bool RF32> struct EpiResF {
    static constexpr bool PERM = true, AFTER_DRAIN = false;
    const void* R; bf16_t* C; int ldc;
    __device__ __forceinline__ void operator()(const f32x4 (&acc)[2][2][4][2], const Unit& u, int wr, int wc, int fr, int fq) const {
        const int row0 = u.pm * BM + wr * 64 + fr, col0 = u.pn * BM + wc * 32 + 8 * fq;
#pragma unroll
        for (int ai = 0; ai < 2; ++ai)
#pragma unroll
            for (int m = 0; m < 4; ++m) { const int row = row0 + ai * HALF + m * 16; const size_t ro = (size_t)row * ldc + col0;
#pragma unroll
                for (int bj = 0; bj < 2; ++bj) { f32x4 r0, r1;
                    if (RF32) { r0 = *(const f32x4*)((const float*)R + ro + bj * HALF); r1 = *(const f32x4*)((const float*)R + ro + bj * HALF + 4); }
                    else { const u32x4 rb = *(const u32x4*)((const bf16_t*)R + ro + bj * HALF);
                        r0 = (f32x4){bflo(rb.x), bfhi(rb.x), bflo(rb.y), bfhi(rb.y)}; r1 = (f32x4){bflo(rb.z), bfhi(rb.z), bflo(rb.w), bfhi(rb.w)}; }
                    const f32x4 v0 = acc[ai][bj][m][0] + r0, v1 = acc[ai][bj][m][1] + r1;
                    u32x4 w; w.x = pk2(v0[0], v0[1]); w.y = pk2(v0[2], v0[3]); w.z = pk2(v1[0], v1[1]); w.w = pk2(v1[2], v1[3]);
                    *(u32x4*)(C + ro + bj * HALF) = w; } }
    }
};
struct EpiGU {
    static constexpr bool PERM = true, AFTER_DRAIN = false;
    unsigned char* H;
    __device__ __forceinline__ void operator()(const f32x4 (&acc)[2][2][4][2], const Unit& u, int wr, int wc, int fr, int fq) const {
        const int row0 = u.pm * BM + wr * 64 + fr, col0 = (u.pn & 7) * HALF + wc * 32 + 8 * fq;
#pragma unroll
        for (int ai = 0; ai < 2; ++ai)
#pragma unroll
            for (int m = 0; m < 4; ++m) { unsigned char* rowp = H + (size_t)(row0 + ai * HALF + m * 16) * 1024 + col0;
                float h[8];
#pragma unroll
                for (int n = 0; n < 2; ++n)
#pragma unroll
                    for (int j = 0; j < 4; ++j) { const float g = acc[ai][0][m][n][j], uu = acc[ai][1][m][n][j]; h[4 * n + j] = 8.0f * g * uu * __builtin_amdgcn_rcpf(1.0f + __expf(-g)); }
                v2u w; w.x = pk4_fp8(h[0], h[1], h[2], h[3]); w.y = pk4_fp8(h[4], h[5], h[6], h[7]);
                *(v2u*)rowp = w; }
    }
};
struct EpiDown {
    static constexpr bool PERM = true, AFTER_DRAIN = false;
    const int* la; const float* lw; bf16_t* YB;
    __device__ __forceinline__ void operator()(const f32x4 (&acc)[2][2][4][2], const Unit& u, int wr, int wc, int fr, int fq) const {
        const int row0 = wr * 64 + fr, col0 = (u.pn & 7) * BM + wc * 32 + 8 * fq;
#pragma unroll
        for (int ai = 0; ai < 2; ++ai)
#pragma unroll
            for (int m = 0; m < 4; ++m) { const int row = row0 + ai * HALF + m * 16;
                if (row < u.nv) { const int dest = la[u.lb + row]; const float w8 = lw[u.lb + row] * 16.0f; unsigned char* rowp = (unsigned char*)YB + (size_t)dest * D + col0;
#pragma unroll
                    for (int bj = 0; bj < 2; ++bj) { const f32x4 v0 = acc[ai][bj][m][0] * w8, v1 = acc[ai][bj][m][1] * w8;
                        v2u w; w.x = pk4_fp8(v0[0], v0[1], v0[2], v0[3]); w.y = pk4_fp8(v1[0], v1[1], v1[2], v1[3]);
                        *(v2u*)(rowp + bj * HALF) = w; } } }
    }
};
struct MoeOrder {
    int pk, G, c; const int* la;
    __device__ __forceinline__ bool next(int i, Unit& u) const {
        const int L = i * G + c, tile = L >> 3, pn = L & 7;
        const unsigned long long m = __ballot(tile < (int)((unsigned)pk >> 24));
        if (m == 0ull) return false;
        const int e = (int)__builtin_ctzll(m); const int pe = __builtin_amdgcn_readlane(pk, e); const int ml = tile - ((pe >> 16) & 255);
        u.pm = tile; u.pn = e * 8 + pn; u.lb = e * 16384 + ml * 256; u.nv = (pe & 0xffff) - ml * 256; return true;
    }
    __device__ __forceinline__ void a_ready(const Unit&) const {}
    __device__ __forceinline__ void done(const Unit&) const {}
};
}

struct Ctx {
    LAS unsigned char* lds;
    int tid, lane, wave, gw, NGW, G;
    const float* in[24]; float* out; unsigned char* ws;
};
#define WSP(type, off) ((type*)(C.ws + (off)))

__device__ __forceinline__ void load_row(const float* xrow, int lane, f32x4 (&v)[8]) {
#pragma unroll
    for (int j = 0; j < 8; ++j) v[j] = ((const f32x4*)xrow)[lane + 64 * j];
}
__device__ __forceinline__ void load_row_bf16(const bf16* xrow, int lane, f32x4 (&v)[8]) {
#pragma unroll
    for (int j = 0; j < 8; ++j) { const v2u u = ((const v2u*)xrow)[lane + 64 * j]; v[j] = (f32x4){bflo(u.x), bfhi(u.x), bflo(u.y), bfhi(u.y)}; }
}
__device__ __forceinline__ float row_inv_rms(const f32x4 (&v)[8]) {
    float s = 0.f;
#pragma unroll
    for (int j = 0; j < 8; ++j) s += (v[j].x * v[j].x + v[j].y * v[j].y) + (v[j].z * v[j].z + v[j].w * v[j].w);
    s = wave_sum(s);
    return 1.0f / sqrtf(s * (1.0f / D) + RMS_EPS);
}
__device__ __forceinline__ unsigned pk4_i8(float a, float b, float c, float d) {
    const int ia = __float2int_rn(a), ib = __float2int_rn(b), ic = __float2int_rn(c), id = __float2int_rn(d);
    return (unsigned)(ia & 0xff) | ((unsigned)(ib & 0xff) << 8) | ((unsigned)(ic & 0xff) << 16) | ((unsigned)id << 24);
}
__device__ __forceinline__ void norm_store_row_i8(unsigned char* orow8, float* sa, f32x4 (&v)[8], float inv, const float* g, int lane) {
    float am = 0.f;
#pragma unroll
    for (int j = 0; j < 8; ++j) { const f32x4 gg = ((const f32x4*)g)[lane + 64 * j]; v[j] = v[j] * inv * gg;
        am = fmaxf(fmaxf(am, fmaxf(fabsf(v[j].x), fabsf(v[j].y))), fmaxf(fabsf(v[j].z), fabsf(v[j].w))); }
    am = fmaxf(wave_max(am), 1e-30f);
    const float qs = 127.0f / am;
#pragma unroll
    for (int j = 0; j < 8; ++j) ((unsigned*)orow8)[lane + 64 * j] = pk4_i8(v[j].x * qs, v[j].y * qs, v[j].z * qs, v[j].w * qs);
    if (lane == 0) *sa = am * (1.0f / 127.0f);
}
__device__ __forceinline__ void norm_store_row(bf16* orow, f32x4 (&v)[8], float inv, const float* g, int lane) {
#pragma unroll
    for (int j = 0; j < 8; ++j) { const f32x4 gg = ((const f32x4*)g)[lane + 64 * j]; v[j] = v[j] * inv * gg;
        v2u o; o.x = pk2(v[j].x, v[j].y); o.y = pk2(v[j].z, v[j].w); ((v2u*)orow)[lane + 64 * j] = o; }
}

struct TrItem { const float* W; bf16* WT; int ldn, K, drow, k0, n0; float qs; };
__device__ __forceinline__ void tr_load(const TrItem& d, int lane, f32x4 (&v)[16]) {
#pragma unroll
    for (int i = 0; i < 16; ++i) v[i] = *(const f32x4*)(d.W + (size_t)(d.k0 + 4 * i + (lane >> 4)) * d.ldn + d.n0 + 4 * (lane & 15));
}
__device__ __forceinline__ void tr_finish(const TrItem& d, const f32x4 (&v)[16], LAS float* scr, int lane) {
#pragma unroll
    for (int i = 0; i < 16; ++i) { LAS float* p = scr + (4 * i + (lane >> 4)) * TR_PITCH + 4 * (lane & 15); p[0] = v[i].x; p[1] = v[i].y; p[2] = v[i].z; p[3] = v[i].w; }
    LDS_WAIT(); asm volatile("" ::: "memory");
    const int c = lane >> 3;
#pragma unroll
    for (int j = 0; j < 8; ++j) { const int n = (lane & 7) + 8 * j; const LAS float* s = scr + (8 * c) * TR_PITCH + n;
        v4u o; o.x = pk2(s[0 * TR_PITCH], s[1 * TR_PITCH]); o.y = pk2(s[2 * TR_PITCH], s[3 * TR_PITCH]); o.z = pk2(s[4 * TR_PITCH], s[5 * TR_PITCH]); o.w = pk2(s[6 * TR_PITCH], s[7 * TR_PITCH]);
        *(v4u*)(d.WT + (size_t)(d.drow + n) * d.K + d.k0 + 8 * c) = o; }
    LDS_WAIT(); asm volatile("" ::: "memory");
}
__device__ __forceinline__ void tr_finish_i8(const TrItem& d, const f32x4 (&v)[16], LAS float* scr, int lane) {
#pragma unroll
    for (int i = 0; i < 16; ++i) { LAS float* p = scr + (4 * i + (lane >> 4)) * TR_PITCH + 4 * (lane & 15); p[0] = v[i].x; p[1] = v[i].y; p[2] = v[i].z; p[3] = v[i].w; }
    LDS_WAIT(); asm volatile("" ::: "memory");
    const int c = lane & 3; const float qs = d.qs;
#pragma unroll
    for (int j = 0; j < 4; ++j) { const int n = (lane >> 2) + 16 * j; const LAS float* s = scr + (16 * c) * TR_PITCH + n;
        v4u o;
        o.x = pk4_i8(s[0 * TR_PITCH] * qs, s[1 * TR_PITCH] * qs, s[2 * TR_PITCH] * qs, s[3 * TR_PITCH] * qs);
        o.y = pk4_i8(s[4 * TR_PITCH] * qs, s[5 * TR_PITCH] * qs, s[6 * TR_PITCH] * qs, s[7 * TR_PITCH] * qs);
        o.z = pk4_i8(s[8 * TR_PITCH] * qs, s[9 * TR_PITCH] * qs, s[10 * TR_PITCH] * qs, s[11 * TR_PITCH] * qs);
        o.w = pk4_i8(s[12 * TR_PITCH] * qs, s[13 * TR_PITCH] * qs, s[14 * TR_PITCH] * qs, s[15 * TR_PITCH] * qs);
        *(v4u*)((unsigned char*)d.WT + (size_t)(d.drow + n) * d.K + d.k0 + 16 * c) = o; }
    LDS_WAIT(); asm volatile("" ::: "memory");
}
__device__ __forceinline__ bool tr_group(int& r, const float* W, int ldn, int K, int c0, int nblk, bf16* WT, int drow0, TrItem& d) {
    const int cnt = (K / 64) * nblk;
    if (r < cnt) { const int kb = r / nblk, nb = r % nblk; d.W = W + c0; d.WT = WT; d.ldn = ldn; d.K = K; d.drow = drow0 + 64 * nb; d.k0 = 64 * kb; d.n0 = 64 * nb; return true; }
    r -= cnt; return false;
}
struct CvItem { const float* W; unsigned char* WT; int ldn, K, drow, k0, n0; };
__device__ __forceinline__ CvItem moe_cv_decode(const Ctx& C, int hi) {
    const int pr = hi >> 1, h = hi & 1, le = pr / 768, rem = pr % 768, kind = rem >> 8, r = rem & 255; CvItem d;
    if (kind < 2) {
        const int kb = 2 * (r >> 4) + h, nb = r & 15, n0 = 64 * nb;
        d.W = (kind == 0 ? C.in[21] : C.in[22]) + (size_t)le * 2048 * 1024; d.WT = WSP(unsigned char, WS_WGU) + (size_t)le * 2048 * 2048;
        d.ldn = 1024; d.K = 2048; d.drow = 256 * (n0 >> 7) + (n0 & 127) + 128 * kind; d.k0 = 64 * kb; d.n0 = n0;
    } else {
        const int kb = 2 * (r >> 5) + h, nb = r & 31;
        d.W = C.in[23] + (size_t)le * 1024 * 2048; d.WT = WSP(unsigned char, WS_WD) + (size_t)le * 2048 * 1024;
        d.ldn = 2048; d.K = 1024; d.drow = 64 * nb; d.k0 = 64 * kb; d.n0 = 64 * nb;
    }
    return d;
}
__device__ __forceinline__ void tr8_load(const CvItem& d, int lane, f32x4 (&v)[16]) {
#pragma unroll
    for (int i = 0; i < 16; ++i) v[i] = *(const f32x4*)(d.W + (size_t)(d.k0 + 4 * i + (lane >> 4)) * d.ldn + d.n0 + 4 * (lane & 15));
}
#ifndef TR8_HYP
#define TR8_HYP 1
#endif
typedef int v2i_t __attribute__((ext_vector_type(2)));
__device__ __forceinline__ void tr8_finish(const CvItem& d, const f32x4 (&v)[16], LAS float* scr, int lane, int h) {
    LAS unsigned char* tile = (LAS unsigned char*)scr;
#pragma unroll
    for (int i = 0; i < 16; ++i) *(LAS unsigned*)(tile + (64 * h + 4 * i + (lane >> 4)) * 72 + 4 * (lane & 15)) = pk4_fp8(v[i].x * 64.f, v[i].y * 64.f, v[i].z * 64.f, v[i].w * 64.f);
    if (h == 0) return;
    LDS_WAIT(); asm volatile("" ::: "memory");
    const int G = lane >> 4, i16 = lane & 15;
    const int q = TR8_HYP == 1 ? (i16 >> 1) : (i16 & 7), p = TR8_HYP == 1 ? (i16 & 1) : (i16 >> 3);
    const int kbase = d.k0 - 64;
#pragma unroll
    for (int j = 0; j < 4; ++j)
#pragma unroll
        for (int cc = 0; cc < 2; ++cc) {
            const int ck = 16 * (G + 4 * cc);
            const v2i_t lo = __builtin_amdgcn_ds_read_tr8_b64_v2i32((LAS v2i_t*)(tile + (ck + q) * 72 + 16 * j + 8 * p));
            const v2i_t hi = __builtin_amdgcn_ds_read_tr8_b64_v2i32((LAS v2i_t*)(tile + (ck + 8 + q) * 72 + 16 * j + 8 * p));
            v4u o; o.x = (unsigned)lo.x; o.y = (unsigned)lo.y; o.z = (unsigned)hi.x; o.w = (unsigned)hi.y;
            *(v4u*)(d.WT + (size_t)(d.drow + 16 * j + i16) * d.K + kbase + ck) = o;
        }
    LDS_WAIT(); asm volatile("" ::: "memory");
}
__device__ __forceinline__ void moe_cv_item(const Ctx& C, int pr, LAS float* scr, int lane) {
    { const CvItem d = moe_cv_decode(C, 2 * pr); f32x4 v[16]; tr8_load(d, lane, v); tr8_finish(d, v, scr, lane, 0); }
    { const CvItem d = moe_cv_decode(C, 2 * pr + 1); f32x4 v[16]; tr8_load(d, lane, v); tr8_finish(d, v, scr, lane, 1); }
}
#ifndef CV_STEAL
#define CV_STEAL 0
#endif
constexpr int CVQ_FIRST = CV_STEAL ? 32 * 1536 : 64 * 1536, CVQ_TOTAL = 64 * 1536 - CVQ_FIRST;
__device__ __forceinline__ void cv_steal(const Ctx& C, int maxn, unsigned* pd) {
    unsigned* q = (unsigned*)(C.ws + WS_CTL) + CW_CVQ;
    LAS float* scr = (LAS float*)(C.lds + C.wave * TR_WAVE_BYTES);
    for (int n = 0; n < maxn; ++n) {
        unsigned idx = 0;
        if (C.lane == 0) { if (pd && __hip_atomic_load(pd, __ATOMIC_RELAXED, __HIP_MEMORY_SCOPE_AGENT) >= (unsigned)C.G) idx = 0xffffffffu; else idx = atomicAdd(q, 1u); }
        idx = (unsigned)__builtin_amdgcn_readfirstlane((int)idx);
        if (idx >= (unsigned)CVQ_TOTAL) break;
        moe_cv_item(C, (CVQ_FIRST + (int)idx) / 2, scr, C.lane);
    }
}
__device__ __forceinline__ void cv_steal_tail(const Ctx& C, int k) {
    unsigned* pd = (unsigned*)(C.ws + WS_CTL) + CW_PD + 64 * k;
    if (C.tid == 0) atomicAdd(pd, 1u);
    cv_steal(C, 1 << 20, pd);
}
#ifdef SEQ_PROBE
__device__ __forceinline__ void seq_probe(const Ctx& C) {
    unsigned char* out = WSP(unsigned char, WS_YB);
    constexpr int SEG = SEQ_PROBE, ROWS = 4096 / SEG, LPR = SEG / 4;
    for (int t = 0; t < 3; ++t) {
        const float* src = C.in[21 + t]; const int ldn = t < 2 ? 1024 : 2048; const size_t nrows = (size_t)2 * 32 * 2048 * 1024 / ldn;
        const size_t nblk_r = nrows / ROWS, nblk_c = ldn / SEG;
        for (size_t ch = (size_t)C.gw; ch < nblk_r * nblk_c; ch += (size_t)C.NGW) {
            const size_t rb = ch / nblk_c, cb = ch % nblk_c;
            f32x4 v[16];
#pragma unroll
            for (int i = 0; i < 16; ++i) { const int rr = (i * 64 + C.lane) / LPR, cc = (i * 64 + C.lane) % LPR; v[i] = *(const f32x4*)(src + (rb * ROWS + rr) * ldn + cb * SEG + 4 * cc); }
#pragma unroll
            for (int i = 0; i < 16; ++i) *(unsigned*)(out + ((ch * 4096 + i * 256 + 4 * C.lane) & (size_t)(64 * 1024 * 1024 - 1))) = pk4_fp8(v[i].x * 64.f, v[i].y * 64.f, v[i].z * 64.f, v[i].w * 64.f);
        }
    }
}
#endif
constexpr int CV_MOVED = 4608;
constexpr int CV_NEXP = 64 * 192, CV_KEEP = CV_NEXP - CV_MOVED;
constexpr int CW_CVQB = 10496;
__device__ __forceinline__ void cv_loop(const Ctx& C, unsigned* cvq, const int npos, const int woN, const int ibase) {
    const int lane = C.lane;
    {
        constexpr int NBE = (CVQ_FIRST / 1536) * 3 * 64, NBI = NBE + 128, CP = 272;
        LAS unsigned char* tiles = (LAS unsigned char*)(C.lds);
        const int w = C.wave, G4 = lane >> 4, i16 = lane & 15, q = i16 >> 1, p = i16 & 1;
        const float* const wg_in = C.in[21]; const float* const wu_in = C.in[22]; const float* const wd_in = C.in[23]; const float* const wo_in = C.in[15];
#define BI_FIELDS(bi_) const bool wo_ = (bi_) >= NBE; const int bx_ = wo_ ? (bi_) - NBE : (bi_); \
            const int le_ = wo_ ? bx_ >> 7 : bx_ / 192, rem_ = bx_ % 192, kind_ = wo_ ? 3 : rem_ >> 6, r_ = wo_ ? (bx_ & 127) : (rem_ & 63); \
            const float* W_ = wo_ ? wo_in + (size_t)le_ * 2048 * 2048 : (kind_ == 0 ? wg_in : (kind_ == 1 ? wu_in : wd_in)) + (size_t)le_ * 2048 * 1024; \
            unsigned char* WT_ = wo_ ? WSP(unsigned char, WS_WOUT) + (size_t)le_ * 2048 * 2048 : (kind_ < 2 ? WSP(unsigned char, WS_WGU) + (size_t)le_ * 2048 * 2048 : WSP(unsigned char, WS_WD) + (size_t)le_ * 2048 * 1024); \
            const int ldn_ = kind_ < 2 ? 1024 : 2048, K_ = (kind_ < 2 || wo_) ? 2048 : 1024, k0_ = kind_ < 2 ? 128 * (r_ >> 2) : 128 * (r_ >> 3), n0_ = kind_ < 2 ? 256 * (r_ & 3) : 256 * (r_ & 7); \
            (void)W_; (void)WT_; (void)ldn_; (void)K_; (void)k0_; (void)n0_
#define BI_LOAD(bi_, v_) do { BI_FIELDS(bi_); _Pragma("unroll") for (int i = 0; i < 16; ++i) v_[i] = *(const f32x4*)(W_ + (size_t)(k0_ + 16 * w + i) * ldn_ + n0_ + 4 * lane); } while (0)
        volatile LAS int* qs_ = (volatile LAS int*)(C.lds + GOFF_OFF);
#define CV_ITEM(p_) ((p_) >= npos ? NBI : ((p_) < woN ? NBE + (p_) : ibase + (p_) - woN))
        if (C.tid == 0) { qs_[0] = (int)atomicAdd(cvq, 1u); qs_[1] = (int)atomicAdd(cvq, 1u); }
        __syncthreads();
        int bi = CV_ITEM(qs_[0]), bnx = CV_ITEM(qs_[1]), buf = 0, qk = 0; f32x4 v0[16], v1[16];
        if (bi < NBI) BI_LOAD(bi, v0);
#define BI_STEP(vc_, vn_) do { \
            int qn_ = 0; if (C.tid == 0) qn_ = (int)atomicAdd(cvq, 1u);        \
            LAS unsigned char* tile = tiles + buf * (128 * CP); \
            _Pragma("unroll") for (int i = 0; i < 16; ++i) *(LAS unsigned*)(tile + (16 * w + i) * CP + 4 * lane) = pk4_fp8(vc_[i].x * 64.f, vc_[i].y * 64.f, vc_[i].z * 64.f, vc_[i].w * 64.f); \
            const int bn_ = bnx; if (bn_ < NBI) BI_LOAD(bn_, vn_); \
            if (C.tid == 0) qs_[2 + qk] = qn_; \
            __syncthreads(); \
            bnx = CV_ITEM(qs_[2 + qk]); qk ^= 1; \
            { BI_FIELDS(bi); \
            _Pragma("unroll") for (int r4 = 0; r4 < 4; ++r4) { const int nb16 = 2 * w + (r4 & 1), ck = 16 * (G4 + 4 * (r4 >> 1)); \
                const v2i_t lo_ = __builtin_amdgcn_ds_read_tr8_b64_v2i32((LAS v2i_t*)(tile + (ck + q) * CP + 16 * nb16 + 8 * p)); \
                const v2i_t hi_ = __builtin_amdgcn_ds_read_tr8_b64_v2i32((LAS v2i_t*)(tile + (ck + 8 + q) * CP + 16 * nb16 + 8 * p)); \
                v4u o_; o_.x = (unsigned)lo_.x; o_.y = (unsigned)lo_.y; o_.z = (unsigned)hi_.x; o_.w = (unsigned)hi_.y; \
                const int n_ = n0_ + 16 * nb16 + i16; const int drow_ = kind_ < 2 ? 256 * (n_ >> 7) + (n_ & 127) + 128 * kind_ : n_; \
                *(v4u*)(WT_ + (size_t)drow_ * K_ + k0_ + ck) = o_; } } \
            buf ^= 1; bi = bn_; } while (0)
        while (bi < NBI) {
            BI_STEP(v0, v1);
            if (bi >= NBI) break;
            BI_STEP(v1, v0);
        }
#undef BI_STEP
#undef CV_ITEM
#undef BI_LOAD
#undef BI_FIELDS
        __syncthreads();
    }
}
__device__ __forceinline__ void tr_finish_i8c(const TrItem& d, const f32x4 (&v)[16], LAS float* scr, int lane, const float (&qs)[4]) {
#pragma unroll
    for (int i = 0; i < 16; ++i) { LAS float* p = scr + (4 * i + (lane >> 4)) * TR_PITCH + 4 * (lane & 15); p[0] = v[i].x; p[1] = v[i].y; p[2] = v[i].z; p[3] = v[i].w; }
    LDS_WAIT(); asm volatile("" ::: "memory");
    const int c = lane & 3;
#pragma unroll
    for (int j = 0; j < 4; ++j) { const int n = (lane >> 2) + 16 * j; const LAS float* s = scr + (16 * c) * TR_PITCH + n; const float q = qs[j];
        v4u o;
        o.x = pk4_i8(s[0 * TR_PITCH] * q, s[1 * TR_PITCH] * q, s[2 * TR_PITCH] * q, s[3 * TR_PITCH] * q);
        o.y = pk4_i8(s[4 * TR_PITCH] * q, s[5 * TR_PITCH] * q, s[6 * TR_PITCH] * q, s[7 * TR_PITCH] * q);
        o.z = pk4_i8(s[8 * TR_PITCH] * q, s[9 * TR_PITCH] * q, s[10 * TR_PITCH] * q, s[11 * TR_PITCH] * q);
        o.w = pk4_i8(s[12 * TR_PITCH] * q, s[13 * TR_PITCH] * q, s[14 * TR_PITCH] * q, s[15 * TR_PITCH] * q);
        *(v4u*)((unsigned char*)d.WT + (size_t)(d.drow + n) * d.K + d.k0 + 16 * c) = o; }
    LDS_WAIT(); asm volatile("" ::: "memory");
}
constexpr int QG_FOX = 96 + 8 + 1, QG_GLA = 72 + 8 + 1, QG_MKV = 16, QG_WO1 = 32, QG_ALL = QG_FOX + QG_GLA + QG_MKV + QG_WO1;
__device__ __forceinline__ void quant_group(const Ctx& C, int g) {
    const float* const wf_in = C.in[5]; const float* const wl_in = C.in[9]; const float* const wm_in = C.in[3]; const float* const wo_in = C.in[15];
    const float* Wb; int ldn, c0, drow0; unsigned char* WT; float* SWC;
    if (g < QG_FOX) { Wb = wf_in; ldn = FOX_IN; WT = WSP(unsigned char, WS_WFOX); SWC = WSP(float, WS_SWC_FOX);
        if (g < 96) { c0 = 64 * g; drow0 = 64 * g; } else if (g < 104) { c0 = 6156 + 64 * (g - 96); drow0 = FP_QM + 64 * (g - 96); } else { c0 = 6144; drow0 = FP_F; } }
    else if (g < QG_FOX + QG_GLA) { const int q = g - QG_FOX; Wb = wl_in; ldn = GLA_IN; WT = WSP(unsigned char, WS_WGLA); SWC = WSP(float, WS_SWC_GLA);
        if (q < 72) { c0 = 64 * q; drow0 = 64 * q; } else if (q < 80) { c0 = 4624 + 64 * (q - 72); drow0 = GP_QM + 64 * (q - 72); } else { c0 = 4608; drow0 = GP_A; } }
    else if (g < QG_FOX + QG_GLA + QG_MKV) { const int q = g - QG_FOX - QG_GLA; Wb = wm_in; ldn = 1024; WT = WSP(unsigned char, WS_WMKV); SWC = WSP(float, WS_SWC_MKV); c0 = 64 * q; drow0 = 64 * q; }
    else { const int q = g - QG_FOX - QG_GLA - QG_MKV; Wb = wo_in + (size_t)D * D; ldn = D; WT = WSP(unsigned char, WS_WOUT) + (size_t)D * D; SWC = WSP(float, WS_SWC_WO1); c0 = 64 * q; drow0 = 64 * q; }
    const int lane = C.lane, w = C.wave;
    LAS float* scr = (LAS float*)(C.lds + w * TR_WAVE_BYTES);
    LAS float* cmax = (LAS float*)(C.lds + GOFF_OFF);
    TrItem e; e.W = Wb + c0; e.WT = (bf16*)WT; e.ldn = ldn; e.K = D; e.drow = drow0; e.n0 = 0; e.k0 = 0; e.qs = 0.f;
    f32x4 t[16]; float m0 = 0.f, m1 = 0.f, m2 = 0.f, m3 = 0.f;
#pragma unroll 1
    for (int j = 0; j < 4; ++j) { e.k0 = 64 * (4 * w + j); tr_load(e, lane, t);
#pragma unroll
        for (int i = 0; i < 16; ++i) { m0 = fmaxf(m0, fabsf(t[i].x)); m1 = fmaxf(m1, fabsf(t[i].y)); m2 = fmaxf(m2, fabsf(t[i].z)); m3 = fmaxf(m3, fabsf(t[i].w)); } }
    m0 = fmaxf(m0, __shfl_xor(m0, 16)); m1 = fmaxf(m1, __shfl_xor(m1, 16)); m2 = fmaxf(m2, __shfl_xor(m2, 16)); m3 = fmaxf(m3, __shfl_xor(m3, 16));
    m0 = fmaxf(m0, __shfl_xor(m0, 32)); m1 = fmaxf(m1, __shfl_xor(m1, 32)); m2 = fmaxf(m2, __shfl_xor(m2, 32)); m3 = fmaxf(m3, __shfl_xor(m3, 32));
    __syncthreads();
    if (lane < 16) *(LAS f32x4*)(cmax + w * 64 + 4 * lane) = (f32x4){m0, m1, m2, m3};
    __syncthreads();
    float qs[4];
#pragma unroll
    for (int j = 0; j < 4; ++j) { const int n = (lane >> 2) + 16 * j; float mx = cmax[n];
#pragma unroll
        for (int w8 = 1; w8 < 8; ++w8) mx = fmaxf(mx, cmax[w8 * 64 + n]);
        mx = fmaxf(mx, 1e-30f); qs[j] = 127.0f / mx;
        if (w == 0 && (lane & 3) == 0) SWC[drow0 + n] = mx * (1.0f / 127.0f); }
#pragma unroll 1
    for (int j = 0; j < 4; ++j) { e.k0 = 64 * (4 * w + j); tr_load(e, lane, t); tr_finish_i8c(e, t, scr, lane, qs); }
}
__device__ __forceinline__ void p0_prologue(const Ctx& C) {
    for (int g = blockIdx.x; g < QG_ALL; g += C.G) quant_group(C, g);
    __syncthreads();
    LAS float* scr = (LAS float*)(C.lds + C.wave * TR_WAVE_BYTES);
    const int lane = C.lane;
    cv_loop(C, (unsigned*)(C.ws + WS_CTL) + CW_CVQ, 128 + CV_KEEP, 128, 0);
    for (int m = 2 * C.gw; m < T; m += 2 * C.NGW) {
        f32x4 v[8], w[8];
        load_row(C.in[0] + (size_t)m * D, lane, v); load_row(C.in[0] + (size_t)(m + 1) * D, lane, w);
        const float iv = row_inv_rms(v), iw = row_inv_rms(w);
        norm_store_row_i8(WSP(unsigned char, WS_HN) + (size_t)m * D, WSP(float, WS_SA) + m, v, iv, C.in[4], lane);
        norm_store_row_i8(WSP(unsigned char, WS_HN) + (size_t)(m + 1) * D, WSP(float, WS_SA) + m + 1, w, iw, C.in[4], lane);
    }
    for (int r = C.gw; r < NB * ML; r += C.NGW) { f32x4 v[8]; load_row(C.in[1] + (size_t)r * D, lane, v); const float inv = row_inv_rms(v);
        norm_store_row_i8(WSP(unsigned char, WS_MEMN) + (size_t)r * D, WSP(float, WS_SAM) + r, v, inv, C.in[2], lane); }
    for (int i = blockIdx.x * 512 + C.tid; i < 2 * 64 * D; i += C.G * 512) {
        const int k = i & (D - 1), rho = (i >> 11) & 63, layer = i >> 17;
        float v = 0.f;
        if (rho < 32) { const int hh = (rho >> 2) & 1, reg = 4 * (rho >> 3) + (rho & 3), e = (2 * hh + (reg >> 3)) * 8 + (reg & 7); v = C.in[19][((size_t)layer * D + k) * 32 + e]; }
        else if (rho < 40) v = C.in[17][((size_t)layer * D + k) * 4 + (rho & 3)];
        const unsigned hi = pk2(v, 0.f) & 0xffffu; const float lo = v - bflo(hi);
        bf16* wr = WSP(bf16, WS_WR) + (size_t)layer * 2 * 64 * D;
        wr[(size_t)rho * D + k] = (bf16)hi; wr[(size_t)(64 + rho) * D + k] = (bf16)(pk2(lo, 0.f) & 0xffffu);
    }
}

__device__ __forceinline__ void p1_quant(const Ctx& C) {
    LAS float* scr = (LAS float*)(C.lds + C.wave * TR_WAVE_BYTES);
    const int lane = C.lane;
    const unsigned* am = (const unsigned*)(C.ws + WS_CTL) + CW_AMAX;
    const float qf = 127.0f / fmaxf(__builtin_bit_cast(float, am[0]), 1e-30f), qg = 127.0f / fmaxf(__builtin_bit_cast(float, am[64]), 1e-30f), qm = 127.0f / fmaxf(__builtin_bit_cast(float, am[128]), 1e-30f),
                qo0 = 127.0f / fmaxf(__builtin_bit_cast(float, am[192]), 1e-30f), qo1 = 127.0f / fmaxf(__builtin_bit_cast(float, am[256]), 1e-30f);
    constexpr int I_FOX = 32 * (96 + 8 + 1), I_GLA = 32 * (72 + 8 + 1), I_WO = 32 * 32, I_MKV = 32 * 16;
    constexpr int OTHER = I_FOX + I_GLA + I_MKV + I_WO;
#define OTHER_DECODE(it_, d_) do { int r = (it_); \
        if (tr_group(r, C.in[5], FOX_IN, D, 0, 96, WSP(bf16, WS_WFOX), 0, d_)) { (d_).qs = qf; break; }              \
        if (tr_group(r, C.in[5], FOX_IN, D, 6156, 8, WSP(bf16, WS_WFOX), FP_QM, d_)) { (d_).qs = qf; break; }        \
        if (tr_group(r, C.in[5], FOX_IN, D, 6144, 1, WSP(bf16, WS_WFOX), FP_F, d_)) { (d_).qs = qf; break; }         \
        if (tr_group(r, C.in[9], GLA_IN, D, 0, 72, WSP(bf16, WS_WGLA), 0, d_)) { (d_).qs = qg; break; }              \
        if (tr_group(r, C.in[9], GLA_IN, D, 4624, 8, WSP(bf16, WS_WGLA), GP_QM, d_)) { (d_).qs = qg; break; }        \
        if (tr_group(r, C.in[9], GLA_IN, D, 4608, 1, WSP(bf16, WS_WGLA), GP_A, d_)) { (d_).qs = qg; break; }         \
        if (tr_group(r, C.in[3], 1024, D, 0, 16, WSP(bf16, WS_WMKV), 0, d_)) { (d_).qs = qm; break; } \
        tr_group(r, C.in[15] + (size_t)D * D, D, D, 0, 32, (bf16*)(WSP(unsigned char, WS_WOUT) + (size_t)D * D), 0, d_); (d_).qs = qo1; } while (0)
    {
        int it = C.gw; TrItem e0, e1; f32x4 t0[16], t1[16];
        if (it < OTHER) { OTHER_DECODE(it, e0); tr_load(e0, lane, t0); }
        while (it < OTHER) {
            const int it1 = it + C.NGW;
            if (it1 < OTHER) { OTHER_DECODE(it1, e1); tr_load(e1, lane, t1); }
            tr_finish_i8(e0, t0, scr, lane);
            if (it1 >= OTHER) break;
            const int it2 = it1 + C.NGW;
            if (it2 < OTHER) { OTHER_DECODE(it2, e0); tr_load(e0, lane, t0); }
            tr_finish_i8(e1, t1, scr, lane);
            it = it2;
        }
    }
#undef OTHER_DECODE
}
__device__ __forceinline__ float log_sigmoid(float x) { return fminf(x, 0.f) - log1pf(expf(-fabsf(x))); }
__device__ __forceinline__ float log_sigmoid_fast(float x) { return fminf(x, 0.f) - __logf(1.0f + __expf(-fabsf(x))); }

__device__ __forceinline__ void headnorm_inplace(bf16* rowp, int col0, int nh, const float* g, int lane) {
    const float g0 = g[2 * lane], g1 = g[2 * lane + 1];
    for (int h = 0; h < nh; ++h) {
        unsigned* p = (unsigned*)(rowp + col0 + h * HD) + lane; const unsigned u = *p; const float a = bflo(u), b = bfhi(u);
        const float ss = wave_sum(a * a + b * b); const float inv = 1.0f / sqrtf(ss * (1.0f / HD) + RMS_EPS);
        *p = pk2(a * inv * g0, b * inv * g1);
    }
}
__device__ __forceinline__ void p3_fox_thin(const Ctx& C) {
    bf16* P = WSP(bf16, WS_P);
    for (int it = C.gw; it < NB * ML * MH; it += C.NGW) {
        const int row = it >> 2, mh = it & 3;
        const unsigned u = *((const unsigned*)(WSP(bf16, WS_MKV) + (size_t)row * 1024 + mh * HD) + C.lane); const float a = bflo(u), b = bfhi(u);
        const float ss = wave_sum(a * a + b * b); const float inv = 1.0f / sqrtf(ss * (1.0f / HD) + RMS_EPS);
#pragma unroll
        for (int l = 0; l < 2; ++l) { const float* g = C.in[14] + l * HD;
            *((unsigned*)(WSP(bf16, WS_MK) + (size_t)l * 1024 * 512 + (size_t)row * 512 + mh * HD) + C.lane) = pk2(a * inv * g[2 * C.lane], b * inv * g[2 * C.lane + 1]); }
    }
    LAS float* sm = (LAS float*)(C.lds + RING_OFF);
    for (int bh = blockIdx.x; bh < NB * FH; bh += C.G) {
        const int b = bh / FH, h = bh % FH; const float bf = C.in[6][h];
        const float* fl = WSP(float, WS_FL) + (size_t)(b * S) * 16 + h;
        float ls[8], tot = 0.f;
#pragma unroll
        for (int i = 0; i < 8; ++i) { ls[i] = log_sigmoid(fl[(size_t)(8 * C.tid + i) * 16] + bf); tot += ls[i]; ls[i] = tot; }
        float inc = tot;
#pragma unroll
        for (int o = 1; o < 64; o <<= 1) { const float t = __shfl_up(inc, o); if (C.lane >= o) inc += t; }
        __syncthreads();
        if (C.lane == 63) sm[C.wave] = inc;
        __syncthreads();
        float woff = 0.f;
        for (int w = 0; w < C.wave; ++w) woff += sm[w];
        const float excl = woff + inc - tot;
        float* cp = WSP(float, WS_C) + (size_t)bh * S + 8 * C.tid;
#pragma unroll
        for (int i = 0; i < 8; ++i) cp[i] = excl + ls[i];
    }
}

__device__ __forceinline__ void naive_attn_row(const bf16* qptr, const bf16* Kb, int kstride, const bf16* Vb, int vstride, int nk, const float* cptr, float ct,
                                               LAS float* qs, int lane, float& o0, float& o1) {
    { const unsigned qq = *((const unsigned*)qptr + lane); qs[2 * lane] = bflo(qq); qs[2 * lane + 1] = bfhi(qq); }
    LDS_WAIT(); asm volatile("" ::: "memory");
    float m = -1e30f, l = 0.f, a0 = 0.f, a1 = 0.f;
    for (int j0 = 0; j0 < nk; j0 += 64) {
        const int j = j0 + lane; const bool valid = j < nk; const int jc = valid ? j : nk - 1;
        const bf16* kr = Kb + (size_t)jc * kstride;
        float s = 0.f;
#pragma unroll 4
        for (int d8 = 0; d8 < 16; ++d8) {
            const v4u kk = *(const v4u*)(kr + 8 * d8);
            const f32x4 qa = *(const LAS f32x4*)(qs + 8 * d8), qb = *(const LAS f32x4*)(qs + 8 * d8 + 4);
            s += bflo(kk.x) * qa.x + bfhi(kk.x) * qa.y + bflo(kk.y) * qa.z + bfhi(kk.y) * qa.w + bflo(kk.z) * qb.x + bfhi(kk.z) * qb.y + bflo(kk.w) * qb.z + bfhi(kk.w) * qb.w;
        }
        s *= 0.08838834764831845f;
        if (cptr) s += ct - cptr[jc];
        if (!valid) s = -__builtin_inff();
        const float mn = fmaxf(m, wave_max(s)); const float alpha = expf(m - mn); const float p = valid ? expf(s - mn) : 0.f;
        l = l * alpha + wave_sum(p); a0 *= alpha; a1 *= alpha; m = mn;
        const int cnt = (nk - j0) < 64 ? (nk - j0) : 64;
        for (int jj = 0; jj < cnt; ++jj) { const float pj = __shfl(p, jj); const unsigned vv = *((const unsigned*)(Vb + (size_t)(j0 + jj) * vstride) + lane); a0 += pj * bflo(vv); a1 += pj * bfhi(vv); }
    }
    o0 = a0 / l; o1 = a1 / l;
    asm volatile("" ::: "memory");
}
__device__ __forceinline__ void naive_mem_attn(const Ctx& C, const bf16* P, int ldp, int qcol, int layer, int row, int mh, LAS float* qs) {
    const int b = row / S; float o0, o1;
    naive_attn_row(P + (size_t)row * ldp + qcol + mh * HD, WSP(bf16, WS_MK) + (size_t)layer * 1024 * 512 + (size_t)(b * ML) * 512 + mh * HD, 512,
                   WSP(bf16, WS_MKV) + (size_t)(b * ML) * 1024 + 512 + mh * HD, 1024, ML, nullptr, 0.f, qs, C.lane, o0, o1);
    *((unsigned*)(WSP(bf16, WS_CAT) + (size_t)row * D + FW + mh * HD) + C.lane) = pk2(o0, o1);
}
__device__ __forceinline__ void p4_fox_attn_naive(const Ctx& C) {
    LAS float* qs = (LAS float*)(C.lds + RING_OFF + C.wave * 16384);
    const bf16* P = WSP(bf16, WS_P);
    for (int it = C.gw; it < T * 16; it += C.NGW) {
        const int hh = it / T, row = it % T;
        if (hh < FH) {
            const int b = row / S, t = row % S; float o0, o1;
            const float* cp = WSP(float, WS_C) + (size_t)(b * FH + hh) * S;
            naive_attn_row(P + (size_t)row * FOX_NP + FP_Q + hh * HD, P + (size_t)(b * S) * FOX_NP + FP_K + hh * HD, FOX_NP, P + (size_t)(b * S) * FOX_NP + FP_V + hh * HD, FOX_NP,
                           t + 1, cp, cp[t], qs, C.lane, o0, o1);
            const unsigned og = *((const unsigned*)(P + (size_t)row * FOX_NP + FP_OG + hh * HD) + C.lane);
            const float g0 = 1.0f / (1.0f + expf(-bflo(og))), g1 = 1.0f / (1.0f + expf(-bfhi(og)));
            *((unsigned*)(WSP(bf16, WS_CAT) + (size_t)row * D + hh * HD) + C.lane) = pk2(o0 * g0, o1 * g1);
        } else naive_mem_attn(C, P, FOX_NP, FP_QM, 0, row, hh - FH, qs);
    }
}

__device__ __forceinline__ void p12_gla_thin(const Ctx& C) {
    bf16* P = WSP(bf16, WS_P);
    const float* w2 = C.in[10]; const float* ba = C.in[11];
    for (int m = C.gw; m < T; m += C.NGW) {
        headnorm_inplace(P + (size_t)m * GLA_NP, GP_QM, MH, C.in[13] + HD, C.lane);
        const float* fl = WSP(float, WS_FL) + (size_t)m * 16;
        float al[16];
#pragma unroll
        for (int r = 0; r < 16; ++r) al[r] = fl[r];
        float* la = WSP(float, WS_LA) + (size_t)m * GKW;
#pragma unroll 1
        for (int j = 0; j < 12; ++j) { const int c = C.lane + 64 * j; float s = ba[c];
#pragma unroll
            for (int r = 0; r < 16; ++r) s += al[r] * w2[r * GKW + c];
            la[c] = expf(log_sigmoid(s) * (1.0f / 16.0f)); }
    }
}
__device__ __forceinline__ void p13_gla_naive(const Ctx& C) {
    const bf16* P = WSP(bf16, WS_P); const float* LA = WSP(float, WS_LA); float* GO = WSP(float, WS_GO);
    const int lane = C.lane;
    for (int it = C.gw; it < NB * GH * 128; it += C.NGW) {
        const int bh = it >> 7, e0 = (it & 127) * 3, b = bh >> 2, h = bh & 3;
        float st[3][3];
#pragma unroll
        for (int i = 0; i < 3; ++i)
#pragma unroll
            for (int e = 0; e < 3; ++e) st[i][e] = 0.f;
        const float qsc = 0.07216878364870322f;
        for (int t0 = 0; t0 < S; t0 += 4) {
            float a[4][3], k[4][3], q[4][3], v[4][3];
#pragma unroll
            for (int u = 0; u < 4; ++u) { const size_t row = (size_t)(b * S + t0 + u);
#pragma unroll
                for (int i = 0; i < 3; ++i) { const int d = lane + 64 * i;
                    a[u][i] = LA[row * GKW + h * GDK + d]; k[u][i] = bf2f(P[row * GLA_NP + GP_K + h * GDK + d]); q[u][i] = bf2f(P[row * GLA_NP + GP_Q + h * GDK + d]) * qsc; }
#pragma unroll
                for (int e = 0; e < 3; ++e) v[u][e] = bf2f(P[row * GLA_NP + GP_V + h * GDV + e0 + e]); }
#pragma unroll
            for (int u = 0; u < 4; ++u) { float o[3] = {0.f, 0.f, 0.f};
#pragma unroll
                for (int i = 0; i < 3; ++i)
#pragma unroll
                    for (int e = 0; e < 3; ++e) { st[i][e] = a[u][i] * st[i][e] + k[u][i] * v[u][e]; o[e] += q[u][i] * st[i][e]; }
#pragma unroll
                for (int e = 0; e < 3; ++e) o[e] = wave_sum(o[e]);
                if (lane < 3) GO[(size_t)(b * S + t0 + u) * GVW + h * GDV + e0 + lane] = lane == 0 ? o[0] : (lane == 1 ? o[1] : o[2]); }
        }
    }
}
constexpr size_t WS_CAT8 = WS_H, WS_SC = WS_H + 40 * MiB;
__device__ __forceinline__ void p14_gla_onorm(const Ctx& C) {
    const bf16* __restrict__ P = WSP(bf16, WS_P); const float* __restrict__ GO = WSP(float, WS_GO); const float* __restrict__ og = C.in[12]; const bf16* __restrict__ CAT = WSP(bf16, WS_CAT);
    unsigned char* __restrict__ C8 = WSP(unsigned char, WS_CAT8); float* __restrict__ SC = WSP(float, WS_SC);
    const int lane = C.lane;
    float g0[3], g1[3];
#pragma unroll
    for (int i = 0; i < 3; ++i) { g0[i] = og[128 * i + 2 * lane]; g1[i] = og[128 * i + 2 * lane + 1]; }
    for (int m0 = 2 * C.gw; m0 < T; m0 += 2 * C.NGW) {
        f32x2 x[2][4][3]; unsigned ru[2][4][3]; float ss[2][4]; v4u mo[2];
#pragma unroll
        for (int q = 0; q < 2; ++q) { mo[q] = *((const v4u*)(CAT + (size_t)(m0 + q) * D + FW) + lane);
#pragma unroll
            for (int h = 0; h < GH; ++h) { ss[q][h] = 0.f;
#pragma unroll
                for (int i = 0; i < 3; ++i) { const unsigned gu = *((const unsigned*)((const bf16*)GO + (size_t)(m0 + q) * GVW + h * GDV + 128 * i) + lane); x[q][h][i] = (f32x2){bflo(gu), bfhi(gu)};
                    ru[q][h][i] = *((const unsigned*)(P + (size_t)(m0 + q) * GLA_NP + GP_R + h * GDV + 128 * i) + lane); } } }
#pragma unroll
        for (int q = 0; q < 2; ++q)
#pragma unroll
            for (int h = 0; h < GH; ++h)
#pragma unroll
                for (int i = 0; i < 3; ++i) ss[q][h] += x[q][h][i].x * x[q][h][i].x + x[q][h][i].y * x[q][h][i].y;
#pragma unroll
        for (int o = 1; o < 64; o <<= 1)
#pragma unroll
            for (int q = 0; q < 2; ++q)
#pragma unroll
                for (int h = 0; h < GH; ++h) ss[q][h] += __shfl_xor(ss[q][h], o);
        float am[2];
#pragma unroll
        for (int q = 0; q < 2; ++q) {
            am[q] = fmaxf(fmaxf(fmaxf(fabsf(bflo(mo[q].x)), fabsf(bfhi(mo[q].x))), fmaxf(fabsf(bflo(mo[q].y)), fabsf(bfhi(mo[q].y)))), fmaxf(fmaxf(fabsf(bflo(mo[q].z)), fabsf(bfhi(mo[q].z))), fmaxf(fabsf(bflo(mo[q].w)), fabsf(bfhi(mo[q].w)))));
#pragma unroll
            for (int h = 0; h < GH; ++h) { const float inv = 1.0f / sqrtf(ss[q][h] * (1.0f / GDV) + RMS_EPS);
#pragma unroll
                for (int i = 0; i < 3; ++i) { const float r0 = bflo(ru[q][h][i]), r1 = bfhi(ru[q][h][i]);
                    x[q][h][i].x = x[q][h][i].x * inv * g0[i] * (r0 * __builtin_amdgcn_rcpf(1.0f + __expf(-r0))); x[q][h][i].y = x[q][h][i].y * inv * g1[i] * (r1 * __builtin_amdgcn_rcpf(1.0f + __expf(-r1)));
                    am[q] = fmaxf(am[q], fmaxf(fabsf(x[q][h][i].x), fabsf(x[q][h][i].y))); } } }
#pragma unroll
        for (int o = 1; o < 64; o <<= 1) { am[0] = fmaxf(am[0], __shfl_xor(am[0], o)); am[1] = fmaxf(am[1], __shfl_xor(am[1], o)); }
#pragma unroll
        for (int q = 0; q < 2; ++q) { const float a = fmaxf(am[q], 1e-30f), qs = 127.0f / a; unsigned char* row8 = C8 + (size_t)(m0 + q) * D;
#pragma unroll
            for (int h = 0; h < GH; ++h)
#pragma unroll
                for (int i = 0; i < 3; ++i) ((unsigned short*)(row8 + h * GDV + 128 * i))[lane] = (unsigned short)(pk4_i8(x[q][h][i].x * qs, x[q][h][i].y * qs, 0.f, 0.f) & 0xffffu);
            v2u o8; o8.x = pk4_i8(bflo(mo[q].x) * qs, bfhi(mo[q].x) * qs, bflo(mo[q].y) * qs, bfhi(mo[q].y) * qs); o8.y = pk4_i8(bflo(mo[q].z) * qs, bfhi(mo[q].z) * qs, bflo(mo[q].w) * qs, bfhi(mo[q].w) * qs);
            ((v2u*)(row8 + FW))[lane] = o8;
            if (lane == 0) SC[m0 + q] = a * (1.0f / 127.0f); }
    }
}

__device__ __forceinline__ void p_requant_cat(const Ctx& C) {
    const bf16* __restrict__ CAT = WSP(bf16, WS_CAT); unsigned char* __restrict__ C8 = WSP(unsigned char, WS_CAT8); float* __restrict__ SC = WSP(float, WS_SC);
    const int lane = C.lane;
    for (int m0 = 2 * C.gw; m0 < T; m0 += 2 * C.NGW) {
        v2u x[2][8]; float am[2];
#pragma unroll
        for (int q = 0; q < 2; ++q)
#pragma unroll
            for (int j = 0; j < 8; ++j) x[q][j] = ((const v2u*)(CAT + (size_t)(m0 + q) * D))[lane + 64 * j];
#pragma unroll
        for (int q = 0; q < 2; ++q) { am[q] = 0.f;
#pragma unroll
            for (int j = 0; j < 8; ++j) am[q] = fmaxf(fmaxf(am[q], fmaxf(fabsf(bflo(x[q][j].x)), fabsf(bfhi(x[q][j].x)))), fmaxf(fabsf(bflo(x[q][j].y)), fabsf(bfhi(x[q][j].y)))); }
#pragma unroll
        for (int o = 1; o < 64; o <<= 1) { am[0] = fmaxf(am[0], __shfl_xor(am[0], o)); am[1] = fmaxf(am[1], __shfl_xor(am[1], o)); }
#pragma unroll
        for (int q = 0; q < 2; ++q) { const float a = fmaxf(am[q], 1e-30f), qs = 127.0f / a;
#pragma unroll
            for (int j = 0; j < 8; ++j) ((unsigned*)(C8 + (size_t)(m0 + q) * D))[lane + 64 * j] = pk4_i8(bflo(x[q][j].x) * qs, bfhi(x[q][j].x) * qs, bflo(x[q][j].y) * qs, bfhi(x[q][j].y) * qs);
            if (lane == 0) SC[m0 + q] = a * (1.0f / 127.0f); }
    }
}

__device__ __forceinline__ void p6_router(const Ctx& C, int layer, bool commit = true) {
    const float* X = WSP(float, WS_XB); const float* g = C.in[16] + layer * D;
    const float* wg = C.in[17] + (size_t)layer * D * 4; const float* we = C.in[19] + (size_t)layer * D * 32;
    const float* bg = C.in[18] + layer * 4; const float* be = C.in[20] + layer * 32;
    unsigned* cnt = (unsigned*)(C.ws + WS_CTL) + CW_CNT + layer * 32;
    int* toke = (int*)(C.ws + WS_ROUTE + RT_TOKE); int* toks = (int*)(C.ws + WS_ROUTE + RT_TOKS); float* tokw = (float*)(C.ws + WS_ROUTE + RT_TOKW);
    const int lane = C.lane;
    LAS float* hs = (LAS float*)(C.lds + RING_OFF + C.wave * 16384);
    for (int pr = C.gw; pr < T / 2; pr += C.NGW) {
        {
            f32x4 x0[8], x1[8];
            load_row(X + (size_t)(2 * pr) * D, lane, x0); load_row(X + (size_t)(2 * pr + 1) * D, lane, x1);
            const float i0 = row_inv_rms(x0), i1 = row_inv_rms(x1);
            norm_store_row(WSP(bf16, WS_HN) + (size_t)(2 * pr) * D, x0, i0, g, lane);
            norm_store_row(WSP(bf16, WS_HN) + (size_t)(2 * pr + 1) * D, x1, i1, g, lane);
#pragma unroll
            for (int j = 0; j < 8; ++j) { ((LAS f32x4*)hs)[lane + 64 * j] = x0[j]; ((LAS f32x4*)(hs + D))[lane + 64 * j] = x1[j]; }
        }
        LDS_WAIT(); asm volatile("" ::: "memory");
        float a0[36], a1[36];
#pragma unroll
        for (int n = 0; n < 36; ++n) { a0[n] = 0.f; a1[n] = 0.f; }
#pragma unroll 2
        for (int kk = 0; kk < 32; ++kk) {
            const int k = lane + 64 * kk; const float h0 = hs[k], h1 = hs[D + k];
            const f32x4 w4 = *(const f32x4*)(wg + (size_t)k * 4);
#pragma unroll
            for (int n = 0; n < 4; ++n) { a0[n] += h0 * w4[n]; a1[n] += h1 * w4[n]; }
#pragma unroll
            for (int q = 0; q < 8; ++q) { const f32x4 w = *(const f32x4*)(we + (size_t)k * 32 + 4 * q);
#pragma unroll
                for (int n = 0; n < 4; ++n) { a0[4 + 4 * q + n] += h0 * w[n]; a1[4 + 4 * q + n] += h1 * w[n]; } }
        }
        asm volatile("" ::: "memory");
#pragma unroll
        for (int n = 0; n < 36; ++n) { a0[n] = wave_sum(a0[n]); a1[n] = wave_sum(a1[n]); }
#pragma unroll
        for (int rr = 0; rr < 2; ++rr) {
            float lg[36];
#pragma unroll
            for (int n = 0; n < 36; ++n) lg[n] = rr == 0 ? a0[n] : a1[n];
            float gl[4]; int gi = 0; float gm;
#pragma unroll
            for (int n = 0; n < 4; ++n) gl[n] = lg[n] + bg[n];
            gm = gl[0];
#pragma unroll
            for (int n = 1; n < 4; ++n) if (gl[n] > gm) { gm = gl[n]; gi = n; }
            float gs = 0.f;
#pragma unroll
            for (int n = 0; n < 4; ++n) gs += expf(gl[n] - gm);
            const float gp = 1.0f / gs;
            float ev[8];
#pragma unroll
            for (int j = 0; j < 8; ++j) { const float v0 = lg[4 + j] + be[j], v1 = lg[12 + j] + be[8 + j], v2 = lg[20 + j] + be[16 + j], v3 = lg[28 + j] + be[24 + j];
                ev[j] = gi == 0 ? v0 : (gi == 1 ? v1 : (gi == 2 ? v2 : v3)); }
            int e1 = 0; float m1 = ev[0];
#pragma unroll
            for (int j = 1; j < 8; ++j) if (ev[j] > m1) { m1 = ev[j]; e1 = j; }
            int e2 = -1; float m2 = -__builtin_inff();
#pragma unroll
            for (int j = 0; j < 8; ++j) if (j != e1 && ev[j] > m2) { m2 = ev[j]; e2 = j; }
            const float z = expf(m2 - m1); const float w1 = gp / (1.0f + z), w2 = gp * z / (1.0f + z);
            if (lane == 0) {
                const int tok = 2 * pr + rr; const int id1 = gi * 8 + e1, id2 = gi * 8 + e2;
                if (commit) { const unsigned s1 = atomicAdd(cnt + id1, 1u), s2 = atomicAdd(cnt + id2, 1u); toks[2 * tok] = (int)s1; toks[2 * tok + 1] = (int)s2; }
                toke[2 * tok] = id1; tokw[2 * tok] = w1;
                toke[2 * tok + 1] = id2; tokw[2 * tok + 1] = w2;
            }
        }
    }
}
__device__ __forceinline__ void p6_router_mfma(const Ctx& C, int layer, bool commit = true) {
    const bf16* X = WSP(bf16, WS_XB); const float* g = C.in[16] + layer * D;
    const bf16* WR = WSP(bf16, WS_WR) + (size_t)layer * 2 * 64 * D;
    const float* bg = C.in[18] + layer * 4; const float* be = C.in[20] + layer * 32;
    unsigned* cnt = (unsigned*)(C.ws + WS_CTL) + CW_CNT + layer * 32;
    int* lsta = WSP(int, WS_LSTA); float* lstw = WSP(float, WS_LSTW); unsigned char* __restrict__ XN8 = WSP(unsigned char, WS_XN8);
    const int lane = C.lane, r = lane & 31, h = lane >> 5;
    LAS float* red = (LAS float*)(C.lds + RING_OFF);
    LAS float* invs = red + 4 * 2 * 21 * 64;
    for (int tb = blockIdx.x; tb < T / 64; tb += C.G) {
        const int tg = C.wave & 1, kq = C.wave >> 1;
        const int row = 64 * tb + 32 * tg + r;
        const bf16* xp = X + (size_t)row * D + 8 * h; const float* gp = g + 8 * h;
        const bf16* w0 = WR + (size_t)r * D + 8 * h;
        f32x16 acc0, acc1;
#pragma unroll
        for (int i = 0; i < 16; ++i) { acc0[i] = 0.f; acc1[i] = 0.f; }
        float ss = 0.f;
#pragma unroll 4
        for (int s = 32 * kq; s < 32 * kq + 32; ++s) {
            const v4u xr = *(const v4u*)(xp + 16 * s);
            const f32x4 xa = (f32x4){bflo(xr.x), bfhi(xr.x), bflo(xr.y), bfhi(xr.y)}, xb = (f32x4){bflo(xr.z), bfhi(xr.z), bflo(xr.w), bfhi(xr.w)};
            const f32x4 ga = *(const f32x4*)(gp + 16 * s), gb = *(const f32x4*)(gp + 16 * s + 4);
            ss += (xa.x * xa.x + xa.y * xa.y) + (xa.z * xa.z + xa.w * xa.w) + (xb.x * xb.x + xb.y * xb.y) + (xb.z * xb.z + xb.w * xb.w);
            const f32x4 va = xa * ga, vb = xb * gb;
            v4u hi; hi.x = pk2(va.x, va.y); hi.y = pk2(va.z, va.w); hi.z = pk2(vb.x, vb.y); hi.w = pk2(vb.z, vb.w);
            v4u lo; lo.x = pk2(va.x - bflo(hi.x), va.y - bfhi(hi.x)); lo.y = pk2(va.z - bflo(hi.y), va.w - bfhi(hi.y));
            lo.z = pk2(vb.x - bflo(hi.z), vb.y - bfhi(hi.z)); lo.w = pk2(vb.z - bflo(hi.w), vb.w - bfhi(hi.w));
            const bf16x8 xh = __builtin_bit_cast(bf16x8, hi), xl = __builtin_bit_cast(bf16x8, lo);
            const bf16x8 a0h = *(const bf16x8*)(w0 + 16 * s), a1h = *(const bf16x8*)(w0 + (size_t)32 * D + 16 * s);
            const bf16x8 a0l = *(const bf16x8*)(w0 + (size_t)64 * D + 16 * s), a1l = *(const bf16x8*)(w0 + (size_t)96 * D + 16 * s);
            acc0 = __builtin_amdgcn_mfma_f32_32x32x16_bf16(a0h, xh, acc0, 0, 0, 0); acc1 = __builtin_amdgcn_mfma_f32_32x32x16_bf16(a1h, xh, acc1, 0, 0, 0);
            acc0 = __builtin_amdgcn_mfma_f32_32x32x16_bf16(a0l, xh, acc0, 0, 0, 0); acc1 = __builtin_amdgcn_mfma_f32_32x32x16_bf16(a1l, xh, acc1, 0, 0, 0);
            acc0 = __builtin_amdgcn_mfma_f32_32x32x16_bf16(a0h, xl, acc0, 0, 0, 0); acc1 = __builtin_amdgcn_mfma_f32_32x32x16_bf16(a1h, xl, acc1, 0, 0, 0);
        }
        __syncthreads();
        { LAS float* rp = red + ((kq * 2 + tg) * 21) * 64 + lane;
#pragma unroll
          for (int i = 0; i < 16; ++i) rp[i * 64] = acc0[i];
#pragma unroll
          for (int i = 0; i < 4; ++i) rp[(16 + i) * 64] = acc1[i];
          rp[20 * 64] = ss; }
        __syncthreads();
        if (kq == 0) {
#pragma unroll
        for (int q = 1; q < 4; ++q) { const LAS float* rp = red + ((q * 2 + tg) * 21) * 64 + lane;
#pragma unroll
            for (int i = 0; i < 16; ++i) acc0[i] += rp[i * 64];
#pragma unroll
            for (int i = 0; i < 4; ++i) acc1[i] += rp[(16 + i) * 64];
            ss += rp[20 * 64]; }
        ss += __shfl_xor(ss, 32);
        const float inv = 1.0f / sqrtf(ss * (1.0f / D) + RMS_EPS);
        if (h == 0) invs[32 * tg + r] = inv;
        float gl[4]; int gi = 0;
#pragma unroll
        for (int n = 0; n < 4; ++n) gl[n] = acc1[n] * inv + bg[n];
        float gm = gl[0];
#pragma unroll
        for (int n = 1; n < 4; ++n) if (gl[n] > gm) { gm = gl[n]; gi = n; }
        float gs = 0.f;
#pragma unroll
        for (int n = 0; n < 4; ++n) gs += expf(gl[n] - gm);
        const float gpr = 1.0f / gs;
        float ev[8];
#pragma unroll
        for (int j = 0; j < 8; ++j) ev[j] = ((gi & 1) ? acc0[8 + j] : acc0[j]) * inv + be[gi * 8 + j];
        int e1 = 0; float m1 = ev[0];
#pragma unroll
        for (int j = 1; j < 8; ++j) if (ev[j] > m1) { m1 = ev[j]; e1 = j; }
        int e2 = -1; float m2 = -__builtin_inff();
#pragma unroll
        for (int j = 0; j < 8; ++j) if (j != e1 && ev[j] > m2) { m2 = ev[j]; e2 = j; }
        const float z = expf(m2 - m1); const float w1 = gpr / (1.0f + z), w2 = gpr * z / (1.0f + z);
        if (h == (gi >> 1) && commit) {
            const int tok = row; const int id1 = gi * 8 + e1, id2 = gi * 8 + e2;
            const unsigned s1 = atomicAdd(cnt + id1, 1u), s2 = atomicAdd(cnt + id2, 1u);
            lsta[id1 * T + (int)s1] = 2 * tok; lstw[id1 * T + (int)s1] = w1;
            lsta[id2 * T + (int)s2] = 2 * tok + 1; lstw[id2 * T + (int)s2] = w2;
        }
        }
        __syncthreads();
        { const bf16* __restrict__ Xr = X; const float* __restrict__ g4 = g;
          f32x4 gg[8];
#pragma unroll
          for (int j = 0; j < 8; ++j) gg[j] = ((const f32x4*)g4)[lane + 64 * j] * 8.0f;
          const int t0 = 64 * tb + 8 * C.wave;
#pragma unroll 1
          for (int i = 0; i < 8; i += 4) {
              v2u x[4][8]; float iv[4];
#pragma unroll
              for (int q = 0; q < 4; ++q) {
#pragma unroll
                  for (int j = 0; j < 8; ++j) x[q][j] = ((const v2u*)(Xr + (size_t)(t0 + i + q) * D))[lane + 64 * j];
                  iv[q] = invs[8 * C.wave + i + q]; }
#pragma unroll
              for (int q = 0; q < 4; ++q)
#pragma unroll
                  for (int j = 0; j < 8; ++j)
                      ((unsigned*)(XN8 + (size_t)(t0 + i + q) * D))[lane + 64 * j] = pk4_fp8(bflo(x[q][j].x) * iv[q] * gg[j].x, bfhi(x[q][j].x) * iv[q] * gg[j].y, bflo(x[q][j].y) * iv[q] * gg[j].z, bfhi(x[q][j].y) * iv[q] * gg[j].w);
          } }
    }
    if (CV_STEAL && commit) {
        if (layer == 0) { if (C.wave * C.G + (int)blockIdx.x >= T / 32) cv_steal(C, 4, nullptr); }
        else cv_steal(C, 1 << 20, nullptr);
    }
}
__device__ __forceinline__ void p7_dispatch(const Ctx& C, int layer) {
    const unsigned* cnt = (const unsigned*)(C.ws + WS_CTL) + CW_CNT + layer * 32;
    const int* toke = (const int*)(C.ws + WS_ROUTE + RT_TOKE); const int* toks = (const int*)(C.ws + WS_ROUTE + RT_TOKS); const float* tokw = (const float*)(C.ws + WS_ROUTE + RT_TOKW);
    int* rowdest = (int*)(C.ws + WS_ROUTE + RT_ROWDEST) + layer * MAXROWS; float* roww = (float*)(C.ws + WS_ROUTE + RT_ROWW);
    int* tilee = (int*)(C.ws + WS_ROUTE + RT_TILEE) + layer * 256;
    const int lane = C.lane;
    const int c = lane < NE ? (int)__hip_atomic_load(cnt + lane, __ATOMIC_RELAXED, __HIP_MEMORY_SCOPE_AGENT) : 0;
    const int padded = (c + 255) & ~255;
    int inc = padded;
#pragma unroll
    for (int o = 1; o < 64; o <<= 1) { const int t = __shfl_up(inc, o); if (lane >= o) inc += t; }
    const int pstart = inc - padded;
    if (blockIdx.x == 0 && C.wave == 0) {
        if (lane < NE) for (int tl = pstart >> 8; tl < (pstart + padded) >> 8; ++tl) tilee[tl] = lane;
        if (lane == 63) tilee[255] = inc >> 8;
    }
    const bf16* __restrict__ X = WSP(bf16, WS_XB); const float* __restrict__ INV = WSP(float, WS_INV); const float* __restrict__ g = C.in[16] + layer * D; unsigned char* __restrict__ XG = WSP(unsigned char, WS_XG);
    f32x4 gg[8];
#pragma unroll
    for (int j = 0; j < 8; ++j) gg[j] = ((const f32x4*)g)[lane + 64 * j] * 8.0f;
    for (int tb = C.gw * 8; tb < T; tb += C.NGW * 8) {
        int e = 0, slot = 0; float w = 0.f; const int a = 2 * tb + lane;
        if (lane < 16) { e = toke[a]; slot = toks[a]; w = tokw[a]; }
        const int dest_l = __shfl(pstart, e) + slot;
        if (lane < 16) { rowdest[dest_l] = a; roww[dest_l] = w; }
#pragma unroll 1
        for (int i = 0; i < 8; i += 4) {
            v2u x[4][8]; float iv[4]; int dd[4][2];
#pragma unroll
            for (int q = 0; q < 4; ++q) {
#pragma unroll
                for (int j = 0; j < 8; ++j) x[q][j] = ((const v2u*)(X + (size_t)(tb + i + q) * D))[lane + 64 * j];
                iv[q] = INV[tb + i + q]; dd[q][0] = __shfl(dest_l, 2 * (i + q)); dd[q][1] = __shfl(dest_l, 2 * (i + q) + 1); }
#pragma unroll
            for (int q = 0; q < 4; ++q)
#pragma unroll
                for (int j = 0; j < 8; ++j) {
                    const unsigned o = pk4_fp8(bflo(x[q][j].x) * iv[q] * gg[j].x, bfhi(x[q][j].x) * iv[q] * gg[j].y, bflo(x[q][j].y) * iv[q] * gg[j].z, bfhi(x[q][j].y) * iv[q] * gg[j].w);
                    ((unsigned*)(XG + (size_t)dd[q][0] * D))[lane + 64 * j] = o; ((unsigned*)(XG + (size_t)dd[q][1] * D))[lane + 64 * j] = o;
                }
        }
    }
}
__device__ __forceinline__ void p_combine(const Ctx& C, bf16* __restrict__ xo, float* __restrict__ fo, const float* __restrict__ g, float pscale_in = 1.0f) {
    const unsigned char* __restrict__ YB8 = WSP(unsigned char, WS_YB); const bf16* __restrict__ xi = WSP(bf16, WS_XB); unsigned char* __restrict__ HN = WSP(unsigned char, WS_HN); float* __restrict__ SA = WSP(float, WS_SA);
    const int lane = C.lane;
    const float pscale = pscale_in;
    for (int m0 = 2 * C.gw; m0 < T; m0 += 2 * C.NGW) {
        v2u xr[2][8]; unsigned ya[2][8], yb[2][8];
#pragma unroll
        for (int q = 0; q < 2; ++q)
#pragma unroll
            for (int j = 0; j < 8; ++j) { const size_t m = (size_t)(m0 + q);
                xr[q][j] = ((const v2u*)(xi + m * D))[lane + 64 * j]; ya[q][j] = ((const unsigned*)(YB8 + 2 * m * D))[lane + 64 * j]; yb[q][j] = ((const unsigned*)(YB8 + (2 * m + 1) * D))[lane + 64 * j]; }
#pragma unroll
        for (int q = 0; q < 2; ++q) { const size_t m = (size_t)(m0 + q);
            f32x4 v[8];
#pragma unroll
            for (int j = 0; j < 8; ++j) {
                const f32x2 a0 = __builtin_amdgcn_cvt_pk_f32_fp8((int)ya[q][j], false), a1 = __builtin_amdgcn_cvt_pk_f32_fp8((int)ya[q][j], true);
                const f32x2 b0 = __builtin_amdgcn_cvt_pk_f32_fp8((int)yb[q][j], false), b1 = __builtin_amdgcn_cvt_pk_f32_fp8((int)yb[q][j], true);
                v[j].x = bflo(xr[q][j].x) + (a0.x + b0.x) * 0.0625f; v[j].y = bfhi(xr[q][j].x) + (a0.y + b0.y) * 0.0625f;
                v[j].z = bflo(xr[q][j].y) + (a1.x + b1.x) * 0.0625f; v[j].w = bfhi(xr[q][j].y) + (a1.y + b1.y) * 0.0625f;
                if (fo) ((f32x4*)(fo + m * D))[lane + 64 * j] = v[j] * pscale;
                else { v2u o; o.x = pk2(v[j].x, v[j].y); o.y = pk2(v[j].z, v[j].w); ((v2u*)(xo + m * D))[lane + 64 * j] = o; }
            }
            if (g) { const float inv = row_inv_rms(v); norm_store_row_i8(HN + m * D, SA + m, v, inv, g, lane); }
        }
    }
}

constexpr int AT_K = 0, AT_V = 32768, AT_C = 65536, AT_U = 66560, AT_F = 66624;
constexpr float LOG2E = 1.4426950408889634f;
constexpr float AT_C2 = 0.08838834764831845f * 1.4426950408889634f;
__device__ __forceinline__ unsigned off_b(unsigned row, unsigned ch) { return 256u * row + 16u * (ch ^ (((row & 3u) << 2) | ((row >> 2) & 3u))); }

template <bool FOX, bool O8>
__device__ __forceinline__ void attn_unit(LAS unsigned char* lds, const bf16* Qb, int ldq, const bf16* Kb, int ldk, const bf16* Vb, int ldv, const float* cb, float B2, int qrow0, int nkt,
                                          bf16* Ob, int ldo, const bf16* OGb, int ldog, int tid, int lane, int wave) {
    const int r = lane & 31, h = lane >> 5;
    const int qpos = qrow0 + 32 * wave + r;
    bf16x8 qf[8];
    { const bf16* qp = Qb + (size_t)(32 * wave + r) * ldq + 8 * h;
#pragma unroll
      for (int s = 0; s < 8; ++s) qf[s] = *(const bf16x8*)(qp + 16 * s); }
    f32x16 o[4];
#pragma unroll
    for (int c = 0; c < 4; ++c)
#pragma unroll
        for (int i = 0; i < 16; ++i) o[c][i] = 0.f;
    float m = -1e30f, l = 0.f;
    unsigned goffK[2], goffV[2];
#pragma unroll
    for (int i = 0; i < 2; ++i) { const unsigned row = 4u * (2u * wave + i) + (lane >> 4), ch = (lane & 15) ^ (((row & 3u) << 2) | ((row >> 2) & 3u));
        goffK[i] = (row * (unsigned)ldk + 8u * ch) * 2u; goffV[i] = (row * (unsigned)ldv + 8u * ch) * 2u; }
    float cr = 0.f;
#define AT_DMA(kt, b) do { const char* kb_ = (const char*)(Kb + (size_t)(64 * (kt)) * ldk); const char* vb_ = (const char*)(Vb + (size_t)(64 * (kt)) * ldv); \
        _Pragma("unroll") for (int i = 0; i < 2; ++i) { \
            __builtin_amdgcn_global_load_lds((const unsigned*)(kb_ + goffK[i]), (LAS unsigned*)(lds + AT_K + (b) * 16384 + (2 * wave + i) * 1024), 16, 0, 0); \
            __builtin_amdgcn_global_load_lds((const unsigned*)(vb_ + goffV[i]), (LAS unsigned*)(lds + AT_V + (b) * 16384 + (2 * wave + i) * 1024), 16, 0, 0); } \
        if (FOX && tid < 64) cr = cb[64 * (kt) + tid] * LOG2E; } while (0)
#define AT_CSTORE(b) do { if (FOX && tid < 64) *(LAS float*)(lds + AT_C + (b) * 256 + 4 * tid) = cr; } while (0)
    const int kfirst = FOX ? nkt - 1 : 0, kdir = FOX ? -1 : 1;
    AT_DMA(kfirst, 0); AT_CSTORE(0);
    asm volatile("s_waitcnt vmcnt(0)" ::: "memory");
    __syncthreads();
    unsigned kb0 = 256u * r + 16u * ((unsigned)h ^ (((r & 3u) << 2) | ((r >> 2) & 3u)));
    const unsigned tq = (lane & 15) >> 2, tp = lane & 3, tblk = (lane >> 4) & 1;
    unsigned vb0 = 1024u * h + 256u * tq + 64u * tq + 16u * ((2u * tblk + (tp >> 1)) ^ ((unsigned)h & 3u)) + 8u * (tp & 1);
    unsigned vb1 = 2048u + 1024u * h + 256u * tq + 64u * tq + 16u * ((2u * tblk + (tp >> 1)) ^ ((2u + (unsigned)h) & 3u)) + 8u * (tp & 1);
    const int minq = qrow0 + 32 * wave;
    bool wdone = false;
    volatile LAS unsigned* flags = (volatile LAS unsigned*)(lds + AT_F);
#pragma unroll 1
    for (int it = 0; it < nkt; ++it) {
        asm volatile("" : "+v"(kb0), "+v"(vb0), "+v"(vb1));
        const int kt = kfirst + it * kdir;
        const int b = it & 1;
        if (it + 1 < nkt) AT_DMA(kt + kdir, b ^ 1);
        const bool active = !FOX || (64 * kt <= minq + 31);
        if (FOX && active && !wdone) {
            const float ub = B2 - *(const LAS float*)(lds + AT_C + b * 256 + 63 * 4);
            if (__all(ub - m < -160.f)) wdone = true;
        }
        if (active && !wdone) {
            f32x16 p0, p1;
#pragma unroll
            for (int i = 0; i < 16; ++i) { p0[i] = 0.f; p1[i] = 0.f; }
            const LAS unsigned char* kbuf = lds + AT_K + b * 16384;
#pragma unroll
            for (int s = 0; s < 8; ++s) {
                const bf16x8 a0 = *(const LAS bf16x8*)(kbuf + (kb0 ^ (32u * s))), a1 = *(const LAS bf16x8*)(kbuf + (kb0 ^ (32u * s)) + 8192);
                p0 = __builtin_amdgcn_mfma_f32_32x32x16_bf16(a0, qf[s], p0, 0, 0, 0);
                p1 = __builtin_amdgcn_mfma_f32_32x32x16_bf16(a1, qf[s], p1, 0, 0, 0);
            }
            if (FOX) {
                const LAS float* cbuf = (const LAS float*)(lds + AT_C + b * 256);
#pragma unroll
                for (int g = 0; g < 4; ++g) { const f32x4 c0 = *(const LAS f32x4*)(cbuf + 8 * g + 4 * h), c1 = *(const LAS f32x4*)(cbuf + 32 + 8 * g + 4 * h);
#pragma unroll
                    for (int j = 0; j < 4; ++j) { p0[4 * g + j] = fmaf(p0[4 * g + j], AT_C2, -c0[j]); p1[4 * g + j] = fmaf(p1[4 * g + j], AT_C2, -c1[j]); } }
                if (64 * kt + 63 > minq) {
                    const int dq = qpos - 64 * kt - 4 * h;
#pragma unroll
                    for (int i = 0; i < 16; ++i) { const int ci = (i & 3) + 8 * (i >> 2);
                        if (ci > dq) p0[i] = -__builtin_inff();
                        if (ci + 32 > dq) p1[i] = -__builtin_inff(); }
                }
            } else {
#pragma unroll
                for (int i = 0; i < 16; ++i) { p0[i] *= AT_C2; p1[i] *= AT_C2; }
            }
            float pmax = p0[0];
#pragma unroll
            for (int i = 1; i < 16; ++i) pmax = fmaxf(pmax, p0[i]);
#pragma unroll
            for (int i = 0; i < 16; ++i) pmax = fmaxf(pmax, p1[i]);
            pmax = fmaxf(pmax, __shfl_xor(pmax, 32));
            const float mn = fmaxf(m, pmax), alpha = __builtin_amdgcn_exp2f(m - mn);
            const bool resc = __any(mn > m);
            m = mn;
            float ps = 0.f;
#pragma unroll
            for (int i = 0; i < 16; ++i) { p0[i] = __builtin_amdgcn_exp2f(p0[i] - mn); p1[i] = __builtin_amdgcn_exp2f(p1[i] - mn); ps += p0[i] + p1[i]; }
            ps += __shfl_xor(ps, 32);
            l = l * alpha + ps;
            if (resc) {
#pragma unroll
                for (int c = 0; c < 4; ++c)
#pragma unroll
                    for (int i = 0; i < 16; ++i) o[c][i] *= alpha;
            }
            bf16x8 pf[4];
#pragma unroll
            for (int s = 0; s < 2; ++s) {
                v4u w0, w1;
                w0.x = pk2(p0[8 * s], p0[8 * s + 1]); w0.y = pk2(p0[8 * s + 2], p0[8 * s + 3]); w0.z = pk2(p0[8 * s + 4], p0[8 * s + 5]); w0.w = pk2(p0[8 * s + 6], p0[8 * s + 7]);
                w1.x = pk2(p1[8 * s], p1[8 * s + 1]); w1.y = pk2(p1[8 * s + 2], p1[8 * s + 3]); w1.z = pk2(p1[8 * s + 4], p1[8 * s + 5]); w1.w = pk2(p1[8 * s + 6], p1[8 * s + 7]);
                pf[s] = __builtin_bit_cast(bf16x8, w0); pf[2 + s] = __builtin_bit_cast(bf16x8, w1);
            }
            const LAS unsigned char* vbuf = lds + AT_V + b * 16384;
#pragma unroll
            for (int ks = 0; ks < 4; ++ks)
#pragma unroll
                for (int c = 0; c < 4; ++c) {
                    const s16x4 lo = __builtin_amdgcn_ds_read_tr16_b64_v4i16((LAS s16x4*)(vbuf + ((vb0 ^ (64u * c)) + 4096u * ks)));
                    const s16x4 hi = __builtin_amdgcn_ds_read_tr16_b64_v4i16((LAS s16x4*)(vbuf + ((vb1 ^ (64u * c)) + 4096u * ks)));
                    const bf16x8 vf = __builtin_shufflevector(lo, hi, 0, 1, 2, 3, 4, 5, 6, 7);
                    o[c] = __builtin_amdgcn_mfma_f32_32x32x16_bf16(vf, pf[ks], o[c], 0, 0, 0);
                }
        }
        if (FOX && lane == 0) flags[8 * b + wave] = wdone ? 1u : 0u;
        if (it + 1 < nkt) AT_CSTORE(b ^ 1);
        asm volatile("s_waitcnt vmcnt(0)" ::: "memory");
        __syncthreads();
        if (FOX) { const v4u f0 = *(const LAS v4u*)(lds + AT_F + 32 * b), f1 = *(const LAS v4u*)(lds + AT_F + 32 * b + 16);
            if ((f0.x & f0.y & f0.z & f0.w & f1.x & f1.y & f1.z & f1.w) != 0u) break; }
    }
#undef AT_DMA
#undef AT_CSTORE
    const float il = 1.0f / l;
    bf16* orow = Ob + (size_t)(32 * wave + r) * ldo + 4 * h;
    unsigned char* orow8 = (unsigned char*)Ob + (size_t)(32 * wave + r) * ldo + 4 * h;
    const bf16* grow = FOX ? OGb + (size_t)(32 * wave + r) * ldog + 4 * h : nullptr;
#pragma unroll
    for (int c = 0; c < 4; ++c)
#pragma unroll
        for (int g = 0; g < 4; ++g) {
            float y0 = o[c][4 * g] * il, y1 = o[c][4 * g + 1] * il, y2 = o[c][4 * g + 2] * il, y3 = o[c][4 * g + 3] * il;
            if (FOX) { const v2u gg = *(const v2u*)(grow + 32 * c + 8 * g);
                y0 *= 1.0f / (1.0f + __expf(-bflo(gg.x))); y1 *= 1.0f / (1.0f + __expf(-bfhi(gg.x))); y2 *= 1.0f / (1.0f + __expf(-bflo(gg.y))); y3 *= 1.0f / (1.0f + __expf(-bfhi(gg.y))); }
            if (O8) *(unsigned*)(orow8 + 32 * c + 8 * g) = pk4_fp8(16.0f * y0, 16.0f * y1, 16.0f * y2, 16.0f * y3);
            else { v2u w; w.x = pk2(y0, y1); w.y = pk2(y2, y3);
                *(v2u*)(orow + 32 * c + 8 * g) = w; }
        }
}
template <bool O8>
__device__ __forceinline__ void mem_attn_unit(const Ctx& C, int v, const bf16* P, int ldp, int qcol, int layer) {
    const int qblk = v >> 2, mh = v & 3, b = qblk >> 4;
    attn_unit<false, O8>(C.lds + RING_OFF, P + (size_t)(qblk * 256) * ldp + qcol + mh * HD, ldp,
                     WSP(bf16, WS_MK) + (size_t)layer * 1024 * 512 + (size_t)(b * ML) * 512 + mh * HD, 512, WSP(bf16, WS_MKV) + (size_t)(b * ML) * 1024 + 512 + mh * HD, 1024,
                     nullptr, 0.f, 0, ML / 64, O8 ? (bf16*)(WSP(unsigned char, WS_CAT8) + (size_t)(qblk * 256) * D + FW + mh * HD) : WSP(bf16, WS_CAT) + (size_t)(qblk * 256) * D + FW + mh * HD, D, nullptr, 0, C.tid, C.lane, C.wave);
}
__device__ __forceinline__ void p4_fox_attn(const Ctx& C, int qsel = 0) {
    const bf16* P = WSP(bf16, WS_P);
    unsigned* ctr = (unsigned*)(C.ws + WS_CTL) + CW_Q0 + 128 * qsel;
    volatile LAS unsigned* uw = (volatile LAS unsigned*)(C.lds + RING_OFF + AT_U);
    const float gqm = wave_max(fmaxf(fabsf(C.in[7][2 * C.lane]), fabsf(C.in[7][2 * C.lane + 1]))), gkm = wave_max(fmaxf(fabsf(C.in[8][2 * C.lane]), fabsf(C.in[8][2 * C.lane + 1])));
    const float B2 = 11.313708499f * gqm * gkm * LOG2E * 1.02f + 1.0f;
    const bool cvfirst = ((int)blockIdx.x >> 3) >= (C.G >> 3) - 12;
    unsigned* cvqb = (unsigned*)(C.ws + WS_CTL) + CW_CVQB + 64 * qsel;
    if (cvfirst) cv_loop(C, cvqb, CV_MOVED, 0, CV_KEEP);
    for (;;) {
        __syncthreads();
        if (C.tid == 0) *uw = atomicAdd(ctr, 1u);
        __syncthreads();
        const int u = (int)*uw;
        if (u >= 768 + 256) break;
#if !defined(AT_ONLY_MEM)
        if (u < 768) {
            const int qb = 15 - u / 48, bh = u % 48, b = bh / FH, hh = bh % FH;
            const size_t rb = (size_t)(b * S + 256 * qb);
            attn_unit<true, true>(C.lds + RING_OFF, P + rb * FOX_NP + FP_Q + hh * HD, FOX_NP, P + (size_t)(b * S) * FOX_NP + FP_K + hh * HD, FOX_NP, P + (size_t)(b * S) * FOX_NP + FP_V + hh * HD, FOX_NP,
                           WSP(float, WS_C) + (size_t)bh * S, B2, 256 * qb, 4 * qb + 4, (bf16*)(WSP(unsigned char, WS_CAT8) + rb * D + hh * HD), D, P + rb * FOX_NP + FP_OG + hh * HD, FOX_NP, C.tid, C.lane, C.wave);
        } else
#endif
#if !defined(AT_ONLY_FOX)
        mem_attn_unit<true>(C, u - 768, P, FOX_NP, FP_QM, 0);
#else
        {}
#endif
    }
    if (!cvfirst) cv_loop(C, cvqb, CV_MOVED, 0, CV_KEEP);
}

__device__ __forceinline__ void p13_mem_attn(const Ctx& C, int qsel = 0) {
    const bf16* P = WSP(bf16, WS_P);
    unsigned* ctr = (unsigned*)(C.ws + WS_CTL) + CW_Q1 + 128 * qsel;
    volatile LAS unsigned* uw = (volatile LAS unsigned*)(C.lds + RING_OFF + AT_U);
    for (;;) {
        __syncthreads();
        if (C.tid == 0) *uw = atomicAdd(ctr, 1u);
        __syncthreads();
        const int u = (int)*uw;
        if (u >= 256) break;
        mem_attn_unit<false>(C, u, P, GLA_NP, GP_QM, 1);
    }
}

constexpr int GT_STRIDE = 400;
constexpr int GT_QE = 0, GT_KE = 25600, GT_V = 51200;
constexpr int GSEG = 8, GCH = 8;
constexpr size_t WS_QE = WS_H, WS_KE = WS_H + 24 * MiB, WS_DL = WS_H + 48 * MiB, WS_DSEG = WS_H + 49 * MiB;
constexpr size_t WS_SLOC = WS_XG + 96 * MiB;

__device__ __forceinline__ float amax_scale_dev(const Ctx& C, int t) { return __builtin_bit_cast(float, ((const unsigned*)(C.ws + WS_CTL) + CW_AMAX)[64 * t]) * (1.0f / 127.0f); }
__device__ __forceinline__ void p12_gla_prep(const Ctx& C) {
    bf16* P = WSP(bf16, WS_P);
    const float* __restrict__ w2 = C.in[10]; const float* __restrict__ ba = C.in[11]; const bf16* __restrict__ Pc = P;
    bf16* __restrict__ QE = WSP(bf16, WS_QE); bf16* __restrict__ KE = WSP(bf16, WS_KE); float* __restrict__ DL = WSP(float, WS_DL);
    const float qsc = 0.07216878364870322f;
    const unsigned char* __restrict__ HN = WSP(unsigned char, WS_HN); const unsigned char* __restrict__ WA = WSP(unsigned char, WS_WGLA) + (size_t)GP_A * D;
    const float* __restrict__ SA = WSP(float, WS_SA); const float* __restrict__ swa = WSP(float, WS_SWC_GLA) + GP_A;
    LAS float* al = (LAS float*)(C.lds + RING_OFF);
    for (int cg = blockIdx.x; cg < T / 64; cg += C.G) {
        __syncthreads();
        if (C.wave < 2) {
            const int r = C.lane & 31, h = C.lane >> 5; const size_t tok = (size_t)cg * 64 + 32 * C.wave + r;
            const unsigned char* ap = WA + (size_t)r * D + 16 * h; const unsigned char* bp = HN + tok * D + 16 * h;
            i32x16 acc;
#pragma unroll
            for (int i = 0; i < 16; ++i) acc[i] = 0;
#pragma unroll 8
            for (int s = 0; s < D / 32; ++s) acc = __builtin_amdgcn_mfma_i32_32x32x32_i8(*(const i32x4*)(ap + 32 * s), *(const i32x4*)(bp + 32 * s), acc, 0, 0, 0);
            const float sc = SA[tok]; const f32x4 c0 = *(const f32x4*)(swa + 4 * h) * sc, c1 = *(const f32x4*)(swa + 8 + 4 * h) * sc;
            LAS float* o = al + (32 * C.wave + r) * 16 + 4 * h;
            *(LAS f32x4*)o = (f32x4){(float)acc[0] * c0.x, (float)acc[1] * c0.y, (float)acc[2] * c0.z, (float)acc[3] * c0.w};
            *(LAS f32x4*)(o + 8) = (f32x4){(float)acc[4] * c1.x, (float)acc[5] * c1.y, (float)acc[6] * c1.z, (float)acc[7] * c1.w};
        }
        __syncthreads();
        for (int c = C.tid; c < GKW; c += 512) {
            float w[16];
#pragma unroll
            for (int r = 0; r < 16; ++r) w[r] = w2[r * GKW + c];
            const float bb = ba[c]; float bc = 0.f;
#pragma unroll 1
            for (int t0 = 0; t0 < 64; t0 += 8) {
                float gl[8], qv[8], kv[8];
#pragma unroll
                for (int u = 0; u < 8; ++u) {
                    const size_t row = (size_t)cg * 64 + t0 + u;
                    const LAS float* fl = al + (t0 + u) * 16;
                    float s = bb;
#pragma unroll
                    for (int r = 0; r < 16; ++r) s += fl[r] * w[r];
                    gl[u] = log_sigmoid_fast(s) * (1.0f / 16.0f);
                    qv[u] = bf2f(Pc[row * GLA_NP + GP_Q + c]); kv[u] = bf2f(Pc[row * GLA_NP + GP_K + c]);
                }
#pragma unroll
                for (int u = 0; u < 8; ++u) {
                    const size_t row = (size_t)cg * 64 + t0 + u;
                    bc += gl[u];
                    QE[row * GKW + c] = (bf16)(pk2(qv[u] * __expf(bc) * qsc, 0.f) & 0xffffu);
                    KE[row * GKW + c] = (bf16)(pk2(kv[u] * __expf(-bc), 0.f) & 0xffffu);
                }
            }
            DL[(size_t)cg * GKW + c] = __expf(bc);
        }
    }
}

__device__ __forceinline__ bf16x8 pack8(const f32x16& x, int s) {
    v4u w; w.x = pk2(x[8 * s], x[8 * s + 1]); w.y = pk2(x[8 * s + 2], x[8 * s + 3]); w.z = pk2(x[8 * s + 4], x[8 * s + 5]); w.w = pk2(x[8 * s + 6], x[8 * s + 7]);
    return __builtin_bit_cast(bf16x8, w);
}
__device__ __forceinline__ s16x4 tr4(const LAS unsigned char* tile, int r0, int c0, int lane) {
    const int q = (lane & 15) >> 2, p = lane & 3, blk = (lane >> 4) & 1;
    return __builtin_amdgcn_ds_read_tr16_b64_v4i16((LAS s16x4*)(tile + (r0 + q) * GT_STRIDE + 2 * (c0 + 16 * blk + 4 * p)));
}
template <bool OUT>
__device__ __forceinline__ void gla_unit(const Ctx& C, int u) {
    const int seg = u & 7, eh = (u >> 3) & 1, bh = u >> 4, b = bh >> 2, hd = bh & 3;
    const int tid = C.tid, lane = C.lane, w = C.wave, r = lane & 31, h = lane >> 5;
    LAS unsigned char* lds = C.lds + RING_OFF;
    const bf16* QE = WSP(bf16, WS_QE); const bf16* KE = WSP(bf16, WS_KE); const bf16* P = WSP(bf16, WS_P);
    const float* DL = WSP(float, WS_DL); float* DSEG = WSP(float, WS_DSEG); float* SLOC = WSP(float, WS_SLOC); float* GO = WSP(float, WS_GO);
    f32x16 Sx[6];
#pragma unroll
    for (int dt = 0; dt < 6; ++dt)
#pragma unroll
        for (int i = 0; i < 16; ++i) Sx[dt][i] = 0.f;
    if (OUT && w < 6) {
        for (int sp = 0; sp < seg; ++sp) {
            const float* sl = SLOC + ((((size_t)(bh * GSEG + sp) * 2 + eh) * 6 + w) * 6) * 1024;
            const float* dsg = DSEG + (size_t)(bh * GSEG + sp) * GDK;
#pragma unroll
            for (int dt = 0; dt < 6; ++dt)
#pragma unroll
                for (int g = 0; g < 4; ++g) { const f32x4 dv = *(const f32x4*)(dsg + 32 * dt + 8 * g + 4 * h);
#pragma unroll
                    for (int j = 0; j < 4; ++j) Sx[dt][4 * g + j] = dv[j] * Sx[dt][4 * g + j] + sl[(dt * 16 + 4 * g + j) * 64 + lane]; }
        }
    }
    float dacc[3] = {1.f, 1.f, 1.f};
#pragma unroll 1
    for (int cc = 0; cc < GCH; ++cc) {
        const int cs = seg * GCH + cc; const size_t row0 = (size_t)b * S + (size_t)cs * 64; const int cg = b * 64 + cs;
        __syncthreads();
#pragma unroll
        for (int i = 0; i < 3; ++i) { const int n = tid + 512 * i, row = n / 24, ch = n % 24;
            if (OUT) *(LAS v4u*)(lds + GT_QE + row * GT_STRIDE + 16 * ch) = *(const v4u*)(QE + (row0 + row) * GKW + hd * GDK + 8 * ch);
            *(LAS v4u*)(lds + GT_KE + row * GT_STRIDE + 16 * ch) = *(const v4u*)(KE + (row0 + row) * GKW + hd * GDK + 8 * ch);
            *(LAS v4u*)(lds + GT_V + row * GT_STRIDE + 16 * ch) = *(const v4u*)(P + (row0 + row) * GLA_NP + GP_V + hd * GDV + eh * 192 + 8 * ch); }
        __syncthreads();
        if (w < 6) {
            int lane = C.lane; asm volatile("" : "+v"(lane));
            const int r = lane & 31, h = lane >> 5;
            const LAS unsigned char* tq = lds + GT_QE; const LAS unsigned char* tk = lds + GT_KE; const LAS unsigned char* tv = lds + GT_V;
            if (OUT) {
#pragma unroll
                for (int it = 0; it < 2; ++it) {
                    f32x16 ao;
#pragma unroll
                    for (int i = 0; i < 16; ++i) ao[i] = 0.f;
#pragma unroll
                    for (int dt = 0; dt < 6; ++dt)
#pragma unroll
                        for (int s = 0; s < 2; ++s) {
                            const bf16x8 a = pack8(Sx[dt], s);
                            const LAS unsigned char* qp = tq + (32 * it + r) * GT_STRIDE + 2 * (32 * dt + 16 * s + 4 * h);
                            const s16x4 lo = *(const LAS s16x4*)qp, hi = *(const LAS s16x4*)(qp + 16);
                            const bf16x8 bq = __builtin_shufflevector(lo, hi, 0, 1, 2, 3, 4, 5, 6, 7);
                            ao = __builtin_amdgcn_mfma_f32_32x32x16_bf16(a, bq, ao, 0, 0, 0);
                        }
                    __builtin_amdgcn_sched_barrier(0);
#pragma unroll
                    for (int jt = 0; jt <= it; ++jt) {
                        f32x16 at;
#pragma unroll
                        for (int i = 0; i < 16; ++i) at[i] = 0.f;
#pragma unroll
                        for (int s = 0; s < 12; ++s) {
                            const bf16x8 a = *(const LAS bf16x8*)(tk + (32 * jt + r) * GT_STRIDE + 16 * (2 * s + h));
                            const bf16x8 bq = *(const LAS bf16x8*)(tq + (32 * it + r) * GT_STRIDE + 16 * (2 * s + h));
                            at = __builtin_amdgcn_mfma_f32_32x32x16_bf16(a, bq, at, 0, 0, 0);
                        }
                        if (jt == it) {
#pragma unroll
                            for (int i = 0; i < 16; ++i) if (((i & 3) + 8 * (i >> 2) + 4 * h) > r) at[i] = 0.f;
                        }
#pragma unroll
                        for (int s = 0; s < 2; ++s) {
                            const bf16x8 bp = pack8(at, s);
                            const s16x4 lo = tr4(tv, 32 * jt + 16 * s + 4 * h, 32 * w, lane), hi = tr4(tv, 32 * jt + 16 * s + 8 + 4 * h, 32 * w, lane);
                            const bf16x8 av = __builtin_shufflevector(lo, hi, 0, 1, 2, 3, 4, 5, 6, 7);
                            ao = __builtin_amdgcn_mfma_f32_32x32x16_bf16(av, bp, ao, 0, 0, 0);
                        }
                    }
                    __builtin_amdgcn_sched_barrier(0);
                    bf16* op = (bf16*)GO + (row0 + 32 * it + r) * GVW + hd * GDV + eh * 192 + 32 * w + 4 * h;
#pragma unroll
                    for (int g = 0; g < 4; ++g) { v2u o2; o2.x = pk2(ao[4 * g], ao[4 * g + 1]); o2.y = pk2(ao[4 * g + 2], ao[4 * g + 3]); *(v2u*)(op + 8 * g) = o2; }
                }
            }
            __builtin_amdgcn_sched_barrier(0);
            bf16x8 bv[4];
#pragma unroll
            for (int ks = 0; ks < 4; ++ks) { const s16x4 lo = tr4(tv, 16 * ks + 8 * h, 32 * w, lane), hi = tr4(tv, 16 * ks + 8 * h + 4, 32 * w, lane);
                bv[ks] = __builtin_shufflevector(lo, hi, 0, 1, 2, 3, 4, 5, 6, 7); }
            const float* dlp = DL + (size_t)cg * GKW + hd * GDK;
#pragma unroll
            for (int dt = 0; dt < 6; ++dt) {
#pragma unroll
                for (int ks = 0; ks < 4; ++ks) { const s16x4 lo = tr4(tk, 16 * ks + 8 * h, 32 * dt, lane), hi = tr4(tk, 16 * ks + 8 * h + 4, 32 * dt, lane);
                    const bf16x8 ak = __builtin_shufflevector(lo, hi, 0, 1, 2, 3, 4, 5, 6, 7);
                    Sx[dt] = __builtin_amdgcn_mfma_f32_32x32x16_bf16(ak, bv[ks], Sx[dt], 0, 0, 0); }
#pragma unroll
                for (int g = 0; g < 4; ++g) { const f32x4 dv = *(const f32x4*)(dlp + 32 * dt + 8 * g + 4 * h);
#pragma unroll
                    for (int j = 0; j < 4; ++j) Sx[dt][4 * g + j] *= dv[j]; }
            }
        } else if (!OUT && w == 6) {
            const float* dlp = DL + (size_t)cg * GKW + hd * GDK;
#pragma unroll
            for (int i = 0; i < 3; ++i) dacc[i] *= dlp[lane + 64 * i];
        }
    }
    if (!OUT) {
        if (w < 6) { float* sl = SLOC + ((((size_t)(bh * GSEG + seg) * 2 + eh) * 6 + w) * 6) * 1024;
#pragma unroll
            for (int dt = 0; dt < 6; ++dt)
#pragma unroll
                for (int i = 0; i < 16; ++i) sl[(dt * 16 + i) * 64 + lane] = Sx[dt][i]; }
        else if (w == 6 && eh == 0) {
#pragma unroll
            for (int i = 0; i < 3; ++i) DSEG[(size_t)(bh * GSEG + seg) * GDK + lane + 64 * i] = dacc[i]; }
    }
}
__device__ __forceinline__ void p13a_gla_local(const Ctx& C) { for (int u = blockIdx.x; u < 256; u += C.G) if ((u & 7) != 7) gla_unit<false>(C, u); }
__device__ __forceinline__ void p13b_gla_out(const Ctx& C) { for (int u = blockIdx.x; u < 256; u += C.G) gla_unit<true>(C, u); }

constexpr int NPHASE = 24;
#ifndef PROBE_PHASE
#define PROBE_PHASE (-1)
#endif

struct Args { const float* in[24]; float* out; unsigned char* ws; int ph_lo, ph_hi; };
#define PG8_ALIGN true
#define PG8_SP2 true
#ifndef PG8_ALIGN_F8
#define PG8_ALIGN_F8 true
#endif
#ifndef PG8_SP2_F8
#define PG8_SP2_F8 true
#endif

template <class Epi, class Sched, bool F8 = false, bool I8 = false, bool GATHER = false>
__device__ __forceinline__ void run_gemm(const Ctx& C, const bf16* A, const bf16* Bt, int K, const Sched& Sd, const Epi& E, int sx = pg8::F8_SCALE_X) {
    pg8::Gemm g{A, Bt, pg8::F8_SCALE_W, sx, K};
    pg8::gemm_phase<Epi, Sched, F8 ? PG8_ALIGN_F8 : PG8_ALIGN, F8 ? PG8_SP2_F8 : PG8_SP2, F8, I8, GATHER>(C.lds + RING_OFF, g, Sd, E, C.lds + GOFF_OFF);
}
__device__ __forceinline__ pg8::MoeOrder moe_order(const Ctx& C, int layer) {
    const unsigned* cnt = (const unsigned*)(C.ws + WS_CTL) + CW_CNT + layer * 32;
    const int lane = C.lane;
    const int c = lane < NE ? (int)__hip_atomic_load(cnt + lane, __ATOMIC_RELAXED, __HIP_MEMORY_SCOPE_AGENT) : 0;
    const int tl = (c + 255) >> 8;
    int inc = tl;
#pragma unroll
    for (int o = 1; o < 64; o <<= 1) { const int t = __shfl_up(inc, o); if (lane >= o) inc += t; }
    const int pk = lane < NE ? (c | ((inc - tl) << 16) | (inc << 24)) : 0;
    return pg8::MoeOrder{pk, C.G, (int)blockIdx.x, WSP(int, WS_LSTA)};
}
__device__ __forceinline__ float amax_scale(const Ctx& C, int t) { return __builtin_bit_cast(float, ((const unsigned*)(C.ws + WS_CTL) + CW_AMAX)[64 * t]) * (1.0f / 127.0f); }
__device__ __forceinline__ void ph_proj1(const Ctx& C) {
    pg8::StaticOrder Sd; Sd.init(T, GP_A, C.G, (int)blockIdx.x);
    pg8::EpiPT<true> E{WSP(bf16, WS_P), GLA_NP, nullptr, -1, nullptr, 0, 1 << 30, 0, WSP(float, WS_SA), WSP(float, WS_SWC_GLA), nullptr, nullptr,
                        0, 0, 0, 0, GP_QM / 256, GP_QM / 256 + 2, nullptr, nullptr, C.in[13] + HD, (LAS float*)(C.lds + GOFF_OFF)};
    run_gemm<pg8::EpiPT<true>, pg8::StaticOrder, false, true>(C, WSP(bf16, WS_HN), WSP(bf16, WS_WGLA), D / 2, Sd, E);
}
__device__ __forceinline__ void ph_proj0(const Ctx& C) {
    constexpr size_t TILEB = (size_t)256 * D;
    static_assert((WS_MEMN - WS_HN) % TILEB == 0 && (WS_WMKV - WS_WFOX) % TILEB == 0 && WS_MEMN > WS_HN && WS_WMKV > WS_WFOX, "tile-offset addressing of the second GEMM");
    constexpr int PM2 = (int)((WS_MEMN - WS_HN) / TILEB), PN2 = (int)((WS_WMKV - WS_WFOX) / TILEB);
    pg8::TwoGemmOrder Sd; Sd.S.init(T, FOX_NP, C.G, (int)blockIdx.x); Sd.nx2 = 4; Sd.n2 = 16; Sd.pm2 = PM2; Sd.pn2 = PN2;
    pg8::EpiPT<true> E{WSP(bf16, WS_P), FOX_NP, WSP(float, WS_FL), FP_F / 256, WSP(bf16, WS_MKV), 1024, PM2, PN2, WSP(float, WS_SA), WSP(float, WS_SWC_FOX), WSP(float, WS_SAM), WSP(float, WS_SWC_MKV),
                        FP_Q / 256, FP_Q / 256 + 6, FP_K / 256, FP_K / 256 + 6, FP_QM / 256, FP_QM / 256 + 2, C.in[7], C.in[8], C.in[13], (LAS float*)(C.lds + GOFF_OFF)};
    run_gemm<pg8::EpiPT<true>, pg8::TwoGemmOrder, false, true>(C, WSP(bf16, WS_HN), WSP(bf16, WS_WFOX), D / 2, Sd, E);
}
__device__ __forceinline__ void ph_wout(const Ctx& C, int layer) {
    pg8::StaticOrder Sd; Sd.init(T, D, C.G, (int)blockIdx.x);
    const bf16* A8 = (const bf16*)WSP(unsigned char, WS_CAT8); const bf16* B8 = (const bf16*)(WSP(unsigned char, WS_WOUT) + (size_t)layer * D * D);
    if (layer == 0) { pg8::EpiResF<true> E{C.in[0], WSP(bf16, WS_XB), D}; run_gemm<pg8::EpiResF<true>, pg8::StaticOrder, true>(C, A8, B8, D / 2, Sd, E, 123); }
    else { pg8::EpiRes<false> E{WSP(bf16, WS_XA), WSP(bf16, WS_XB), D, WSP(float, WS_SC), WSP(float, WS_SWC_WO1)}; run_gemm<pg8::EpiRes<false>, pg8::StaticOrder, false, true>(C, A8, B8, D / 2, Sd, E); }
}
__device__ __forceinline__ void ph_gu(const Ctx& C, int layer, int wl = -1) {
    const pg8::MoeOrder Sd = moe_order(C, layer); pg8::EpiGU E{WSP(unsigned char, WS_H)};
    run_gemm<pg8::EpiGU, pg8::MoeOrder, true, false, true>(C, WSP(bf16, WS_XN8), (const bf16*)(WSP(unsigned char, WS_WGU) + (size_t)(wl < 0 ? layer : wl) * NE * 2048 * 2048), D / 2, Sd, E);
}
__device__ __forceinline__ void ph_down(const Ctx& C, int layer, int wl = -1) {
    const pg8::MoeOrder Sd = moe_order(C, layer);
    pg8::EpiDown E{WSP(int, WS_LSTA), WSP(float, WS_LSTW), WSP(bf16, WS_YB)};
    run_gemm<pg8::EpiDown, pg8::MoeOrder, true>(C, WSP(bf16, WS_H), (const bf16*)(WSP(unsigned char, WS_WD) + (size_t)(wl < 0 ? layer : wl) * NE * 2048 * 1024), DE / 2, Sd, E);
}

__global__ void __launch_bounds__(NWAVES * 64, 2) fwd_kernel(Args args) {
    extern __shared__ __attribute__((aligned(16))) unsigned char lds[];
    Ctx C;
    C.lds = (LAS unsigned char*)lds;
    C.tid = threadIdx.x; C.lane = C.tid & 63; C.wave = __builtin_amdgcn_readfirstlane(C.tid >> 6);
    C.G = gridDim.x; C.gw = blockIdx.x * NWAVES + C.wave; C.NGW = C.G * NWAVES;
#pragma unroll
    for (int i = 0; i < 24; ++i) C.in[i] = args.in[i];
    C.out = args.out; C.ws = args.ws;
    volatile LAS unsigned* MISC = (volatile LAS unsigned*)(C.lds + MISC_OFF);
    for (int u = C.tid; u < (LDS_BYTES - LDSCTL_OFF) / 4; u += NWAVES * 64) ((LAS unsigned*)(C.lds + LDSCTL_OFF))[u] = 0u;
    __syncthreads();
    const int lo = args.ph_lo, hi = args.ph_hi;
    if (PROBE_PHASE >= 0 && blockIdx.x == 0 && C.tid == 0) ((unsigned long long*)(C.ws + WS_CTL) + (CW_PROBE / 2))[0] = __builtin_amdgcn_s_memrealtime();
    XcdBarrier bar; bar.bar = (unsigned*)(C.ws + WS_CTL) + CW_BAR; bar.x = 0; bar.st = nullptr;
    if (hi - lo > 1) bar = xcd_barrier_post((unsigned*)(C.ws + WS_CTL) + CW_BAR, MISC + 8);
#ifndef PHSEL
#define PHSEL 0xFFFFFFFFu
#endif
#define SITE(s) ((PHSEL >> (s)) & 1u)
#ifndef DUPMASK
#define DUPMASK 0u
#endif
#define DUP(s) ((DUPMASK >> (s)) & 1u)
#define IN(k) (lo <= (k) && (k) < hi)
#define PROBE_STAMP(k) do { if (PROBE_PHASE == (k) && blockIdx.x == 0 && C.tid == 0) { unsigned long long* pw = (unsigned long long*)(C.ws + WS_CTL) + (CW_PROBE / 2); \
        const unsigned long long t1 = __builtin_amdgcn_s_memrealtime(); ((float*)(pw + 1))[0] = (float)(t1 - pw[0]) * 0.01f; } } while (0)
#define SEAM(k) do { if (IN(k) && IN((k) + 1)) xcd_barrier(bar); PROBE_STAMP(k); } while (0)

    if (SITE(0) && IN(0)) p0_prologue(C);
    if (DUP(0) && IN(0)) { __syncthreads(); p0_prologue(C); }
#ifdef SEQ_PROBE
    if (IN(0)) { __syncthreads(); seq_probe(C); }
#endif
    do { if (IN(0) && IN(2)) xcd_barrier(bar); PROBE_STAMP(1); } while (0);
#ifdef XTRA_BARRIERS
    if (hi - lo > 1) { for (int xb = 0; xb < XTRA_BARRIERS; ++xb) xcd_barrier(bar); }
#endif
    if (SITE(2) && IN(2)) ph_proj0(C);
    if (DUP(2) && IN(2)) { __syncthreads(); ph_proj0(C); }
#ifdef L2_PROBE
    if (IN(2)) { __syncthreads(); ph_l2probe(C); }
#endif
    if (CV_STEAL && SITE(2) && IN(2) && IN(2 + 1)) cv_steal_tail(C, 0);
    SEAM(2);
    if (SITE(3) && IN(3)) p3_fox_thin(C);
    if (DUP(3) && IN(3)) { __syncthreads(); p3_fox_thin(C); }
    SEAM(3);
    if (SITE(4) && IN(4)) p4_fox_attn(C);
    if (DUP(4) && IN(4)) { __syncthreads(); p4_fox_attn(C, 1); }
    if (CV_STEAL && SITE(4) && IN(4) && IN(4 + 1)) cv_steal_tail(C, 1);
    SEAM(4);
    if (SITE(5) && IN(5)) ph_wout(C, 0);
    if (DUP(5) && IN(5)) { __syncthreads(); ph_wout(C, 0); }
    SEAM(5);
    if (SITE(6) && IN(6)) p6_router_mfma(C, 0);
    if (DUP(6) && IN(6)) { __syncthreads(); p6_router_mfma(C, 0, false); }
    do { if (IN(6) && IN(8)) xcd_barrier(bar); PROBE_STAMP(6); } while (0);
#ifdef DUP_COLD
    if (IN(8)) { ph_gu(C, 0, 1); __syncthreads(); }
#endif
    if (SITE(8) && IN(8)) ph_gu(C, 0);
    if (DUP(8) && IN(8)) { __syncthreads(); ph_gu(C, 0); }
    if (CV_STEAL && SITE(8) && IN(8) && IN(8 + 1)) cv_steal_tail(C, 2);
    SEAM(8);
#ifdef DUP_COLD
    if (IN(9)) { ph_down(C, 0, 1); __syncthreads(); }
#endif
    if (SITE(9) && IN(9)) ph_down(C, 0);
    if (DUP(9) && IN(9)) { __syncthreads(); ph_down(C, 0); }
    if (CV_STEAL && SITE(9) && IN(9) && IN(9 + 1)) cv_steal_tail(C, 3);
    SEAM(9);
    if (SITE(10) && IN(10)) p_combine(C, WSP(bf16, WS_XA), nullptr, C.in[4] + D);
    if (DUP(10) && IN(10)) { __syncthreads(); p_combine(C, WSP(bf16, WS_XA), nullptr, C.in[4] + D); }
    SEAM(10);
    if (SITE(11) && IN(11)) ph_proj1(C);
    if (DUP(11) && IN(11)) { __syncthreads(); ph_proj1(C); }
    if (CV_STEAL && SITE(11) && IN(11) && IN(11 + 1)) cv_steal_tail(C, 4);
    SEAM(11);
    if (SITE(12) && IN(12)) p12_gla_prep(C);
    if (DUP(12) && IN(12)) { __syncthreads(); p12_gla_prep(C); }
    SEAM(12);
    if (SITE(13) && IN(13)) p13a_gla_local(C);
    if (DUP(13) && IN(13)) { __syncthreads(); p13a_gla_local(C); }
    SEAM(13);
#if defined(NO_MEM14)
    if (SITE(14) && IN(14)) { p13b_gla_out(C); }
#elif defined(NO_GLA14)
    if (SITE(14) && IN(14)) { p13_mem_attn(C); }
#else
    if (SITE(14) && IN(14)) { p13b_gla_out(C); p13_mem_attn(C); }
#endif
    if (DUP(14) && IN(14)) { __syncthreads(); p13b_gla_out(C); p13_mem_attn(C, 1); }
    SEAM(14);
    if (SITE(15) && IN(15)) p14_gla_onorm(C);
    if (DUP(15) && IN(15)) { __syncthreads(); p14_gla_onorm(C); }
    SEAM(15);
    if (SITE(16) && IN(16)) ph_wout(C, 1);
    if (DUP(16) && IN(16)) { __syncthreads(); ph_wout(C, 1); }
    SEAM(16);
    if (SITE(17) && IN(17)) p6_router_mfma(C, 1);
    if (DUP(17) && IN(17)) { __syncthreads(); p6_router_mfma(C, 1, false); }
    do { if (IN(17) && IN(19)) xcd_barrier(bar); PROBE_STAMP(17); } while (0);
    if (SITE(19) && IN(19)) ph_gu(C, 1);
    if (DUP(19) && IN(19)) { __syncthreads(); ph_gu(C, 1); }
    SEAM(19);
    if (SITE(20) && IN(20)) ph_down(C, 1);
    if (DUP(20) && IN(20)) { __syncthreads(); ph_down(C, 1); }
    SEAM(20);
    if (SITE(21) && IN(21)) p_combine(C, nullptr, C.out, nullptr, PROBE_PHASE >= 0 ? 1.0f + sqrtf(((const float*)((const unsigned long long*)(C.ws + WS_CTL) + (CW_PROBE / 2) + 1))[0] * 1e-4f) : 1.0f);
    if (DUP(21) && IN(21)) { __syncthreads(); p_combine(C, nullptr, C.out, nullptr); }
#undef IN
#undef SEAM
}

extern "C" void kernel_launch(void* const* d_in, const int* in_sizes, int n_in, void* d_out, int out_size, void* d_ws, size_t ws_size, hipStream_t stream) {
    static int grid = 0;
    if (grid == 0) {
        if (n_in != 24 || out_size != T * D || ws_size < WS_END) { fprintf(stderr, "kernel_launch: unexpected problem (n_in %d, out %d, ws %zu < %zu)\n", n_in, out_size, ws_size, (size_t)WS_END); grid = -1; return; }
        int dev = 0, cus = 0, per_cu = 0;
        if (hipGetDevice(&dev) != hipSuccess || hipDeviceGetAttribute(&cus, hipDeviceAttributeMultiprocessorCount, dev) != hipSuccess) { grid = -1; return; }
        if (hipFuncSetAttribute((const void*)fwd_kernel, hipFuncAttributeMaxDynamicSharedMemorySize, LDS_BYTES) != hipSuccess) { fprintf(stderr, "kernel_launch: hipFuncSetAttribute failed\n"); grid = -1; return; }
        if (hipOccupancyMaxActiveBlocksPerMultiprocessor(&per_cu, (const void*)fwd_kernel, NWAVES * 64, LDS_BYTES) != hipSuccess || per_cu < 1)
            fprintf(stderr, "kernel_launch: occupancy query reports %d workgroups per CU\n", per_cu);
        (void)hipGetLastError();
        grid = cus;
    }
    if (grid < 0) return;
    if (hipMemsetAsync((char*)d_ws + WS_CTL, 0, CTL_ZERO_BYTES, stream) != hipSuccess) return;
    Args a{};
    for (int i = 0; i < 24; ++i) a.in[i] = (const float*)d_in[i];
    a.out = (float*)d_out; a.ws = (unsigned char*)d_ws;
#if MK_N_LAUNCHES == 1
    a.ph_lo = 0; a.ph_hi = NPHASE;
    hipLaunchKernelGGL(fwd_kernel, dim3(grid), dim3(NWAVES * 64), LDS_BYTES, stream, a);
#else
    for (int p = 0; p < NPHASE; ++p) { a.ph_lo = p; a.ph_hi = p + 1; hipLaunchKernelGGL(fwd_kernel, dim3(grid), dim3(NWAVES * 64), LDS_BYTES, stream, a); }
#endif
}
```

```cpp
#include <hip/hip_runtime.h>
#include <cstdio>
#include <cstdint>
#ifndef MK_N_LAUNCHES
#define MK_N_LAUNCHES 1
#endif
namespace pg8 {
#define PG8_LAS __attribute__((address_space(3)))
typedef unsigned short bf16_t;
typedef short bf16x8 __attribute__((ext_vector_type(8)));
typedef float f32x4 __attribute__((ext_vector_type(4)));
typedef unsigned u32x4 __attribute__((ext_vector_type(4)));
typedef int pg8_v4i __attribute__((ext_vector_type(4)));
constexpr int F8_SCALE_W = 121, F8_SCALE_X = 124;
constexpr int BM = 256, BK = 64, HALF = 128, HTB = HALF * BK * 2  , STAGE_BYTES = 8 * HTB, NXCD = 8, WGM = 8;

__host__ __device__ __forceinline__ int lds_byte(int r, int c) { const int st = (r >> 4) * 2 + (c >> 5), rr = r & 15, cc = c & 31, ob = rr * 64 + cc * 2; return st * 1024 + (ob ^ (((ob >> 9) & 1) << 5)); }
__host__ __device__ __forceinline__ void stage_rc(int b, int& R, int& C) { const int st = b / 1024, sb = b % 1024, swz = sb ^ (((sb >> 9) & 1) << 5); R = (st >> 1) * 16 + swz / 64; C = (st & 1) * 32 + (swz % 64) / 2; }
__host__ __device__ __forceinline__ int perm32(int rho) { const int n = rho >> 4, i = rho & 15; return 8 * (i >> 2) + 4 * n + (i & 3); }

struct Unit { int pm, pn, lb = 0, nv = 256; };
struct Gemm { const bf16_t* A; const bf16_t* Bt; int M, N, K; };

struct StaticOrder {
    int nM, nN, nwg, G, c;
    __host__ __device__ void init(int M, int N, int G_, int c_) { nM = M / BM; nN = N / BM; nwg = nM * nN; G = G_; c = c_; }
    __host__ __device__ bool next(int i, Unit& u) const {
        const long L = (long)i * G + c; if (L >= nwg) return false;
        int wgid = (int)L; { const int q = nwg / NXCD, r = nwg % NXCD, xcd = wgid % NXCD, off = wgid / NXCD; wgid = (xcd < r ? xcd * (q + 1) : r * (q + 1) + (xcd - r) * q) + off; }
        const int nig = WGM * nN, gid = wgid / nig, fm = gid * WGM, gsz = (nM - fm) < WGM ? (nM - fm) : WGM;
        u.pm = fm + ((wgid % nig) % gsz); u.pn = (wgid % nig) / gsz; return true;
    }
    __device__ __forceinline__ void a_ready(const Unit&) const {}
    __device__ __forceinline__ void done(const Unit&) const {}
};
template <class Epi, class Sched, bool ALIGN_EPI = false, bool SP2 = false, bool F8 = false, bool I8 = false, bool GATHER = false>
__device__ __forceinline__ void gemm_phase(PG8_LAS unsigned char* lds, const Gemm g, const Sched& S, const Epi& E, PG8_LAS unsigned char* gofs = nullptr) {
    const int tid = threadIdx.x, wid = __builtin_amdgcn_readfirstlane(tid >> 6), lane = tid & 63, wr = wid >> 2, wc = wid & 3, fr = lane & 15, fq = lane >> 4;
    const int K = g.K, nt = K / BK;
    unsigned voffA[2], voffB[2];
#pragma unroll
    for (int i = 0; i < 2; ++i) { int R, C; stage_rc(tid * 16 + i * 8192, R, C); const int Rb = Epi::PERM ? ((R & ~31) + perm32(R & 31)) : R;
        voffA[i] = (unsigned)(R * K + C) * 2u; voffB[i] = (unsigned)(Rb * K + C) * 2u; }
    const size_t kstep = (size_t)(BK * 2);
    const size_t hstep = (size_t)HALF * K * 2;
    const size_t tstep = 2 * hstep;
    const unsigned ldsw = (unsigned)wid * 1024u;
    const int aoff = lds_byte(wr * 64 + fr, fq * 8), boff = lds_byte(wc * 32 + fr, fq * 8);
#define PG8_SA(b, h) (((b) * 2 + (h)) * HTB)
#define PG8_SB(b, h) ((4 + (b) * 2 + (h)) * HTB)
#define PG8_STAGE(bufoff, gbase, voff) do { _Pragma("unroll") for (int _i = 0; _i < 2; ++_i) \
        __builtin_amdgcn_global_load_lds((const unsigned*)((const char*)(gbase) + (voff)[_i]), (PG8_LAS unsigned*)(lds + (bufoff) + ldsw + _i * 8192), 16, 0, 0); } while (0)
#define PG8_STAGE_A(bufoff, gbase, h) do { if constexpr (GATHER) PG8_STAGE(bufoff, gbase, voffG[h]); else PG8_STAGE(bufoff, (gbase) + (h) * hstep, voffA); } while (0)
#define PG8_LDA(dst, b, h) do { _Pragma("unroll") for (int m = 0; m < 4; ++m) _Pragma("unroll") for (int k = 0; k < 2; ++k) dst[m][k] = *(const PG8_LAS bf16x8*)(lds + PG8_SA(b, h) + aoff + m * 2048 + k * 1024); } while (0)
#define PG8_LDB(dst, b, h) do { _Pragma("unroll") for (int n = 0; n < 2; ++n) _Pragma("unroll") for (int k = 0; k < 2; ++k) dst[n][k] = *(const PG8_LAS bf16x8*)(lds + PG8_SB(b, h) + boff + n * 2048 + k * 1024); } while (0)
#define PG8_CAT(x0, x1) __builtin_shufflevector(__builtin_bit_cast(pg8_v4i, x0), __builtin_bit_cast(pg8_v4i, x1), 0, 1, 2, 3, 4, 5, 6, 7)
#define PG8_MMA(ai, bj, At, Bt) do { __builtin_amdgcn_s_setprio(1); \
        if constexpr (F8) { _Pragma("unroll") for (int m = 0; m < 4; ++m) _Pragma("unroll") for (int n = 0; n < 2; ++n) \
            asm volatile("v_mfma_scale_f32_16x16x128_f8f6f4 %0, %1, %2, %0, %3, %4 op_sel_hi:[0,0,0]" : "+v"(acc[ai][bj][m][n]) : "v"(PG8_CAT(Bt[n][0], Bt[n][1])), "v"(PG8_CAT(At[m][0], At[m][1])), "v"(f8sw), "v"(f8sx)); } \
        else if constexpr (I8) { _Pragma("unroll") for (int m = 0; m < 4; ++m) _Pragma("unroll") for (int n = 0; n < 2; ++n) _Pragma("unroll") for (int k = 0; k < 2; ++k) \
            acc[ai][bj][m][n] = __builtin_bit_cast(f32x4, __builtin_amdgcn_mfma_i32_16x16x64_i8(__builtin_bit_cast(pg8_v4i, Bt[n][k]), __builtin_bit_cast(pg8_v4i, At[m][k]), __builtin_bit_cast(pg8_v4i, acc[ai][bj][m][n]), 0, 0, 0)); } \
        else { _Pragma("unroll") for (int m = 0; m < 4; ++m) _Pragma("unroll") for (int n = 0; n < 2; ++n) _Pragma("unroll") for (int k = 0; k < 2; ++k) \
            acc[ai][bj][m][n] = __builtin_amdgcn_mfma_f32_16x16x32_bf16(Bt[n][k], At[m][k], acc[ai][bj][m][n], 0, 0, 0); } \
        __builtin_amdgcn_s_setprio(0); } while (0)
#define PG8_WAIT_V(n) asm volatile("s_waitcnt vmcnt(" #n ")" ::: "memory")
#define PG8_WAIT_L(n) asm volatile("s_waitcnt lgkmcnt(" #n ")" ::: "memory")
#define PG8_BAR __builtin_amdgcn_s_barrier()
#define PG8_SCHED __builtin_amdgcn_sched_barrier(0)
    Unit cur, nxt; int ui = 0;
    if (!S.next(0, cur)) return;
    f32x4 acc[2][2][4][2];
#pragma unroll
    for (int a = 0; a < 2; ++a)
#pragma unroll
        for (int b = 0; b < 2; ++b)
#pragma unroll
            for (int m = 0; m < 4; ++m)
#pragma unroll
                for (int n = 0; n < 2; ++n) acc[a][b][m][n] = (f32x4){0.f, 0.f, 0.f, 0.f};
    bf16x8 At[4][2], B0[2][2], B1[2][2];
    const int f8sw = g.M, f8sx = g.N; (void)f8sw; (void)f8sx;
    const char* cA = (const char*)g.A + (GATHER ? (size_t)0 : (size_t)cur.pm * tstep); const char* cB = (const char*)g.Bt + (size_t)cur.pn * tstep;
    S.a_ready(cur);
    static_assert(!GATHER || SP2, "gather staging is written for the SP2 loop");
    unsigned voffG[2][2]; int gR[2]; unsigned gC[2];
#pragma unroll
    for (int i = 0; i < 2; ++i) { int R, Cc; stage_rc(tid * 16 + i * 8192, R, Cc); gR[i] = R; gC[i] = (unsigned)Cc * 2u; voffG[0][i] = voffG[1][i] = 0u; }
#define PG8_GLOAD(dst, u) do { _Pragma("unroll") for (int _h = 0; _h < 2; ++_h) _Pragma("unroll") for (int _i = 0; _i < 2; ++_i) { const int _r = HALF * _h + gR[_i]; dst[_h][_i] = _r < (u).nv ? (unsigned)S.la[(u).lb + _r] : 0u; } } while (0)
#define PG8_GCONV(dst) do { _Pragma("unroll") for (int _h = 0; _h < 2; ++_h) _Pragma("unroll") for (int _i = 0; _i < 2; ++_i) dst[_h][_i] = (dst[_h][_i] >> 1) * ((unsigned)K * 2u) + gC[_i]; } while (0)
#define PG8_GLOAD_ASM(dst, u) do { _Pragma("unroll") for (int _h = 0; _h < 2; ++_h) _Pragma("unroll") for (int _i = 0; _i < 2; ++_i) { const int _r = HALF * _h + gR[_i]; \
        const int* _p = S.la + (u).lb + (_r < (u).nv ? _r : 0); asm volatile("global_load_dword %0, %1, off" : "=v"(dst[_h][_i]) : "v"(_p) : "memory"); } } while (0)
    if constexpr (GATHER) { PG8_GLOAD(voffG, cur); PG8_GCONV(voffG); }
    if constexpr (SP2) {
        PG8_STAGE(PG8_SB(0, 0), cB, voffB); PG8_STAGE(PG8_SB(0, 1), cB + hstep, voffB); PG8_STAGE_A(PG8_SA(0, 0), cA, 0); PG8_STAGE_A(PG8_SA(0, 1), cA, 1);
        if (wr == 1) PG8_BAR;
        PG8_WAIT_V(2); PG8_BAR;
        PG8_STAGE(PG8_SB(1, 0), cB + kstep, voffB); PG8_STAGE_A(PG8_SA(1, 0), cA + kstep, 0); PG8_STAGE(PG8_SB(1, 1), cB + hstep + kstep, voffB);
        PG8_WAIT_V(6); PG8_BAR;
    } else {
        PG8_STAGE(PG8_SB(0, 0), cB, voffB); PG8_STAGE(PG8_SA(0, 0), cA, voffA); PG8_STAGE(PG8_SB(0, 1), cB + hstep, voffB); PG8_STAGE(PG8_SA(0, 1), cA + hstep, voffA);
        if (wr == 1) PG8_BAR;
        PG8_WAIT_V(4); PG8_BAR;
        PG8_STAGE(PG8_SB(1, 0), cB + kstep, voffB); PG8_STAGE(PG8_SA(1, 0), cA + kstep, voffA); PG8_STAGE(PG8_SB(1, 1), cB + hstep + kstep, voffB);
        PG8_WAIT_V(6); PG8_BAR;
    }
    for (;;) {
        const bool has_next = S.next(ui + 1, nxt);
        const char* nA = (has_next && !GATHER) ? (const char*)g.A + (size_t)nxt.pm * tstep : cA; const char* nB = has_next ? (const char*)g.Bt + (size_t)nxt.pn * tstep : cB;
#pragma unroll 1
        for (int t = 0; t < nt; t += 2) {
            const bool last = (t == nt - 2);
            const char* a1 = cA + (size_t)(t + 1) * kstep;
            const char* a2 = last ? nA : cA + (size_t)(t + 2) * kstep; const char* b2 = last ? nB : cB + (size_t)(t + 2) * kstep;
            const char* a3 = a2 + kstep; const char* b3 = b2 + kstep;
            if (last && has_next) S.a_ready(nxt);
            if constexpr (SP2) {
            PG8_LDB(B0, 0, 0); PG8_LDB(B1, 0, 1); PG8_SCHED; PG8_LDA(At, 0, 0); PG8_STAGE_A(PG8_SA(1, 1), a1, 1);
            unsigned gtmp[2][2];
            if constexpr (GATHER) { PG8_SCHED;
                if (last && has_next) {
                    const u32x4 o = *(const PG8_LAS u32x4*)(gofs + tid * 16); voffG[0][0] = o.x; voffG[0][1] = o.y; voffG[1][0] = o.z; voffG[1][1] = o.w; }
                if (t == 0 && has_next) PG8_GLOAD_ASM(gtmp, nxt);
                PG8_SCHED; }
            PG8_WAIT_V(8); PG8_WAIT_L(0); PG8_BAR; PG8_MMA(0, 0, At, B0); PG8_MMA(0, 1, At, B1); PG8_BAR; PG8_SCHED;
            PG8_LDA(At, 0, 1); PG8_STAGE(PG8_SB(0, 0), b2, voffB); PG8_STAGE(PG8_SB(0, 1), b2 + hstep, voffB); PG8_STAGE_A(PG8_SA(0, 0), a2, 0);
            PG8_WAIT_V(8); PG8_WAIT_L(0); PG8_BAR; PG8_MMA(1, 0, At, B0); PG8_MMA(1, 1, At, B1); PG8_BAR; PG8_SCHED;
            PG8_LDB(B0, 1, 0); PG8_LDB(B1, 1, 1); PG8_SCHED; PG8_LDA(At, 1, 0); PG8_STAGE_A(PG8_SA(0, 1), a2, 1);
            PG8_WAIT_V(8); PG8_WAIT_L(0); PG8_BAR; PG8_MMA(0, 0, At, B0); PG8_MMA(0, 1, At, B1); PG8_BAR; PG8_SCHED;
            PG8_LDA(At, 1, 1); PG8_STAGE(PG8_SB(1, 0), b3, voffB); PG8_STAGE(PG8_SB(1, 1), b3 + hstep, voffB); PG8_STAGE_A(PG8_SA(1, 0), a3, 0);
            PG8_WAIT_V(8); PG8_WAIT_L(0); PG8_BAR;
            if constexpr (GATHER) { if (t == 0 && has_next) { PG8_GCONV(gtmp); u32x4 o; o.x = gtmp[0][0]; o.y = gtmp[0][1]; o.z = gtmp[1][0]; o.w = gtmp[1][1]; *(PG8_LAS u32x4*)(gofs + tid * 16) = o; } PG8_SCHED; }
            PG8_MMA(1, 0, At, B0); PG8_MMA(1, 1, At, B1); PG8_BAR; PG8_SCHED;
            } else {
            PG8_LDB(B0, 0, 0); PG8_SCHED; PG8_LDA(At, 0, 0); PG8_STAGE(PG8_SA(1, 1), a1 + hstep, voffA);
            PG8_WAIT_L(8); PG8_BAR; PG8_WAIT_L(0); PG8_MMA(0, 0, At, B0); PG8_BAR; PG8_SCHED;
            PG8_LDB(B1, 0, 1); PG8_STAGE(PG8_SB(0, 0), b2, voffB);
            PG8_BAR; PG8_WAIT_L(0); PG8_MMA(0, 1, At, B1); PG8_BAR;
            PG8_LDA(At, 0, 1); PG8_STAGE(PG8_SA(0, 0), a2, voffA);
            PG8_BAR; PG8_WAIT_L(0); PG8_MMA(1, 0, At, B0); PG8_BAR; PG8_SCHED;
            PG8_STAGE(PG8_SB(0, 1), b2 + hstep, voffB);
            PG8_WAIT_V(6); PG8_BAR; PG8_MMA(1, 1, At, B1); PG8_BAR;
            PG8_LDB(B0, 1, 0); PG8_SCHED; PG8_LDA(At, 1, 0); PG8_STAGE(PG8_SA(0, 1), a2 + hstep, voffA);
            PG8_WAIT_L(8); PG8_BAR; PG8_WAIT_L(0); PG8_MMA(0, 0, At, B0); PG8_BAR; PG8_SCHED;
            PG8_LDB(B1, 1, 1); PG8_STAGE(PG8_SB(1, 0), b3, voffB);
            PG8_BAR; PG8_WAIT_L(0); PG8_MMA(0, 1, At, B1); PG8_BAR;
            PG8_LDA(At, 1, 1); PG8_STAGE(PG8_SA(1, 0), a3, voffA);
            PG8_BAR; PG8_WAIT_L(0); PG8_MMA(1, 0, At, B0); PG8_BAR; PG8_SCHED;
            PG8_STAGE(PG8_SB(1, 1), b3 + hstep, voffB);
            PG8_WAIT_V(6); PG8_BAR; PG8_MMA(1, 1, At, B1); PG8_BAR;
            }
        }
        if constexpr (F8) asm volatile("s_nop 15\n\ts_nop 15" ::: "memory");
        if constexpr (ALIGN_EPI) { if (wr == 0) PG8_BAR; }
        if constexpr (!Epi::AFTER_DRAIN) { E(acc, cur, wr, wc, fr, fq); S.done(cur); }
        if (!has_next) break;
#pragma unroll
        for (int a = 0; a < 2; ++a)
#pragma unroll
            for (int b = 0; b < 2; ++b)
#pragma unroll
                for (int m = 0; m < 4; ++m)
#pragma unroll
                    for (int n = 0; n < 2; ++n) acc[a][b][m][n] = (f32x4){0.f, 0.f, 0.f, 0.f};
        cur = nxt; cA = nA; cB = nB; ++ui;
        if constexpr (ALIGN_EPI) { if (wr == 1) PG8_BAR; }
    }
    PG8_WAIT_V(0);
    if constexpr (!ALIGN_EPI) { if (wr == 0) PG8_BAR; }
    PG8_BAR;
    if constexpr (Epi::AFTER_DRAIN) { E.fused(acc, cur, wr, wc, fr, fq, lds, wid, lane); S.done(cur); }
#undef PG8_SA
#undef PG8_SB
#undef PG8_STAGE
#undef PG8_STAGE_A
#undef PG8_GLOAD
#undef PG8_GLOAD_ASM
#undef PG8_GCONV
#undef PG8_LDA
#undef PG8_LDB
#undef PG8_MMA
#undef PG8_CAT
#undef PG8_WAIT_V
#undef PG8_WAIT_L
#undef PG8_BAR
#undef PG8_SCHED
}
}

#define GAS __attribute__((address_space(1)))
#define LAS __attribute__((address_space(3)))
typedef unsigned short bf16;
typedef unsigned v4u __attribute__((ext_vector_type(4)));
typedef unsigned v2u __attribute__((ext_vector_type(2)));
typedef float f32x4 __attribute__((ext_vector_type(4)));
typedef float f32x2 __attribute__((ext_vector_type(2)));
typedef short bf16x8 __attribute__((ext_vector_type(8)));
typedef float f32x16 __attribute__((ext_vector_type(16)));
typedef short s16x4 __attribute__((ext_vector_type(4)));
typedef int i32x4 __attribute__((ext_vector_type(4)));
typedef int i32x16 __attribute__((ext_vector_type(16)));
typedef __bf16 bf16x2_t __attribute__((ext_vector_type(2)));
#define LDS_WAIT() asm volatile("s_waitcnt lgkmcnt(0)" ::: "memory")
#define VM_WAIT() asm volatile("s_waitcnt vmcnt(0)" ::: "memory")
__device__ __forceinline__ unsigned pk2(float lo, float hi) { f32x2 v = {lo, hi}; bf16x2_t r = __builtin_convertvector(v, bf16x2_t); return __builtin_bit_cast(unsigned, r); }
__device__ __forceinline__ float bflo(unsigned u) { return __builtin_bit_cast(float, u << 16); }
__device__ __forceinline__ float bfhi(unsigned u) { return __builtin_bit_cast(float, u & 0xffff0000u); }
__device__ __forceinline__ float bf2f(bf16 b) { return __builtin_bit_cast(float, ((unsigned)b) << 16); }
__device__ __forceinline__ float wave_sum(float v) {
#pragma unroll
    for (int o = 1; o < 64; o <<= 1) v += __shfl_xor(v, o);
    return v;
}
__device__ __forceinline__ float wave_max(float v) {
#pragma unroll
    for (int o = 1; o < 64; o <<= 1) v = fmaxf(v, __shfl_xor(v, o));
    return v;
}

__device__ __forceinline__ unsigned pk4_fp8(float a, float b, float c, float d) {
    a = __builtin_amdgcn_fmed3f(a, -448.f, 448.f); b = __builtin_amdgcn_fmed3f(b, -448.f, 448.f); c = __builtin_amdgcn_fmed3f(c, -448.f, 448.f); d = __builtin_amdgcn_fmed3f(d, -448.f, 448.f);
    int r = __builtin_amdgcn_cvt_pk_fp8_f32(a, b, 0, false);
    r = __builtin_amdgcn_cvt_pk_fp8_f32(c, d, r, true);
    return (unsigned)r;
}
#define XB_TMO      128
#define XB_XCNT(j)  (256  + 64 * (j))
#define XB_XSUB(j)  (1280 + 64 * (j))
#define XB_XGEN(j)  (2304 + 64 * (j))
#define XB_TOP      3328
#define XB_TOPGEN   3392
#define XCD_BAR_WORDS 3456
#define XB_SPIN_CAP (1u << 23)

__device__ __forceinline__ unsigned xb_ld(unsigned* p)              { return __hip_atomic_load(p, __ATOMIC_RELAXED, __HIP_MEMORY_SCOPE_AGENT); }
__device__ __forceinline__ unsigned xb_add(unsigned* p, unsigned v) { return __hip_atomic_fetch_add(p, v, __ATOMIC_RELAXED, __HIP_MEMORY_SCOPE_AGENT); }
__device__ __forceinline__ unsigned xb_xcc_id() { return (unsigned)__builtin_amdgcn_s_getreg((3 << 11) | 20) & 0xFu; }
#define XB_SPIN(cond, bar) do { unsigned _sp = 0; while (cond) { __builtin_amdgcn_s_sleep(1); \
    if ((++_sp & 255u) == 0u) { if (xb_ld(&(bar)[XB_TMO])) break; if (_sp > XB_SPIN_CAP) { atomicAdd(&(bar)[XB_TMO], 1u); break; } } } } while (0)

struct XcdBarrier {
    unsigned* bar; unsigned x;
    volatile LAS unsigned* st;
};

__device__ __forceinline__ XcdBarrier xcd_barrier_post(unsigned* bar, volatile LAS unsigned* st) {
    XcdBarrier b; b.bar = bar; b.x = xb_xcc_id(); b.st = st;
    if (threadIdx.x == 0) (void)xb_add(&bar[XB_XCNT(b.x)], 1u);
    return b;
}
__device__ __forceinline__ void xcd_barrier_complete(unsigned* bar, unsigned x, unsigned& nloc, unsigned& nx) {
    const unsigned G = gridDim.x * gridDim.y * gridDim.z;
    unsigned sum, cnt, mine, sp = 0u;
    for (;;) {
        sum = 0u; cnt = 0u; mine = 0u;
#pragma unroll
        for (unsigned j = 0; j < 16; ++j) { const unsigned c = xb_ld(&bar[XB_XCNT(j)]); sum += c; cnt += (c > 0u) ? 1u : 0u; mine = (j == x) ? c : mine; }
        if (sum == G) break;
        __builtin_amdgcn_s_sleep(1);
        if ((++sp & 255u) == 0u) { if (xb_ld(&bar[XB_TMO])) break; if (sp > XB_SPIN_CAP) { atomicAdd(&bar[XB_TMO], 1u); break; } }
    }
    nloc = mine > 0u ? mine : 1u; nx = cnt > 0u ? cnt : 1u;
}

__device__ __forceinline__ void xcd_barrier(const XcdBarrier& b) {
    asm volatile("s_waitcnt vmcnt(0)" ::: "memory");
    __syncthreads();
    if (threadIdx.x == 0) {
        unsigned* bar = b.bar;
        __builtin_amdgcn_s_waitcnt(0);
        unsigned nloc = b.st[0], nx = b.st[1];
        if (nloc == 0u) { xcd_barrier_complete(bar, b.x, nloc, nx); b.st[0] = nloc; b.st[1] = nx; }
        const unsigned old = xb_add(&bar[XB_XSUB(b.x)], 1u);
        const unsigned gen = old / nloc;
        if (old + 1u == (gen + 1u) * nloc) {
            __builtin_amdgcn_fence(__ATOMIC_RELEASE, "agent");
            asm volatile("s_waitcnt vmcnt(0)" ::: "memory");
            const unsigned og = xb_add(&bar[XB_TOP], 1u);
            const unsigned tg = og / nx;
            if (og + 1u == (tg + 1u) * nx) xb_add(&bar[XB_TOPGEN], 1u);
            else XB_SPIN(xb_ld(&bar[XB_TOPGEN]) == tg, bar);
            __builtin_amdgcn_fence(__ATOMIC_ACQUIRE, "agent");
            xb_add(&bar[XB_XGEN(b.x)], 1u);
            asm volatile("s_waitcnt vmcnt(0)" ::: "memory");
        } else {
            XB_SPIN(xb_ld(&bar[XB_XGEN(b.x)]) == gen, bar);
            __builtin_amdgcn_fence(__ATOMIC_ACQUIRE, "agent");
            asm volatile("s_waitcnt vmcnt(0)" ::: "memory");
        }
    }
    __syncthreads();
}

constexpr int D = 2048, NB = 4, S = 4096, T = NB * S;
constexpr int HD = 128, FH = 12, FW = 1536, MH = 4, MW = 512, ML = 256;
constexpr int FOX_IN = 6668, FOX_NP = 6912;
constexpr int GLA_IN = 5136, GLA_NP = 5376;
constexpr int GH = 4, GDK = 192, GDV = 384, GKW = 768, GVW = 1536;
constexpr int NE = 32, DE = 1024, MAXROWS = 40960, MAXTILES = 160;
constexpr int FP_Q = 0, FP_K = 1536, FP_V = 3072, FP_OG = 4608, FP_QM = 6144, FP_F = 6656;
constexpr int GP_Q = 0, GP_K = 768, GP_V = 1536, GP_R = 3072, GP_QM = 4608, GP_A = 5120;
constexpr float RMS_EPS = 1e-6f;
constexpr int NWAVES = 8;

constexpr size_t MiB = 1u << 20;
constexpr size_t WS_CTL = 0, CTL_ZERO_BYTES = 1 * MiB;
constexpr size_t WS_ROUTE = 1 * MiB;
constexpr size_t WS_WFOX = 4 * MiB;
constexpr size_t WS_WGLA = WS_WFOX + 27 * MiB;
constexpr size_t WS_WOUT = WS_WGLA + 21 * MiB;
constexpr size_t WS_WMKV = WS_WOUT + 16 * MiB;
constexpr size_t WS_WGU = WS_WMKV + 4 * MiB;
constexpr size_t WS_WD = WS_WGU + 512 * MiB;
constexpr size_t WS_HN = WS_WD + 256 * MiB;
constexpr size_t WS_P = WS_HN + 65 * MiB;
constexpr size_t WS_CAT = WS_P + 216 * MiB;
constexpr size_t WS_XA = WS_CAT + 64 * MiB;
constexpr size_t WS_XB = WS_XA + 128 * MiB;
constexpr size_t WS_XG = WS_XB + 128 * MiB;
constexpr size_t WS_H = WS_XG + 160 * MiB;
constexpr size_t WS_YB = WS_H + 80 * MiB;
constexpr size_t WS_MEMN = WS_YB + 128 * MiB;
constexpr size_t WS_MKV = WS_MEMN + 4 * MiB;
constexpr size_t WS_MK = WS_MKV + 2 * MiB;
constexpr size_t WS_C = WS_MK + 2 * MiB;
constexpr size_t WS_FL = WS_C + 1 * MiB;
constexpr size_t WS_WR = WS_FL + 1 * MiB;
constexpr size_t WS_INV = WS_WR + 1 * MiB;
constexpr size_t WS_END = WS_INV + 1 * MiB;
constexpr size_t WS_SWC_FOX = WS_INV, WS_SWC_GLA = WS_INV + 32 * 1024, WS_SWC_MKV = WS_INV + 64 * 1024, WS_SWC_WO1 = WS_INV + 72 * 1024;
constexpr size_t WS_GO = WS_XG, WS_LA = WS_H;
constexpr size_t WS_XN8 = WS_XG, WS_LSTA = WS_XG + 32 * MiB, WS_LSTW = WS_XG + 34 * MiB;
constexpr size_t WS_SA = WS_HN + 48 * MiB, WS_SAM = WS_MEMN + 3 * MiB;
constexpr size_t RT_TOKE = 0;
constexpr size_t RT_TOKS = RT_TOKE + 2 * T * 4;
constexpr size_t RT_TOKW = RT_TOKS + 2 * T * 4;
constexpr size_t RT_ROWDEST = RT_TOKW + 2 * T * 4;
constexpr size_t RT_ROWW = RT_ROWDEST + 2 * MAXROWS * 4;
constexpr size_t RT_TILEE = RT_ROWW + MAXROWS * 4;
constexpr size_t RT_END = RT_TILEE + 2 * 256 * 4;
static_assert(RT_END <= 3 * MiB, "routing arrays");
constexpr int CW_BAR = 4096;
constexpr int CW_CNT = 8192;
constexpr int CW_Q0 = 8320, CW_Q1 = 8384;
constexpr int CW_AMAX = 12416;
constexpr int CW_PROBE = 12288;
constexpr int CW_CVQ = 9216, CW_PD = 9280;
static_assert((CW_PD + 64 * 16) * 4 <= (int)CTL_ZERO_BYTES, "ctl");

constexpr int RING_OFF = 0, RING_BYTES = 131072;
constexpr int TR_PITCH = 65, TR_WAVE_BYTES = 64 * TR_PITCH * 4;
constexpr int LDSCTL_OFF = 8 * TR_WAVE_BYTES, MISC_OFF = LDSCTL_OFF + 320;
constexpr int GOFF_OFF = LDSCTL_OFF + 4096;
constexpr int LDS_BYTES = GOFF_OFF + 8192;
static_assert(LDSCTL_OFF >= RING_BYTES && LDS_BYTES <= 163840, "LDS map");

namespace pg8 {
template <bool I8> struct EpiPT {
    static constexpr bool PERM = true, AFTER_DRAIN = false;
    bf16_t* P; int ldp; float* FL; int ftile; bf16_t* P2; int ldp2, pm2, pn2; const float* SA; const float* SWC; const float* SA2; const float* SWC2;
    int nq0, nq1, nk0, nk1, nm0, nm1; const float* GQ; const float* GK; const float* GM; PG8_LAS float* nscr;
    __device__ __forceinline__ f32x4 val(const f32x4& a, float s, const f32x4& c) const {
        if (!I8) return a;
        const pg8_v4i i = __builtin_bit_cast(pg8_v4i, a); return (f32x4){(float)i.x * (s * c.x), (float)i.y * (s * c.y), (float)i.z * (s * c.z), (float)i.w * (s * c.w)};
    }
    __device__ __forceinline__ void operator()(const f32x4 (&acc)[2][2][4][2], const Unit& u, int wr, int wc, int fr, int fq) const {
        const bool second = u.pm >= pm2;
        bf16_t* O = second ? P2 : P; const int ld = second ? ldp2 : ldp;
        const int row0 = (second ? u.pm - pm2 : u.pm) * BM + wr * 64 + fr, col0 = (second ? u.pn - pn2 : u.pn) * BM + wc * 32 + 8 * fq;
        f32x4 cs[2][2];
        { const float* cp = (second ? SWC2 : SWC) + col0;
#pragma unroll
          for (int bj = 0; bj < 2; ++bj) { cs[bj][0] = I8 ? *(const f32x4*)(cp + bj * HALF) : (f32x4){1.f, 1.f, 1.f, 1.f}; cs[bj][1] = I8 ? *(const f32x4*)(cp + bj * HALF + 4) : (f32x4){1.f, 1.f, 1.f, 1.f}; } }
        const float* G = nullptr;
        if (!second) { if (u.pn >= nq0 && u.pn < nq1) G = GQ; else if (u.pn >= nk0 && u.pn < nk1) G = GK; else if (u.pn >= nm0 && u.pn < nm1) G = GM; }
        if (G != nullptr) {
            PG8_LAS float* sp = nscr + ((wr * 8) * 16 + fr) * 8 + wc;
#pragma unroll
            for (int ai = 0; ai < 2; ++ai)
#pragma unroll
                for (int m = 0; m < 4; ++m) { const float s = I8 ? SA[row0 + ai * HALF + m * 16] : 1.0f;
#pragma unroll
                    for (int bj = 0; bj < 2; ++bj) { const f32x4 v0 = val(acc[ai][bj][m][0], s, cs[bj][0]), v1 = val(acc[ai][bj][m][1], s, cs[bj][1]);
                        float ss = (v0[0] * v0[0] + v0[1] * v0[1]) + (v0[2] * v0[2] + v0[3] * v0[3]) + (v1[0] * v1[0] + v1[1] * v1[1]) + (v1[2] * v1[2] + v1[3] * v1[3]);
                        ss += __shfl_xor(ss, 16); ss += __shfl_xor(ss, 32);
                        if (fq == 0) sp[((ai * 4 + m) * 16) * 8 + bj * 4] = ss; } }
            asm volatile("s_waitcnt lgkmcnt(0)" ::: "memory");
            __builtin_amdgcn_s_barrier();
            const f32x4 g0 = *(const f32x4*)(G + wc * 32 + 8 * fq), g1 = *(const f32x4*)(G + wc * 32 + 8 * fq + 4);
#pragma unroll
            for (int ai = 0; ai < 2; ++ai)
#pragma unroll
                for (int m = 0; m < 4; ++m) { const int row = row0 + ai * HALF + m * 16; bf16_t* rowp = O + (size_t)row * ld + col0; const float s = I8 ? SA[row] : 1.0f;
#pragma unroll
                    for (int bj = 0; bj < 2; ++bj) { const f32x4 pp = *(const PG8_LAS f32x4*)(nscr + (((wr * 8) + ai * 4 + m) * 16 + fr) * 8 + bj * 4);
                        const float inv = 1.0f / sqrtf(((pp[0] + pp[1]) + (pp[2] + pp[3])) * (1.0f / 128.0f) + 1e-6f);
                        f32x4 a0 = acc[ai][bj][m][0], a1 = acc[ai][bj][m][1]; asm volatile("" : "+v"(a0), "+v"(a1));
                        const f32x4 v0 = val(a0, s, cs[bj][0]) * inv * g0, v1 = val(a1, s, cs[bj][1]) * inv * g1;
                        u32x4 w; w.x = pk2(v0[0], v0[1]); w.y = pk2(v0[2], v0[3]); w.z = pk2(v1[0], v1[1]); w.w = pk2(v1[2], v1[3]);
                        *(u32x4*)(rowp + bj * HALF) = w; } }
            return;
        }
#pragma unroll
        for (int ai = 0; ai < 2; ++ai)
#pragma unroll
            for (int m = 0; m < 4; ++m) { const int row = row0 + ai * HALF + m * 16; bf16_t* rowp = O + (size_t)row * ld + col0;
                const float s = I8 ? (second ? SA2[row] : SA[row]) : 1.0f;
#pragma unroll
                for (int bj = 0; bj < 2; ++bj) { const f32x4 v0 = val(acc[ai][bj][m][0], s, cs[bj][0]), v1 = val(acc[ai][bj][m][1], s, cs[bj][1]);
                    u32x4 w; w.x = pk2(v0[0], v0[1]); w.y = pk2(v0[2], v0[3]); w.z = pk2(v1[0], v1[1]); w.w = pk2(v1[2], v1[3]);
                    *(u32x4*)(rowp + bj * HALF) = w; }
                if (!second && u.pn == ftile && wc == 0 && fq < 2) { float* fp = FL + (size_t)row * 16 + 8 * fq;
                    *(f32x4*)(fp) = val(acc[ai][0][m][0], s, cs[0][0]); *(f32x4*)(fp + 4) = val(acc[ai][0][m][1], s, cs[0][1]); } }
    }
};
typedef EpiPT<false> EpiP;
struct TwoGemmOrder {
    StaticOrder S; int nx2, n2, pm2, pn2;
    __device__ __forceinline__ bool next(int i, Unit& u) const {
        if (S.next(i, u)) return true;
        const long L = (long)i * S.G + S.c - S.nwg; if (L < 0 || L >= n2) return false;
        u.pm = pm2 + (int)(L % nx2); u.pn = pn2 + (int)(L / nx2); return true;
    }
    __device__ __forceinline__ void a_ready(const Unit&) const {}
    __device__ __forceinline__ void done(const Unit&) const {}
};
template <bool RF32> struct EpiRes {
    static constexpr bool PERM = true, AFTER_DRAIN = false;
    const void* R; bf16_t* C; int ldc; const float* SC; const float* SWC;
    __device__ __forceinline__ void operator()(const f32x4 (&acc)[2][2][4][2], const Unit& u, int wr, int wc, int fr, int fq) const {
        const int row0 = u.pm * BM + wr * 64 + fr, col0 = u.pn * BM + wc * 32 + 8 * fq;
#pragma unroll
        for (int ai = 0; ai < 2; ++ai)
#pragma unroll
            for (int m = 0; m < 4; ++m) { const int row = row0 + ai * HALF + m * 16; const size_t ro = (size_t)row * ldc + col0; const float s = SC[row];
#pragma unroll
                for (int bj = 0; bj < 2; ++bj) { f32x4 r0, r1;
                    if (RF32) { r0 = *(const f32x4*)((const float*)R + ro + bj * HALF); r1 = *(const f32x4*)((const float*)R + ro + bj * HALF + 4); }
                    else { const u32x4 rb = *(const u32x4*)((const bf16_t*)R + ro + bj * HALF);
                        r0 = (f32x4){bflo(rb.x), bfhi(rb.x), bflo(rb.y), bfhi(rb.y)}; r1 = (f32x4){bflo(rb.z), bfhi(rb.z), bflo(rb.w), bfhi(rb.w)}; }
                    const pg8_v4i i0 = __builtin_bit_cast(pg8_v4i, acc[ai][bj][m][0]), i1 = __builtin_bit_cast(pg8_v4i, acc[ai][bj][m][1]);
                    const f32x4 c0 = *(const f32x4*)(SWC + col0 + bj * HALF) * s, c1 = *(const f32x4*)(SWC + col0 + bj * HALF + 4) * s;
                    const f32x4 v0 = (f32x4){(float)i0.x, (float)i0.y, (float)i0.z, (float)i0.w} * c0 + r0, v1 = (f32x4){(float)i1.x, (float)i1.y, (float)i1.z, (float)i1.w} * c1 + r1;
                    u32x4 w; w.x = pk2(v0[0], v0[1]); w.y = pk2(v0[2], v0[3]); w.z = pk2(v1[0], v1[1]); w.w = pk2(v1[2], v1[3]);
                    *(u32x4*)(C + ro + bj * HALF) = w; } }
    }
};
template <bool RF32> struct EpiResF {
    static constexpr bool PERM = true, AFTER_DRAIN = false;
    const void* R; bf16_t* C; int ldc;
    __device__ __forceinline__ void operator()(const f32x4 (&acc)[2][2][4][2], const Unit& u, int wr, int wc, int fr, int fq) const {
        const int row0 = u.pm * BM + wr * 64 + fr, col0 = u.pn * BM + wc * 32 + 8 * fq;
#pragma unroll
        for (int ai = 0; ai < 2; ++ai)
#pragma unroll
            for (int m = 0; m < 4; ++m) { const int row = row0 + ai * HALF + m * 16; const size_t ro = (size_t)row * ldc + col0;
#pragma unroll
                for (int bj = 0; bj < 2; ++bj) { f32x4 r0, r1;
                    if (RF32) { r0 = *(const f32x4*)((const float*)R + ro + bj * HALF); r1 = *(const f32x4*)((const float*)R + ro + bj * HALF + 4); }
                    else { const u32x4 rb = *(const u32x4*)((const bf16_t*)R + ro + bj * HALF);
                        r0 = (f32x4){bflo(rb.x), bfhi(rb.x), bflo(rb.y), bfhi(rb.y)}; r1 = (f32x4){bflo(rb.z), bfhi(rb.z), bflo(rb.w), bfhi(rb.w)}; }
                    const f32x4 v0 = acc[ai][bj][m][0] + r0, v1 = acc[ai][bj][m][1] + r1;
                    u32x4 w; w.x = pk2(v0[0], v0[1]); w.y = pk2(v0[2], v0[3]); w.z = pk2(v1[0], v1[1]); w.w = pk2(v1[2], v1[3]);
                    *(u32x4*)(C + ro + bj * HALF) = w; } }
    }
};
struct EpiGU {
    static constexpr bool PERM = true, AFTER_DRAIN = false;
    unsigned char* H;
    __device__ __forceinline__ void operator()(const f32x4 (&acc)[2][2][4][2], const Unit& u, int wr, int wc, int fr, int fq) const {
        const int row0 = u.pm * BM + wr * 64 + fr, col0 = (u.pn & 7) * HALF + wc * 32 + 8 * fq;
#pragma unroll
        for (int ai = 0; ai < 2; ++ai)
#pragma unroll
            for (int m = 0; m < 4; ++m) { unsigned char* rowp = H + (size_t)(row0 + ai * HALF + m * 16) * 1024 + col0;
                float h[8];
#pragma unroll
                for (int n = 0; n < 2; ++n)
#pragma unroll
                    for (int j = 0; j < 4; ++j) { const float g = acc[ai][0][m][n][j], uu = acc[ai][1][m][n][j]; h[4 * n + j] = 8.0f * g * uu * __builtin_amdgcn_rcpf(1.0f + __expf(-g)); }
                v2u w; w.x = pk4_fp8(h[0], h[1], h[2], h[3]); w.y = pk4_fp8(h[4], h[5], h[6], h[7]);
                *(v2u*)rowp = w; }
    }
};
struct EpiDown {
    static constexpr bool PERM = true, AFTER_DRAIN = false;
    const int* la; const float* lw; bf16_t* YB;
    __device__ __forceinline__ void operator()(const f32x4 (&acc)[2][2][4][2], const Unit& u, int wr, int wc, int fr, int fq) const {
        const int row0 = wr * 64 + fr, col0 = (u.pn & 7) * BM + wc * 32 + 8 * fq;
#pragma unroll
        for (int ai = 0; ai < 2; ++ai)
#pragma unroll
            for (int m = 0; m < 4; ++m) { const int row = row0 + ai * HALF + m * 16;
                if (row < u.nv) { const int dest = la[u.lb + row]; const float w8 = lw[u.lb + row] * 16.0f; unsigned char* rowp = (unsigned char*)YB + (size_t)dest * D + col0;
#pragma unroll
                    for (int bj = 0; bj < 2; ++bj) { const f32x4 v0 = acc[ai][bj][m][0] * w8, v1 = acc[ai][bj][m][1] * w8;
                        v2u w; w.x = pk4_fp8(v0[0], v0[1], v0[2], v0[3]); w.y = pk4_fp8(v1[0], v1[1], v1[2], v1[3]);
                        *(v2u*)(rowp + bj * HALF) = w; } } }
    }
};
struct MoeOrder {
    int pk, G, c; const int* la;
    __device__ __forceinline__ bool next(int i, Unit& u) const {
        const int L = i * G + c, tile = L >> 3, pn = L & 7;
        const unsigned long long m = __ballot(tile < (int)((unsigned)pk >> 24));
        if (m == 0ull) return false;
        const int e = (int)__builtin_ctzll(m); const int pe = __builtin_amdgcn_readlane(pk, e); const int ml = tile - ((pe >> 16) & 255);
        u.pm = tile; u.pn = e * 8 + pn; u.lb = e * 16384 + ml * 256; u.nv = (pe & 0xffff) - ml * 256; return true;
    }
    __device__ __forceinline__ void a_ready(const Unit&) const {}
    __device__ __forceinline__ void done(const Unit&) const {}
};
}

struct Ctx {
    LAS unsigned char* lds;
    int tid, lane, wave, gw, NGW, G;
    const float* in[24]; float* out; unsigned char* ws;
};
#define WSP(type, off) ((type*)(C.ws + (off)))

__device__ __forceinline__ void load_row(const float* xrow, int lane, f32x4 (&v)[8]) {
#pragma unroll
    for (int j = 0; j < 8; ++j) v[j] = ((const f32x4*)xrow)[lane + 64 * j];
}
__device__ __forceinline__ void load_row_bf16(const bf16* xrow, int lane, f32x4 (&v)[8]) {
#pragma unroll
    for (int j = 0; j < 8; ++j) { const v2u u = ((const v2u*)xrow)[lane + 64 * j]; v[j] = (f32x4){bflo(u.x), bfhi(u.x), bflo(u.y), bfhi(u.y)}; }
}
__device__ __forceinline__ float row_inv_rms(const f32x4 (&v)[8]) {
    float s = 0.f;
#pragma unroll
    for (int j = 0; j < 8; ++j) s += (v[j].x * v[j].x + v[j].y * v[j].y) + (v[j].z * v[j].z + v[j].w * v[j].w);
    s = wave_sum(s);
    return 1.0f / sqrtf(s * (1.0f / D) + RMS_EPS);
}
__device__ __forceinline__ unsigned pk4_i8(float a, float b, float c, float d) {
    const int ia = __float2int_rn(a), ib = __float2int_rn(b), ic = __float2int_rn(c), id = __float2int_rn(d);
    return (unsigned)(ia & 0xff) | ((unsigned)(ib & 0xff) << 8) | ((unsigned)(ic & 0xff) << 16) | ((unsigned)id << 24);
}
__device__ __forceinline__ void norm_store_row_i8(unsigned char* orow8, float* sa, f32x4 (&v)[8], float inv, const float* g, int lane) {
    float am = 0.f;
#pragma unroll
    for (int j = 0; j < 8; ++j) { const f32x4 gg = ((const f32x4*)g)[lane + 64 * j]; v[j] = v[j] * inv * gg;
        am = fmaxf(fmaxf(am, fmaxf(fabsf(v[j].x), fabsf(v[j].y))), fmaxf(fabsf(v[j].z), fabsf(v[j].w))); }
    am = fmaxf(wave_max(am), 1e-30f);
    const float qs = 127.0f / am;
#pragma unroll
    for (int j = 0; j < 8; ++j) ((unsigned*)orow8)[lane + 64 * j] = pk4_i8(v[j].x * qs, v[j].y * qs, v[j].z * qs, v[j].w * qs);
    if (lane == 0) *sa = am * (1.0f / 127.0f);
}
__device__ __forceinline__ void norm_store_row(bf16* orow, f32x4 (&v)[8], float inv, const float* g, int lane) {
#pragma unroll
    for (int j = 0; j < 8; ++j) { const f32x4 gg = ((const f32x4*)g)[lane + 64 * j]; v[j] = v[j] * inv * gg;
        v2u o; o.x = pk2(v[j].x, v[j].y); o.y = pk2(v[j].z, v[j].w); ((v2u*)orow)[lane + 64 * j] = o; }
}

struct TrItem { const float* W; bf16* WT; int ldn, K, drow, k0, n0; float qs; };
__device__ __forceinline__ void tr_load(const TrItem& d, int lane, f32x4 (&v)[16]) {
#pragma unroll
    for (int i = 0; i < 16; ++i) v[i] = *(const f32x4*)(d.W + (size_t)(d.k0 + 4 * i + (lane >> 4)) * d.ldn + d.n0 + 4 * (lane & 15));
}
__device__ __forceinline__ void tr_finish(const TrItem& d, const f32x4 (&v)[16], LAS float* scr, int lane) {
#pragma unroll
    for (int i = 0; i < 16; ++i) { LAS float* p = scr + (4 * i + (lane >> 4)) * TR_PITCH + 4 * (lane & 15); p[0] = v[i].x; p[1] = v[i].y; p[2] = v[i].z; p[3] = v[i].w; }
    LDS_WAIT(); asm volatile("" ::: "memory");
    const int c = lane >> 3;
#pragma unroll
    for (int j = 0; j < 8; ++j) { const int n = (lane & 7) + 8 * j; const LAS float* s = scr + (8 * c) * TR_PITCH + n;
        v4u o; o.x = pk2(s[0 * TR_PITCH], s[1 * TR_PITCH]); o.y = pk2(s[2 * TR_PITCH], s[3 * TR_PITCH]); o.z = pk2(s[4 * TR_PITCH], s[5 * TR_PITCH]); o.w = pk2(s[6 * TR_PITCH], s[7 * TR_PITCH]);
        *(v4u*)(d.WT + (size_t)(d.drow + n) * d.K + d.k0 + 8 * c) = o; }
    LDS_WAIT(); asm volatile("" ::: "memory");
}
__device__ __forceinline__ void tr_finish_i8(const TrItem& d, const f32x4 (&v)[16], LAS float* scr, int lane) {
#pragma unroll
    for (int i = 0; i < 16; ++i) { LAS float* p = scr + (4 * i + (lane >> 4)) * TR_PITCH + 4 * (lane & 15); p[0] = v[i].x; p[1] = v[i].y; p[2] = v[i].z; p[3] = v[i].w; }
    LDS_WAIT(); asm volatile("" ::: "memory");
    const int c = lane & 3; const float qs = d.qs;
#pragma unroll
    for (int j = 0; j < 4; ++j) { const int n = (lane >> 2) + 16 * j; const LAS float* s = scr + (16 * c) * TR_PITCH + n;
        v4u o;
        o.x = pk4_i8(s[0 * TR_PITCH] * qs, s[1 * TR_PITCH] * qs, s[2 * TR_PITCH] * qs, s[3 * TR_PITCH] * qs);
        o.y = pk4_i8(s[4 * TR_PITCH] * qs, s[5 * TR_PITCH] * qs, s[6 * TR_PITCH] * qs, s[7 * TR_PITCH] * qs);
        o.z = pk4_i8(s[8 * TR_PITCH] * qs, s[9 * TR_PITCH] * qs, s[10 * TR_PITCH] * qs, s[11 * TR_PITCH] * qs);
        o.w = pk4_i8(s[12 * TR_PITCH] * qs, s[13 * TR_PITCH] * qs, s[14 * TR_PITCH] * qs, s[15 * TR_PITCH] * qs);
        *(v4u*)((unsigned char*)d.WT + (size_t)(d.drow + n) * d.K + d.k0 + 16 * c) = o; }
    LDS_WAIT(); asm volatile("" ::: "memory");
}
__device__ __forceinline__ bool tr_group(int& r, const float* W, int ldn, int K, int c0, int nblk, bf16* WT, int drow0, TrItem& d) {
    const int cnt = (K / 64) * nblk;
    if (r < cnt) { const int kb = r / nblk, nb = r % nblk; d.W = W + c0; d.WT = WT; d.ldn = ldn; d.K = K; d.drow = drow0 + 64 * nb; d.k0 = 64 * kb; d.n0 = 64 * nb; return true; }
    r -= cnt; return false;
}
struct CvItem { const float* W; unsigned char* WT; int ldn, K, drow, k0, n0; };
__device__ __forceinline__ CvItem moe_cv_decode(const Ctx& C, int hi) {
    const int pr = hi >> 1, h = hi & 1, le = pr / 768, rem = pr % 768, kind = rem >> 8, r = rem & 255; CvItem d;
    if (kind < 2) {
        const int kb = 2 * (r >> 4) + h, nb = r & 15, n0 = 64 * nb;
        d.W = (kind == 0 ? C.in[21] : C.in[22]) + (size_t)le * 2048 * 1024; d.WT = WSP(unsigned char, WS_WGU) + (size_t)le * 2048 * 2048;
        d.ldn = 1024; d.K = 2048; d.drow = 256 * (n0 >> 7) + (n0 & 127) + 128 * kind; d.k0 = 64 * kb; d.n0 = n0;
    } else {
        const int kb = 2 * (r >> 5) + h, nb = r & 31;
        d.W = C.in[23] + (size_t)le * 1024 * 2048; d.WT = WSP(unsigned char, WS_WD) + (size_t)le * 2048 * 1024;
        d.ldn = 2048; d.K = 1024; d.drow = 64 * nb; d.k0 = 64 * kb; d.n0 = 64 * nb;
    }
    return d;
}
__device__ __forceinline__ void tr8_load(const CvItem& d, int lane, f32x4 (&v)[16]) {
#pragma unroll
    for (int i = 0; i < 16; ++i) v[i] = *(const f32x4*)(d.W + (size_t)(d.k0 + 4 * i + (lane >> 4)) * d.ldn + d.n0 + 4 * (lane & 15));
}
#ifndef TR8_HYP
#define TR8_HYP 1
#endif
typedef int v2i_t __attribute__((ext_vector_type(2)));
__device__ __forceinline__ void tr8_finish(const CvItem& d, const f32x4 (&v)[16], LAS float* scr, int lane, int h) {
    LAS unsigned char* tile = (LAS unsigned char*)scr;
#pragma unroll
    for (int i = 0; i < 16; ++i) *(LAS unsigned*)(tile + (64 * h + 4 * i + (lane >> 4)) * 72 + 4 * (lane & 15)) = pk4_fp8(v[i].x * 64.f, v[i].y * 64.f, v[i].z * 64.f, v[i].w * 64.f);
    if (h == 0) return;
    LDS_WAIT(); asm volatile("" ::: "memory");
    const int G = lane >> 4, i16 = lane & 15;
    const int q = TR8_HYP == 1 ? (i16 >> 1) : (i16 & 7), p = TR8_HYP == 1 ? (i16 & 1) : (i16 >> 3);
    const int kbase = d.k0 - 64;
#pragma unroll
    for (int j = 0; j < 4; ++j)
#pragma unroll
        for (int cc = 0; cc < 2; ++cc) {
            const int ck = 16 * (G + 4 * cc);
            const v2i_t lo = __builtin_amdgcn_ds_read_tr8_b64_v2i32((LAS v2i_t*)(tile + (ck + q) * 72 + 16 * j + 8 * p));
            const v2i_t hi = __builtin_amdgcn_ds_read_tr8_b64_v2i32((LAS v2i_t*)(tile + (ck + 8 + q) * 72 + 16 * j + 8 * p));
            v4u o; o.x = (unsigned)lo.x; o.y = (unsigned)lo.y; o.z = (unsigned)hi.x; o.w = (unsigned)hi.y;
            *(v4u*)(d.WT + (size_t)(d.drow + 16 * j + i16) * d.K + kbase + ck) = o;
        }
    LDS_WAIT(); asm volatile("" ::: "memory");
}
__device__ __forceinline__ void moe_cv_item(const Ctx& C, int pr, LAS float* scr, int lane) {
    { const CvItem d = moe_cv_decode(C, 2 * pr); f32x4 v[16]; tr8_load(d, lane, v); tr8_finish(d, v, scr, lane, 0); }
    { const CvItem d = moe_cv_decode(C, 2 * pr + 1); f32x4 v[16]; tr8_load(d, lane, v); tr8_finish(d, v, scr, lane, 1); }
}
#ifndef CV_STEAL
#define CV_STEAL 0
#endif
constexpr int CVQ_FIRST = CV_STEAL ? 32 * 1536 : 64 * 1536, CVQ_TOTAL = 64 * 1536 - CVQ_FIRST;
__device__ __forceinline__ void cv_steal(const Ctx& C, int maxn, unsigned* pd) {
    unsigned* q = (unsigned*)(C.ws + WS_CTL) + CW_CVQ;
    LAS float* scr = (LAS float*)(C.lds + C.wave * TR_WAVE_BYTES);
    for (int n = 0; n < maxn; ++n) {
        unsigned idx = 0;
        if (C.lane == 0) { if (pd && __hip_atomic_load(pd, __ATOMIC_RELAXED, __HIP_MEMORY_SCOPE_AGENT) >= (unsigned)C.G) idx = 0xffffffffu; else idx = atomicAdd(q, 1u); }
        idx = (unsigned)__builtin_amdgcn_readfirstlane((int)idx);
        if (idx >= (unsigned)CVQ_TOTAL) break;
        moe_cv_item(C, (CVQ_FIRST + (int)idx) / 2, scr, C.lane);
    }
}
__device__ __forceinline__ void cv_steal_tail(const Ctx& C, int k) {
    unsigned* pd = (unsigned*)(C.ws + WS_CTL) + CW_PD + 64 * k;
    if (C.tid == 0) atomicAdd(pd, 1u);
    cv_steal(C, 1 << 20, pd);
}
#ifdef SEQ_PROBE
__device__ __forceinline__ void seq_probe(const Ctx& C) {
    unsigned char* out = WSP(unsigned char, WS_YB);
    constexpr int SEG = SEQ_PROBE, ROWS = 4096 / SEG, LPR = SEG / 4;
    for (int t = 0; t < 3; ++t) {
        const float* src = C.in[21 + t]; const int ldn = t < 2 ? 1024 : 2048; const size_t nrows = (size_t)2 * 32 * 2048 * 1024 / ldn;
        const size_t nblk_r = nrows / ROWS, nblk_c = ldn / SEG;
        for (size_t ch = (size_t)C.gw; ch < nblk_r * nblk_c; ch += (size_t)C.NGW) {
            const size_t rb = ch / nblk_c, cb = ch % nblk_c;
            f32x4 v[16];
#pragma unroll
            for (int i = 0; i < 16; ++i) { const int rr = (i * 64 + C.lane) / LPR, cc = (i * 64 + C.lane) % LPR; v[i] = *(const f32x4*)(src + (rb * ROWS + rr) * ldn + cb * SEG + 4 * cc); }
#pragma unroll
            for (int i = 0; i < 16; ++i) *(unsigned*)(out + ((ch * 4096 + i * 256 + 4 * C.lane) & (size_t)(64 * 1024 * 1024 - 1))) = pk4_fp8(v[i].x * 64.f, v[i].y * 64.f, v[i].z * 64.f, v[i].w * 64.f);
        }
    }
}
#endif
constexpr int CV_MOVED = 3072;
constexpr int CV_NEXP = 64 * 192, CV_KEEP = CV_NEXP - CV_MOVED;
constexpr int CW_CVQB = 10496;
__device__ __forceinline__ void cv_loop(const Ctx& C, unsigned* cvq, const int npos, const int woN, const int ibase) {
    const int lane = C.lane;
    {
        constexpr int NBE = (CVQ_FIRST / 1536) * 3 * 64, NBI = NBE + 128, CP = 272;
        LAS unsigned char* tiles = (LAS unsigned char*)(C.lds);
        const int w = C.wave, G4 = lane >> 4, i16 = lane & 15, q = i16 >> 1, p = i16 & 1;
        const float* const wg_in = C.in[21]; const float* const wu_in = C.in[22]; const float* const wd_in = C.in[23]; const float* const wo_in = C.in[15];
#define BI_FIELDS(bi_) const bool wo_ = (bi_) >= NBE; const int bx_ = wo_ ? (bi_) - NBE : (bi_); \
            const int le_ = wo_ ? bx_ >> 7 : bx_ / 192, rem_ = bx_ % 192, kind_ = wo_ ? 3 : rem_ >> 6, r_ = wo_ ? (bx_ & 127) : (rem_ & 63); \
            const float* W_ = wo_ ? wo_in + (size_t)le_ * 2048 * 2048 : (kind_ == 0 ? wg_in : (kind_ == 1 ? wu_in : wd_in)) + (size_t)le_ * 2048 * 1024; \
            unsigned char* WT_ = wo_ ? WSP(unsigned char, WS_WOUT) + (size_t)le_ * 2048 * 2048 : (kind_ < 2 ? WSP(unsigned char, WS_WGU) + (size_t)le_ * 2048 * 2048 : WSP(unsigned char, WS_WD) + (size_t)le_ * 2048 * 1024); \
            const int ldn_ = kind_ < 2 ? 1024 : 2048, K_ = (kind_ < 2 || wo_) ? 2048 : 1024, k0_ = kind_ < 2 ? 128 * (r_ >> 2) : 128 * (r_ >> 3), n0_ = kind_ < 2 ? 256 * (r_ & 3) : 256 * (r_ & 7); \
            (void)W_; (void)WT_; (void)ldn_; (void)K_; (void)k0_; (void)n0_
#define BI_LOAD(bi_, v_) do { BI_FIELDS(bi_); _Pragma("unroll") for (int i = 0; i < 16; ++i) v_[i] = *(const f32x4*)(W_ + (size_t)(k0_ + 16 * w + i) * ldn_ + n0_ + 4 * lane); } while (0)
        volatile LAS int* qs_ = (volatile LAS int*)(C.lds + GOFF_OFF);
#define CV_ITEM(p_) ((p_) >= npos ? NBI : ((p_) < woN ? NBE + (p_) : ibase + (p_) - woN))
        if (C.tid == 0) { qs_[0] = (int)atomicAdd(cvq, 1u); qs_[1] = (int)atomicAdd(cvq, 1u); }
        __syncthreads();
        int bi = CV_ITEM(qs_[0]), bnx = CV_ITEM(qs_[1]), buf = 0, qk = 0; f32x4 v0[16], v1[16];
        if (bi < NBI) BI_LOAD(bi, v0);
#define BI_STEP(vc_, vn_) do { \
            int qn_ = 0; if (C.tid == 0) qn_ = (int)atomicAdd(cvq, 1u);        \
            LAS unsigned char* tile = tiles + buf * (128 * CP); \
            _Pragma("unroll") for (int i = 0; i < 16; ++i) *(LAS unsigned*)(tile + (16 * w + i) * CP + 4 * lane) = pk4_fp8(vc_[i].x * 64.f, vc_[i].y * 64.f, vc_[i].z * 64.f, vc_[i].w * 64.f); \
            const int bn_ = bnx; if (bn_ < NBI) BI_LOAD(bn_, vn_); \
            if (C.tid == 0) qs_[2 + qk] = qn_; \
            __syncthreads(); \
            bnx = CV_ITEM(qs_[2 + qk]); qk ^= 1; \
            { BI_FIELDS(bi); \
            _Pragma("unroll") for (int r4 = 0; r4 < 4; ++r4) { const int nb16 = 2 * w + (r4 & 1), ck = 16 * (G4 + 4 * (r4 >> 1)); \
                const v2i_t lo_ = __builtin_amdgcn_ds_read_tr8_b64_v2i32((LAS v2i_t*)(tile + (ck + q) * CP + 16 * nb16 + 8 * p)); \
                const v2i_t hi_ = __builtin_amdgcn_ds_read_tr8_b64_v2i32((LAS v2i_t*)(tile + (ck + 8 + q) * CP + 16 * nb16 + 8 * p)); \
                v4u o_; o_.x = (unsigned)lo_.x; o_.y = (unsigned)lo_.y; o_.z = (unsigned)hi_.x; o_.w = (unsigned)hi_.y; \
                const int n_ = n0_ + 16 * nb16 + i16; const int drow_ = kind_ < 2 ? 256 * (n_ >> 7) + (n_ & 127) + 128 * kind_ : n_; \
                *(v4u*)(WT_ + (size_t)drow_ * K_ + k0_ + ck) = o_; } } \
            buf ^= 1; bi = bn_; } while (0)
        while (bi < NBI) {
            BI_STEP(v0, v1);
            if (bi >= NBI) break;
            BI_STEP(v1, v0);
        }
#undef BI_STEP
#undef CV_ITEM
#undef BI_LOAD
#undef BI_FIELDS
        __syncthreads();
    }
}
__device__ __forceinline__ void tr_finish_i8c(const TrItem& d, const f32x4 (&v)[16], LAS float* scr, int lane, const float (&qs)[4]) {
#pragma unroll
    for (int i = 0; i < 16; ++i) { LAS float* p = scr + (4 * i + (lane >> 4)) * TR_PITCH + 4 * (lane & 15); p[0] = v[i].x; p[1] = v[i].y; p[2] = v[i].z; p[3] = v[i].w; }
    LDS_WAIT(); asm volatile("" ::: "memory");
    const int c = lane & 3;
#pragma unroll
    for (int j = 0; j < 4; ++j) { const int n = (lane >> 2) + 16 * j; const LAS float* s = scr + (16 * c) * TR_PITCH + n; const float q = qs[j];
        v4u o;
        o.x = pk4_i8(s[0 * TR_PITCH] * q, s[1 * TR_PITCH] * q, s[2 * TR_PITCH] * q, s[3 * TR_PITCH] * q);
        o.y = pk4_i8(s[4 * TR_PITCH] * q, s[5 * TR_PITCH] * q, s[6 * TR_PITCH] * q, s[7 * TR_PITCH] * q);
        o.z = pk4_i8(s[8 * TR_PITCH] * q, s[9 * TR_PITCH] * q, s[10 * TR_PITCH] * q, s[11 * TR_PITCH] * q);
        o.w = pk4_i8(s[12 * TR_PITCH] * q, s[13 * TR_PITCH] * q, s[14 * TR_PITCH] * q, s[15 * TR_PITCH] * q);
        *(v4u*)((unsigned char*)d.WT + (size_t)(d.drow + n) * d.K + d.k0 + 16 * c) = o; }
    LDS_WAIT(); asm volatile("" ::: "memory");
}
constexpr int QG_FOX = 96 + 8 + 1, QG_GLA = 72 + 8 + 1, QG_MKV = 16, QG_WO1 = 32, QG_ALL = QG_FOX + QG_GLA + QG_MKV + QG_WO1;
__device__ __forceinline__ void quant_group(const Ctx& C, int g) {
    const float* const wf_in = C.in[5]; const float* const wl_in = C.in[9]; const float* const wm_in = C.in[3]; const float* const wo_in = C.in[15];
    const float* Wb; int ldn, c0, drow0; unsigned char* WT; float* SWC;
    if (g < QG_FOX) { Wb = wf_in; ldn = FOX_IN; WT = WSP(unsigned char, WS_WFOX); SWC = WSP(float, WS_SWC_FOX);
        if (g < 96) { c0 = 64 * g; drow0 = 64 * g; } else if (g < 104) { c0 = 6156 + 64 * (g - 96); drow0 = FP_QM + 64 * (g - 96); } else { c0 = 6144; drow0 = FP_F; } }
    else if (g < QG_FOX + QG_GLA) { const int q = g - QG_FOX; Wb = wl_in; ldn = GLA_IN; WT = WSP(unsigned char, WS_WGLA); SWC = WSP(float, WS_SWC_GLA);
        if (q < 72) { c0 = 64 * q; drow0 = 64 * q; } else if (q < 80) { c0 = 4624 + 64 * (q - 72); drow0 = GP_QM + 64 * (q - 72); } else { c0 = 4608; drow0 = GP_A; } }
    else if (g < QG_FOX + QG_GLA + QG_MKV) { const int q = g - QG_FOX - QG_GLA; Wb = wm_in; ldn = 1024; WT = WSP(unsigned char, WS_WMKV); SWC = WSP(float, WS_SWC_MKV); c0 = 64 * q; drow0 = 64 * q; }
    else { const int q = g - QG_FOX - QG_GLA - QG_MKV; Wb = wo_in + (size_t)D * D; ldn = D; WT = WSP(unsigned char, WS_WOUT) + (size_t)D * D; SWC = WSP(float, WS_SWC_WO1); c0 = 64 * q; drow0 = 64 * q; }
    const int lane = C.lane, w = C.wave;
    LAS float* scr = (LAS float*)(C.lds + w * TR_WAVE_BYTES);
    LAS float* cmax = (LAS float*)(C.lds + GOFF_OFF);
    TrItem e; e.W = Wb + c0; e.WT = (bf16*)WT; e.ldn = ldn; e.K = D; e.drow = drow0; e.n0 = 0; e.k0 = 0; e.qs = 0.f;
    f32x4 t[16]; float m0 = 0.f, m1 = 0.f, m2 = 0.f, m3 = 0.f;
#pragma unroll 1
    for (int j = 0; j < 4; ++j) { e.k0 = 64 * (4 * w + j); tr_load(e, lane, t);
#pragma unroll
        for (int i = 0; i < 16; ++i) { m0 = fmaxf(m0, fabsf(t[i].x)); m1 = fmaxf(m1, fabsf(t[i].y)); m2 = fmaxf(m2, fabsf(t[i].z)); m3 = fmaxf(m3, fabsf(t[i].w)); } }
    m0 = fmaxf(m0, __shfl_xor(m0, 16)); m1 = fmaxf(m1, __shfl_xor(m1, 16)); m2 = fmaxf(m2, __shfl_xor(m2, 16)); m3 = fmaxf(m3, __shfl_xor(m3, 16));
    m0 = fmaxf(m0, __shfl_xor(m0, 32)); m1 = fmaxf(m1, __shfl_xor(m1, 32)); m2 = fmaxf(m2, __shfl_xor(m2, 32)); m3 = fmaxf(m3, __shfl_xor(m3, 32));
    __syncthreads();
    if (lane < 16) *(LAS f32x4*)(cmax + w * 64 + 4 * lane) = (f32x4){m0, m1, m2, m3};
    __syncthreads();
    float qs[4];
#pragma unroll
    for (int j = 0; j < 4; ++j) { const int n = (lane >> 2) + 16 * j; float mx = cmax[n];
#pragma unroll
        for (int w8 = 1; w8 < 8; ++w8) mx = fmaxf(mx, cmax[w8 * 64 + n]);
        mx = fmaxf(mx, 1e-30f); qs[j] = 127.0f / mx;
        if (w == 0 && (lane & 3) == 0) SWC[drow0 + n] = mx * (1.0f / 127.0f); }
#pragma unroll 1
    for (int j = 0; j < 4; ++j) { e.k0 = 64 * (4 * w + j); tr_load(e, lane, t); tr_finish_i8c(e, t, scr, lane, qs); }
}
constexpr int CW_QGL = 10624;
__device__ __forceinline__ void qg_late(const Ctx& C, unsigned* ctr) {
    volatile LAS int* slot = (volatile LAS int*)(C.lds + GOFF_OFF + 4096);
    for (;;) {
        __syncthreads();
        if (C.tid == 0) *slot = (int)atomicAdd(ctr, 1u);
        __syncthreads();
        const int j = *slot;
        if (j >= QG_GLA + QG_WO1) break;
        quant_group(C, j < QG_GLA ? QG_FOX + j : QG_FOX + QG_MKV + j);
    }
}
__device__ __forceinline__ void p0_prologue(const Ctx& C) {
    for (int j = blockIdx.x; j < QG_FOX + QG_MKV; j += C.G) quant_group(C, j < QG_FOX ? j : QG_GLA + j);
    __syncthreads();
    LAS float* scr = (LAS float*)(C.lds + C.wave * TR_WAVE_BYTES);
    const int lane = C.lane;
    cv_loop(C, (unsigned*)(C.ws + WS_CTL) + CW_CVQ, 128 + CV_KEEP, 128, 0);
    for (int m = 2 * C.gw; m < T; m += 2 * C.NGW) {
        f32x4 v[8], w[8];
        load_row(C.in[0] + (size_t)m * D, lane, v); load_row(C.in[0] + (size_t)(m + 1) * D, lane, w);
        const float iv = row_inv_rms(v), iw = row_inv_rms(w);
        norm_store_row_i8(WSP(unsigned char, WS_HN) + (size_t)m * D, WSP(float, WS_SA) + m, v, iv, C.in[4], lane);
        norm_store_row_i8(WSP(unsigned char, WS_HN) + (size_t)(m + 1) * D, WSP(float, WS_SA) + m + 1, w, iw, C.in[4], lane);
    }
    for (int r = C.gw; r < NB * ML; r += C.NGW) { f32x4 v[8]; load_row(C.in[1] + (size_t)r * D, lane, v); const float inv = row_inv_rms(v);
        norm_store_row_i8(WSP(unsigned char, WS_MEMN) + (size_t)r * D, WSP(float, WS_SAM) + r, v, inv, C.in[2], lane); }
    for (int i = blockIdx.x * 512 + C.tid; i < 2 * 64 * D; i += C.G * 512) {
        const int k = i & (D - 1), rho = (i >> 11) & 63, layer = i >> 17;
        float v = 0.f;
        if (rho < 32) { const int hh = (rho >> 2) & 1, reg = 4 * (rho >> 3) + (rho & 3), e = (2 * hh + (reg >> 3)) * 8 + (reg & 7); v = C.in[19][((size_t)layer * D + k) * 32 + e]; }
        else if (rho < 40) v = C.in[17][((size_t)layer * D + k) * 4 + (rho & 3)];
        const unsigned hi = pk2(v, 0.f) & 0xffffu; const float lo = v - bflo(hi);
        bf16* wr = WSP(bf16, WS_WR) + (size_t)layer * 2 * 64 * D;
        wr[(size_t)rho * D + k] = (bf16)hi; wr[(size_t)(64 + rho) * D + k] = (bf16)(pk2(lo, 0.f) & 0xffffu);
    }
}

__device__ __forceinline__ void p1_quant(const Ctx& C) {
    LAS float* scr = (LAS float*)(C.lds + C.wave * TR_WAVE_BYTES);
    const int lane = C.lane;
    const unsigned* am = (const unsigned*)(C.ws + WS_CTL) + CW_AMAX;
    const float qf = 127.0f / fmaxf(__builtin_bit_cast(float, am[0]), 1e-30f), qg = 127.0f / fmaxf(__builtin_bit_cast(float, am[64]), 1e-30f), qm = 127.0f / fmaxf(__builtin_bit_cast(float, am[128]), 1e-30f),
                qo0 = 127.0f / fmaxf(__builtin_bit_cast(float, am[192]), 1e-30f), qo1 = 127.0f / fmaxf(__builtin_bit_cast(float, am[256]), 1e-30f);
    constexpr int I_FOX = 32 * (96 + 8 + 1), I_GLA = 32 * (72 + 8 + 1), I_WO = 32 * 32, I_MKV = 32 * 16;
    constexpr int OTHER = I_FOX + I_GLA + I_MKV + I_WO;
#define OTHER_DECODE(it_, d_) do { int r = (it_); \
        if (tr_group(r, C.in[5], FOX_IN, D, 0, 96, WSP(bf16, WS_WFOX), 0, d_)) { (d_).qs = qf; break; }              \
        if (tr_group(r, C.in[5], FOX_IN, D, 6156, 8, WSP(bf16, WS_WFOX), FP_QM, d_)) { (d_).qs = qf; break; }        \
        if (tr_group(r, C.in[5], FOX_IN, D, 6144, 1, WSP(bf16, WS_WFOX), FP_F, d_)) { (d_).qs = qf; break; }         \
        if (tr_group(r, C.in[9], GLA_IN, D, 0, 72, WSP(bf16, WS_WGLA), 0, d_)) { (d_).qs = qg; break; }              \
        if (tr_group(r, C.in[9], GLA_IN, D, 4624, 8, WSP(bf16, WS_WGLA), GP_QM, d_)) { (d_).qs = qg; break; }        \
        if (tr_group(r, C.in[9], GLA_IN, D, 4608, 1, WSP(bf16, WS_WGLA), GP_A, d_)) { (d_).qs = qg; break; }         \
        if (tr_group(r, C.in[3], 1024, D, 0, 16, WSP(bf16, WS_WMKV), 0, d_)) { (d_).qs = qm; break; } \
        tr_group(r, C.in[15] + (size_t)D * D, D, D, 0, 32, (bf16*)(WSP(unsigned char, WS_WOUT) + (size_t)D * D), 0, d_); (d_).qs = qo1; } while (0)
    {
        int it = C.gw; TrItem e0, e1; f32x4 t0[16], t1[16];
        if (it < OTHER) { OTHER_DECODE(it, e0); tr_load(e0, lane, t0); }
        while (it < OTHER) {
            const int it1 = it + C.NGW;
            if (it1 < OTHER) { OTHER_DECODE(it1, e1); tr_load(e1, lane, t1); }
            tr_finish_i8(e0, t0, scr, lane);
            if (it1 >= OTHER) break;
            const int it2 = it1 + C.NGW;
            if (it2 < OTHER) { OTHER_DECODE(it2, e0); tr_load(e0, lane, t0); }
            tr_finish_i8(e1, t1, scr, lane);
            it = it2;
        }
    }
#undef OTHER_DECODE
}
__device__ __forceinline__ float log_sigmoid(float x) { return fminf(x, 0.f) - log1pf(expf(-fabsf(x))); }
__device__ __forceinline__ float log_sigmoid_fast(float x) { return fminf(x, 0.f) - __logf(1.0f + __expf(-fabsf(x))); }

__device__ __forceinline__ void headnorm_inplace(bf16* rowp, int col0, int nh, const float* g, int lane) {
    const float g0 = g[2 * lane], g1 = g[2 * lane + 1];
    for (int h = 0; h < nh; ++h) {
        unsigned* p = (unsigned*)(rowp + col0 + h * HD) + lane; const unsigned u = *p; const float a = bflo(u), b = bfhi(u);
        const float ss = wave_sum(a * a + b * b); const float inv = 1.0f / sqrtf(ss * (1.0f / HD) + RMS_EPS);
        *p = pk2(a * inv * g0, b * inv * g1);
    }
}
__device__ __forceinline__ void p3_fox_thin(const Ctx& C) {
    bf16* P = WSP(bf16, WS_P);
    for (int it = C.gw; it < NB * ML * MH; it += C.NGW) {
        const int row = it >> 2, mh = it & 3;
        const unsigned u = *((const unsigned*)(WSP(bf16, WS_MKV) + (size_t)row * 1024 + mh * HD) + C.lane); const float a = bflo(u), b = bfhi(u);
        const float ss = wave_sum(a * a + b * b); const float inv = 1.0f / sqrtf(ss * (1.0f / HD) + RMS_EPS);
#pragma unroll
        for (int l = 0; l < 2; ++l) { const float* g = C.in[14] + l * HD;
            *((unsigned*)(WSP(bf16, WS_MK) + (size_t)l * 1024 * 512 + (size_t)row * 512 + mh * HD) + C.lane) = pk2(a * inv * g[2 * C.lane], b * inv * g[2 * C.lane + 1]); }
    }
    LAS float* sm = (LAS float*)(C.lds + RING_OFF);
    for (int bh = blockIdx.x; bh < NB * FH; bh += C.G) {
        const int b = bh / FH, h = bh % FH; const float bf = C.in[6][h];
        const float* fl = WSP(float, WS_FL) + (size_t)(b * S) * 16 + h;
        float ls[8], tot = 0.f;
#pragma unroll
        for (int i = 0; i < 8; ++i) { ls[i] = log_sigmoid(fl[(size_t)(8 * C.tid + i) * 16] + bf); tot += ls[i]; ls[i] = tot; }
        float inc = tot;
#pragma unroll
        for (int o = 1; o < 64; o <<= 1) { const float t = __shfl_up(inc, o); if (C.lane >= o) inc += t; }
        __syncthreads();
        if (C.lane == 63) sm[C.wave] = inc;
        __syncthreads();
        float woff = 0.f;
        for (int w = 0; w < C.wave; ++w) woff += sm[w];
        const float excl = woff + inc - tot;
        float* cp = WSP(float, WS_C) + (size_t)bh * S + 8 * C.tid;
#pragma unroll
        for (int i = 0; i < 8; ++i) cp[i] = excl + ls[i];
    }
}

__device__ __forceinline__ void naive_attn_row(const bf16* qptr, const bf16* Kb, int kstride, const bf16* Vb, int vstride, int nk, const float* cptr, float ct,
                                               LAS float* qs, int lane, float& o0, float& o1) {
    { const unsigned qq = *((const unsigned*)qptr + lane); qs[2 * lane] = bflo(qq); qs[2 * lane + 1] = bfhi(qq); }
    LDS_WAIT(); asm volatile("" ::: "memory");
    float m = -1e30f, l = 0.f, a0 = 0.f, a1 = 0.f;
    for (int j0 = 0; j0 < nk; j0 += 64) {
        const int j = j0 + lane; const bool valid = j < nk; const int jc = valid ? j : nk - 1;
        const bf16* kr = Kb + (size_t)jc * kstride;
        float s = 0.f;
#pragma unroll 4
        for (int d8 = 0; d8 < 16; ++d8) {
            const v4u kk = *(const v4u*)(kr + 8 * d8);
            const f32x4 qa = *(const LAS f32x4*)(qs + 8 * d8), qb = *(const LAS f32x4*)(qs + 8 * d8 + 4);
            s += bflo(kk.x) * qa.x + bfhi(kk.x) * qa.y + bflo(kk.y) * qa.z + bfhi(kk.y) * qa.w + bflo(kk.z) * qb.x + bfhi(kk.z) * qb.y + bflo(kk.w) * qb.z + bfhi(kk.w) * qb.w;
        }
        s *= 0.08838834764831845f;
        if (cptr) s += ct - cptr[jc];
        if (!valid) s = -__builtin_inff();
        const float mn = fmaxf(m, wave_max(s)); const float alpha = expf(m - mn); const float p = valid ? expf(s - mn) : 0.f;
        l = l * alpha + wave_sum(p); a0 *= alpha; a1 *= alpha; m = mn;
        const int cnt = (nk - j0) < 64 ? (nk - j0) : 64;
        for (int jj = 0; jj < cnt; ++jj) { const float pj = __shfl(p, jj); const unsigned vv = *((const unsigned*)(Vb + (size_t)(j0 + jj) * vstride) + lane); a0 += pj * bflo(vv); a1 += pj * bfhi(vv); }
    }
    o0 = a0 / l; o1 = a1 / l;
    asm volatile("" ::: "memory");
}
__device__ __forceinline__ void naive_mem_attn(const Ctx& C, const bf16* P, int ldp, int qcol, int layer, int row, int mh, LAS float* qs) {
    const int b = row / S; float o0, o1;
    naive_attn_row(P + (size_t)row * ldp + qcol + mh * HD, WSP(bf16, WS_MK) + (size_t)layer * 1024 * 512 + (size_t)(b * ML) * 512 + mh * HD, 512,
                   WSP(bf16, WS_MKV) + (size_t)(b * ML) * 1024 + 512 + mh * HD, 1024, ML, nullptr, 0.f, qs, C.lane, o0, o1);
    *((unsigned*)(WSP(bf16, WS_CAT) + (size_t)row * D + FW + mh * HD) + C.lane) = pk2(o0, o1);
}
__device__ __forceinline__ void p4_fox_attn_naive(const Ctx& C) {
    LAS float* qs = (LAS float*)(C.lds + RING_OFF + C.wave * 16384);
    const bf16* P = WSP(bf16, WS_P);
    for (int it = C.gw; it < T * 16; it += C.NGW) {
        const int hh = it / T, row = it % T;
        if (hh < FH) {
            const int b = row / S, t = row % S; float o0, o1;
            const float* cp = WSP(float, WS_C) + (size_t)(b * FH + hh) * S;
            naive_attn_row(P + (size_t)row * FOX_NP + FP_Q + hh * HD, P + (size_t)(b * S) * FOX_NP + FP_K + hh * HD, FOX_NP, P + (size_t)(b * S) * FOX_NP + FP_V + hh * HD, FOX_NP,
                           t + 1, cp, cp[t], qs, C.lane, o0, o1);
            const unsigned og = *((const unsigned*)(P + (size_t)row * FOX_NP + FP_OG + hh * HD) + C.lane);
            const float g0 = 1.0f / (1.0f + expf(-bflo(og))), g1 = 1.0f / (1.0f + expf(-bfhi(og)));
            *((unsigned*)(WSP(bf16, WS_CAT) + (size_t)row * D + hh * HD) + C.lane) = pk2(o0 * g0, o1 * g1);
        } else naive_mem_attn(C, P, FOX_NP, FP_QM, 0, row, hh - FH, qs);
    }
}

__device__ __forceinline__ void p12_gla_thin(const Ctx& C) {
    bf16* P = WSP(bf16, WS_P);
    const float* w2 = C.in[10]; const float* ba = C.in[11];
    for (int m = C.gw; m < T; m += C.NGW) {
        headnorm_inplace(P + (size_t)m * GLA_NP, GP_QM, MH, C.in[13] + HD, C.lane);
        const float* fl = WSP(float, WS_FL) + (size_t)m * 16;
        float al[16];
#pragma unroll
        for (int r = 0; r < 16; ++r) al[r] = fl[r];
        float* la = WSP(float, WS_LA) + (size_t)m * GKW;
#pragma unroll 1
        for (int j = 0; j < 12; ++j) { const int c = C.lane + 64 * j; float s = ba[c];
#pragma unroll
            for (int r = 0; r < 16; ++r) s += al[r] * w2[r * GKW + c];
            la[c] = expf(log_sigmoid(s) * (1.0f / 16.0f)); }
    }
}
__device__ __forceinline__ void p13_gla_naive(const Ctx& C) {
    const bf16* P = WSP(bf16, WS_P); const float* LA = WSP(float, WS_LA); float* GO = WSP(float, WS_GO);
    const int lane = C.lane;
    for (int it = C.gw; it < NB * GH * 128; it += C.NGW) {
        const int bh = it >> 7, e0 = (it & 127) * 3, b = bh >> 2, h = bh & 3;
        float st[3][3];
#pragma unroll
        for (int i = 0; i < 3; ++i)
#pragma unroll
            for (int e = 0; e < 3; ++e) st[i][e] = 0.f;
        const float qsc = 0.07216878364870322f;
        for (int t0 = 0; t0 < S; t0 += 4) {
            float a[4][3], k[4][3], q[4][3], v[4][3];
#pragma unroll
            for (int u = 0; u < 4; ++u) { const size_t row = (size_t)(b * S + t0 + u);
#pragma unroll
                for (int i = 0; i < 3; ++i) { const int d = lane + 64 * i;
                    a[u][i] = LA[row * GKW + h * GDK + d]; k[u][i] = bf2f(P[row * GLA_NP + GP_K + h * GDK + d]); q[u][i] = bf2f(P[row * GLA_NP + GP_Q + h * GDK + d]) * qsc; }
#pragma unroll
                for (int e = 0; e < 3; ++e) v[u][e] = bf2f(P[row * GLA_NP + GP_V + h * GDV + e0 + e]); }
#pragma unroll
            for (int u = 0; u < 4; ++u) { float o[3] = {0.f, 0.f, 0.f};
#pragma unroll
                for (int i = 0; i < 3; ++i)
#pragma unroll
                    for (int e = 0; e < 3; ++e) { st[i][e] = a[u][i] * st[i][e] + k[u][i] * v[u][e]; o[e] += q[u][i] * st[i][e]; }
#pragma unroll
                for (int e = 0; e < 3; ++e) o[e] = wave_sum(o[e]);
                if (lane < 3) GO[(size_t)(b * S + t0 + u) * GVW + h * GDV + e0 + lane] = lane == 0 ? o[0] : (lane == 1 ? o[1] : o[2]); }
        }
    }
}
constexpr size_t WS_CAT8 = WS_H, WS_SC = WS_H + 40 * MiB;
__device__ __forceinline__ void p14_gla_onorm(const Ctx& C) {
    const bf16* __restrict__ P = WSP(bf16, WS_P); const float* __restrict__ GO = WSP(float, WS_GO); const float* __restrict__ og = C.in[12]; const bf16* __restrict__ CAT = WSP(bf16, WS_CAT);
    unsigned char* __restrict__ C8 = WSP(unsigned char, WS_CAT8); float* __restrict__ SC = WSP(float, WS_SC);
    const int lane = C.lane;
    float g0[3], g1[3];
#pragma unroll
    for (int i = 0; i < 3; ++i) { g0[i] = og[128 * i + 2 * lane]; g1[i] = og[128 * i + 2 * lane + 1]; }
    for (int m0 = 2 * C.gw; m0 < T; m0 += 2 * C.NGW) {
        f32x2 x[2][4][3]; unsigned ru[2][4][3]; float ss[2][4]; v4u mo[2];
#pragma unroll
        for (int q = 0; q < 2; ++q) { mo[q] = *((const v4u*)(CAT + (size_t)(m0 + q) * D + FW) + lane);
#pragma unroll
            for (int h = 0; h < GH; ++h) { ss[q][h] = 0.f;
#pragma unroll
                for (int i = 0; i < 3; ++i) { const unsigned gu = *((const unsigned*)((const bf16*)GO + (size_t)(m0 + q) * GVW + h * GDV + 128 * i) + lane); x[q][h][i] = (f32x2){bflo(gu), bfhi(gu)};
                    ru[q][h][i] = *((const unsigned*)(P + (size_t)(m0 + q) * GLA_NP + GP_R + h * GDV + 128 * i) + lane); } } }
#pragma unroll
        for (int q = 0; q < 2; ++q)
#pragma unroll
            for (int h = 0; h < GH; ++h)
#pragma unroll
                for (int i = 0; i < 3; ++i) ss[q][h] += x[q][h][i].x * x[q][h][i].x + x[q][h][i].y * x[q][h][i].y;
#pragma unroll
        for (int o = 1; o < 64; o <<= 1)
#pragma unroll
            for (int q = 0; q < 2; ++q)
#pragma unroll
                for (int h = 0; h < GH; ++h) ss[q][h] += __shfl_xor(ss[q][h], o);
        float am[2];
#pragma unroll
        for (int q = 0; q < 2; ++q) {
            am[q] = fmaxf(fmaxf(fmaxf(fabsf(bflo(mo[q].x)), fabsf(bfhi(mo[q].x))), fmaxf(fabsf(bflo(mo[q].y)), fabsf(bfhi(mo[q].y)))), fmaxf(fmaxf(fabsf(bflo(mo[q].z)), fabsf(bfhi(mo[q].z))), fmaxf(fabsf(bflo(mo[q].w)), fabsf(bfhi(mo[q].w)))));
#pragma unroll
            for (int h = 0; h < GH; ++h) { const float inv = 1.0f / sqrtf(ss[q][h] * (1.0f / GDV) + RMS_EPS);
#pragma unroll
                for (int i = 0; i < 3; ++i) { const float r0 = bflo(ru[q][h][i]), r1 = bfhi(ru[q][h][i]);
                    x[q][h][i].x = x[q][h][i].x * inv * g0[i] * (r0 * __builtin_amdgcn_rcpf(1.0f + __expf(-r0))); x[q][h][i].y = x[q][h][i].y * inv * g1[i] * (r1 * __builtin_amdgcn_rcpf(1.0f + __expf(-r1)));
                    am[q] = fmaxf(am[q], fmaxf(fabsf(x[q][h][i].x), fabsf(x[q][h][i].y))); } } }
#pragma unroll
        for (int o = 1; o < 64; o <<= 1) { am[0] = fmaxf(am[0], __shfl_xor(am[0], o)); am[1] = fmaxf(am[1], __shfl_xor(am[1], o)); }
#pragma unroll
        for (int q = 0; q < 2; ++q) { const float a = fmaxf(am[q], 1e-30f), qs = 127.0f / a; unsigned char* row8 = C8 + (size_t)(m0 + q) * D;
#pragma unroll
            for (int h = 0; h < GH; ++h)
#pragma unroll
                for (int i = 0; i < 3; ++i) ((unsigned short*)(row8 + h * GDV + 128 * i))[lane] = (unsigned short)(pk4_i8(x[q][h][i].x * qs, x[q][h][i].y * qs, 0.f, 0.f) & 0xffffu);
            v2u o8; o8.x = pk4_i8(bflo(mo[q].x) * qs, bfhi(mo[q].x) * qs, bflo(mo[q].y) * qs, bfhi(mo[q].y) * qs); o8.y = pk4_i8(bflo(mo[q].z) * qs, bfhi(mo[q].z) * qs, bflo(mo[q].w) * qs, bfhi(mo[q].w) * qs);
            ((v2u*)(row8 + FW))[lane] = o8;
            if (lane == 0) SC[m0 + q] = a * (1.0f / 127.0f); }
    }
}

__device__ __forceinline__ void p_requant_cat(const Ctx& C) {
    const bf16* __restrict__ CAT = WSP(bf16, WS_CAT); unsigned char* __restrict__ C8 = WSP(unsigned char, WS_CAT8); float* __restrict__ SC = WSP(float, WS_SC);
    const int lane = C.lane;
    for (int m0 = 2 * C.gw; m0 < T; m0 += 2 * C.NGW) {
        v2u x[2][8]; float am[2];
#pragma unroll
        for (int q = 0; q < 2; ++q)
#pragma unroll
            for (int j = 0; j < 8; ++j) x[q][j] = ((const v2u*)(CAT + (size_t)(m0 + q) * D))[lane + 64 * j];
#pragma unroll
        for (int q = 0; q < 2; ++q) { am[q] = 0.f;
#pragma unroll
            for (int j = 0; j < 8; ++j) am[q] = fmaxf(fmaxf(am[q], fmaxf(fabsf(bflo(x[q][j].x)), fabsf(bfhi(x[q][j].x)))), fmaxf(fabsf(bflo(x[q][j].y)), fabsf(bfhi(x[q][j].y)))); }
#pragma unroll
        for (int o = 1; o < 64; o <<= 1) { am[0] = fmaxf(am[0], __shfl_xor(am[0], o)); am[1] = fmaxf(am[1], __shfl_xor(am[1], o)); }
#pragma unroll
        for (int q = 0; q < 2; ++q) { const float a = fmaxf(am[q], 1e-30f), qs = 127.0f / a;
#pragma unroll
            for (int j = 0; j < 8; ++j) ((unsigned*)(C8 + (size_t)(m0 + q) * D))[lane + 64 * j] = pk4_i8(bflo(x[q][j].x) * qs, bfhi(x[q][j].x) * qs, bflo(x[q][j].y) * qs, bfhi(x[q][j].y) * qs);
            if (lane == 0) SC[m0 + q] = a * (1.0f / 127.0f); }
    }
}

__device__ __forceinline__ void p6_router(const Ctx& C, int layer, bool commit = true) {
    const float* X = WSP(float, WS_XB); const float* g = C.in[16] + layer * D;
    const float* wg = C.in[17] + (size_t)layer * D * 4; const float* we = C.in[19] + (size_t)layer * D * 32;
    const float* bg = C.in[18] + layer * 4; const float* be = C.in[20] + layer * 32;
    unsigned* cnt = (unsigned*)(C.ws + WS_CTL) + CW_CNT + layer * 32;
    int* toke = (int*)(C.ws + WS_ROUTE + RT_TOKE); int* toks = (int*)(C.ws + WS_ROUTE + RT_TOKS); float* tokw = (float*)(C.ws + WS_ROUTE + RT_TOKW);
    const int lane = C.lane;
    LAS float* hs = (LAS float*)(C.lds + RING_OFF + C.wave * 16384);
    for (int pr = C.gw; pr < T / 2; pr += C.NGW) {
        {
            f32x4 x0[8], x1[8];
            load_row(X + (size_t)(2 * pr) * D, lane, x0); load_row(X + (size_t)(2 * pr + 1) * D, lane, x1);
            const float i0 = row_inv_rms(x0), i1 = row_inv_rms(x1);
            norm_store_row(WSP(bf16, WS_HN) + (size_t)(2 * pr) * D, x0, i0, g, lane);
            norm_store_row(WSP(bf16, WS_HN) + (size_t)(2 * pr + 1) * D, x1, i1, g, lane);
#pragma unroll
            for (int j = 0; j < 8; ++j) { ((LAS f32x4*)hs)[lane + 64 * j] = x0[j]; ((LAS f32x4*)(hs + D))[lane + 64 * j] = x1[j]; }
        }
        LDS_WAIT(); asm volatile("" ::: "memory");
        float a0[36], a1[36];
#pragma unroll
        for (int n = 0; n < 36; ++n) { a0[n] = 0.f; a1[n] = 0.f; }
#pragma unroll 2
        for (int kk = 0; kk < 32; ++kk) {
            const int k = lane + 64 * kk; const float h0 = hs[k], h1 = hs[D + k];
            const f32x4 w4 = *(const f32x4*)(wg + (size_t)k * 4);
#pragma unroll
            for (int n = 0; n < 4; ++n) { a0[n] += h0 * w4[n]; a1[n] += h1 * w4[n]; }
#pragma unroll
            for (int q = 0; q < 8; ++q) { const f32x4 w = *(const f32x4*)(we + (size_t)k * 32 + 4 * q);
#pragma unroll
                for (int n = 0; n < 4; ++n) { a0[4 + 4 * q + n] += h0 * w[n]; a1[4 + 4 * q + n] += h1 * w[n]; } }
        }
        asm volatile("" ::: "memory");
#pragma unroll
        for (int n = 0; n < 36; ++n) { a0[n] = wave_sum(a0[n]); a1[n] = wave_sum(a1[n]); }
#pragma unroll
        for (int rr = 0; rr < 2; ++rr) {
            float lg[36];
#pragma unroll
            for (int n = 0; n < 36; ++n) lg[n] = rr == 0 ? a0[n] : a1[n];
            float gl[4]; int gi = 0; float gm;
#pragma unroll
            for (int n = 0; n < 4; ++n) gl[n] = lg[n] + bg[n];
            gm = gl[0];
#pragma unroll
            for (int n = 1; n < 4; ++n) if (gl[n] > gm) { gm = gl[n]; gi = n; }
            float gs = 0.f;
#pragma unroll
            for (int n = 0; n < 4; ++n) gs += expf(gl[n] - gm);
            const float gp = 1.0f / gs;
            float ev[8];
#pragma unroll
            for (int j = 0; j < 8; ++j) { const float v0 = lg[4 + j] + be[j], v1 = lg[12 + j] + be[8 + j], v2 = lg[20 + j] + be[16 + j], v3 = lg[28 + j] + be[24 + j];
                ev[j] = gi == 0 ? v0 : (gi == 1 ? v1 : (gi == 2 ? v2 : v3)); }
            int e1 = 0; float m1 = ev[0];
#pragma unroll
            for (int j = 1; j < 8; ++j) if (ev[j] > m1) { m1 = ev[j]; e1 = j; }
            int e2 = -1; float m2 = -__builtin_inff();
#pragma unroll
            for (int j = 0; j < 8; ++j) if (j != e1 && ev[j] > m2) { m2 = ev[j]; e2 = j; }
            const float z = expf(m2 - m1); const float w1 = gp / (1.0f + z), w2 = gp * z / (1.0f + z);
            if (lane == 0) {
                const int tok = 2 * pr + rr; const int id1 = gi * 8 + e1, id2 = gi * 8 + e2;
                if (commit) { const unsigned s1 = atomicAdd(cnt + id1, 1u), s2 = atomicAdd(cnt + id2, 1u); toks[2 * tok] = (int)s1; toks[2 * tok + 1] = (int)s2; }
                toke[2 * tok] = id1; tokw[2 * tok] = w1;
                toke[2 * tok + 1] = id2; tokw[2 * tok + 1] = w2;
            }
        }
    }
}
__device__ __forceinline__ void p6_router_mfma(const Ctx& C, int layer, bool commit = true) {
    const bf16* X = WSP(bf16, WS_XB); const float* g = C.in[16] + layer * D;
    const bf16* WR = WSP(bf16, WS_WR) + (size_t)layer * 2 * 64 * D;
    const float* bg = C.in[18] + layer * 4; const float* be = C.in[20] + layer * 32;
    unsigned* cnt = (unsigned*)(C.ws + WS_CTL) + CW_CNT + layer * 32;
    int* lsta = WSP(int, WS_LSTA); float* lstw = WSP(float, WS_LSTW); unsigned char* __restrict__ XN8 = WSP(unsigned char, WS_XN8);
    const int lane = C.lane, r = lane & 31, h = lane >> 5;
    LAS float* red = (LAS float*)(C.lds + RING_OFF);
    LAS float* invs = red + 4 * 2 * 21 * 64;
    for (int tb = blockIdx.x; tb < T / 64; tb += C.G) {
        const int tg = C.wave & 1, kq = C.wave >> 1;
        const int row = 64 * tb + 32 * tg + r;
        const bf16* xp = X + (size_t)row * D + 8 * h; const float* gp = g + 8 * h;
        const bf16* w0 = WR + (size_t)r * D + 8 * h;
        f32x16 acc0, acc1;
#pragma unroll
        for (int i = 0; i < 16; ++i) { acc0[i] = 0.f; acc1[i] = 0.f; }
        float ss = 0.f;
#pragma unroll 4
        for (int s = 32 * kq; s < 32 * kq + 32; ++s) {
            const v4u xr = *(const v4u*)(xp + 16 * s);
            const f32x4 xa = (f32x4){bflo(xr.x), bfhi(xr.x), bflo(xr.y), bfhi(xr.y)}, xb = (f32x4){bflo(xr.z), bfhi(xr.z), bflo(xr.w), bfhi(xr.w)};
            const f32x4 ga = *(const f32x4*)(gp + 16 * s), gb = *(const f32x4*)(gp + 16 * s + 4);
            ss += (xa.x * xa.x + xa.y * xa.y) + (xa.z * xa.z + xa.w * xa.w) + (xb.x * xb.x + xb.y * xb.y) + (xb.z * xb.z + xb.w * xb.w);
            const f32x4 va = xa * ga, vb = xb * gb;
            v4u hi; hi.x = pk2(va.x, va.y); hi.y = pk2(va.z, va.w); hi.z = pk2(vb.x, vb.y); hi.w = pk2(vb.z, vb.w);
            v4u lo; lo.x = pk2(va.x - bflo(hi.x), va.y - bfhi(hi.x)); lo.y = pk2(va.z - bflo(hi.y), va.w - bfhi(hi.y));
            lo.z = pk2(vb.x - bflo(hi.z), vb.y - bfhi(hi.z)); lo.w = pk2(vb.z - bflo(hi.w), vb.w - bfhi(hi.w));
            const bf16x8 xh = __builtin_bit_cast(bf16x8, hi), xl = __builtin_bit_cast(bf16x8, lo);
            const bf16x8 a0h = *(const bf16x8*)(w0 + 16 * s), a1h = *(const bf16x8*)(w0 + (size_t)32 * D + 16 * s);
            const bf16x8 a0l = *(const bf16x8*)(w0 + (size_t)64 * D + 16 * s), a1l = *(const bf16x8*)(w0 + (size_t)96 * D + 16 * s);
            acc0 = __builtin_amdgcn_mfma_f32_32x32x16_bf16(a0h, xh, acc0, 0, 0, 0); acc1 = __builtin_amdgcn_mfma_f32_32x32x16_bf16(a1h, xh, acc1, 0, 0, 0);
            acc0 = __builtin_amdgcn_mfma_f32_32x32x16_bf16(a0l, xh, acc0, 0, 0, 0); acc1 = __builtin_amdgcn_mfma_f32_32x32x16_bf16(a1l, xh, acc1, 0, 0, 0);
            acc0 = __builtin_amdgcn_mfma_f32_32x32x16_bf16(a0h, xl, acc0, 0, 0, 0); acc1 = __builtin_amdgcn_mfma_f32_32x32x16_bf16(a1h, xl, acc1, 0, 0, 0);
        }
        __syncthreads();
        { LAS float* rp = red + ((kq * 2 + tg) * 21) * 64 + lane;
#pragma unroll
          for (int i = 0; i < 16; ++i) rp[i * 64] = acc0[i];
#pragma unroll
          for (int i = 0; i < 4; ++i) rp[(16 + i) * 64] = acc1[i];
          rp[20 * 64] = ss; }
        __syncthreads();
        if (kq == 0) {
#pragma unroll
        for (int q = 1; q < 4; ++q) { const LAS float* rp = red + ((q * 2 + tg) * 21) * 64 + lane;
#pragma unroll
            for (int i = 0; i < 16; ++i) acc0[i] += rp[i * 64];
#pragma unroll
            for (int i = 0; i < 4; ++i) acc1[i] += rp[(16 + i) * 64];
            ss += rp[20 * 64]; }
        ss += __shfl_xor(ss, 32);
        const float inv = 1.0f / sqrtf(ss * (1.0f / D) + RMS_EPS);
        if (h == 0) invs[32 * tg + r] = inv;
        float gl[4]; int gi = 0;
#pragma unroll
        for (int n = 0; n < 4; ++n) gl[n] = acc1[n] * inv + bg[n];
        float gm = gl[0];
#pragma unroll
        for (int n = 1; n < 4; ++n) if (gl[n] > gm) { gm = gl[n]; gi = n; }
        float gs = 0.f;
#pragma unroll
        for (int n = 0; n < 4; ++n) gs += expf(gl[n] - gm);
        const float gpr = 1.0f / gs;
        float ev[8];
#pragma unroll
        for (int j = 0; j < 8; ++j) ev[j] = ((gi & 1) ? acc0[8 + j] : acc0[j]) * inv + be[gi * 8 + j];
        int e1 = 0; float m1 = ev[0];
#pragma unroll
        for (int j = 1; j < 8; ++j) if (ev[j] > m1) { m1 = ev[j]; e1 = j; }
        int e2 = -1; float m2 = -__builtin_inff();
#pragma unroll
        for (int j = 0; j < 8; ++j) if (j != e1 && ev[j] > m2) { m2 = ev[j]; e2 = j; }
        const float z = expf(m2 - m1); const float w1 = gpr / (1.0f + z), w2 = gpr * z / (1.0f + z);
        if (h == (gi >> 1) && commit) {
            const int tok = row; const int id1 = gi * 8 + e1, id2 = gi * 8 + e2;
            const unsigned s1 = atomicAdd(cnt + id1, 1u), s2 = atomicAdd(cnt + id2, 1u);
            lsta[id1 * T + (int)s1] = 2 * tok; lstw[id1 * T + (int)s1] = w1;
            lsta[id2 * T + (int)s2] = 2 * tok + 1; lstw[id2 * T + (int)s2] = w2;
        }
        }
        __syncthreads();
        { const bf16* __restrict__ Xr = X; const float* __restrict__ g4 = g;
          f32x4 gg[8];
#pragma unroll
          for (int j = 0; j < 8; ++j) gg[j] = ((const f32x4*)g4)[lane + 64 * j] * 8.0f;
          const int t0 = 64 * tb + 8 * C.wave;
#pragma unroll 1
          for (int i = 0; i < 8; i += 4) {
              v2u x[4][8]; float iv[4];
#pragma unroll
              for (int q = 0; q < 4; ++q) {
#pragma unroll
                  for (int j = 0; j < 8; ++j) x[q][j] = ((const v2u*)(Xr + (size_t)(t0 + i + q) * D))[lane + 64 * j];
                  iv[q] = invs[8 * C.wave + i + q]; }
#pragma unroll
              for (int q = 0; q < 4; ++q)
#pragma unroll
                  for (int j = 0; j < 8; ++j)
                      ((unsigned*)(XN8 + (size_t)(t0 + i + q) * D))[lane + 64 * j] = pk4_fp8(bflo(x[q][j].x) * iv[q] * gg[j].x, bfhi(x[q][j].x) * iv[q] * gg[j].y, bflo(x[q][j].y) * iv[q] * gg[j].z, bfhi(x[q][j].y) * iv[q] * gg[j].w);
          } }
    }
    if (CV_STEAL && commit) {
        if (layer == 0) { if (C.wave * C.G + (int)blockIdx.x >= T / 32) cv_steal(C, 4, nullptr); }
        else cv_steal(C, 1 << 20, nullptr);
    }
}
__device__ __forceinline__ void p7_dispatch(const Ctx& C, int layer) {
    const unsigned* cnt = (const unsigned*)(C.ws + WS_CTL) + CW_CNT + layer * 32;
    const int* toke = (const int*)(C.ws + WS_ROUTE + RT_TOKE); const int* toks = (const int*)(C.ws + WS_ROUTE + RT_TOKS); const float* tokw = (const float*)(C.ws + WS_ROUTE + RT_TOKW);
    int* rowdest = (int*)(C.ws + WS_ROUTE + RT_ROWDEST) + layer * MAXROWS; float* roww = (float*)(C.ws + WS_ROUTE + RT_ROWW);
    int* tilee = (int*)(C.ws + WS_ROUTE + RT_TILEE) + layer * 256;
    const int lane = C.lane;
    const int c = lane < NE ? (int)__hip_atomic_load(cnt + lane, __ATOMIC_RELAXED, __HIP_MEMORY_SCOPE_AGENT) : 0;
    const int padded = (c + 255) & ~255;
    int inc = padded;
#pragma unroll
    for (int o = 1; o < 64; o <<= 1) { const int t = __shfl_up(inc, o); if (lane >= o) inc += t; }
    const int pstart = inc - padded;
    if (blockIdx.x == 0 && C.wave == 0) {
        if (lane < NE) for (int tl = pstart >> 8; tl < (pstart + padded) >> 8; ++tl) tilee[tl] = lane;
        if (lane == 63) tilee[255] = inc >> 8;
    }
    const bf16* __restrict__ X = WSP(bf16, WS_XB); const float* __restrict__ INV = WSP(float, WS_INV); const float* __restrict__ g = C.in[16] + layer * D; unsigned char* __restrict__ XG = WSP(unsigned char, WS_XG);
    f32x4 gg[8];
#pragma unroll
    for (int j = 0; j < 8; ++j) gg[j] = ((const f32x4*)g)[lane + 64 * j] * 8.0f;
    for (int tb = C.gw * 8; tb < T; tb += C.NGW * 8) {
        int e = 0, slot = 0; float w = 0.f; const int a = 2 * tb + lane;
        if (lane < 16) { e = toke[a]; slot = toks[a]; w = tokw[a]; }
        const int dest_l = __shfl(pstart, e) + slot;
        if (lane < 16) { rowdest[dest_l] = a; roww[dest_l] = w; }
#pragma unroll 1
        for (int i = 0; i < 8; i += 4) {
            v2u x[4][8]; float iv[4]; int dd[4][2];
#pragma unroll
            for (int q = 0; q < 4; ++q) {
#pragma unroll
                for (int j = 0; j < 8; ++j) x[q][j] = ((const v2u*)(X + (size_t)(tb + i + q) * D))[lane + 64 * j];
                iv[q] = INV[tb + i + q]; dd[q][0] = __shfl(dest_l, 2 * (i + q)); dd[q][1] = __shfl(dest_l, 2 * (i + q) + 1); }
#pragma unroll
            for (int q = 0; q < 4; ++q)
#pragma unroll
                for (int j = 0; j < 8; ++j) {
                    const unsigned o = pk4_fp8(bflo(x[q][j].x) * iv[q] * gg[j].x, bfhi(x[q][j].x) * iv[q] * gg[j].y, bflo(x[q][j].y) * iv[q] * gg[j].z, bfhi(x[q][j].y) * iv[q] * gg[j].w);
                    ((unsigned*)(XG + (size_t)dd[q][0] * D))[lane + 64 * j] = o; ((unsigned*)(XG + (size_t)dd[q][1] * D))[lane + 64 * j] = o;
                }
        }
    }
}
__device__ __forceinline__ void p_combine(const Ctx& C, bf16* __restrict__ xo, float* __restrict__ fo, const float* __restrict__ g, float pscale_in = 1.0f) {
    const unsigned char* __restrict__ YB8 = WSP(unsigned char, WS_YB); const bf16* __restrict__ xi = WSP(bf16, WS_XB); unsigned char* __restrict__ HN = WSP(unsigned char, WS_HN); float* __restrict__ SA = WSP(float, WS_SA);
    const int lane = C.lane;
    const float pscale = pscale_in;
    for (int m0 = 2 * C.gw; m0 < T; m0 += 2 * C.NGW) {
        v2u xr[2][8]; unsigned ya[2][8], yb[2][8];
#pragma unroll
        for (int q = 0; q < 2; ++q)
#pragma unroll
            for (int j = 0; j < 8; ++j) { const size_t m = (size_t)(m0 + q);
                xr[q][j] = ((const v2u*)(xi + m * D))[lane + 64 * j]; ya[q][j] = ((const unsigned*)(YB8 + 2 * m * D))[lane + 64 * j]; yb[q][j] = ((const unsigned*)(YB8 + (2 * m + 1) * D))[lane + 64 * j]; }
#pragma unroll
        for (int q = 0; q < 2; ++q) { const size_t m = (size_t)(m0 + q);
            f32x4 v[8];
#pragma unroll
            for (int j = 0; j < 8; ++j) {
                const f32x2 a0 = __builtin_amdgcn_cvt_pk_f32_fp8((int)ya[q][j], false), a1 = __builtin_amdgcn_cvt_pk_f32_fp8((int)ya[q][j], true);
                const f32x2 b0 = __builtin_amdgcn_cvt_pk_f32_fp8((int)yb[q][j], false), b1 = __builtin_amdgcn_cvt_pk_f32_fp8((int)yb[q][j], true);
                v[j].x = bflo(xr[q][j].x) + (a0.x + b0.x) * 0.0625f; v[j].y = bfhi(xr[q][j].x) + (a0.y + b0.y) * 0.0625f;
                v[j].z = bflo(xr[q][j].y) + (a1.x + b1.x) * 0.0625f; v[j].w = bfhi(xr[q][j].y) + (a1.y + b1.y) * 0.0625f;
                if (fo) ((f32x4*)(fo + m * D))[lane + 64 * j] = v[j] * pscale;
                else { v2u o; o.x = pk2(v[j].x, v[j].y); o.y = pk2(v[j].z, v[j].w); ((v2u*)(xo + m * D))[lane + 64 * j] = o; }
            }
            if (g) { const float inv = row_inv_rms(v); norm_store_row_i8(HN + m * D, SA + m, v, inv, g, lane); }
        }
    }
}

constexpr int AT_K = 0, AT_V = 32768, AT_C = 65536, AT_U = 66560, AT_F = 66624;
constexpr float LOG2E = 1.4426950408889634f;
constexpr float AT_C2 = 0.08838834764831845f * 1.4426950408889634f;
__device__ __forceinline__ unsigned off_b(unsigned row, unsigned ch) { return 256u * row + 16u * (ch ^ (((row & 3u) << 2) | ((row >> 2) & 3u))); }

template <bool FOX, bool O8>
__device__ __forceinline__ void attn_unit(LAS unsigned char* lds, const bf16* Qb, int ldq, const bf16* Kb, int ldk, const bf16* Vb, int ldv, const float* cb, float B2, int qrow0, int nkt,
                                          bf16* Ob, int ldo, const bf16* OGb, int ldog, int tid, int lane, int wave) {
    const int r = lane & 31, h = lane >> 5;
    const int qpos = qrow0 + 32 * wave + r;
    bf16x8 qf[8];
    { const bf16* qp = Qb + (size_t)(32 * wave + r) * ldq + 8 * h;
#pragma unroll
      for (int s = 0; s < 8; ++s) qf[s] = *(const bf16x8*)(qp + 16 * s); }
    f32x16 o[4];
#pragma unroll
    for (int c = 0; c < 4; ++c)
#pragma unroll
        for (int i = 0; i < 16; ++i) o[c][i] = 0.f;
    float m = -1e30f, l = 0.f;
    unsigned goffK[2], goffV[2];
#pragma unroll
    for (int i = 0; i < 2; ++i) { const unsigned row = 4u * (2u * wave + i) + (lane >> 4), ch = (lane & 15) ^ (((row & 3u) << 2) | ((row >> 2) & 3u));
        goffK[i] = (row * (unsigned)ldk + 8u * ch) * 2u; goffV[i] = (row * (unsigned)ldv + 8u * ch) * 2u; }
    float cr = 0.f;
#define AT_DMA(kt, b) do { const char* kb_ = (const char*)(Kb + (size_t)(64 * (kt)) * ldk); const char* vb_ = (const char*)(Vb + (size_t)(64 * (kt)) * ldv); \
        _Pragma("unroll") for (int i = 0; i < 2; ++i) { \
            __builtin_amdgcn_global_load_lds((const unsigned*)(kb_ + goffK[i]), (LAS unsigned*)(lds + AT_K + (b) * 16384 + (2 * wave + i) * 1024), 16, 0, 0); \
            __builtin_amdgcn_global_load_lds((const unsigned*)(vb_ + goffV[i]), (LAS unsigned*)(lds + AT_V + (b) * 16384 + (2 * wave + i) * 1024), 16, 0, 0); } \
        if (FOX && tid < 64) cr = cb[64 * (kt) + tid] * LOG2E; } while (0)
#define AT_CSTORE(b) do { if (FOX && tid < 64) *(LAS float*)(lds + AT_C + (b) * 256 + 4 * tid) = cr; } while (0)
    const int kfirst = FOX ? nkt - 1 : 0, kdir = FOX ? -1 : 1;
    AT_DMA(kfirst, 0); AT_CSTORE(0);
    asm volatile("s_waitcnt vmcnt(0)" ::: "memory");
    __syncthreads();
    unsigned kb0 = 256u * r + 16u * ((unsigned)h ^ (((r & 3u) << 2) | ((r >> 2) & 3u)));
    const unsigned tq = (lane & 15) >> 2, tp = lane & 3, tblk = (lane >> 4) & 1;
    unsigned vb0 = 1024u * h + 256u * tq + 64u * tq + 16u * ((2u * tblk + (tp >> 1)) ^ ((unsigned)h & 3u)) + 8u * (tp & 1);
    unsigned vb1 = 2048u + 1024u * h + 256u * tq + 64u * tq + 16u * ((2u * tblk + (tp >> 1)) ^ ((2u + (unsigned)h) & 3u)) + 8u * (tp & 1);
    const int minq = qrow0 + 32 * wave;
    bool wdone = false;
    volatile LAS unsigned* flags = (volatile LAS unsigned*)(lds + AT_F);
#pragma unroll 1
    for (int it = 0; it < nkt; ++it) {
        asm volatile("" : "+v"(kb0), "+v"(vb0), "+v"(vb1));
        const int kt = kfirst + it * kdir;
        const int b = it & 1;
        if (it + 1 < nkt) AT_DMA(kt + kdir, b ^ 1);
        const bool active = !FOX || (64 * kt <= minq + 31);
        if (FOX && active && !wdone) {
            const float ub = B2 - *(const LAS float*)(lds + AT_C + b * 256 + 63 * 4);
            if (__all(ub - m < -160.f)) wdone = true;
        }
        if (active && !wdone) {
            f32x16 p0, p1;
#pragma unroll
            for (int i = 0; i < 16; ++i) { p0[i] = 0.f; p1[i] = 0.f; }
            const LAS unsigned char* kbuf = lds + AT_K + b * 16384;
#pragma unroll
            for (int s = 0; s < 8; ++s) {
                const bf16x8 a0 = *(const LAS bf16x8*)(kbuf + (kb0 ^ (32u * s))), a1 = *(const LAS bf16x8*)(kbuf + (kb0 ^ (32u * s)) + 8192);
                p0 = __builtin_amdgcn_mfma_f32_32x32x16_bf16(a0, qf[s], p0, 0, 0, 0);
                p1 = __builtin_amdgcn_mfma_f32_32x32x16_bf16(a1, qf[s], p1, 0, 0, 0);
            }
            if (FOX) {
                const LAS float* cbuf = (const LAS float*)(lds + AT_C + b * 256);
#pragma unroll
                for (int g = 0; g < 4; ++g) { const f32x4 c0 = *(const LAS f32x4*)(cbuf + 8 * g + 4 * h), c1 = *(const LAS f32x4*)(cbuf + 32 + 8 * g + 4 * h);
#pragma unroll
                    for (int j = 0; j < 4; ++j) { p0[4 * g + j] = fmaf(p0[4 * g + j], AT_C2, -c0[j]); p1[4 * g + j] = fmaf(p1[4 * g + j], AT_C2, -c1[j]); } }
                if (64 * kt + 63 > minq) {
                    const int dq = qpos - 64 * kt - 4 * h;
#pragma unroll
                    for (int i = 0; i < 16; ++i) { const int ci = (i & 3) + 8 * (i >> 2);
                        if (ci > dq) p0[i] = -__builtin_inff();
                        if (ci + 32 > dq) p1[i] = -__builtin_inff(); }
                }
            } else {
#pragma unroll
                for (int i = 0; i < 16; ++i) { p0[i] *= AT_C2; p1[i] *= AT_C2; }
            }
            float pmax = p0[0];
#pragma unroll
            for (int i = 1; i < 16; ++i) pmax = fmaxf(pmax, p0[i]);
#pragma unroll
            for (int i = 0; i < 16; ++i) pmax = fmaxf(pmax, p1[i]);
            pmax = fmaxf(pmax, __shfl_xor(pmax, 32));
            const float mn = fmaxf(m, pmax), alpha = __builtin_amdgcn_exp2f(m - mn);
            const bool resc = __any(mn > m);
            m = mn;
            float ps = 0.f;
#pragma unroll
            for (int i = 0; i < 16; ++i) { p0[i] = __builtin_amdgcn_exp2f(p0[i] - mn); p1[i] = __builtin_amdgcn_exp2f(p1[i] - mn); ps += p0[i] + p1[i]; }
            ps += __shfl_xor(ps, 32);
            l = l * alpha + ps;
            if (resc) {
#pragma unroll
                for (int c = 0; c < 4; ++c)
#pragma unroll
                    for (int i = 0; i < 16; ++i) o[c][i] *= alpha;
            }
            bf16x8 pf[4];
#pragma unroll
            for (int s = 0; s < 2; ++s) {
                v4u w0, w1;
                w0.x = pk2(p0[8 * s], p0[8 * s + 1]); w0.y = pk2(p0[8 * s + 2], p0[8 * s + 3]); w0.z = pk2(p0[8 * s + 4], p0[8 * s + 5]); w0.w = pk2(p0[8 * s + 6], p0[8 * s + 7]);
                w1.x = pk2(p1[8 * s], p1[8 * s + 1]); w1.y = pk2(p1[8 * s + 2], p1[8 * s + 3]); w1.z = pk2(p1[8 * s + 4], p1[8 * s + 5]); w1.w = pk2(p1[8 * s + 6], p1[8 * s + 7]);
                pf[s] = __builtin_bit_cast(bf16x8, w0); pf[2 + s] = __builtin_bit_cast(bf16x8, w1);
            }
            const LAS unsigned char* vbuf = lds + AT_V + b * 16384;
#pragma unroll
            for (int ks = 0; ks < 4; ++ks)
#pragma unroll
                for (int c = 0; c < 4; ++c) {
                    const s16x4 lo = __builtin_amdgcn_ds_read_tr16_b64_v4i16((LAS s16x4*)(vbuf + ((vb0 ^ (64u * c)) + 4096u * ks)));
                    const s16x4 hi = __builtin_amdgcn_ds_read_tr16_b64_v4i16((LAS s16x4*)(vbuf + ((vb1 ^ (64u * c)) + 4096u * ks)));
                    const bf16x8 vf = __builtin_shufflevector(lo, hi, 0, 1, 2, 3, 4, 5, 6, 7);
                    o[c] = __builtin_amdgcn_mfma_f32_32x32x16_bf16(vf, pf[ks], o[c], 0, 0, 0);
                }
        }
        if (FOX && lane == 0) flags[8 * b + wave] = wdone ? 1u : 0u;
        if (it + 1 < nkt) AT_CSTORE(b ^ 1);
        asm volatile("s_waitcnt vmcnt(0)" ::: "memory");
        __syncthreads();
        if (FOX) { const v4u f0 = *(const LAS v4u*)(lds + AT_F + 32 * b), f1 = *(const LAS v4u*)(lds + AT_F + 32 * b + 16);
            if ((f0.x & f0.y & f0.z & f0.w & f1.x & f1.y & f1.z & f1.w) != 0u) break; }
    }
#undef AT_DMA
#undef AT_CSTORE
    const float il = 1.0f / l;
    bf16* orow = Ob + (size_t)(32 * wave + r) * ldo + 4 * h;
    unsigned char* orow8 = (unsigned char*)Ob + (size_t)(32 * wave + r) * ldo + 4 * h;
    const bf16* grow = FOX ? OGb + (size_t)(32 * wave + r) * ldog + 4 * h : nullptr;
#pragma unroll
    for (int c = 0; c < 4; ++c)
#pragma unroll
        for (int g = 0; g < 4; ++g) {
            float y0 = o[c][4 * g] * il, y1 = o[c][4 * g + 1] * il, y2 = o[c][4 * g + 2] * il, y3 = o[c][4 * g + 3] * il;
            if (FOX) { const v2u gg = *(const v2u*)(grow + 32 * c + 8 * g);
                y0 *= 1.0f / (1.0f + __expf(-bflo(gg.x))); y1 *= 1.0f / (1.0f + __expf(-bfhi(gg.x))); y2 *= 1.0f / (1.0f + __expf(-bflo(gg.y))); y3 *= 1.0f / (1.0f + __expf(-bfhi(gg.y))); }
            if (O8) *(unsigned*)(orow8 + 32 * c + 8 * g) = pk4_fp8(16.0f * y0, 16.0f * y1, 16.0f * y2, 16.0f * y3);
            else { v2u w; w.x = pk2(y0, y1); w.y = pk2(y2, y3);
                *(v2u*)(orow + 32 * c + 8 * g) = w; }
        }
}
template <bool O8>
__device__ __forceinline__ void mem_attn_unit(const Ctx& C, int v, const bf16* P, int ldp, int qcol, int layer) {
    const int qblk = v >> 2, mh = v & 3, b = qblk >> 4;
    attn_unit<false, O8>(C.lds + RING_OFF, P + (size_t)(qblk * 256) * ldp + qcol + mh * HD, ldp,
                     WSP(bf16, WS_MK) + (size_t)layer * 1024 * 512 + (size_t)(b * ML) * 512 + mh * HD, 512, WSP(bf16, WS_MKV) + (size_t)(b * ML) * 1024 + 512 + mh * HD, 1024,
                     nullptr, 0.f, 0, ML / 64, O8 ? (bf16*)(WSP(unsigned char, WS_CAT8) + (size_t)(qblk * 256) * D + FW + mh * HD) : WSP(bf16, WS_CAT) + (size_t)(qblk * 256) * D + FW + mh * HD, D, nullptr, 0, C.tid, C.lane, C.wave);
}
__device__ __forceinline__ void p4_fox_attn(const Ctx& C, int qsel = 0) {
    const bf16* P = WSP(bf16, WS_P);
    unsigned* ctr = (unsigned*)(C.ws + WS_CTL) + CW_Q0 + 128 * qsel;
    volatile LAS unsigned* uw = (volatile LAS unsigned*)(C.lds + RING_OFF + AT_U);
    const float gqm = wave_max(fmaxf(fabsf(C.in[7][2 * C.lane]), fabsf(C.in[7][2 * C.lane + 1]))), gkm = wave_max(fmaxf(fabsf(C.in[8][2 * C.lane]), fabsf(C.in[8][2 * C.lane + 1])));
    const float B2 = 11.313708499f * gqm * gkm * LOG2E * 1.02f + 1.0f;
    const bool cvfirst = ((int)blockIdx.x >> 3) >= (C.G >> 3) - 8;
    unsigned* cvqb = (unsigned*)(C.ws + WS_CTL) + CW_CVQB + 64 * qsel;
    unsigned* qgl = (unsigned*)(C.ws + WS_CTL) + CW_QGL + 64 * qsel;
    if (cvfirst) { qg_late(C, qgl); cv_loop(C, cvqb, CV_MOVED, 0, CV_KEEP); }
    for (;;) {
        __syncthreads();
        if (C.tid == 0) *uw = atomicAdd(ctr, 1u);
        __syncthreads();
        const int u = (int)*uw;
        if (u >= 768 + 256) break;
#if !defined(AT_ONLY_MEM)
        if (u < 768) {
            const int qb = 15 - u / 48, bh = u % 48, b = bh / FH, hh = bh % FH;
            const size_t rb = (size_t)(b * S + 256 * qb);
            attn_unit<true, true>(C.lds + RING_OFF, P + rb * FOX_NP + FP_Q + hh * HD, FOX_NP, P + (size_t)(b * S) * FOX_NP + FP_K + hh * HD, FOX_NP, P + (size_t)(b * S) * FOX_NP + FP_V + hh * HD, FOX_NP,
                           WSP(float, WS_C) + (size_t)bh * S, B2, 256 * qb, 4 * qb + 4, (bf16*)(WSP(unsigned char, WS_CAT8) + rb * D + hh * HD), D, P + rb * FOX_NP + FP_OG + hh * HD, FOX_NP, C.tid, C.lane, C.wave);
        } else
#endif
#if !defined(AT_ONLY_FOX)
        mem_attn_unit<true>(C, u - 768, P, FOX_NP, FP_QM, 0);
#else
        {}
#endif
    }
    if (!cvfirst) { cv_loop(C, cvqb, CV_MOVED, 0, CV_KEEP); qg_late(C, qgl); }
}

__device__ __forceinline__ void p13_mem_attn(const Ctx& C, int qsel = 0) {
    const bf16* P = WSP(bf16, WS_P);
    unsigned* ctr = (unsigned*)(C.ws + WS_CTL) + CW_Q1 + 128 * qsel;
    volatile LAS unsigned* uw = (volatile LAS unsigned*)(C.lds + RING_OFF + AT_U);
    for (;;) {
        __syncthreads();
        if (C.tid == 0) *uw = atomicAdd(ctr, 1u);
        __syncthreads();
        const int u = (int)*uw;
        if (u >= 256) break;
        mem_attn_unit<false>(C, u, P, GLA_NP, GP_QM, 1);
    }
}

constexpr int GT_STRIDE = 400;
constexpr int GT_QE = 0, GT_KE = 25600, GT_V = 51200;
constexpr int GSEG = 8, GCH = 8;
constexpr size_t WS_QE = WS_H, WS_KE = WS_H + 24 * MiB, WS_DL = WS_H + 48 * MiB, WS_DSEG = WS_H + 49 * MiB;
constexpr size_t WS_SLOC = WS_XG + 96 * MiB;

__device__ __forceinline__ float amax_scale_dev(const Ctx& C, int t) { return __builtin_bit_cast(float, ((const unsigned*)(C.ws + WS_CTL) + CW_AMAX)[64 * t]) * (1.0f / 127.0f); }
__device__ __forceinline__ void p12_gla_prep(const Ctx& C) {
    bf16* P = WSP(bf16, WS_P);
    const float* __restrict__ w2 = C.in[10]; const float* __restrict__ ba = C.in[11]; const bf16* __restrict__ Pc = P;
    bf16* __restrict__ QE = WSP(bf16, WS_QE); bf16* __restrict__ KE = WSP(bf16, WS_KE); float* __restrict__ DL = WSP(float, WS_DL);
    const float qsc = 0.07216878364870322f;
    const unsigned char* __restrict__ HN = WSP(unsigned char, WS_HN); const unsigned char* __restrict__ WA = WSP(unsigned char, WS_WGLA) + (size_t)GP_A * D;
    const float* __restrict__ SA = WSP(float, WS_SA); const float* __restrict__ swa = WSP(float, WS_SWC_GLA) + GP_A;
    LAS float* al = (LAS float*)(C.lds + RING_OFF);
    for (int cg = blockIdx.x; cg < T / 64; cg += C.G) {
        __syncthreads();
        if (C.wave < 2) {
            const int r = C.lane & 31, h = C.lane >> 5; const size_t tok = (size_t)cg * 64 + 32 * C.wave + r;
            const unsigned char* ap = WA + (size_t)r * D + 16 * h; const unsigned char* bp = HN + tok * D + 16 * h;
            i32x16 acc;
#pragma unroll
            for (int i = 0; i < 16; ++i) acc[i] = 0;
#pragma unroll 8
            for (int s = 0; s < D / 32; ++s) acc = __builtin_amdgcn_mfma_i32_32x32x32_i8(*(const i32x4*)(ap + 32 * s), *(const i32x4*)(bp + 32 * s), acc, 0, 0, 0);
            const float sc = SA[tok]; const f32x4 c0 = *(const f32x4*)(swa + 4 * h) * sc, c1 = *(const f32x4*)(swa + 8 + 4 * h) * sc;
            LAS float* o = al + (32 * C.wave + r) * 16 + 4 * h;
            *(LAS f32x4*)o = (f32x4){(float)acc[0] * c0.x, (float)acc[1] * c0.y, (float)acc[2] * c0.z, (float)acc[3] * c0.w};
            *(LAS f32x4*)(o + 8) = (f32x4){(float)acc[4] * c1.x, (float)acc[5] * c1.y, (float)acc[6] * c1.z, (float)acc[7] * c1.w};
        }
        __syncthreads();
        for (int c = C.tid; c < GKW; c += 512) {
            float w[16];
#pragma unroll
            for (int r = 0; r < 16; ++r) w[r] = w2[r * GKW + c];
            const float bb = ba[c]; float bc = 0.f;
#pragma unroll 1
            for (int t0 = 0; t0 < 64; t0 += 8) {
                float gl[8], qv[8], kv[8];
#pragma unroll
                for (int u = 0; u < 8; ++u) {
                    const size_t row = (size_t)cg * 64 + t0 + u;
                    const LAS float* fl = al + (t0 + u) * 16;
                    float s = bb;
#pragma unroll
                    for (int r = 0; r < 16; ++r) s += fl[r] * w[r];
                    gl[u] = log_sigmoid_fast(s) * (1.0f / 16.0f);
                    qv[u] = bf2f(Pc[row * GLA_NP + GP_Q + c]); kv[u] = bf2f(Pc[row * GLA_NP + GP_K + c]);
                }
#pragma unroll
                for (int u = 0; u < 8; ++u) {
                    const size_t row = (size_t)cg * 64 + t0 + u;
                    bc += gl[u];
                    QE[row * GKW + c] = (bf16)(pk2(qv[u] * __expf(bc) * qsc, 0.f) & 0xffffu);
                    KE[row * GKW + c] = (bf16)(pk2(kv[u] * __expf(-bc), 0.f) & 0xffffu);
                }
            }
            DL[(size_t)cg * GKW + c] = __expf(bc);
        }
    }
}

__device__ __forceinline__ bf16x8 pack8(const f32x16& x, int s) {
    v4u w; w.x = pk2(x[8 * s], x[8 * s + 1]); w.y = pk2(x[8 * s + 2], x[8 * s + 3]); w.z = pk2(x[8 * s + 4], x[8 * s + 5]); w.w = pk2(x[8 * s + 6], x[8 * s + 7]);
    return __builtin_bit_cast(bf16x8, w);
}
__device__ __forceinline__ s16x4 tr4(const LAS unsigned char* tile, int r0, int c0, int lane) {
    const int q = (lane & 15) >> 2, p = lane & 3, blk = (lane >> 4) & 1;
    return __builtin_amdgcn_ds_read_tr16_b64_v4i16((LAS s16x4*)(tile + (r0 + q) * GT_STRIDE + 2 * (c0 + 16 * blk + 4 * p)));
}
template <bool OUT>
__device__ __forceinline__ void gla_unit(const Ctx& C, int u) {
    const int seg = u & 7, eh = (u >> 3) & 1, bh = u >> 4, b = bh >> 2, hd = bh & 3;
    const int tid = C.tid, lane = C.lane, w = C.wave, r = lane & 31, h = lane >> 5;
    LAS unsigned char* lds = C.lds + RING_OFF;
    const bf16* QE = WSP(bf16, WS_QE); const bf16* KE = WSP(bf16, WS_KE); const bf16* P = WSP(bf16, WS_P);
    const float* DL = WSP(float, WS_DL); float* DSEG = WSP(float, WS_DSEG); float* SLOC = WSP(float, WS_SLOC); float* GO = WSP(float, WS_GO);
    f32x16 Sx[6];
#pragma unroll
    for (int dt = 0; dt < 6; ++dt)
#pragma unroll
        for (int i = 0; i < 16; ++i) Sx[dt][i] = 0.f;
    if (OUT && w < 6) {
        for (int sp = 0; sp < seg; ++sp) {
            const float* sl = SLOC + ((((size_t)(bh * GSEG + sp) * 2 + eh) * 6 + w) * 6) * 1024;
            const float* dsg = DSEG + (size_t)(bh * GSEG + sp) * GDK;
#pragma unroll
            for (int dt = 0; dt < 6; ++dt)
#pragma unroll
                for (int g = 0; g < 4; ++g) { const f32x4 dv = *(const f32x4*)(dsg + 32 * dt + 8 * g + 4 * h);
#pragma unroll
                    for (int j = 0; j < 4; ++j) Sx[dt][4 * g + j] = dv[j] * Sx[dt][4 * g + j] + sl[(dt * 16 + 4 * g + j) * 64 + lane]; }
        }
    }
    float dacc[3] = {1.f, 1.f, 1.f};
#pragma unroll 1
    for (int cc = 0; cc < GCH; ++cc) {
        const int cs = seg * GCH + cc; const size_t row0 = (size_t)b * S + (size_t)cs * 64; const int cg = b * 64 + cs;
        __syncthreads();
#pragma unroll
        for (int i = 0; i < 3; ++i) { const int n = tid + 512 * i, row = n / 24, ch = n % 24;
            if (OUT) *(LAS v4u*)(lds + GT_QE + row * GT_STRIDE + 16 * ch) = *(const v4u*)(QE + (row0 + row) * GKW + hd * GDK + 8 * ch);
            *(LAS v4u*)(lds + GT_KE + row * GT_STRIDE + 16 * ch) = *(const v4u*)(KE + (row0 + row) * GKW + hd * GDK + 8 * ch);
            *(LAS v4u*)(lds + GT_V + row * GT_STRIDE + 16 * ch) = *(const v4u*)(P + (row0 + row) * GLA_NP + GP_V + hd * GDV + eh * 192 + 8 * ch); }
        __syncthreads();
        if (w < 6) {
            int lane = C.lane; asm volatile("" : "+v"(lane));
            const int r = lane & 31, h = lane >> 5;
            const LAS unsigned char* tq = lds + GT_QE; const LAS unsigned char* tk = lds + GT_KE; const LAS unsigned char* tv = lds + GT_V;
            if (OUT) {
#pragma unroll
                for (int it = 0; it < 2; ++it) {
                    f32x16 ao;
#pragma unroll
                    for (int i = 0; i < 16; ++i) ao[i] = 0.f;
#pragma unroll
                    for (int dt = 0; dt < 6; ++dt)
#pragma unroll
                        for (int s = 0; s < 2; ++s) {
                            const bf16x8 a = pack8(Sx[dt], s);
                            const LAS unsigned char* qp = tq + (32 * it + r) * GT_STRIDE + 2 * (32 * dt + 16 * s + 4 * h);
                            const s16x4 lo = *(const LAS s16x4*)qp, hi = *(const LAS s16x4*)(qp + 16);
                            const bf16x8 bq = __builtin_shufflevector(lo, hi, 0, 1, 2, 3, 4, 5, 6, 7);
                            ao = __builtin_amdgcn_mfma_f32_32x32x16_bf16(a, bq, ao, 0, 0, 0);
                        }
                    __builtin_amdgcn_sched_barrier(0);
#pragma unroll
                    for (int jt = 0; jt <= it; ++jt) {
                        f32x16 at;
#pragma unroll
                        for (int i = 0; i < 16; ++i) at[i] = 0.f;
#pragma unroll
                        for (int s = 0; s < 12; ++s) {
                            const bf16x8 a = *(const LAS bf16x8*)(tk + (32 * jt + r) * GT_STRIDE + 16 * (2 * s + h));
                            const bf16x8 bq = *(const LAS bf16x8*)(tq + (32 * it + r) * GT_STRIDE + 16 * (2 * s + h));
                            at = __builtin_amdgcn_mfma_f32_32x32x16_bf16(a, bq, at, 0, 0, 0);
                        }
                        if (jt == it) {
#pragma unroll
                            for (int i = 0; i < 16; ++i) if (((i & 3) + 8 * (i >> 2) + 4 * h) > r) at[i] = 0.f;
                        }
#pragma unroll
                        for (int s = 0; s < 2; ++s) {
                            const bf16x8 bp = pack8(at, s);
                            const s16x4 lo = tr4(tv, 32 * jt + 16 * s + 4 * h, 32 * w, lane), hi = tr4(tv, 32 * jt + 16 * s + 8 + 4 * h, 32 * w, lane);
                            const bf16x8 av = __builtin_shufflevector(lo, hi, 0, 1, 2, 3, 4, 5, 6, 7);
                            ao = __builtin_amdgcn_mfma_f32_32x32x16_bf16(av, bp, ao, 0, 0, 0);
                        }
                    }
                    __builtin_amdgcn_sched_barrier(0);
                    bf16* op = (bf16*)GO + (row0 + 32 * it + r) * GVW + hd * GDV + eh * 192 + 32 * w + 4 * h;
#pragma unroll
                    for (int g = 0; g < 4; ++g) { v2u o2; o2.x = pk2(ao[4 * g], ao[4 * g + 1]); o2.y = pk2(ao[4 * g + 2], ao[4 * g + 3]); *(v2u*)(op + 8 * g) = o2; }
                }
            }
            __builtin_amdgcn_sched_barrier(0);
            bf16x8 bv[4];
#pragma unroll
            for (int ks = 0; ks < 4; ++ks) { const s16x4 lo = tr4(tv, 16 * ks + 8 * h, 32 * w, lane), hi = tr4(tv, 16 * ks + 8 * h + 4, 32 * w, lane);
                bv[ks] = __builtin_shufflevector(lo, hi, 0, 1, 2, 3, 4, 5, 6, 7); }
            const float* dlp = DL + (size_t)cg * GKW + hd * GDK;
#pragma unroll
            for (int dt = 0; dt < 6; ++dt) {
#pragma unroll
                for (int ks = 0; ks < 4; ++ks) { const s16x4 lo = tr4(tk, 16 * ks + 8 * h, 32 * dt, lane), hi = tr4(tk, 16 * ks + 8 * h + 4, 32 * dt, lane);
                    const bf16x8 ak = __builtin_shufflevector(lo, hi, 0, 1, 2, 3, 4, 5, 6, 7);
                    Sx[dt] = __builtin_amdgcn_mfma_f32_32x32x16_bf16(ak, bv[ks], Sx[dt], 0, 0, 0); }
#pragma unroll
                for (int g = 0; g < 4; ++g) { const f32x4 dv = *(const f32x4*)(dlp + 32 * dt + 8 * g + 4 * h);
#pragma unroll
                    for (int j = 0; j < 4; ++j) Sx[dt][4 * g + j] *= dv[j]; }
            }
        } else if (!OUT && w == 6) {
            const float* dlp = DL + (size_t)cg * GKW + hd * GDK;
#pragma unroll
            for (int i = 0; i < 3; ++i) dacc[i] *= dlp[lane + 64 * i];
        }
    }
    if (!OUT) {
        if (w < 6) { float* sl = SLOC + ((((size_t)(bh * GSEG + seg) * 2 + eh) * 6 + w) * 6) * 1024;
#pragma unroll
            for (int dt = 0; dt < 6; ++dt)
#pragma unroll
                for (int i = 0; i < 16; ++i) sl[(dt * 16 + i) * 64 + lane] = Sx[dt][i]; }
        else if (w == 6 && eh == 0) {
#pragma unroll
            for (int i = 0; i < 3; ++i) DSEG[(size_t)(bh * GSEG + seg) * GDK + lane + 64 * i] = dacc[i]; }
    }
}
__device__ __forceinline__ void p13a_gla_local(const Ctx& C) { for (int u = blockIdx.x; u < 256; u += C.G) if ((u & 7) != 7) gla_unit<false>(C, u); }
__device__ __forceinline__ void p13b_gla_out(const Ctx& C) { for (int u = blockIdx.x; u < 256; u += C.G) gla_unit<true>(C, u); }

constexpr int NPHASE = 24;
#ifndef PROBE_PHASE
#define PROBE_PHASE (-1)
#endif

struct Args { const float* in[24]; float* out; unsigned char* ws; int ph_lo, ph_hi; };
#define PG8_ALIGN true
#define PG8_SP2 true
#ifndef PG8_ALIGN_F8
#define PG8_ALIGN_F8 true
#endif
#ifndef PG8_SP2_F8
#define PG8_SP2_F8 true
#endif

template <class Epi, class Sched, bool F8 = false, bool I8 = false, bool GATHER = false>
__device__ __forceinline__ void run_gemm(const Ctx& C, const bf16* A, const bf16* Bt, int K, const Sched& Sd, const Epi& E, int sx = pg8::F8_SCALE_X) {
    pg8::Gemm g{A, Bt, pg8::F8_SCALE_W, sx, K};
    pg8::gemm_phase<Epi, Sched, F8 ? PG8_ALIGN_F8 : PG8_ALIGN, F8 ? PG8_SP2_F8 : PG8_SP2, F8, I8, GATHER>(C.lds + RING_OFF, g, Sd, E, C.lds + GOFF_OFF);
}
__device__ __forceinline__ pg8::MoeOrder moe_order(const Ctx& C, int layer) {
    const unsigned* cnt = (const unsigned*)(C.ws + WS_CTL) + CW_CNT + layer * 32;
    const int lane = C.lane;
    const int c = lane < NE ? (int)__hip_atomic_load(cnt + lane, __ATOMIC_RELAXED, __HIP_MEMORY_SCOPE_AGENT) : 0;
    const int tl = (c + 255) >> 8;
    int inc = tl;
#pragma unroll
    for (int o = 1; o < 64; o <<= 1) { const int t = __shfl_up(inc, o); if (lane >= o) inc += t; }
    const int pk = lane < NE ? (c | ((inc - tl) << 16) | (inc << 24)) : 0;
    return pg8::MoeOrder{pk, C.G, (int)blockIdx.x, WSP(int, WS_LSTA)};
}
__device__ __forceinline__ float amax_scale(const Ctx& C, int t) { return __builtin_bit_cast(float, ((const unsigned*)(C.ws + WS_CTL) + CW_AMAX)[64 * t]) * (1.0f / 127.0f); }
__device__ __forceinline__ void ph_proj1(const Ctx& C) {
    pg8::StaticOrder Sd; Sd.init(T, GP_A, C.G, (int)blockIdx.x);
    pg8::EpiPT<true> E{WSP(bf16, WS_P), GLA_NP, nullptr, -1, nullptr, 0, 1 << 30, 0, WSP(float, WS_SA), WSP(float, WS_SWC_GLA), nullptr, nullptr,
                        0, 0, 0, 0, GP_QM / 256, GP_QM / 256 + 2, nullptr, nullptr, C.in[13] + HD, (LAS float*)(C.lds + GOFF_OFF)};
    run_gemm<pg8::EpiPT<true>, pg8::StaticOrder, false, true>(C, WSP(bf16, WS_HN), WSP(bf16, WS_WGLA), D / 2, Sd, E);
}
__device__ __forceinline__ void ph_proj0(const Ctx& C) {
    constexpr size_t TILEB = (size_t)256 * D;
    static_assert((WS_MEMN - WS_HN) % TILEB == 0 && (WS_WMKV - WS_WFOX) % TILEB == 0 && WS_MEMN > WS_HN && WS_WMKV > WS_WFOX, "tile-offset addressing of the second GEMM");
    constexpr int PM2 = (int)((WS_MEMN - WS_HN) / TILEB), PN2 = (int)((WS_WMKV - WS_WFOX) / TILEB);
    pg8::TwoGemmOrder Sd; Sd.S.init(T, FOX_NP, C.G, (int)blockIdx.x); Sd.nx2 = 4; Sd.n2 = 16; Sd.pm2 = PM2; Sd.pn2 = PN2;
    pg8::EpiPT<true> E{WSP(bf16, WS_P), FOX_NP, WSP(float, WS_FL), FP_F / 256, WSP(bf16, WS_MKV), 1024, PM2, PN2, WSP(float, WS_SA), WSP(float, WS_SWC_FOX), WSP(float, WS_SAM), WSP(float, WS_SWC_MKV),
                        FP_Q / 256, FP_Q / 256 + 6, FP_K / 256, FP_K / 256 + 6, FP_QM / 256, FP_QM / 256 + 2, C.in[7], C.in[8], C.in[13], (LAS float*)(C.lds + GOFF_OFF)};
    run_gemm<pg8::EpiPT<true>, pg8::TwoGemmOrder, false, true>(C, WSP(bf16, WS_HN), WSP(bf16, WS_WFOX), D / 2, Sd, E);
}
__device__ __forceinline__ void ph_wout(const Ctx& C, int layer) {
    pg8::StaticOrder Sd; Sd.init(T, D, C.G, (int)blockIdx.x);
    const bf16* A8 = (const bf16*)WSP(unsigned char, WS_CAT8); const bf16* B8 = (const bf16*)(WSP(unsigned char, WS_WOUT) + (size_t)layer * D * D);
    if (layer == 0) { pg8::EpiResF<true> E{C.in[0], WSP(bf16, WS_XB), D}; run_gemm<pg8::EpiResF<true>, pg8::StaticOrder, true>(C, A8, B8, D / 2, Sd, E, 123); }
    else { pg8::EpiRes<false> E{WSP(bf16, WS_XA), WSP(bf16, WS_XB), D, WSP(float, WS_SC), WSP(float, WS_SWC_WO1)}; run_gemm<pg8::EpiRes<false>, pg8::StaticOrder, false, true>(C, A8, B8, D / 2, Sd, E); }
}
__device__ __forceinline__ void ph_gu(const Ctx& C, int layer, int wl = -1) {
    const pg8::MoeOrder Sd = moe_order(C, layer); pg8::EpiGU E{WSP(unsigned char, WS_H)};
    run_gemm<pg8::EpiGU, pg8::MoeOrder, true, false, true>(C, WSP(bf16, WS_XN8), (const bf16*)(WSP(unsigned char, WS_WGU) + (size_t)(wl < 0 ? layer : wl) * NE * 2048 * 2048), D / 2, Sd, E);
}
__device__ __forceinline__ void ph_down(const Ctx& C, int layer, int wl = -1) {
    const pg8::MoeOrder Sd = moe_order(C, layer);
    pg8::EpiDown E{WSP(int, WS_LSTA), WSP(float, WS_LSTW), WSP(bf16, WS_YB)};
    run_gemm<pg8::EpiDown, pg8::MoeOrder, true>(C, WSP(bf16, WS_H), (const bf16*)(WSP(unsigned char, WS_WD) + (size_t)(wl < 0 ? layer : wl) * NE * 2048 * 1024), DE / 2, Sd, E);
}

__global__ void __launch_bounds__(NWAVES * 64, 2) fwd_kernel(Args args) {
    extern __shared__ __attribute__((aligned(16))) unsigned char lds[];
    Ctx C;
    C.lds = (LAS unsigned char*)lds;
    C.tid = threadIdx.x; C.lane = C.tid & 63; C.wave = __builtin_amdgcn_readfirstlane(C.tid >> 6);
    C.G = gridDim.x; C.gw = blockIdx.x * NWAVES + C.wave; C.NGW = C.G * NWAVES;
#pragma unroll
    for (int i = 0; i < 24; ++i) C.in[i] = args.in[i];
    C.out = args.out; C.ws = args.ws;
    volatile LAS unsigned* MISC = (volatile LAS unsigned*)(C.lds + MISC_OFF);
    for (int u = C.tid; u < (LDS_BYTES - LDSCTL_OFF) / 4; u += NWAVES * 64) ((LAS unsigned*)(C.lds + LDSCTL_OFF))[u] = 0u;
    __syncthreads();
    const int lo = args.ph_lo, hi = args.ph_hi;
    if (PROBE_PHASE >= 0 && blockIdx.x == 0 && C.tid == 0) ((unsigned long long*)(C.ws + WS_CTL) + (CW_PROBE / 2))[0] = __builtin_amdgcn_s_memrealtime();
    XcdBarrier bar; bar.bar = (unsigned*)(C.ws + WS_CTL) + CW_BAR; bar.x = 0; bar.st = nullptr;
    if (hi - lo > 1) bar = xcd_barrier_post((unsigned*)(C.ws + WS_CTL) + CW_BAR, MISC + 8);
#ifndef PHSEL
#define PHSEL 0xFFFFFFFFu
#endif
#define SITE(s) ((PHSEL >> (s)) & 1u)
#ifndef DUPMASK
#define DUPMASK 0u
#endif
#define DUP(s) ((DUPMASK >> (s)) & 1u)
#define IN(k) (lo <= (k) && (k) < hi)
#define PROBE_STAMP(k) do { if (PROBE_PHASE == (k) && blockIdx.x == 0 && C.tid == 0) { unsigned long long* pw = (unsigned long long*)(C.ws + WS_CTL) + (CW_PROBE / 2); \
        const unsigned long long t1 = __builtin_amdgcn_s_memrealtime(); ((float*)(pw + 1))[0] = (float)(t1 - pw[0]) * 0.01f; } } while (0)
#define SEAM(k) do { if (IN(k) && IN((k) + 1)) xcd_barrier(bar); PROBE_STAMP(k); } while (0)

    if (SITE(0) && IN(0)) p0_prologue(C);
    if (DUP(0) && IN(0)) { __syncthreads(); p0_prologue(C); }
#ifdef SEQ_PROBE
    if (IN(0)) { __syncthreads(); seq_probe(C); }
#endif
    do { if (IN(0) && IN(2)) xcd_barrier(bar); PROBE_STAMP(1); } while (0);
#ifdef XTRA_BARRIERS
    if (hi - lo > 1) { for (int xb = 0; xb < XTRA_BARRIERS; ++xb) xcd_barrier(bar); }
#endif
    if (SITE(2) && IN(2)) ph_proj0(C);
    if (DUP(2) && IN(2)) { __syncthreads(); ph_proj0(C); }
#ifdef L2_PROBE
    if (IN(2)) { __syncthreads(); ph_l2probe(C); }
#endif
    if (CV_STEAL && SITE(2) && IN(2) && IN(2 + 1)) cv_steal_tail(C, 0);
    SEAM(2);
    if (SITE(3) && IN(3)) p3_fox_thin(C);
    if (DUP(3) && IN(3)) { __syncthreads(); p3_fox_thin(C); }
    SEAM(3);
    if (SITE(4) && IN(4)) p4_fox_attn(C);
    if (DUP(4) && IN(4)) { __syncthreads(); p4_fox_attn(C, 1); }
    if (CV_STEAL && SITE(4) && IN(4) && IN(4 + 1)) cv_steal_tail(C, 1);
    SEAM(4);
    if (SITE(5) && IN(5)) ph_wout(C, 0);
    if (DUP(5) && IN(5)) { __syncthreads(); ph_wout(C, 0); }
    SEAM(5);
    if (SITE(6) && IN(6)) p6_router_mfma(C, 0);
    if (DUP(6) && IN(6)) { __syncthreads(); p6_router_mfma(C, 0, false); }
    do { if (IN(6) && IN(8)) xcd_barrier(bar); PROBE_STAMP(6); } while (0);
#ifdef DUP_COLD
    if (IN(8)) { ph_gu(C, 0, 1); __syncthreads(); }
#endif
    if (SITE(8) && IN(8)) ph_gu(C, 0);
    if (DUP(8) && IN(8)) { __syncthreads(); ph_gu(C, 0); }
    if (CV_STEAL && SITE(8) && IN(8) && IN(8 + 1)) cv_steal_tail(C, 2);
    SEAM(8);
#ifdef DUP_COLD
    if (IN(9)) { ph_down(C, 0, 1); __syncthreads(); }
#endif
    if (SITE(9) && IN(9)) ph_down(C, 0);
    if (DUP(9) && IN(9)) { __syncthreads(); ph_down(C, 0); }
    if (CV_STEAL && SITE(9) && IN(9) && IN(9 + 1)) cv_steal_tail(C, 3);
    SEAM(9);
    if (SITE(10) && IN(10)) p_combine(C, WSP(bf16, WS_XA), nullptr, C.in[4] + D);
    if (DUP(10) && IN(10)) { __syncthreads(); p_combine(C, WSP(bf16, WS_XA), nullptr, C.in[4] + D); }
    SEAM(10);
    if (SITE(11) && IN(11)) ph_proj1(C);
    if (DUP(11) && IN(11)) { __syncthreads(); ph_proj1(C); }
    if (CV_STEAL && SITE(11) && IN(11) && IN(11 + 1)) cv_steal_tail(C, 4);
    SEAM(11);
    if (SITE(12) && IN(12)) p12_gla_prep(C);
    if (DUP(12) && IN(12)) { __syncthreads(); p12_gla_prep(C); }
    SEAM(12);
    if (SITE(13) && IN(13)) p13a_gla_local(C);
    if (DUP(13) && IN(13)) { __syncthreads(); p13a_gla_local(C); }
    SEAM(13);
#if defined(NO_MEM14)
    if (SITE(14) && IN(14)) { p13b_gla_out(C); }
#elif defined(NO_GLA14)
    if (SITE(14) && IN(14)) { p13_mem_attn(C); }
#else
    if (SITE(14) && IN(14)) { p13b_gla_out(C); p13_mem_attn(C); }
#endif
    if (DUP(14) && IN(14)) { __syncthreads(); p13b_gla_out(C); p13_mem_attn(C, 1); }
    SEAM(14);
    if (SITE(15) && IN(15)) p14_gla_onorm(C);
    if (DUP(15) && IN(15)) { __syncthreads(); p14_gla_onorm(C); }
    SEAM(15);
    if (SITE(16) && IN(16)) ph_wout(C, 1);
    if (DUP(16) && IN(16)) { __syncthreads(); ph_wout(C, 1); }
    SEAM(16);
    if (SITE(17) && IN(17)) p6_router_mfma(C, 1);
    if (DUP(17) && IN(17)) { __syncthreads(); p6_router_mfma(C, 1, false); }
    do { if (IN(17) && IN(19)) xcd_barrier(bar); PROBE_STAMP(17); } while (0);
    if (SITE(19) && IN(19)) ph_gu(C, 1);
    if (DUP(19) && IN(19)) { __syncthreads(); ph_gu(C, 1); }
    SEAM(19);
    if (SITE(20) && IN(20)) ph_down(C, 1);
    if (DUP(20) && IN(20)) { __syncthreads(); ph_down(C, 1); }
    SEAM(20);
    if (SITE(21) && IN(21)) p_combine(C, nullptr, C.out, nullptr, PROBE_PHASE >= 0 ? 1.0f + sqrtf(((const float*)((const unsigned long long*)(C.ws + WS_CTL) + (CW_PROBE / 2) + 1))[0] * 1e-4f) : 1.0f);
    if (DUP(21) && IN(21)) { __syncthreads(); p_combine(C, nullptr, C.out, nullptr); }
#undef IN
#undef SEAM
}

extern "C" void kernel_launch(void* const* d_in, const int* in_sizes, int n_in, void* d_out, int out_size, void* d_ws, size_t ws_size, hipStream_t stream) {
    static int grid = 0;
    if (grid == 0) {
        if (n_in != 24 || out_size != T * D || ws_size < WS_END) { fprintf(stderr, "kernel_launch: unexpected problem (n_in %d, out %d, ws %zu < %zu)\n", n_in, out_size, ws_size, (size_t)WS_END); grid = -1; return; }
        int dev = 0, cus = 0, per_cu = 0;
        if (hipGetDevice(&dev) != hipSuccess || hipDeviceGetAttribute(&cus, hipDeviceAttributeMultiprocessorCount, dev) != hipSuccess) { grid = -1; return; }
        if (hipFuncSetAttribute((const void*)fwd_kernel, hipFuncAttributeMaxDynamicSharedMemorySize, LDS_BYTES) != hipSuccess) { fprintf(stderr, "kernel_launch: hipFuncSetAttribute failed\n"); grid = -1; return; }
        if (hipOccupancyMaxActiveBlocksPerMultiprocessor(&per_cu, (const void*)fwd_kernel, NWAVES * 64, LDS_BYTES) != hipSuccess || per_cu < 1)
            fprintf(stderr, "kernel_launch: occupancy query reports %d workgroups per CU\n", per_cu);
        (void)hipGetLastError();
        grid = cus;
    }
    if (grid < 0) return;
    if (hipMemsetAsync((char*)d_ws + WS_CTL, 0, CTL_ZERO_BYTES, stream) != hipSuccess) return;
    Args a{};
    for (int i = 0; i < 24; ++i) a.in[i] = (const float*)d_in[i];
    a.out = (float*)d_out; a.ws = (unsigned char*)d_ws;
#if MK_N_LAUNCHES == 1
    a.ph_lo = 0; a.ph_hi = NPHASE;
    hipLaunchKernelGGL(fwd_kernel, dim3(grid), dim3(NWAVES * 64), LDS_BYTES, stream, a);
#else
    for (int p = 0; p < NPHASE; ++p) { a.ph_lo = p; a.ph_hi = p + 1; hipLaunchKernelGGL(fwd_kernel, dim3(grid), dim3(NWAVES * 64), LDS_BYTES, stream, a); }
#endif
}
```
